# Optimizing an MI355X kernel written in HIP

```python
import math
import jax
import jax.numpy as jnp
from jax import lax
import numpy as np

D_MODEL = 2048
BATCH = 16
SEQ = 256
DEPTH = 4
DEC_BATCH = 4
DEC_SEQ = 4096
PAST_LEN = 256

GRID_W = 64
H_A = 4
DA_QK = 64
DA_V = 128
H_B = 6
DB_K = 64
DB_V = 128
GATE_RANK = 16
GATE_TAU = 16.0
GLA_CHUNK = 64
H_C = 6
Q_RANK = 384
KV_RANK = 256
DC_NOPE = 64
DC_ROPE = 32
DC_V = 128
MIX_A = H_A * DA_V
MIX_B = H_B * DB_V
MIX_C = H_C * DC_V
MIX_WIDTH = MIX_A + MIX_B + MIX_C
IN_SIZES = (2 * H_A * DA_QK, 2 * H_A * DA_QK, H_A * DA_V, H_B * DB_K, H_B * DB_K, H_B * DB_V, H_B * DB_V, 2 * GATE_RANK, Q_RANK, KV_RANK, DC_ROPE)
IN_COLS = sum(IN_SIZES)
D_FF = 5632
ROPE_BASE = 10000.0
Q_BLOCK = 128
EPS = 1e-6

kernel_name = 'hybrid_diffusion_prefix_trunk_step'


def _rmsnorm(x, g):
    xf = x.astype(jnp.float32)
    y = xf * lax.rsqrt(jnp.mean(xf * xf, axis=-1, keepdims=True) + EPS)
    return (y * g.astype(jnp.float32)).astype(x.dtype)


def _split_cols(p):
    out = []
    start = 0
    for size in IN_SIZES:
        out.append(p[..., start:start + size])
        start += size
    return out


def _rope_tables(n_rows, rot_dim):
    pos_r = jnp.repeat(jnp.arange(n_rows, dtype=jnp.float32), GRID_W)
    pos_c = jnp.tile(jnp.arange(GRID_W, dtype=jnp.float32), n_rows)
    n_freq = rot_dim // 4
    inv = ROPE_BASE ** (-jnp.arange(n_freq, dtype=jnp.float32) / n_freq)
    a_r = pos_r[:, None] * inv[None]
    a_c = pos_c[:, None] * inv[None]
    ang = jnp.concatenate([a_r, a_r, a_c, a_c], axis=-1)
    return jnp.cos(ang), jnp.sin(ang)


def _apply_rope(x, cos, sin):
    shp = (1, cos.shape[0]) + (1,) * (x.ndim - 3) + (cos.shape[1],)
    c = cos.reshape(shp).astype(x.dtype)
    s = sin.reshape(shp).astype(x.dtype)
    x0, x1, x2, x3 = jnp.split(x, 4, axis=-1)
    rot = jnp.concatenate([-x1, x0, -x3, x2], axis=-1)
    return x * c + rot * s


def _block_attend(q_c, k_c, v, scale, q_l=None, k_l=None):
    bsz, n, heads, _ = q_c.shape
    nb = n // Q_BLOCK

    def to_blocks(t):
        return jnp.moveaxis(t.reshape(bsz, nb, Q_BLOCK, heads, t.shape[-1]), 1, 0)

    qs = (to_blocks(q_c),) if q_l is None else (to_blocks(q_c), to_blocks(q_l))

    def one_block(qb):
        logits = jnp.einsum('bqhd,bkhd->bhqk', qb[0], k_c).astype(jnp.float32)
        if q_l is not None:
            logits_l = jnp.einsum('bqhd,bkhd->bhqk', qb[1], k_l).astype(jnp.float32)
            logits = jnp.concatenate([logits, logits_l], axis=-1)
        p = jax.nn.softmax(logits * scale, axis=-1).astype(v.dtype)
        return jnp.einsum('bhqk,bkhe->bqhe', p, v)

    out = lax.map(one_block, qs)
    return jnp.moveaxis(out, 0, 1).reshape(bsz, n, heads, v.shape[-1])


def _diff_attn(p_q, p_k, p_v, lw, layer, rope, ctx):
    bsz, n, _ = p_q.shape
    q = p_q.reshape(bsz, n, H_A, 2, DA_QK)
    k = p_k.reshape(bsz, n, H_A, 2, DA_QK)
    v = p_v.reshape(bsz, n, H_A, DA_V)
    scale = DA_QK ** -0.5
    if ctx is None:
        o1 = _block_attend(q[..., 0, :], k[..., 0, :], v, scale)
        o2 = _block_attend(q[..., 1, :], k[..., 1, :], v, scale)
        new = (k, v)
    else:
        k_c, v_c = ctx
        cos, sin = rope
        q_r = _apply_rope(q, cos, sin)
        k_r = _apply_rope(k, cos, sin)
        v_all = jnp.concatenate([v_c, v], axis=1)
        o1 = _block_attend(q[..., 0, :], k_c[..., 0, :], v_all, scale, q_r[..., 0, :], k_r[..., 0, :])
        o2 = _block_attend(q[..., 1, :], k_c[..., 1, :], v_all, scale, q_r[..., 1, :], k_r[..., 1, :])
        new = None
    lam_init = 0.8 - 0.6 * math.exp(-0.3 * layer)
    lam = (jnp.exp(jnp.sum(lw['lam_q1'].astype(jnp.float32) * lw['lam_k1'].astype(jnp.float32)))
           - jnp.exp(jnp.sum(lw['lam_q2'].astype(jnp.float32) * lw['lam_k2'].astype(jnp.float32))) + lam_init)
    o = o1 - lam.astype(o1.dtype) * o2
    o = _rmsnorm(o, lw['a_norm_g']) * (1.0 - lam_init)
    return o.reshape(bsz, n, MIX_A), new


def _gla_chunk_scan(q, k, v, logg, s0):
    bsz, n, heads, _ = q.shape
    nc = n // GLA_CHUNK

    def chunks(t):
        return jnp.moveaxis(t.astype(jnp.float32).reshape(bsz, nc, GLA_CHUNK, heads, t.shape[-1]), 1, 0)

    causal = jnp.tril(jnp.ones((GLA_CHUNK, GLA_CHUNK), dtype=bool))[None, :, :, None, None]

    def step(s, inp):
        qc, kc, vc, gc = inp
        b = jnp.cumsum(gc, axis=1)
        o_inter = jnp.einsum('bthk,bhkv->bthv', qc * jnp.exp(b), s)
        dec = jnp.exp(jnp.where(causal, b[:, :, None] - b[:, None, :], -jnp.inf))
        att = jnp.einsum('bthk,bshk,btshk->bths', qc, kc, dec)
        o_intra = jnp.einsum('bths,bshv->bthv', att, vc)
        b_last = b[:, -1]
        s_new = jnp.exp(b_last)[..., None] * s + jnp.einsum('bshk,bshv->bhkv', kc * jnp.exp(b_last[:, None] - b), vc)
        return s_new, o_inter + o_intra

    s_end, o = lax.scan(step, s0, (chunks(q), chunks(k), chunks(v), chunks(logg)))
    return jnp.moveaxis(o, 0, 1).reshape(bsz, n, heads, v.shape[-1]).astype(v.dtype), s_end


def _gla(p_q, p_k, p_v, p_r, p_g, lw, ctx):
    bsz, n, _ = p_q.shape
    q = p_q.reshape(bsz, n, H_B, DB_K) * (DB_K ** -0.5)
    k = p_k.reshape(bsz, n, H_B, DB_K)
    v = p_v.reshape(bsz, n, H_B, DB_V)
    g_lr = p_g.reshape(bsz, n, 2, GATE_RANK)
    pre = jnp.einsum('bsdr,drk->bsdk', g_lr, lw['b_gate_w']) + lw['b_gate_b']
    logg = (jax.nn.log_sigmoid(pre.astype(jnp.float32)) / GATE_TAU).reshape(bsz, n, 2, H_B, DB_K)
    if ctx is None:
        s_f = jnp.zeros((bsz, H_B, DB_K, DB_V), jnp.float32)
        s_b = jnp.zeros((bsz, H_B, DB_K, DB_V), jnp.float32)
    else:
        s_f = ctx[:, 0].astype(jnp.float32)
        s_b = ctx[:, 1].astype(jnp.float32)
    o_f, s_f_end = _gla_chunk_scan(q, k, v, logg[:, :, 0], s_f)
    o_b, s_b_end = _gla_chunk_scan(jnp.flip(q, 1), jnp.flip(k, 1), jnp.flip(v, 1), jnp.flip(logg[:, :, 1], 1), s_b)
    o = _rmsnorm(o_f + jnp.flip(o_b, 1), lw['b_norm_g']) * jax.nn.silu(p_r.reshape(bsz, n, H_B, DB_V))
    new = jnp.stack([s_f_end, s_b_end], axis=1).astype(p_q.dtype) if ctx is None else None
    return o.reshape(bsz, n, MIX_B), new


def _mla(p_qd, p_kvd, p_kr, lw, rope, ctx):
    bsz, n, _ = p_qd.shape
    q = (_rmsnorm(p_qd, lw['c_qnorm_g']) @ lw['c_q_up']).reshape(bsz, n, H_C, DC_NOPE + DC_ROPE)
    c_kv = _rmsnorm(p_kvd, lw['c_kvnorm_g'])
    scale = (DC_NOPE + DC_ROPE) ** -0.5

    def expand(ckv, kr):
        b, t, _ = ckv.shape
        kv = (ckv @ lw['c_kv_up']).reshape(b, t, H_C, DC_NOPE + DC_V)
        k = jnp.concatenate([kv[..., :DC_NOPE], jnp.broadcast_to(kr[:, :, None, :], (b, t, H_C, DC_ROPE))], axis=-1)
        return k, kv[..., DC_NOPE:]

    if ctx is None:
        k, v = expand(c_kv, p_kr)
        o = _block_attend(q, k, v, scale)
        new = (c_kv, p_kr)
    else:
        ckv_c, kr_c = ctx
        k_c, v_c = expand(ckv_c, kr_c)
        cos, sin = rope
        q_l = jnp.concatenate([q[..., :DC_NOPE], _apply_rope(q[..., DC_NOPE:], cos, sin)], axis=-1)
        k_l, v_l = expand(c_kv, _apply_rope(p_kr, cos, sin))
        o = _block_attend(q, k_c, jnp.concatenate([v_c, v_l], axis=1), scale, q_l, k_l)
        new = None
    return o.reshape(bsz, n, MIX_C), new


def _conv_ffn(h, w_up, conv_w, conv_b, w_down):
    g, u = jnp.split(h @ w_up, 2, axis=-1)
    gp = jnp.pad(g, ((0, 0), (1, 1), (0, 0)))
    g = gp[:, :-2] * conv_w[0] + gp[:, 1:-1] * conv_w[1] + gp[:, 2:] * conv_w[2] + conv_b
    return (jax.nn.silu(g) * u) @ w_down


def _layer(x, cond, lw, layer, rope, ctx):
    nb = cond.shape[0]
    mod = (jax.nn.silu(cond) @ lw['ada_w'] + lw['ada_b']).reshape(nb, 1, 6, D_MODEL)
    sh1, sc1, g1, sh2, sc2, g2 = (mod[:, :, i] for i in range(6))
    h = _rmsnorm(x, lw['norm1_g']) * (1 + sc1) + sh1
    aq, ak, av, bq, bk, bv, br, bg, cq, ckv, ckr = _split_cols(h @ lw['w_in'])
    if ctx is None:
        rope_a, rope_c = None, None
        ctx_a, ctx_b, ctx_c = None, None, None
    else:
        rope_a, rope_c = rope
        ctx_a, ctx_b, ctx_c = (ctx[0], ctx[1]), ctx[2], (ctx[3], ctx[4])
    a_out, a_new = _diff_attn(aq, ak, av, lw, layer, rope_a, ctx_a)
    b_out, b_new = _gla(bq, bk, bv, br, bg, lw, ctx_b)
    c_out, c_new = _mla(cq, ckv, ckr, lw, rope_c, ctx_c)
    x = x + g1 * (jnp.concatenate([a_out, b_out, c_out], axis=-1) @ lw['w_out'])
    h2 = _rmsnorm(x, lw['norm2_g']) * (1 + sc2) + sh2
    x = x + g2 * _conv_ffn(h2, lw['w_up'], lw['conv_w'], lw['conv_b'], lw['w_down'])
    new = None if ctx is not None else (a_new[0], a_new[1], b_new, c_new[0], c_new[1])
    return x, new


def setup_inputs(seed: int = 0) -> dict:
    key = jax.random.key(seed)
    ks = jax.random.split(key, 32)

    def nrm(i, shape, scale):
        return jax.random.normal(ks[i], shape, jnp.float32) * scale

    return {
        'x_prompt': nrm(0, (BATCH, SEQ, D_MODEL), 1.0),
        'x_sample': nrm(1, (DEC_BATCH, DEC_SEQ, D_MODEL), 1.0),
        'cache_a_k': nrm(2, (DEC_BATCH, DEPTH, PAST_LEN, H_A, 2, DA_QK), 1.0),
        'cache_a_v': nrm(3, (DEC_BATCH, DEPTH, PAST_LEN, H_A, DA_V), 1.0),
        'state_b': nrm(4, (DEC_BATCH, DEPTH, 2, H_B, DB_K, DB_V), 0.5),
        'cache_c_kv': nrm(5, (DEC_BATCH, DEPTH, PAST_LEN, KV_RANK), 1.0),
        'cache_c_krope': nrm(6, (DEC_BATCH, DEPTH, PAST_LEN, DC_ROPE), 1.0),
        'c': nrm(7, (DEC_BATCH, D_MODEL), 1.0),
        'c_ctx': nrm(8, (D_MODEL,), 1.0),
        'norm1_g': 1.0 + nrm(9, (DEPTH, D_MODEL), 0.05),
        'ada_w': nrm(10, (DEPTH, D_MODEL, 6 * D_MODEL), 0.5 * D_MODEL ** -0.5),
        'ada_b': nrm(11, (DEPTH, 6 * D_MODEL), 0.01),
        'w_in': nrm(12, (DEPTH, D_MODEL, IN_COLS), D_MODEL ** -0.5),
        'lam_q1': nrm(13, (DEPTH, DA_QK), 0.1),
        'lam_k1': nrm(14, (DEPTH, DA_QK), 0.1),
        'lam_q2': nrm(15, (DEPTH, DA_QK), 0.1),
        'lam_k2': nrm(16, (DEPTH, DA_QK), 0.1),
        'a_norm_g': 1.0 + nrm(17, (DEPTH, DA_V), 0.05),
        'b_gate_w': nrm(18, (DEPTH, 2, GATE_RANK, H_B * DB_K), GATE_RANK ** -0.5),
        'b_gate_b': nrm(19, (DEPTH, 2, H_B * DB_K), 0.1),
        'b_norm_g': 1.0 + nrm(20, (DEPTH, DB_V), 0.05),
        'c_qnorm_g': 1.0 + nrm(21, (DEPTH, Q_RANK), 0.05),
        'c_q_up': nrm(22, (DEPTH, Q_RANK, H_C * (DC_NOPE + DC_ROPE)), Q_RANK ** -0.5),
        'c_kvnorm_g': 1.0 + nrm(23, (DEPTH, KV_RANK), 0.05),
        'c_kv_up': nrm(24, (DEPTH, KV_RANK, H_C * (DC_NOPE + DC_V)), KV_RANK ** -0.5),
        'w_out': nrm(25, (DEPTH, MIX_WIDTH, D_MODEL), MIX_WIDTH ** -0.5),
        'norm2_g': 1.0 + nrm(26, (DEPTH, D_MODEL), 0.05),
        'w_up': nrm(27, (DEPTH, D_MODEL, 2 * D_FF), D_MODEL ** -0.5),
        'conv_w': nrm(28, (DEPTH, 3, D_FF), 3.0 ** -0.5),
        'conv_b': nrm(29, (DEPTH, D_FF), 0.01),
        'w_down': nrm(30, (DEPTH, D_FF, D_MODEL), D_FF ** -0.5),
        'final_g': 1.0 + nrm(31, (D_MODEL,), 0.05),
    }


def reference(x_prompt, x_sample, cache_a_k, cache_a_v, state_b, cache_c_kv, cache_c_krope, c, c_ctx,
              norm1_g, ada_w, ada_b, w_in, lam_q1, lam_k1, lam_q2, lam_k2, a_norm_g, b_gate_w, b_gate_b,
              b_norm_g, c_qnorm_g, c_q_up, c_kvnorm_g, c_kv_up, w_out, norm2_g, w_up, conv_w, conv_b,
              w_down, final_g):
    n_lat = x_sample.shape[1]
    n_rows = n_lat // GRID_W
    rope = (_rope_tables(n_rows, DA_QK), _rope_tables(n_rows, DC_ROPE))
    cond_ctx = c_ctx[None]
    xp = x_prompt
    xs = x_sample
    ak_l, av_l, sb_l, ckv_l, kr_l = [], [], [], [], []
    for l in range(DEPTH):
        lw = {
            'norm1_g': norm1_g[l], 'ada_w': ada_w[l], 'ada_b': ada_b[l], 'w_in': w_in[l],
            'lam_q1': lam_q1[l], 'lam_k1': lam_k1[l], 'lam_q2': lam_q2[l], 'lam_k2': lam_k2[l],
            'a_norm_g': a_norm_g[l], 'b_gate_w': b_gate_w[l], 'b_gate_b': b_gate_b[l], 'b_norm_g': b_norm_g[l],
            'c_qnorm_g': c_qnorm_g[l], 'c_q_up': c_q_up[l], 'c_kvnorm_g': c_kvnorm_g[l], 'c_kv_up': c_kv_up[l],
            'w_out': w_out[l], 'norm2_g': norm2_g[l], 'w_up': w_up[l], 'conv_w': conv_w[l],
            'conv_b': conv_b[l], 'w_down': w_down[l],
        }
        xp, (ak, av, sb, ckv, kr) = _layer(xp, cond_ctx, lw, l, None, None)
        ak_l.append(ak)
        av_l.append(av)
        sb_l.append(sb)
        ckv_l.append(ckv)
        kr_l.append(kr)
        ctx_l = (cache_a_k[:, l], cache_a_v[:, l], state_b[:, l], cache_c_kv[:, l], cache_c_krope[:, l])
        xs, _ = _layer(xs, c, lw, l, rope, ctx_l)
    y_prompt = _rmsnorm(xp, final_g)
    y_sample = _rmsnorm(xs, final_g)
    new_a_k = jnp.stack(ak_l, axis=1)
    new_a_v = jnp.stack(av_l, axis=1)
    new_state_b = jnp.stack(sb_l, axis=1)
    new_c_kv = jnp.stack(ckv_l, axis=1)
    new_c_krope = jnp.stack(kr_l, axis=1)
    return (y_prompt, y_sample, new_a_k, new_a_v, new_state_b, new_c_kv, new_c_krope)
```

```cpp
#include <hip/hip_runtime.h>
#include <cstdio>
#include <cstdint>
#include <cmath>

namespace pg8 {
#define PG8_LAS __attribute__((address_space(3)))
typedef unsigned short bf16_t;
typedef short bf16x8 __attribute__((ext_vector_type(8)));
typedef float f32x4 __attribute__((ext_vector_type(4)));
typedef unsigned u32x4 __attribute__((ext_vector_type(4)));
constexpr int BM = 256, BK = 64, HALF = 128, HTB = HALF * BK * 2  , STAGE_BYTES = 8 * HTB, NXCD = 8, WGM = 8;

__host__ __device__ __forceinline__ int lds_byte(int r, int c) { const int st = (r >> 4) * 2 + (c >> 5), rr = r & 15, cc = c & 31, ob = rr * 64 + cc * 2; return st * 1024 + (ob ^ (((ob >> 9) & 1) << 5)); }
__host__ __device__ __forceinline__ void stage_rc(int b, int& R, int& C) { const int st = b / 1024, sb = b % 1024, swz = sb ^ (((sb >> 9) & 1) << 5); R = (st >> 1) * 16 + swz / 64; C = (st & 1) * 32 + (swz % 64) / 2; }
__host__ __device__ __forceinline__ int perm32(int rho) { const int n = rho >> 4, i = rho & 15; return 8 * (i >> 2) + 4 * n + (i & 3); }

struct Unit { int pm, pn, kt0; };
struct Gemm { const bf16_t* A; const bf16_t* Bt; int M, N, K, lda, ldb, bgrp; size_t bgrp_stride; };

struct StaticOrder {
    int nM, nN, nwg, G, c;
    __host__ __device__ void init(int M, int N, int G_, int c_) { nM = M / BM; nN = N / BM; nwg = nM * nN; G = G_; c = c_; lim = nwg; }
    int lim;
    __host__ __device__ void map(int wgid, Unit& u) const {
        { const int q = nwg / NXCD, r = nwg % NXCD, xcd = wgid % NXCD, off = wgid / NXCD; wgid = (xcd < r ? xcd * (q + 1) : r * (q + 1) + (xcd - r) * q) + off; }
        const int nig = WGM * nN, gid = wgid / nig, fm = gid * WGM, gsz = (nM - fm) < WGM ? (nM - fm) : WGM;
        u.pm = fm + ((wgid % nig) % gsz); u.pn = (wgid % nig) / gsz; u.kt0 = 0;
    }
    __host__ __device__ bool next(int i, Unit& u) const {
        const long L = (long)i * G + c; if (L >= lim) return false;
        map((int)L, u); return true;
    }
    __device__ __forceinline__ void a_ready(const Unit&) const {}
    __device__ __forceinline__ void done(const Unit&) const {}
};

struct TailOrder : StaticOrder {
    int base, nth;
    __host__ __device__ bool next(int i, Unit& u) const { if (i > 0) return false; const int L = base + (c >> 1); if (L >= nwg) return false; map(L, u); u.kt0 = (c & 1) * nth; return true; }
};

__device__ __forceinline__ unsigned cvt_pk_bf16(float lo, float hi) { unsigned r; asm volatile("v_cvt_pk_bf16_f32 %0, %1, %2" : "=v"(r) : "v"(lo), "v"(hi)); return r; }
typedef float f32x2 __attribute__((ext_vector_type(2)));
__device__ __forceinline__ f32x2 gelu_pk(f32x2 v) {
    const f32x2 av = __builtin_elementwise_abs(v), d = av * 0.2316418882f + 1.0f;
    f32x2 t; t.x = __builtin_amdgcn_rcpf(d.x); t.y = __builtin_amdgcn_rcpf(d.y);
    f32x2 q = t * 0.5307027145f + (-0.7265760135f); q = q * t + 0.7107068705f; q = q * t + (-0.142248368f); q = q * t + 0.127414796f; q = q * t;
    const f32x2 s = (v * v) * (-0.72134752044f);
    f32x2 e; e.x = __builtin_amdgcn_exp2f(s.x); e.y = __builtin_amdgcn_exp2f(s.y);
    const f32x2 m = v * (q * e), r = v - m;
    f32x2 o; o.x = v.x < 0.f ? m.x : r.x; o.y = v.y < 0.f ? m.y : r.y; return o;
}

template <int ACT  > struct EpiBf16 {
    static constexpr bool PERM = true, AFTER_DRAIN = false; static_assert(ACT == 0 || ACT == 1, "EpiBf16: ACT is 0 (none) or 1 (gelu_pk)");
    bf16_t* O; int ldc; const float* bias; int split_cols; size_t split_stride; float scale0;
    __device__ __forceinline__ void operator()(const f32x4 (&acc)[2][2][4][2], const Unit& u, int wr, int wc, int fr, int fq) const {
        const int row0 = u.pm * BM + wr * 64 + fr; int colt = u.pn * BM; bf16_t* base = O;
        float sc = 1.f; if (split_cols) { const int t = colt / split_cols; base += (size_t)t * split_stride; colt -= t * split_cols; if (t == 0) sc = scale0; }
        const int col0 = colt + wc * 32 + 8 * fq, bcol0 = u.pn * BM + wc * 32 + 8 * fq;
        f32x4 bv[2][2];
#pragma unroll
        for (int bj = 0; bj < 2; ++bj)
#pragma unroll
            for (int n = 0; n < 2; ++n) bv[bj][n] = bias ? *(const f32x4*)(bias + bcol0 + bj * HALF + 4 * n) : (f32x4){0.f, 0.f, 0.f, 0.f};
#pragma unroll
        for (int ai = 0; ai < 2; ++ai)
#pragma unroll
            for (int m = 0; m < 4; ++m) { bf16_t* rowp = base + (size_t)(row0 + ai * HALF + m * 16) * ldc + col0;
#pragma unroll
                for (int bj = 0; bj < 2; ++bj) { f32x4 v0 = acc[ai][bj][m][0] + bv[bj][0], v1 = acc[ai][bj][m][1] + bv[bj][1];
                    if (ACT == 1) { f32x2 a = gelu_pk((f32x2){v0[0], v0[1]}), b = gelu_pk((f32x2){v0[2], v0[3]}), c = gelu_pk((f32x2){v1[0], v1[1]}), d = gelu_pk((f32x2){v1[2], v1[3]});
                        v0 = (f32x4){a.x, a.y, b.x, b.y}; v1 = (f32x4){c.x, c.y, d.x, d.y}; }
                    v0 = v0 * sc; v1 = v1 * sc; u32x4 w; w.x = cvt_pk_bf16(v0[0], v0[1]); w.y = cvt_pk_bf16(v0[2], v0[3]); w.z = cvt_pk_bf16(v1[0], v1[1]); w.w = cvt_pk_bf16(v1[2], v1[3]);
                    *(u32x4*)(rowp + bj * HALF) = w; } }
    }
};

template <class Epi, class Sched, bool ALIGN_EPI = false, bool SP2 = false>
__device__ __forceinline__ void gemm_phase(PG8_LAS unsigned char* lds, const Gemm g, const Sched& S, const Epi& E, int tid_in) {
    int tid_ = tid_in; asm volatile("" : "+v"(tid_));
    const int tid = tid_, wid = __builtin_amdgcn_readfirstlane(tid >> 6), lane = tid & 63, wr = wid >> 2, wc = wid & 3, fr = lane & 15, fq = lane >> 4;
    const int K = g.K, nt = K / BK;
    unsigned voffA[2], voffB[2];
#pragma unroll
    for (int i = 0; i < 2; ++i) { int R, C; stage_rc(tid * 16 + i * 8192, R, C); const int Rb = Epi::PERM ? ((R & ~31) + perm32(R & 31)) : R;
        voffA[i] = (unsigned)(R * g.lda + C) * 2u; voffB[i] = (unsigned)(Rb * g.ldb + C) * 2u; }
    const size_t kstep = (size_t)(BK * 2);
    const size_t hstepA = (size_t)HALF * g.lda * 2, hstepB = (size_t)HALF * g.ldb * 2;
    const size_t tstepA = 2 * hstepA, tstepB = 2 * hstepB;
    const unsigned ldsw = (unsigned)wid * 1024u;
    const int aoff = lds_byte(wr * 64 + fr, fq * 8), boff = lds_byte(wc * 32 + fr, fq * 8);
#define PG8_SA(b, h) (((b) * 2 + (h)) * HTB)
#define PG8_SB(b, h) ((4 + (b) * 2 + (h)) * HTB)
#define PG8_STAGE(bufoff, gbase, voff) do { _Pragma("unroll") for (int _i = 0; _i < 2; ++_i) \
        __builtin_amdgcn_global_load_lds((const unsigned*)((const char*)(gbase) + (voff)[_i]), (PG8_LAS unsigned*)(lds + (bufoff) + ldsw + _i * 8192), 16, 0, 0); } while (0)
#define PG8_LDA(dst, b, h) do { _Pragma("unroll") for (int m = 0; m < 4; ++m) _Pragma("unroll") for (int k = 0; k < 2; ++k) dst[m][k] = *(const PG8_LAS bf16x8*)(lds + PG8_SA(b, h) + aoff + m * 2048 + k * 1024); } while (0)
#define PG8_LDB(dst, b, h) do { _Pragma("unroll") for (int n = 0; n < 2; ++n) _Pragma("unroll") for (int k = 0; k < 2; ++k) dst[n][k] = *(const PG8_LAS bf16x8*)(lds + PG8_SB(b, h) + boff + n * 2048 + k * 1024); } while (0)
#define PG8_MMA(ai, bj, At, Bt) do { __builtin_amdgcn_s_setprio(1); _Pragma("unroll") for (int m = 0; m < 4; ++m) _Pragma("unroll") for (int n = 0; n < 2; ++n) _Pragma("unroll") for (int k = 0; k < 2; ++k) \
        acc[ai][bj][m][n] = __builtin_amdgcn_mfma_f32_16x16x32_bf16(Bt[n][k], At[m][k], acc[ai][bj][m][n], 0, 0, 0); __builtin_amdgcn_s_setprio(0); } while (0)
#define PG8_WAIT_V(n) asm volatile("s_waitcnt vmcnt(" #n ")" ::: "memory")
#define PG8_WAIT_L(n) asm volatile("s_waitcnt lgkmcnt(" #n ")" ::: "memory")
#define PG8_BAR __builtin_amdgcn_s_barrier()
#define PG8_SCHED __builtin_amdgcn_sched_barrier(0)
    Unit cur, nxt; int ui = 0;
    if (!S.next(0, cur)) return;
    f32x4 acc[2][2][4][2];
#pragma unroll
    for (int a = 0; a < 2; ++a)
#pragma unroll
        for (int b = 0; b < 2; ++b)
#pragma unroll
            for (int m = 0; m < 4; ++m)
#pragma unroll
                for (int n = 0; n < 2; ++n) acc[a][b][m][n] = (f32x4){0.f, 0.f, 0.f, 0.f};
    bf16x8 At[4][2], B0[2][2], B1[2][2];
    const char* cA = (const char*)g.A + (size_t)cur.pm * tstepA + (size_t)cur.kt0 * kstep; const char* cB = (const char*)g.Bt + (size_t)(cur.pm / g.bgrp) * g.bgrp_stride * 2 + (size_t)cur.pn * tstepB + (size_t)cur.kt0 * kstep;
    S.a_ready(cur);
    if constexpr (SP2) {
        PG8_STAGE(PG8_SB(0, 0), cB, voffB); PG8_STAGE(PG8_SB(0, 1), cB + hstepB, voffB); PG8_STAGE(PG8_SA(0, 0), cA, voffA); PG8_STAGE(PG8_SA(0, 1), cA + hstepA, voffA);
        if (wr == 1) PG8_BAR;
        PG8_WAIT_V(2); PG8_BAR;
        PG8_STAGE(PG8_SB(1, 0), cB + kstep, voffB); PG8_STAGE(PG8_SA(1, 0), cA + kstep, voffA); PG8_STAGE(PG8_SB(1, 1), cB + hstepB + kstep, voffB);
        PG8_WAIT_V(6); PG8_BAR;
    } else {
        PG8_STAGE(PG8_SB(0, 0), cB, voffB); PG8_STAGE(PG8_SA(0, 0), cA, voffA); PG8_STAGE(PG8_SB(0, 1), cB + hstepB, voffB); PG8_STAGE(PG8_SA(0, 1), cA + hstepA, voffA);
        if (wr == 1) PG8_BAR;
        PG8_WAIT_V(4); PG8_BAR;
        PG8_STAGE(PG8_SB(1, 0), cB + kstep, voffB); PG8_STAGE(PG8_SA(1, 0), cA + kstep, voffA); PG8_STAGE(PG8_SB(1, 1), cB + hstepB + kstep, voffB);
        PG8_WAIT_V(6); PG8_BAR;
    }
    for (;;) {
        const bool has_next = S.next(ui + 1, nxt);
        const char* nA = has_next ? (const char*)g.A + (size_t)nxt.pm * tstepA + (size_t)nxt.kt0 * kstep : cA; const char* nB = has_next ? (const char*)g.Bt + (size_t)(nxt.pm / g.bgrp) * g.bgrp_stride * 2 + (size_t)nxt.pn * tstepB + (size_t)nxt.kt0 * kstep : cB;
        for (int t = 0; t < nt; t += 2) {
            const bool last = (t == nt - 2);
            const char* a1 = cA + (size_t)(t + 1) * kstep;
            const char* a2 = last ? nA : cA + (size_t)(t + 2) * kstep; const char* b2 = last ? nB : cB + (size_t)(t + 2) * kstep;
            const char* a3 = a2 + kstep; const char* b3 = b2 + kstep;
            if (last && has_next) S.a_ready(nxt);
            if constexpr (SP2) {
            PG8_LDB(B0, 0, 0); PG8_LDB(B1, 0, 1); PG8_SCHED; PG8_LDA(At, 0, 0); PG8_STAGE(PG8_SA(1, 1), a1 + hstepA, voffA);
            PG8_WAIT_V(8); PG8_WAIT_L(0); PG8_BAR; PG8_MMA(0, 0, At, B0); PG8_MMA(0, 1, At, B1); PG8_BAR; PG8_SCHED;
            PG8_LDA(At, 0, 1); PG8_STAGE(PG8_SB(0, 0), b2, voffB); PG8_STAGE(PG8_SB(0, 1), b2 + hstepB, voffB); PG8_STAGE(PG8_SA(0, 0), a2, voffA);
            PG8_WAIT_V(8); PG8_WAIT_L(0); PG8_BAR; PG8_MMA(1, 0, At, B0); PG8_MMA(1, 1, At, B1); PG8_BAR; PG8_SCHED;
            PG8_LDB(B0, 1, 0); PG8_LDB(B1, 1, 1); PG8_SCHED; PG8_LDA(At, 1, 0); PG8_STAGE(PG8_SA(0, 1), a2 + hstepA, voffA);
            PG8_WAIT_V(8); PG8_WAIT_L(0); PG8_BAR; PG8_MMA(0, 0, At, B0); PG8_MMA(0, 1, At, B1); PG8_BAR; PG8_SCHED;
            PG8_LDA(At, 1, 1); PG8_STAGE(PG8_SB(1, 0), b3, voffB); PG8_STAGE(PG8_SB(1, 1), b3 + hstepB, voffB); PG8_STAGE(PG8_SA(1, 0), a3, voffA);
            PG8_WAIT_V(8); PG8_WAIT_L(0); PG8_BAR; PG8_MMA(1, 0, At, B0); PG8_MMA(1, 1, At, B1); PG8_BAR; PG8_SCHED;
            } else {
            PG8_LDB(B0, 0, 0); PG8_SCHED; PG8_LDA(At, 0, 0); PG8_STAGE(PG8_SA(1, 1), a1 + hstepA, voffA);
            PG8_WAIT_L(8); PG8_BAR; PG8_WAIT_L(0); PG8_MMA(0, 0, At, B0); PG8_BAR; PG8_SCHED;
            PG8_LDB(B1, 0, 1); PG8_STAGE(PG8_SB(0, 0), b2, voffB);
            PG8_BAR; PG8_WAIT_L(0); PG8_MMA(0, 1, At, B1); PG8_BAR;
            PG8_LDA(At, 0, 1); PG8_STAGE(PG8_SA(0, 0), a2, voffA);
            PG8_BAR; PG8_WAIT_L(0); PG8_MMA(1, 0, At, B0); PG8_BAR; PG8_SCHED;
            PG8_STAGE(PG8_SB(0, 1), b2 + hstepB, voffB);
            PG8_WAIT_V(6); PG8_BAR; PG8_MMA(1, 1, At, B1); PG8_BAR;
            PG8_LDB(B0, 1, 0); PG8_SCHED; PG8_LDA(At, 1, 0); PG8_STAGE(PG8_SA(0, 1), a2 + hstepA, voffA);
            PG8_WAIT_L(8); PG8_BAR; PG8_WAIT_L(0); PG8_MMA(0, 0, At, B0); PG8_BAR; PG8_SCHED;
            PG8_LDB(B1, 1, 1); PG8_STAGE(PG8_SB(1, 0), b3, voffB);
            PG8_BAR; PG8_WAIT_L(0); PG8_MMA(0, 1, At, B1); PG8_BAR;
            PG8_LDA(At, 1, 1); PG8_STAGE(PG8_SA(1, 0), a3, voffA);
            PG8_BAR; PG8_WAIT_L(0); PG8_MMA(1, 0, At, B0); PG8_BAR; PG8_SCHED;
            PG8_STAGE(PG8_SB(1, 1), b3 + hstepB, voffB);
            PG8_WAIT_V(6); PG8_BAR; PG8_MMA(1, 1, At, B1); PG8_BAR;
            }
        }
        if constexpr (ALIGN_EPI) { if (wr == 0) PG8_BAR; }
        if constexpr (!Epi::AFTER_DRAIN) { E(acc, cur, wr, wc, fr, fq); S.done(cur); }
        if (!has_next) break;
#pragma unroll
        for (int a = 0; a < 2; ++a)
#pragma unroll
            for (int b = 0; b < 2; ++b)
#pragma unroll
                for (int m = 0; m < 4; ++m)
#pragma unroll
                    for (int n = 0; n < 2; ++n) acc[a][b][m][n] = (f32x4){0.f, 0.f, 0.f, 0.f};
        cur = nxt; cA = nA; cB = nB; ++ui;
        if constexpr (ALIGN_EPI) { if (wr == 1) PG8_BAR; }
    }
    PG8_WAIT_V(0);
    if constexpr (!ALIGN_EPI) { if (wr == 0) PG8_BAR; }
    PG8_BAR;
    if constexpr (Epi::AFTER_DRAIN) { E.fused(acc, cur, wr, wc, fr, fq, lds, wid, lane); S.done(cur); }
#undef PG8_SA
#undef PG8_SB
#undef PG8_STAGE
#undef PG8_LDA
#undef PG8_LDB
#undef PG8_MMA
#undef PG8_WAIT_V
#undef PG8_WAIT_L
#undef PG8_BAR
#undef PG8_SCHED
}
}

constexpr int DM = 2048, NPB = 16, SEQ = 256, DEPTH = 4, NDB = 4, DSEQ = 4096, PAST = 256;
constexpr int MP = NPB * SEQ, MS = NDB * DSEQ, M = MP + MS;
constexpr int NIN = 4544, NINP = 4608;
constexpr int C_AQ = 0, C_AK = 512, C_AV = 1024, C_BQ = 1536, C_BK = 1920, C_BV = 2304, C_BR = 3072, C_BG = 3840, C_CQ = 3872, C_CKV = 4256, C_CKR = 4512;
constexpr int DFF = 5632, NQC = 576, NQCP = 768, NKV = 1152, NKVP = 1280;
constexpr float EPS = 1e-6f;
constexpr int NOATT = 14 * 128, NOGLA = 2 * 768;
enum { I_XP = 0, I_XS, I_CAK, I_CAV, I_STB, I_CCKV, I_CCKR, I_C, I_CCTX, I_N1G, I_ADAW, I_ADAB, I_WIN, I_LQ1, I_LK1, I_LQ2, I_LK2, I_ANG, I_BGW, I_BGB, I_BNG, I_CQG, I_CQUP, I_CKVG, I_CKVUP, I_WOUT, I_N2G, I_WUP, I_CONVW, I_CONVB, I_WDOWN, I_FING, N_INPUTS };
constexpr size_t O_YP = 0, O_YS = O_YP + (size_t)MP * DM, O_AK = O_YS + (size_t)MS * DM, O_AV = O_AK + (size_t)NPB * DEPTH * SEQ * 512, O_SB = O_AV + (size_t)NPB * DEPTH * SEQ * 512,
                 O_CKV = O_SB + (size_t)NPB * DEPTH * 2 * 6 * 64 * 128, O_CKR = O_CKV + (size_t)NPB * DEPTH * SEQ * 256, O_END = O_CKR + (size_t)NPB * DEPTH * SEQ * 32;
static_assert(O_END == 69730304, "output size");

constexpr size_t al256(size_t x) { return (x + 255) & ~(size_t)255; }
constexpr size_t WS_CTL = 0, CTL_ZERO_BYTES = 2u << 20;
constexpr size_t WS_SSQ = 1u << 20;
constexpr size_t SZ_WIN = (size_t)NINP * DM * 2, SZ_WOUT = (size_t)DM * DM * 2, SZ_WUP = (size_t)2 * DFF * DM * 2, SZ_WDN = (size_t)DM * DFF * 2, SZ_WQ = (size_t)NQCP * 384 * 2, SZ_WKV = (size_t)NKVP * 256 * 2;
constexpr size_t WS_WIN = WS_CTL + CTL_ZERO_BYTES, WS_WOUT = WS_WIN + 4 * SZ_WIN, WS_WUP = WS_WOUT + 4 * SZ_WOUT, WS_WDN = WS_WUP + 4 * SZ_WUP, WS_WQ = WS_WDN + 4 * SZ_WDN, WS_WKV = WS_WQ + 4 * SZ_WQ;
constexpr size_t SZ_MOD = (size_t)DEPTH * 5 * 6 * DM * 4;
constexpr size_t WS_MOD = WS_WKV + 4 * SZ_WKV, WS_MODP = WS_MOD + SZ_MOD, WS_RTA = WS_MODP + 8 * SZ_MOD, WS_RTC = WS_RTA + (size_t)DSEQ * 64 * 4, WS_LAM = WS_RTC + (size_t)DSEQ * 32 * 4;
constexpr size_t WS_CAK = WS_LAM + 256, WS_CAV = WS_CAK + (size_t)NDB * DEPTH * PAST * 512 * 2, WS_CKRX = WS_CAV + (size_t)NDB * DEPTH * PAST * 512 * 2, WS_CKVA = WS_CKRX + (size_t)NDB * DEPTH * PAST * 32 * 2,
                 WS_KVCTX = WS_CKVA + (size_t)DEPTH * NDB * PAST * 256 * 2, WS_SIDE = WS_KVCTX + (size_t)DEPTH * NDB * PAST * NKVP * 2, WS_GM = WS_SIDE + (size_t)(M / 256) * 2 * 3 * DFF * 4, WS_SHWI = WS_GM + (size_t)DEPTH * 2 * 5 * DM * 4,
                 WS_SHWU = WS_SHWI + (size_t)DEPTH * 5 * NINP * 4, WS_SSQP = WS_SHWU + (size_t)DEPTH * 5 * 2 * DFF * 4, WS_X = WS_SSQP + (size_t)8 * M * 32 * 4;
constexpr size_t WS_H = WS_X + (size_t)M * DM * 4, WS_T0 = WS_H + (size_t)M * DM * 2;
constexpr size_t WS_P = WS_T0, WS_MIX = WS_P + (size_t)M * NINP * 2, WS_QC = WS_MIX + (size_t)M * DM * 2, WS_KVC = WS_QC + (size_t)M * NQCP * 2, WS_CQN = WS_KVC + (size_t)M * NKVP * 2, WS_CKVN = WS_CQN + (size_t)M * 384 * 2,
                 WS_KRA = WS_CKVN + (size_t)M * 256 * 2, WS_KRC = WS_KRA + (size_t)MS * 512 * 2, WS_OATT = WS_KRC + (size_t)MS * 32 * 2, WS_OGLA = WS_OATT + (size_t)M * NOATT * 4, WS_GATE = WS_OGLA + (size_t)M * NOGLA * 4,
                 WS_ST = WS_GATE + (size_t)M * 768 * 4, WS_DD = WS_ST + (size_t)(M / 64) * 12 * 8192 * 2, WS_END1 = WS_DD + (size_t)(M / 64) * 12 * 64 * 4;
constexpr size_t WS_U = WS_OGLA, WS_QK4 = WS_GATE;
constexpr size_t WS_GU = WS_T0, WS_ACT = WS_GU + (size_t)M * 2 * DFF * 2, WS_END2 = WS_ACT + (size_t)M * DFF * 2;


static_assert(WS_WIN % 256 == 0 && WS_X % 256 == 0 && WS_H % 256 == 0 && WS_T0 % 256 == 0 && WS_QC % 256 == 0 && WS_KVC % 256 == 0 && WS_CQN % 256 == 0 && WS_CKVN % 256 == 0 && WS_OATT % 256 == 0 && WS_ACT % 256 == 0, "alignment");

constexpr size_t WS_SPLITK = WS_END1 > WS_END2 ? WS_END1 : WS_END2, WS_END3 = WS_SPLITK + (size_t)128 * 2 * 65536 * 4;
constexpr size_t WS_END = WS_END3;
static_assert(WS_END <= (size_t)1536 << 20, "workspace map must fit 4 x the largest tensor");
constexpr int CW_TICKET = 65536;

constexpr int RING_BYTES = 131072, MISC_OFF = RING_BYTES + 320, LDS_BYTES = 147456;

#define GAS __attribute__((address_space(1)))
#define LAS __attribute__((address_space(3)))
typedef unsigned short bf16;
typedef unsigned v4u __attribute__((ext_vector_type(4)));
typedef unsigned v2u __attribute__((ext_vector_type(2)));
typedef float f32x4 __attribute__((ext_vector_type(4)));
#define LDS_WAIT() asm volatile("s_waitcnt lgkmcnt(0)" ::: "memory")
__device__ __forceinline__ unsigned f2bf(float f) { unsigned u = __builtin_bit_cast(unsigned, f); return (u + 0x7fffu + ((u >> 16) & 1u)) >> 16; }
__device__ __forceinline__ unsigned pk2(float lo, float hi) { return f2bf(lo) | (f2bf(hi) << 16); }
__device__ __forceinline__ float bf2f(bf16 b) { return __builtin_bit_cast(float, (unsigned)b << 16); }
__device__ __forceinline__ float wave_sum(float v) {
#pragma unroll
    for (int o = 1; o < 64; o <<= 1) v += __shfl_xor(v, o);
    return v;
}
__device__ __forceinline__ float siluf(float x) { return x / (1.f + __expf(-x)); }

namespace pg8 {
__device__ __forceinline__ void rstd_table(const float* ssq, int pm, PG8_LAS float* rtab, int tid) {
    const int row = tid >> 1, half = tid & 1; const float* p = ssq + ((size_t)(pm * BM + row) * 32 + half * 16);
    const f32x4 a = *(const f32x4*)p, b = *(const f32x4*)(p + 4), c = *(const f32x4*)(p + 8), d = *(const f32x4*)(p + 12);
    float s = (((a[0] + a[1]) + (a[2] + a[3])) + ((b[0] + b[1]) + (b[2] + b[3]))) + (((c[0] + c[1]) + (c[2] + c[3])) + ((d[0] + d[1]) + (d[2] + d[3])));
    s += __shfl_xor(s, 1);
    if (half == 0) rtab[row] = 1.0f / sqrtf(s * (1.f / 2048.f) + 1e-6f);
    asm volatile("s_waitcnt lgkmcnt(0)" ::: "memory"); __builtin_amdgcn_s_barrier(); asm volatile("" ::: "memory");
}
struct EpiResid {
    static constexpr bool PERM = true, AFTER_DRAIN = false;
    const float* xin0; const float* xin1;
    float* out; const float* gate;
    bf16_t* H; const float* gm; float* ssq;
    __device__ __forceinline__ void operator()(const f32x4 (&acc)[2][2][4][2], const Unit& u, int wr, int wc, int fr, int fq) const {
        const int mi = u.pm < 16 ? 0 : 1 + ((u.pm - 16) >> 4);
        const float* gp = gate + (size_t)mi * 6 * 2048; const float* xin = u.pm < 16 ? xin0 : xin1;
        const int col0 = u.pn * BM + wc * 32 + 8 * fq;
        f32x4 gv[2][2], gm4[2][2];
#pragma unroll
        for (int bj = 0; bj < 2; ++bj)
#pragma unroll
            for (int n = 0; n < 2; ++n) { gv[bj][n] = *(const f32x4*)(gp + col0 + bj * HALF + 4 * n); gm4[bj][n] = H ? *(const f32x4*)(gm + (size_t)mi * 2048 + col0 + bj * HALF + 4 * n) : (f32x4){0.f, 0.f, 0.f, 0.f}; }
#pragma unroll
        for (int ai = 0; ai < 2; ++ai)
#pragma unroll
            for (int m = 0; m < 4; ++m) { const int row = u.pm * BM + ai * HALF + wr * 64 + m * 16 + fr; const size_t off = (size_t)row * 2048 + col0; float ss = 0.f;
#pragma unroll
                for (int bj = 0; bj < 2; ++bj) { const f32x4 x0 = *(const f32x4*)(xin + off + bj * HALF), x1 = *(const f32x4*)(xin + off + bj * HALF + 4);
                    const f32x4 y0 = x0 + gv[bj][0] * acc[ai][bj][m][0], y1 = x1 + gv[bj][1] * acc[ai][bj][m][1];
                    *(f32x4*)(out + off + bj * HALF) = y0; *(f32x4*)(out + off + bj * HALF + 4) = y1;
                    ss += ((y0[0] * y0[0] + y0[1] * y0[1]) + (y0[2] * y0[2] + y0[3] * y0[3])) + ((y1[0] * y1[0] + y1[1] * y1[1]) + (y1[2] * y1[2] + y1[3] * y1[3]));
                    if (H) { const f32x4 h0 = y0 * gm4[bj][0], h1 = y1 * gm4[bj][1]; u32x4 w; w.x = cvt_pk_bf16(h0[0], h0[1]); w.y = cvt_pk_bf16(h0[2], h0[3]); w.z = cvt_pk_bf16(h1[0], h1[1]); w.w = cvt_pk_bf16(h1[2], h1[3]);
                        *(u32x4*)(H + off + bj * HALF) = w; } }
                if (H) { ss += __shfl_xor(ss, 16); ss += __shfl_xor(ss, 32); if (fq == 0) ssq[(size_t)row * 32 + u.pn * 4 + wc] = ss; } }
    }
};
struct EpiBf16Norm {
    static constexpr bool PERM = true, AFTER_DRAIN = false;
    bf16_t* O; int ldc; const float* ssq; const float* shw; int shw_ld; PG8_LAS float* rtab;
    __device__ __forceinline__ void operator()(const f32x4 (&acc)[2][2][4][2], const Unit& u, int wr, int wc, int fr, int fq) const {
        const int mi = u.pm < 16 ? 0 : 1 + ((u.pm - 16) >> 4);
        rstd_table(ssq, u.pm, rtab, (wr * 4 + wc) * 64 + fq * 16 + fr);
        const int row0 = u.pm * BM + wr * 64 + fr, col0 = u.pn * BM + wc * 32 + 8 * fq; const float* sp = shw + (size_t)mi * shw_ld + col0;
        f32x4 sv[2][2];
#pragma unroll
        for (int bj = 0; bj < 2; ++bj)
#pragma unroll
            for (int n = 0; n < 2; ++n) sv[bj][n] = *(const f32x4*)(sp + bj * HALF + 4 * n);
#pragma unroll
        for (int ai = 0; ai < 2; ++ai)
#pragma unroll
            for (int m = 0; m < 4; ++m) { const int row = row0 + ai * HALF + m * 16; const float rs = rtab[row - u.pm * BM];
                bf16_t* rowp = O + (size_t)row * ldc + col0;
#pragma unroll
                for (int bj = 0; bj < 2; ++bj) { const f32x4 v0 = acc[ai][bj][m][0] * rs + sv[bj][0], v1 = acc[ai][bj][m][1] * rs + sv[bj][1];
                    u32x4 w; w.x = cvt_pk_bf16(v0[0], v0[1]); w.y = cvt_pk_bf16(v0[2], v0[3]); w.z = cvt_pk_bf16(v1[0], v1[1]); w.w = cvt_pk_bf16(v1[2], v1[3]);
                    *(u32x4*)(rowp + bj * HALF) = w; } }
    }
};

struct EpiResidTail {
    static constexpr bool PERM = false, AFTER_DRAIN = false;
    float* X; const float* gate; float* scratch; unsigned* ticket; PG8_LAS unsigned* lw;
    __device__ __forceinline__ void operator()(const f32x4 (&acc)[2][2][4][2], const Unit& u, int wr, int wc, int fr, int fq) const {
        const int t = blockIdx.x >> 1, half = blockIdx.x & 1, tid = threadIdx.x;
        { const __amdgpu_buffer_rsrc_t rs = __builtin_amdgcn_make_buffer_rsrc(scratch + ((size_t)t * 2 + half) * 65536, 0, 65536 * 4, 0x00020000);
#pragma unroll
          for (int ai = 0; ai < 2; ++ai)
#pragma unroll
            for (int bj = 0; bj < 2; ++bj)
#pragma unroll
                for (int m = 0; m < 4; ++m)
#pragma unroll
                    for (int n = 0; n < 2; ++n) { const int j = ((ai * 2 + bj) * 4 + m) * 2 + n; __builtin_amdgcn_raw_buffer_store_b128(__builtin_bit_cast(u32x4, acc[ai][bj][m][n]), rs, (j * 512 + tid) * 16, 0, 16); } }
        asm volatile("s_waitcnt vmcnt(0)" ::: "memory"); __builtin_amdgcn_s_barrier(); asm volatile("" ::: "memory");
        if (tid == 0) { const unsigned old = __hip_atomic_fetch_add(ticket + 64 * t, 1u, __ATOMIC_RELAXED, __HIP_MEMORY_SCOPE_AGENT); *lw = old; }
        asm volatile("s_waitcnt vmcnt(0) lgkmcnt(0)" ::: "memory"); __builtin_amdgcn_s_barrier(); asm volatile("" ::: "memory");
        const unsigned old = *lw;
        if (old == 0u) return;
        __builtin_amdgcn_fence(__ATOMIC_ACQUIRE, "agent"); asm volatile("s_waitcnt vmcnt(0)" ::: "memory");
        const float* oth = scratch + ((size_t)t * 2 + (half ^ 1)) * 65536; const float* own = scratch + ((size_t)t * 2 + half) * 65536;
        const int mi = u.pm < 16 ? 0 : 1 + ((u.pm - 16) >> 4);
        const float* gp = gate + (size_t)mi * 6 * 2048;
        const int col0 = u.pn * BM + wc * 32 + 4 * fq;
#pragma unroll
        for (int ai = 0; ai < 2; ++ai)
#pragma unroll
            for (int m = 0; m < 4; ++m) { const size_t off = (size_t)(u.pm * BM + ai * HALF + wr * 64 + m * 16 + fr) * 2048 + col0;
#pragma unroll
                for (int bj = 0; bj < 2; ++bj)
#pragma unroll
                    for (int n = 0; n < 2; ++n) { const int j = ((ai * 2 + bj) * 4 + m) * 2 + n; const f32x4 pv = *(const f32x4*)(oth + (size_t)(j * 512 + tid) * 4) + *(const f32x4*)(own + (size_t)(j * 512 + tid) * 4);
                        const f32x4 gv = *(const f32x4*)(gp + col0 + bj * HALF + n * 16), xv = *(const f32x4*)(X + off + bj * HALF + n * 16);
                        *(f32x4*)(X + off + bj * HALF + n * 16) = xv + gv * pv; }
                asm volatile("" ::: "memory"); }
    }
};

__device__ __forceinline__ float dpp_ror1(float x) { return __builtin_bit_cast(float, __builtin_amdgcn_update_dpp(__builtin_bit_cast(int, x), __builtin_bit_cast(int, x), 0x121, 0xf, 0xf, false)); }
__device__ __forceinline__ float dpp_rol1(float x) { return __builtin_bit_cast(float, __builtin_amdgcn_update_dpp(__builtin_bit_cast(int, x), __builtin_bit_cast(int, x), 0x12F, 0xf, 0xf, false)); }
struct EpiConvAct {
    static constexpr bool PERM = true, AFTER_DRAIN = false;
    bf16_t* ACT; const float* cw; const float* cb; float* side; PG8_LAS float* ex;
    const float* ssq; const float* shw; PG8_LAS float* rtab;
    __device__ __forceinline__ void operator()(const f32x4 (&acc_)[2][2][4][2], const Unit& u, int wr, int wc, int fr, int fq) const {
        constexpr int FF = 5632;
        const int colw = wc * 32 + 8 * fq, j0 = u.pn * HALF + colw;
        f32x4 (&acc)[2][2][4][2] = const_cast<f32x4 (&)[2][2][4][2]>(acc_);
        rstd_table(ssq, u.pm, rtab, (wr * 4 + wc) * 64 + fq * 16 + fr);
        { const int mi = u.pm < 16 ? 0 : 1 + ((u.pm - 16) >> 4); const float* sp = shw + (size_t)mi * (2 * FF) + u.pn * BM + colw;
          f32x4 sv[2][2];
#pragma unroll
          for (int bj = 0; bj < 2; ++bj)
#pragma unroll
              for (int n = 0; n < 2; ++n) sv[bj][n] = *(const f32x4*)(sp + bj * HALF + 4 * n);
#pragma unroll
          for (int ai = 0; ai < 2; ++ai)
#pragma unroll
              for (int m = 0; m < 4; ++m) { const int row = u.pm * BM + ai * HALF + wr * 64 + m * 16 + fr; const float rs = rtab[row - u.pm * BM];
#pragma unroll
                  for (int bj = 0; bj < 2; ++bj)
#pragma unroll
                      for (int n = 0; n < 2; ++n) acc[ai][bj][m][n] = acc[ai][bj][m][n] * rs + sv[bj][n]; } }
        float w0[8], w1[8], w2[8], bb[8];
#pragma unroll
        for (int q = 0; q < 2; ++q) { const f32x4 a0 = *(const f32x4*)(cw + j0 + 4 * q), a1 = *(const f32x4*)(cw + FF + j0 + 4 * q), a2 = *(const f32x4*)(cw + 2 * FF + j0 + 4 * q), a3 = *(const f32x4*)(cb + j0 + 4 * q);
#pragma unroll
            for (int i = 0; i < 4; ++i) { w0[4 * q + i] = a0[i]; w1[4 * q + i] = a1[i]; w2[4 * q + i] = a2[i]; bb[4 * q + i] = a3[i]; } }
#pragma unroll
        for (int ai = 0; ai < 2; ++ai) { const int blk = 2 * ai + wr;
            if (fr == 0) {
#pragma unroll
                for (int n = 0; n < 2; ++n) *(PG8_LAS f32x4*)(ex + (blk * 2 + 0) * HALF + colw + 4 * n) = acc[ai][0][0][n]; }
            if (fr == 15) {
#pragma unroll
                for (int n = 0; n < 2; ++n) *(PG8_LAS f32x4*)(ex + (blk * 2 + 1) * HALF + colw + 4 * n) = acc[ai][0][3][n]; } }
        asm volatile("s_waitcnt lgkmcnt(0)" ::: "memory"); __builtin_amdgcn_s_barrier(); asm volatile("" ::: "memory");
#pragma unroll
        for (int ai = 0; ai < 2; ++ai) { const int blk = 2 * ai + wr;
#pragma unroll
            for (int m = 0; m < 4; ++m) { float ov[8]; float gcv[8]; float pe[8], ne[8];
                if (m == 0) {
#pragma unroll
                    for (int n = 0; n < 2; ++n) { const f32x4 p4 = blk > 0 ? *(const PG8_LAS f32x4*)(ex + ((blk - 1) * 2 + 1) * HALF + colw + 4 * n) : (f32x4){0.f, 0.f, 0.f, 0.f};
#pragma unroll
                        for (int i = 0; i < 4; ++i) pe[4 * n + i] = p4[i]; } }
                if (m == 3) {
#pragma unroll
                    for (int n = 0; n < 2; ++n) { const f32x4 n4 = blk < 3 ? *(const PG8_LAS f32x4*)(ex + ((blk + 1) * 2 + 0) * HALF + colw + 4 * n) : (f32x4){0.f, 0.f, 0.f, 0.f};
#pragma unroll
                        for (int i = 0; i < 4; ++i) ne[4 * n + i] = n4[i]; } }
#pragma unroll
                for (int k = 0; k < 8; ++k) { const int n = k >> 2, i = k & 3; const float g = acc[ai][0][m][n][i];
                    const float rs = dpp_ror1(g), ls = dpp_rol1(g);
                    const float rp = m > 0 ? dpp_ror1(acc[ai][0][m > 0 ? m - 1 : 0][n][i]) : pe[k];
                    const float ln = m < 3 ? dpp_rol1(acc[ai][0][m < 3 ? m + 1 : 3][n][i]) : ne[k];
                    const float gp = fr > 0 ? rs : rp, gn = fr < 15 ? ls : ln;
                    const float gc = w0[k] * gp + w1[k] * g + w2[k] * gn + bb[k];
                    gcv[k] = gc; ov[k] = gc * __builtin_amdgcn_rcpf(1.f + __expf(-gc)) * acc[ai][1][m][n][i]; }
                const int row = u.pm * BM + ai * HALF + wr * 64 + m * 16 + fr;
                u32x4 w; w.x = cvt_pk_bf16(ov[0], ov[1]); w.y = cvt_pk_bf16(ov[2], ov[3]); w.z = cvt_pk_bf16(ov[4], ov[5]); w.w = cvt_pk_bf16(ov[6], ov[7]);
                *(u32x4*)(ACT + (size_t)row * FF + j0) = w;
                const bool first = (ai == 0 && m == 0) && wr == 0 && fr == 0, last = (ai == 1 && m == 3) && wr == 1 && fr == 15;
                if ((ai == 0 && m == 0) || (ai == 1 && m == 3)) { if (first || last) { float* sp = side + ((size_t)(u.pm * 2 + (last ? 1 : 0)) * 3) * FF + j0;
#pragma unroll
                    for (int n = 0; n < 2; ++n) { *(f32x4*)(sp + 4 * n) = (f32x4){gcv[4 * n], gcv[4 * n + 1], gcv[4 * n + 2], gcv[4 * n + 3]}; *(f32x4*)(sp + FF + 4 * n) = acc[ai][1][m][n]; *(f32x4*)(sp + 2 * FF + 4 * n) = acc[ai][0][m][n]; } } }
            } }
    }
};
}

#define XB_TMO      128
#define XB_XCNT(j)  (256  + 64 * (j))
#define XB_XSUB(j)  (1280 + 64 * (j))
#define XB_XGEN(j)  (2304 + 64 * (j))
#define XB_TOP      3328
#define XB_TOPGEN   3392
#define XCD_BAR_WORDS 3456
#define XB_SPIN_CAP (1u << 18)
__device__ __forceinline__ unsigned xb_ld(unsigned* p)              { return __hip_atomic_load(p, __ATOMIC_RELAXED, __HIP_MEMORY_SCOPE_AGENT); }
__device__ __forceinline__ unsigned xb_add(unsigned* p, unsigned v) { return __hip_atomic_fetch_add(p, v, __ATOMIC_RELAXED, __HIP_MEMORY_SCOPE_AGENT); }
__device__ __forceinline__ unsigned xb_xcc_id() { return (unsigned)__builtin_amdgcn_s_getreg((3 << 11) | 20) & 0xFu; }
#define XB_SPIN(cond, bar) do { unsigned _sp = 0; while (cond) { __builtin_amdgcn_s_sleep(1); \
    if ((++_sp & 255u) == 0u) { if (xb_ld(&(bar)[XB_TMO])) break; if (_sp > XB_SPIN_CAP) { atomicAdd(&(bar)[XB_TMO], 1u); break; } } } } while (0)
struct XcdBarrier { unsigned* bar; unsigned x; volatile LAS unsigned* st; };
__device__ __forceinline__ XcdBarrier xcd_barrier_post(unsigned* bar, volatile LAS unsigned* st) {
    XcdBarrier b; b.bar = bar; b.x = xb_xcc_id(); b.st = st;
    if (threadIdx.x == 0) (void)xb_add(&bar[XB_XCNT(b.x)], 1u);
    return b;
}
__device__ __forceinline__ void xcd_barrier_complete(unsigned* bar, unsigned x, unsigned& nloc, unsigned& nx) {
    const unsigned G = gridDim.x * gridDim.y * gridDim.z;
    unsigned sum, cnt, mine, sp = 0u;
    for (;;) {
        sum = 0u; cnt = 0u; mine = 0u;
#pragma unroll
        for (unsigned j = 0; j < 16; ++j) { const unsigned c = xb_ld(&bar[XB_XCNT(j)]); sum += c; cnt += (c > 0u) ? 1u : 0u; mine = (j == x) ? c : mine; }
        if (sum == G) break;
        __builtin_amdgcn_s_sleep(1);
        if ((++sp & 255u) == 0u) { if (xb_ld(&bar[XB_TMO])) break; if (sp > XB_SPIN_CAP) { atomicAdd(&bar[XB_TMO], 1u); break; } }
    }
    nloc = mine > 0u ? mine : 1u; nx = cnt > 0u ? cnt : 1u;
}
__device__ __forceinline__ void xcd_barrier(const XcdBarrier& b, int tid) {
    asm volatile("s_waitcnt vmcnt(0)" ::: "memory");
    __syncthreads();
    if (tid == 0) {
        unsigned* bar = b.bar;
        __builtin_amdgcn_s_waitcnt(0);
        unsigned nloc = b.st[0], nx = b.st[1];
        if (nloc == 0u) { xcd_barrier_complete(bar, b.x, nloc, nx); b.st[0] = nloc; b.st[1] = nx; }
        const unsigned old = xb_add(&bar[XB_XSUB(b.x)], 1u);
        const unsigned gen = old / nloc;
        if (old + 1u == (gen + 1u) * nloc) {
            __builtin_amdgcn_fence(__ATOMIC_RELEASE, "agent");
            asm volatile("s_waitcnt vmcnt(0)" ::: "memory");
            const unsigned og = xb_add(&bar[XB_TOP], 1u);
            const unsigned tg = og / nx;
            if (og + 1u == (tg + 1u) * nx) xb_add(&bar[XB_TOPGEN], 1u);
            else XB_SPIN(xb_ld(&bar[XB_TOPGEN]) == tg, bar);
            __builtin_amdgcn_fence(__ATOMIC_ACQUIRE, "agent");
            xb_add(&bar[XB_XGEN(b.x)], 1u);
            asm volatile("s_waitcnt vmcnt(0)" ::: "memory");
        } else {
            XB_SPIN(xb_ld(&bar[XB_XGEN(b.x)]) == gen, bar);
            __builtin_amdgcn_fence(__ATOMIC_ACQUIRE, "agent");
            asm volatile("s_waitcnt vmcnt(0)" ::: "memory");
        }
    }
    __syncthreads();
}

#ifndef MK_MFMA_ATT
#define MK_MFMA_ATT 1
#endif
#ifndef MK_MFMA_GLA
#define MK_MFMA_GLA 1
#endif
#ifndef MK_SPLITK
#define MK_SPLITK 0
#endif
constexpr int NWV = 8, NTH = 512;

template <bool UPMAP = false>
__device__ __forceinline__ void transpose_item(const float* W, int K, int N, bf16* WT, LAS float* scr, int item, int lane) {
    const int nblk = N / 32, kb = item / nblk, nb = item % nblk, k0 = 64 * kb, n0 = 32 * nb;
    const int nd0 = UPMAP ? (n0 < DFF ? 256 * (n0 >> 7) + (n0 & 127) : 256 * ((n0 - DFF) >> 7) + 128 + ((n0 - DFF) & 127)) : n0;
    float wv[32];
#pragma unroll
    for (int i = 0; i < 32; ++i) wv[i] = __builtin_nontemporal_load(W + (size_t)(k0 + 2 * i + (lane >> 5)) * N + n0 + (lane & 31));
#pragma unroll
    for (int i = 0; i < 32; ++i) scr[(2 * i + (lane >> 5)) * 33 + (lane & 31)] = wv[i];
    LDS_WAIT(); asm volatile("" ::: "memory");
    const int c = lane & 7;
#pragma unroll
    for (int j = 0; j < 4; ++j) { const int n = (lane >> 3) + 8 * j; const LAS float* s = scr + (8 * c) * 33 + n;
        v4u o; o.x = pk2(s[0 * 33], s[1 * 33]); o.y = pk2(s[2 * 33], s[3 * 33]); o.z = pk2(s[4 * 33], s[5 * 33]); o.w = pk2(s[6 * 33], s[7 * 33]);
        *(v4u*)(WT + (size_t)(nd0 + n) * K + k0 + 8 * c) = o; }
    LDS_WAIT(); asm volatile("" ::: "memory");
}

struct Args { const float* in[N_INPUTS]; float* out; unsigned char* ws; int ph_lo, ph_hi, use_bar, pad; };

__device__ __forceinline__ void pro0_phase(const Args& a, LAS unsigned char* lds, int tid, int lane, int wave, int bid, int G) {
    unsigned char* ws = a.ws;
    const int gw = bid * NWV + wave, NGW = G * NWV;
    LAS float* scr = (LAS float*)(lds + wave * 16384);
    constexpr int IT_IN = (DM / 64) * (NIN / 32), IT_OUT = (DM / 64) * (DM / 32), IT_UP = (DM / 64) * (2 * DFF / 32), IT_DN = (DFF / 64) * (DM / 32), IT_Q = (384 / 64) * (NQC / 32), IT_KV = (256 / 64) * (NKV / 32);
    constexpr int IT_L = IT_IN + IT_OUT + IT_UP + IT_DN + IT_Q + IT_KV;
    for (int it = gw; it < DEPTH * IT_L; it += NGW) {
        const int l = it / IT_L; int r = it % IT_L;
        if (r < IT_IN) { transpose_item(a.in[I_WIN] + (size_t)l * DM * NIN, DM, NIN, (bf16*)(ws + WS_WIN + l * SZ_WIN), scr, r, lane); continue; } r -= IT_IN;
        if (r < IT_OUT) { transpose_item(a.in[I_WOUT] + (size_t)l * DM * DM, DM, DM, (bf16*)(ws + WS_WOUT + l * SZ_WOUT), scr, r, lane); continue; } r -= IT_OUT;
        if (r < IT_UP) { transpose_item<true>(a.in[I_WUP] + (size_t)l * DM * 2 * DFF, DM, 2 * DFF, (bf16*)(ws + WS_WUP + l * SZ_WUP), scr, r, lane); continue; } r -= IT_UP;
        if (r < IT_DN) { transpose_item(a.in[I_WDOWN] + (size_t)l * DFF * DM, DFF, DM, (bf16*)(ws + WS_WDN + l * SZ_WDN), scr, r, lane); continue; } r -= IT_DN;
        if (r < IT_Q) { transpose_item(a.in[I_CQUP] + (size_t)l * 384 * NQC, 384, NQC, (bf16*)(ws + WS_WQ + l * SZ_WQ), scr, r, lane); continue; } r -= IT_Q;
        transpose_item(a.in[I_CKVUP] + (size_t)l * 256 * NKV, 256, NKV, (bf16*)(ws + WS_WKV + l * SZ_WKV), scr, r, lane);
    }
    const int gt = bid * NTH + tid, NGT = G * NTH;
    for (int i = gt; i < DEPTH * (NINP - NIN) * DM / 8; i += NGT) { const int l = i / ((NINP - NIN) * DM / 8), r = i % ((NINP - NIN) * DM / 8); *(v4u*)(ws + WS_WIN + l * SZ_WIN + (size_t)NIN * DM * 2 + (size_t)r * 16) = (v4u){0u, 0u, 0u, 0u}; }
    for (int i = gt; i < DEPTH * (NQCP - NQC) * 384 / 8; i += NGT) { const int l = i / ((NQCP - NQC) * 384 / 8), r = i % ((NQCP - NQC) * 384 / 8); *(v4u*)(ws + WS_WQ + l * SZ_WQ + (size_t)NQC * 384 * 2 + (size_t)r * 16) = (v4u){0u, 0u, 0u, 0u}; }
    for (int i = gt; i < DEPTH * (NKVP - NKV) * 256 / 8; i += NGT) { const int l = i / ((NKVP - NKV) * 256 / 8), r = i % ((NKVP - NKV) * 256 / 8); *(v4u*)(ws + WS_WKV + l * SZ_WKV + (size_t)NKV * 256 * 2 + (size_t)r * 16) = (v4u){0u, 0u, 0u, 0u}; }
    {
        LAS float* sc = (LAS float*)lds;
        __syncthreads();
        for (int it = bid; it < DEPTH * 24 * 8; it += G) {
            const int l = it / 192, cb = (it / 8) % 24, ks = it % 8;
            __syncthreads();
            for (int e = tid; e < 5 * 256; e += NTH) { const int mi = e >> 8, k = ks * 256 + (e & 255); const float cv = mi == 0 ? a.in[I_CCTX][k] : a.in[I_C][(mi - 1) * DM + k]; sc[e] = cv / (1.f + expf(-cv)); }
            __syncthreads();
            const float* wp = a.in[I_ADAW] + ((size_t)l * DM + ks * 256) * (6 * DM) + cb * 512 + tid;
            float s0 = 0.f, s1 = 0.f, s2 = 0.f, s3 = 0.f, s4 = 0.f;
#pragma unroll 8
            for (int k = 0; k < 256; ++k) { const float w = __builtin_nontemporal_load(wp + (size_t)k * (6 * DM)); s0 += sc[k] * w; s1 += sc[256 + k] * w; s2 += sc[512 + k] * w; s3 += sc[768 + k] * w; s4 += sc[1024 + k] * w; }
            float* mp = (float*)(ws + WS_MODP) + ((size_t)ks * DEPTH + l) * 5 * 6 * DM + cb * 512 + tid;
            mp[0] = s0; mp[6 * DM] = s1; mp[2 * 6 * DM] = s2; mp[3 * 6 * DM] = s3; mp[4 * 6 * DM] = s4;
        }
        __syncthreads();
    }
    { const float* s = a.in[I_CAK]; bf16* d = (bf16*)(ws + WS_CAK); for (int i = gt; i < NDB * DEPTH * PAST * 512; i += NGT) d[i] = (bf16)f2bf(s[i]); }
    { const float* s = a.in[I_CAV]; bf16* d = (bf16*)(ws + WS_CAV); for (int i = gt; i < NDB * DEPTH * PAST * 512; i += NGT) d[i] = (bf16)f2bf(s[i]); }
    { const float* s = a.in[I_CCKR]; bf16* d = (bf16*)(ws + WS_CKRX); for (int i = gt; i < NDB * DEPTH * PAST * 32; i += NGT) d[i] = (bf16)f2bf(s[i]); }
    { const float* s = a.in[I_CCKV]; bf16* d = (bf16*)(ws + WS_CKVA);
      for (int i = gt; i < NDB * DEPTH * PAST * 256; i += NGT) { const int c = i & 255, j = (i >> 8) & 255, bl = i >> 16, b = bl >> 2, l = bl & 3; d[(((size_t)l * NDB + b) * PAST + j) * 256 + c] = (bf16)f2bf(s[i]); } }
    { float* ra = (float*)(ws + WS_RTA); float* rc = (float*)(ws + WS_RTC);
      for (int i = gt; i < DSEQ * 16; i += NGT) { const int t = i >> 4, j = i & 15; const float inv = powf(10000.f, -(float)j / 16.f); const float ar = (float)(t >> 6) * inv, ac = (float)(t & 63) * inv;
          ra[t * 64 + j] = cosf(ar); ra[t * 64 + 16 + j] = sinf(ar); ra[t * 64 + 32 + j] = cosf(ac); ra[t * 64 + 48 + j] = sinf(ac); }
      for (int i = gt; i < DSEQ * 8; i += NGT) { const int t = i >> 3, j = i & 7; const float inv = powf(10000.f, -(float)j / 8.f); const float ar = (float)(t >> 6) * inv, ac = (float)(t & 63) * inv;
          rc[t * 32 + j] = cosf(ar); rc[t * 32 + 8 + j] = sinf(ar); rc[t * 32 + 16 + j] = cosf(ac); rc[t * 32 + 24 + j] = sinf(ac); } }
    if (gt < DEPTH) { const int l = gt; float d1 = 0.f, d2 = 0.f;
        for (int i = 0; i < 64; ++i) { d1 += a.in[I_LQ1][l * 64 + i] * a.in[I_LK1][l * 64 + i]; d2 += a.in[I_LQ2][l * 64 + i] * a.in[I_LK2][l * 64 + i]; }
        const float li = 0.8f - 0.6f * expf(-0.3f * (float)l);
        float* lam = (float*)(ws + WS_LAM); lam[l] = expf(d1) - expf(d2) + li; lam[4 + l] = li; }
}

__device__ __forceinline__ void modfin_phase(const Args& a, int gt, int NGT) {
    const float* mp = (const float*)(a.ws + WS_MODP); float* mo = (float*)(a.ws + WS_MOD);
    for (int i = gt; i < DEPTH * 5 * 6 * DM; i += NGT) { const int l = i / (5 * 6 * DM), n = i % (6 * DM); float s = a.in[I_ADAB][l * 6 * DM + n];
#pragma unroll
        for (int ks = 0; ks < 8; ++ks) s += mp[(size_t)ks * DEPTH * 5 * 6 * DM + i];
        mo[i] = s; }
}


namespace att {
using bf16x8 = __attribute__((ext_vector_type(8))) short;
using s16x4  = __attribute__((ext_vector_type(4))) short;
using f32x16 = __attribute__((ext_vector_type(16))) float;
using u32x4  = __attribute__((ext_vector_type(4))) unsigned;
constexpr int SHM_V = 64 * 128 * 2;
#define ATT_SBAR() __builtin_amdgcn_sched_barrier(0)
#define ATT_LBAR() asm volatile("s_waitcnt lgkmcnt(0)\n\ts_barrier" ::: "memory")
__device__ __forceinline__ int crow(int r, int hi) { return (r & 3) + 8 * (r >> 2) + 4 * hi; }
__device__ __forceinline__ unsigned cvtpk(float lo, float hi) { unsigned r; asm volatile("v_cvt_pk_bf16_f32 %0, %1, %2" : "=v"(r) : "v"(lo), "v"(hi)); return r; }
__device__ __forceinline__ void partialSM(f32x16& p0, f32x16& p1, float& m_reg, float& mn, float& alpha, float C, float thr) {
  float pmax = p0[0];
#pragma unroll
  for (int r = 1; r < 16; ++r) pmax = fmaxf(pmax, p0[r]);
#pragma unroll
  for (int r = 0; r < 16; ++r) pmax = fmaxf(pmax, p1[r]);
  { auto rr = __builtin_amdgcn_permlane32_swap(__float_as_uint(pmax), __float_as_uint(pmax), false, false);
    pmax = fmaxf(__uint_as_float(rr[0]), __uint_as_float(rr[1])); }
  if (__builtin_expect(__all(pmax - m_reg <= thr), 1)) { mn = m_reg; alpha = 1.f; }
  else { mn = fmaxf(m_reg, pmax); alpha = __builtin_amdgcn_exp2f((m_reg - mn) * C); m_reg = mn; }
  const float mnC = -mn * C;
  { typedef float f32x2 __attribute__((ext_vector_type(2))); const f32x2 C2 = {C, C}, M2 = {mnC, mnC};
#pragma unroll
    for (int r = 0; r < 16; r += 2) { f32x2 v = {p0[r], p0[r + 1]}; v = __builtin_elementwise_fma(v, C2, M2); p0[r] = v.x; p0[r + 1] = v.y; }
#pragma unroll
    for (int r = 0; r < 16; r += 2) { f32x2 v = {p1[r], p1[r + 1]}; v = __builtin_elementwise_fma(v, C2, M2); p1[r] = v.x; p1[r + 1] = v.y; } }
#pragma unroll
  for (int r = 0; r < 16; ++r) p0[r] = __builtin_amdgcn_exp2f(p0[r]);
}
__device__ __forceinline__ void finishSM(f32x16& p0, f32x16& p1, float alpha, float& l_reg, bf16x8& pa0, bf16x8& pa1, bf16x8& pa2, bf16x8& pa3) {
#pragma unroll
  for (int r = 0; r < 16; ++r) p1[r] = __builtin_amdgcn_exp2f(p1[r]);
  float ps;
  { typedef float f32x2 __attribute__((ext_vector_type(2))); f32x2 s2 = {p0[0], p0[1]};
#pragma unroll
    for (int r = 2; r < 16; r += 2) s2 += (f32x2){p0[r], p0[r + 1]};
#pragma unroll
    for (int r = 0; r < 16; r += 2) s2 += (f32x2){p1[r], p1[r + 1]};
    ps = s2.x + s2.y; }
  { auto rr = __builtin_amdgcn_permlane32_swap(__float_as_uint(ps), __float_as_uint(ps), false, false);
    ps = __uint_as_float(rr[0]) + __uint_as_float(rr[1]); }
  l_reg = l_reg * alpha + ps;
#define ATT_PK4(P, BASE, OUT) do { unsigned a0 = cvtpk(P[BASE + 0], P[BASE + 1]), a1 = cvtpk(P[BASE + 2], P[BASE + 3]);   \
    unsigned b0 = cvtpk(P[BASE + 4], P[BASE + 5]), b1 = cvtpk(P[BASE + 6], P[BASE + 7]);                              \
    auto r0 = __builtin_amdgcn_permlane32_swap(a0, b0, false, false); auto r1 = __builtin_amdgcn_permlane32_swap(a1, b1, false, false); \
    u32x4 w = {r0[0], r1[0], r0[1], r1[1]}; OUT = __builtin_bit_cast(bf16x8, w); } while (0)
  ATT_PK4(p0, 0, pa0); ATT_PK4(p0, 8, pa1); ATT_PK4(p1, 0, pa2); ATT_PK4(p1, 8, pa3);
#undef ATT_PK4
}
template <int DQK>
__device__ __forceinline__ void qkt(f32x16& p0, f32x16& p1, const LAS unsigned char* Ks, const bf16x8* qr, int r32, int hi) {
  constexpr int RS = DQK * 2 + 16;
  p0 = f32x16{}; p1 = f32x16{};
#pragma unroll
  for (int d0 = 0; d0 < DQK / 16; ++d0) { const int cb = d0 * 32 + hi * 16;
    const bf16x8 b0 = *(const LAS bf16x8*)(Ks + r32 * RS + cb);
    const bf16x8 b1 = *(const LAS bf16x8*)(Ks + (32 + r32) * RS + cb);
    p0 = __builtin_amdgcn_mfma_f32_32x32x16_bf16(b0, qr[d0], p0, 0, 0, 0);
    p1 = __builtin_amdgcn_mfma_f32_32x32x16_bf16(b1, qr[d0], p1, 0, 0, 0); }
}
__device__ __forceinline__ int v_st(int k, int c) { const int kk = (k & ~0xC) | ((k & 4) << 1) | ((k & 8) >> 1); return ((kk >> 3) * 4 + (c >> 5)) * 512 + ((kk & 7) * 32 + (c & 31)) * 2; }
__device__ __forceinline__ int v_rd_base(int lane) { return ((lane & 3) << 3) | (((lane >> 2) & 3) << 6) | (((lane >> 4) & 1) << 5) | (((lane >> 5) & 1) << 8); }
constexpr int v_rd_off(int d0, int ks, int half) { return d0 * 512 + ks * 4096 + half * 2048; }
template <int OFF> __device__ __forceinline__ s16x4 tr_read(int vb) {
  s16x4 r; asm volatile("ds_read_b64_tr_b16 %0, %1 offset:%2" : "=&v"(r) : "v"(vb), "i"(OFF) : "memory"); return r;
}
template <int D0> __device__ __forceinline__ void pv_one(f32x16& od, int vb, bf16x8 pa0, bf16x8 pa1, bf16x8 pa2, bf16x8 pa3) {
  const s16x4 l0 = tr_read<v_rd_off(D0, 0, 0)>(vb), h0 = tr_read<v_rd_off(D0, 0, 1)>(vb), l1 = tr_read<v_rd_off(D0, 1, 0)>(vb), h1 = tr_read<v_rd_off(D0, 1, 1)>(vb);
  const s16x4 l2 = tr_read<v_rd_off(D0, 2, 0)>(vb), h2 = tr_read<v_rd_off(D0, 2, 1)>(vb), l3 = tr_read<v_rd_off(D0, 3, 0)>(vb), h3 = tr_read<v_rd_off(D0, 3, 1)>(vb);
  asm volatile("s_waitcnt lgkmcnt(0)" ::: "memory"); ATT_SBAR();
#define ATT_PK(L, H) (bf16x8){L[0], L[1], L[2], L[3], H[0], H[1], H[2], H[3]}
  od = __builtin_amdgcn_mfma_f32_32x32x16_bf16(pa0, ATT_PK(l0, h0), od, 0, 0, 0);
  od = __builtin_amdgcn_mfma_f32_32x32x16_bf16(pa1, ATT_PK(l1, h1), od, 0, 0, 0);
  od = __builtin_amdgcn_mfma_f32_32x32x16_bf16(pa2, ATT_PK(l2, h2), od, 0, 0, 0);
  od = __builtin_amdgcn_mfma_f32_32x32x16_bf16(pa3, ATT_PK(l3, h3), od, 0, 0, 0);
#undef ATT_PK
}
__device__ __forceinline__ void pv_d0(f32x16* o, int vb, bf16x8 pa0, bf16x8 pa1, bf16x8 pa2, bf16x8 pa3) {
  pv_one<0>(o[0], vb, pa0, pa1, pa2, pa3); pv_one<1>(o[1], vb, pa0, pa1, pa2, pa3); pv_one<2>(o[2], vb, pa0, pa1, pa2, pa3); pv_one<3>(o[3], vb, pa0, pa1, pa2, pa3);
}
__device__ __forceinline__ float bfe(bf16x8 v, int e) { return __builtin_bit_cast(float, (unsigned)(unsigned short)v[e] << 16); }
}

struct KSeg { const bf16* kn; int ldn; const bf16* kr; int ldr; const bf16* v; int ldv; int n; };

template <int DQK, int SD, bool OUTBF>
__device__ __forceinline__ void attn_mfma_unit(LAS unsigned char* lds, const bf16* Qp, int ldq, bool rot, const float* rt, int t0, const KSeg& ctx, const KSeg& lat, float scale, void* Opv, int tid,
                                               bool fin = false, float lam = 0.f, float gsc = 0.f, const float* ag = nullptr, bf16* Mx = nullptr) {
  using namespace att;
  constexpr int NF = DQK / 16, RS = DQK * 2 + 16, SHM_K = 64 * RS;
  const int wid = tid >> 6, lane = tid & 63, r32 = lane & 31, hi = lane >> 5;
  LAS unsigned char* V_lds = lds; LAS unsigned char* K_lds = lds + 2 * SHM_V;
  LAS float* wsf = (LAS float*)(lds + 2 * SHM_V + 2 * SHM_K) + wid * 64; LAS float* li_l = wsf; LAS float* al_l = wsf + 32;
  const float C = scale * 1.4426950408889634f, thr = 8.f / scale;
  float m_reg = -1e30f, l_reg = 0; f32x16 o[4] = {}; bf16x8 qr[NF];
  const bf16* Qw = Qp + (size_t)(wid * 32 + r32) * ldq + hi * 8;
#pragma unroll
  for (int d0 = 0; d0 < NF; ++d0) qr[d0] = *reinterpret_cast<const bf16x8*>(Qw + d0 * 16);
  const int sr = tid >> 4, sc = (tid & 15) * 8, vst0 = v_st(sr, sc), vst1 = v_st(32 + sr, sc);
  const int krow = tid >> 3, kch = tid & 7, xrow = tid >> 2, xch = tid & 3; const bool xld = (DQK == 96) && tid < 256;
  const int vb0 = (int)(unsigned)(uintptr_t)V_lds + v_rd_base(lane);
  const int nct = ctx.n >> 6, NT = nct + (lat.n >> 6);
  constexpr int SE = 0, SO = SD - 1;
  struct { bf16x8 vs0, vs1, kn, kx; } st[SD];
#define ATT_SLOAD(i, j) do { const int j_ = (j); const bool c_ = j_ < nct; const KSeg& S_ = c_ ? ctx : lat; const int k0_ = (c_ ? j_ : j_ - nct) * 64; \
    st[i].vs0 = *reinterpret_cast<const bf16x8*>(S_.v + (size_t)(k0_ + sr) * S_.ldv + sc); st[i].vs1 = *reinterpret_cast<const bf16x8*>(S_.v + (size_t)(k0_ + 32 + sr) * S_.ldv + sc); \
    st[i].kn = *reinterpret_cast<const bf16x8*>(S_.kn + (size_t)(k0_ + krow) * S_.ldn + kch * 8); \
    if (xld) st[i].kx = *reinterpret_cast<const bf16x8*>(S_.kr + (size_t)(k0_ + xrow) * S_.ldr + xch * 8); } while (0)
#define ATT_SWRITE(b, i) do { *(LAS bf16x8*)(V_lds + (b) * SHM_V + vst0) = st[i].vs0; *(LAS bf16x8*)(V_lds + (b) * SHM_V + vst1) = st[i].vs1; \
    *(LAS bf16x8*)(K_lds + (b) * SHM_K + krow * RS + kch * 16) = st[i].kn; \
    if (xld) *(LAS bf16x8*)(K_lds + (b) * SHM_K + xrow * RS + 128 + xch * 16) = st[i].kx; } while (0)
#define ATT_SWAIT() do { if constexpr (SD == 2) asm volatile("s_waitcnt vmcnt(3)" ::: "memory"); else asm volatile("s_waitcnt vmcnt(0)" ::: "memory"); } while (0)
#define ATT_RESC(a) do { if (__any((a) < 1.f)) { if (hi == 0) al_l[r32] = (a); asm volatile("s_waitcnt lgkmcnt(0)" ::: "memory"); \
    _Pragma("unroll") for (int d = 0; d < 4; ++d) _Pragma("unroll") for (int r = 0; r < 16; ++r) o[d][r] *= al_l[crow(r, hi)]; } } while (0)
#define ATT_ROTQ() do { const int t_ = t0 + wid * 32 + r32; \
    if constexpr (DQK == 64) { const float* tb = rt + (size_t)t_ * 64 + hi * 8; u32x4 w0, w1, w2, w3; \
        float y0[8], y1[8], y2[8], y3[8]; \
        _Pragma("unroll") for (int e = 0; e < 8; ++e) { const float cr = tb[e], sn = tb[16 + e], cc = tb[32 + e], sc2 = tb[48 + e]; \
            const float x0 = bfe(qr[0], e), x1 = bfe(qr[1], e), x2 = bfe(qr[2], e), x3 = bfe(qr[3], e); \
            y0[e] = x0 * cr - x1 * sn; y1[e] = x1 * cr + x0 * sn; y2[e] = x2 * cc - x3 * sc2; y3[e] = x3 * cc + x2 * sc2; } \
        w0 = (u32x4){cvtpk(y0[0], y0[1]), cvtpk(y0[2], y0[3]), cvtpk(y0[4], y0[5]), cvtpk(y0[6], y0[7])}; w1 = (u32x4){cvtpk(y1[0], y1[1]), cvtpk(y1[2], y1[3]), cvtpk(y1[4], y1[5]), cvtpk(y1[6], y1[7])}; \
        w2 = (u32x4){cvtpk(y2[0], y2[1]), cvtpk(y2[2], y2[3]), cvtpk(y2[4], y2[5]), cvtpk(y2[6], y2[7])}; w3 = (u32x4){cvtpk(y3[0], y3[1]), cvtpk(y3[2], y3[3]), cvtpk(y3[4], y3[5]), cvtpk(y3[6], y3[7])}; \
        qr[0] = __builtin_bit_cast(bf16x8, w0); qr[1] = __builtin_bit_cast(bf16x8, w1); qr[2] = __builtin_bit_cast(bf16x8, w2); qr[3] = __builtin_bit_cast(bf16x8, w3); \
    } else { const float* tb = rt + (size_t)t_ * 32; const float sg = hi ? 1.f : -1.f; \
        const u32x4 a4 = __builtin_bit_cast(u32x4, qr[NF - 2]), a5 = __builtin_bit_cast(u32x4, qr[NF - 1]); u32x4 p4, p5; \
        _Pragma("unroll") for (int i = 0; i < 4; ++i) { p4[i] = (unsigned)__shfl_xor((int)a4[i], 32); p5[i] = (unsigned)__shfl_xor((int)a5[i], 32); } \
        const bf16x8 q4 = __builtin_bit_cast(bf16x8, p4), q5 = __builtin_bit_cast(bf16x8, p5); float y4[8], y5[8]; \
        _Pragma("unroll") for (int e = 0; e < 8; ++e) { const float cr = tb[e], sn = tb[8 + e], cc = tb[16 + e], sc2 = tb[24 + e]; \
            y4[e] = bfe(qr[NF - 2], e) * cr + sg * bfe(q4, e) * sn; y5[e] = bfe(qr[NF - 1], e) * cc + sg * bfe(q5, e) * sc2; } \
        const u32x4 w4 = {cvtpk(y4[0], y4[1]), cvtpk(y4[2], y4[3]), cvtpk(y4[4], y4[5]), cvtpk(y4[6], y4[7])}, w5 = {cvtpk(y5[0], y5[1]), cvtpk(y5[2], y5[3]), cvtpk(y5[4], y5[5]), cvtpk(y5[6], y5[7])}; \
        qr[NF - 2] = __builtin_bit_cast(bf16x8, w4); qr[NF - 1] = __builtin_bit_cast(bf16x8, w5); } } while (0)
  f32x16 pA0, pA1, pB0, pB1; float mnA, mnB, alA, alB; bf16x8 pa0, pa1, pa2, pa3;
  ATT_SLOAD(SE, 0); asm volatile("s_waitcnt vmcnt(0)" ::: "memory"); ATT_SWRITE(0, SE); ATT_LBAR();
  qkt<DQK>(pA0, pA1, K_lds, qr, r32, hi); partialSM(pA0, pA1, m_reg, mnA, alA, C, thr);
  ATT_SLOAD(SO, 1); if constexpr (SD == 2) { if (2 < NT) ATT_SLOAD(SE, 2); }
  ATT_SWAIT(); ATT_SWRITE(1, SO); ATT_LBAR();
  for (int j = 1; j + 1 < NT; j += 2) {
    ATT_SBAR(); qkt<DQK>(pB0, pB1, K_lds + SHM_K, qr, r32, hi);
    finishSM(pA0, pA1, alA, l_reg, pa0, pa1, pa2, pa3); ATT_SBAR();
    ATT_SLOAD(SO, j + SD); ATT_SBAR();
    pv_d0(o, vb0, pa0, pa1, pa2, pa3); partialSM(pB0, pB1, m_reg, mnB, alB, C, thr);
    ATT_LBAR(); ATT_SWAIT(); ATT_SWRITE(0, SE);
    ATT_RESC(alB); ATT_LBAR();
    if (rot && j + 1 == nct) ATT_ROTQ();
    ATT_SBAR(); qkt<DQK>(pA0, pA1, K_lds, qr, r32, hi);
    finishSM(pB0, pB1, alB, l_reg, pa0, pa1, pa2, pa3); ATT_SBAR();
    if (SD == 1 || j + 3 < NT) ATT_SLOAD(SE, j + 1 + SD); ATT_SBAR();
    pv_d0(o, vb0 + SHM_V, pa0, pa1, pa2, pa3); partialSM(pA0, pA1, m_reg, mnA, alA, C, thr);
    ATT_LBAR(); ATT_SWAIT(); ATT_SWRITE(1, SO);
    ATT_RESC(alA); ATT_LBAR();
  }
  ATT_SBAR(); qkt<DQK>(pB0, pB1, K_lds + SHM_K, qr, r32, hi);
  finishSM(pA0, pA1, alA, l_reg, pa0, pa1, pa2, pa3); ATT_SBAR();
  pv_d0(o, vb0, pa0, pa1, pa2, pa3); partialSM(pB0, pB1, m_reg, mnB, alB, C, thr);
  ATT_LBAR(); ATT_RESC(alB);
  finishSM(pB0, pB1, alB, l_reg, pa0, pa1, pa2, pa3); ATT_SBAR();
  pv_d0(o, vb0 + SHM_V, pa0, pa1, pa2, pa3);
  if (hi == 0) li_l[r32] = l_reg; asm volatile("s_waitcnt lgkmcnt(0)" ::: "memory");
  float rli[16];
#pragma unroll
  for (int r = 0; r < 16; ++r) rli[r] = __builtin_amdgcn_rcpf(li_l[crow(r, hi)]);
  if constexpr (OUTBF) { bf16* Ow = (bf16*)Opv + (size_t)(wid * 32) * DM;
#pragma unroll
    for (int r = 0; r < 16; ++r) { const int orow = crow(r, hi);
#pragma unroll
      for (int d0 = 0; d0 < 4; ++d0) Ow[(size_t)orow * DM + d0 * 32 + r32] = (bf16)f2bf(o[d0][r] * rli[r]); }
  } else { float* Ow = (float*)Opv + (size_t)(wid * 32) * NOATT;
    if (!fin) {
#pragma unroll
      for (int r = 0; r < 16; ++r) { const int orow = crow(r, hi);
#pragma unroll
        for (int d0 = 0; d0 < 4; ++d0) Ow[(size_t)orow * NOATT + d0 * 32 + r32] = o[d0][r] * rli[r]; }
    } else {
      bf16* Mw = Mx + (size_t)(wid * 32) * DM; float gv[4];
#pragma unroll
      for (int d0 = 0; d0 < 4; ++d0) gv[d0] = ag[d0 * 32 + r32] * gsc;
#pragma unroll
      for (int r = 0; r < 16; ++r) { const int orow = crow(r, hi); float v[4]; float ss = 0.f;
#pragma unroll
        for (int d0 = 0; d0 < 4; ++d0) { v[d0] = Ow[(size_t)orow * NOATT + d0 * 32 + r32] - lam * (o[d0][r] * rli[r]); ss += v[d0] * v[d0]; }
        ss += __shfl_xor(ss, 1); ss += __shfl_xor(ss, 2); ss += __shfl_xor(ss, 4); ss += __shfl_xor(ss, 8); ss += __shfl_xor(ss, 16);
        const float rs = 1.0f / sqrtf(ss * (1.f / 128.f) + EPS);
#pragma unroll
        for (int d0 = 0; d0 < 4; ++d0) Mw[(size_t)orow * DM + d0 * 32 + r32] = (bf16)f2bf(v[d0] * rs * gv[d0]); } } }
  __syncthreads();
#undef ATT_SLOAD
#undef ATT_SWRITE
#undef ATT_SWAIT
#undef ATT_RESC
#undef ATT_ROTQ
}

__device__ __forceinline__ void norm0_phase(const float* xp, const float* xs_off, const float* gm, bf16* H, float* ssq, int gw, int NGW, int lane) {
    for (int m = gw; m < M; m += NGW) {
        const float* xr = (m < MP ? xp : xs_off) + (size_t)m * DM;
        const int mi = m < MP ? 0 : 1 + (m - MP) / DSEQ; const float* g = gm + (size_t)mi * DM;
        f32x4 v[8]; float s = 0.f;
#pragma unroll
        for (int j = 0; j < 8; ++j) { v[j] = ((const f32x4*)xr)[lane + 64 * j]; s += (v[j].x * v[j].x + v[j].y * v[j].y) + (v[j].z * v[j].z + v[j].w * v[j].w); }
        s = wave_sum(s); if (lane < 32) ssq[(size_t)m * 32 + lane] = lane == 0 ? s : 0.f;
#pragma unroll
        for (int j = 0; j < 8; ++j) { const int c = (lane + 64 * j) * 4; const f32x4 y = v[j] * *(const f32x4*)(g + c); v2u o; o.x = pk2(y.x, y.y); o.y = pk2(y.z, y.w); *(v2u*)(H + (size_t)m * DM + c) = o; }
    }
}
__device__ __forceinline__ void pro2_phase(const Args& a, LAS unsigned char* lds, int tid, int bid, int G, int gt, int NGT) {
    using att::bf16x8; using att::f32x16; using att::crow;
    unsigned char* ws = a.ws; const float* MOD = (const float*)(ws + WS_MOD); float* GM = (float*)(ws + WS_GM);
    for (int i = gt; i < DEPTH * 2 * 5 * DM; i += NGT) { const int c = i % DM, mi = (i / DM) % 5, w = (i / (5 * DM)) & 1, l = i / (2 * 5 * DM);
        const float g = a.in[w ? I_N2G : I_N1G][l * DM + c]; GM[i] = g * (1.f + MOD[((size_t)(l * 5 + mi) * 6 + (w ? 4 : 1)) * DM + c]); }
    const int wave = tid >> 6, lane = tid & 63, r32 = lane & 31, hi = lane >> 5;
    LAS bf16* T = (LAS bf16*)lds;
#pragma unroll 1
    for (int kind = 0; kind < 2; ++kind) {
        __syncthreads();
        for (int e = tid; e < DEPTH * 5 * DM; e += NTH) { const int l = e / (5 * DM), mi = (e / DM) % 5, k = e % DM; T[e] = (bf16)f2bf(MOD[((size_t)(l * 5 + mi) * 6 + (kind ? 3 : 0)) * DM + k]); }
        __syncthreads();
        const int ld = kind ? 2 * DFF : NINP, items_l = ld / 32;
        for (int it = bid * NWV + wave; it < DEPTH * items_l; it += G * NWV) { const int l = it / items_l, rb = it % items_l;
            const bf16* Wr = (kind ? (const bf16*)(ws + WS_WUP + l * SZ_WUP) : (const bf16*)(ws + WS_WIN + l * SZ_WIN)) + (size_t)(rb * 32 + r32) * DM + hi * 8;
            const LAS bf16* Tb = T + (size_t)(l * 5 + (r32 < 5 ? r32 : 4)) * DM + hi * 8;
            f32x16 acc = {};
#pragma unroll 1
            for (int ks = 0; ks < DM / 16; ks += 8) { bf16x8 af[8];
#pragma unroll
                for (int j = 0; j < 8; ++j) af[j] = *reinterpret_cast<const bf16x8*>(Wr + (ks + j) * 16);
#pragma unroll
                for (int j = 0; j < 8; ++j) { bf16x8 bfv = *(const LAS bf16x8*)(Tb + (ks + j) * 16); if (r32 >= 5) bfv = (bf16x8){0, 0, 0, 0, 0, 0, 0, 0};
                    acc = __builtin_amdgcn_mfma_f32_32x32x16_bf16(af[j], bfv, acc, 0, 0, 0); } }
            if (r32 < 5) { float* dst = (kind ? (float*)(ws + WS_SHWU) + (size_t)l * 5 * 2 * DFF : (float*)(ws + WS_SHWI) + (size_t)l * 5 * NINP) + (size_t)r32 * ld + rb * 32;
#pragma unroll
                for (int r = 0; r < 16; ++r) dst[crow(r, hi)] = acc[r]; }
        }
    }
    __syncthreads();
}
__device__ __forceinline__ void final_norm_phase(const float* X, const float* g, float* out, int gw, int NGW, int lane) {
    for (int m = gw; m < M; m += NGW) {
        const float* xr = X + (size_t)m * DM; f32x4 v[8]; float s = 0.f;
#pragma unroll
        for (int j = 0; j < 8; ++j) { v[j] = ((const f32x4*)xr)[lane + 64 * j]; s += (v[j].x * v[j].x + v[j].y * v[j].y) + (v[j].z * v[j].z + v[j].w * v[j].w); }
        const float rstd = 1.0f / sqrtf(wave_sum(s) * (1.f / DM) + EPS);
#pragma unroll
        for (int j = 0; j < 8; ++j) { const int c = (lane + 64 * j) * 4; *(f32x4*)(out + (size_t)m * DM + c) = v[j] * rstd * *(const f32x4*)(g + c); }
    }
}

__device__ __forceinline__ void post_phase(const Args& a, int l, int gw, int NGW, int lane) {
    using att::bf16x8; using att::bfe; using att::cvtpk; using att::u32x4;
    unsigned char* ws = a.ws;
    const bf16* P = (const bf16*)(ws + WS_P); bf16* KRA = (bf16*)(ws + WS_KRA); bf16* KRC = (bf16*)(ws + WS_KRC); bf16* CQN = (bf16*)(ws + WS_CQN); bf16* CKVN = (bf16*)(ws + WS_CKVN);
    const float* RTA = (const float*)(ws + WS_RTA); const float* RTC = (const float*)(ws + WS_RTC);
    const float* gq = a.in[I_CQG] + l * 384; const float* gkv = a.in[I_CKVG] + l * 256;
    for (int m = gw; m < M; m += NGW) {
        const bf16* pr = P + (size_t)m * NINP;
        float xq[8], xk[8]; float sq = 0.f, sk = 0.f;
        if (lane < 48) { const bf16x8 v = *reinterpret_cast<const bf16x8*>(pr + C_CQ + lane * 8);
#pragma unroll
            for (int i = 0; i < 8; ++i) { xq[i] = bfe(v, i); sq += xq[i] * xq[i]; } }
        if (lane < 32) { const bf16x8 v = *reinterpret_cast<const bf16x8*>(pr + C_CKV + lane * 8);
#pragma unroll
            for (int i = 0; i < 8; ++i) { xk[i] = bfe(v, i); sk += xk[i] * xk[i]; } }
        const float rq = 1.0f / sqrtf(wave_sum(sq) * (1.f / 384.f) + EPS), rk = 1.0f / sqrtf(wave_sum(sk) * (1.f / 256.f) + EPS);
        if (lane < 48) { const f32x4 g0 = *(const f32x4*)(gq + lane * 8), g1 = *(const f32x4*)(gq + lane * 8 + 4);
            *(u32x4*)(CQN + (size_t)m * 384 + lane * 8) = (u32x4){cvtpk(xq[0] * rq * g0.x, xq[1] * rq * g0.y), cvtpk(xq[2] * rq * g0.z, xq[3] * rq * g0.w), cvtpk(xq[4] * rq * g1.x, xq[5] * rq * g1.y), cvtpk(xq[6] * rq * g1.z, xq[7] * rq * g1.w)}; }
        if (lane < 32) { const f32x4 g0 = *(const f32x4*)(gkv + lane * 8), g1 = *(const f32x4*)(gkv + lane * 8 + 4);
            const f32x4 y0 = {xk[0] * rk * g0.x, xk[1] * rk * g0.y, xk[2] * rk * g0.z, xk[3] * rk * g0.w}, y1 = {xk[4] * rk * g1.x, xk[5] * rk * g1.y, xk[6] * rk * g1.z, xk[7] * rk * g1.w};
            *(u32x4*)(CKVN + (size_t)m * 256 + lane * 8) = (u32x4){cvtpk(y0.x, y0.y), cvtpk(y0.z, y0.w), cvtpk(y1.x, y1.y), cvtpk(y1.z, y1.w)};
            if (m < MP) { float* o = a.out + O_CKV + (((size_t)(m / SEQ) * DEPTH + l) * SEQ + (m % SEQ)) * 256 + lane * 8; *(f32x4*)o = y0; *(f32x4*)(o + 4) = y1; } }
        if (m >= MP) { const int ms = m - MP, t = ms % DSEQ;
            if (lane < 34) { const bool isa = lane < 32; const int hh = isa ? (lane >> 1) & 1 : lane - 32;
                const int base = isa ? (lane >> 2) * 64 + hh * 32 + (lane & 1) * 8 : hh * 16, dist = isa ? 16 : 8;
                const bf16* src = pr + (isa ? C_AK : C_CKR) + base; const float* tb = isa ? RTA + (size_t)t * 64 + hh * 32 + (lane & 1) * 8 : RTC + (size_t)t * 32 + hh * 16;
                const bf16x8 v0 = *reinterpret_cast<const bf16x8*>(src), v1 = *reinterpret_cast<const bf16x8*>(src + dist);
                const f32x4 c0 = *(const f32x4*)(tb), c1 = *(const f32x4*)(tb + 4), s0 = *(const f32x4*)(tb + dist), s1 = *(const f32x4*)(tb + dist + 4);
                float y0[8], y1[8];
#pragma unroll
                for (int i = 0; i < 8; ++i) { const float cs = i < 4 ? c0[i & 3] : c1[i & 3], sn = i < 4 ? s0[i & 3] : s1[i & 3]; const float x0 = bfe(v0, i), x1 = bfe(v1, i); y0[i] = x0 * cs - x1 * sn; y1[i] = x1 * cs + x0 * sn; }
                bf16* dst = isa ? KRA + (size_t)ms * 512 + base : KRC + (size_t)ms * 32 + base;
                *(u32x4*)dst = (u32x4){cvtpk(y0[0], y0[1]), cvtpk(y0[2], y0[3]), cvtpk(y0[4], y0[5]), cvtpk(y0[6], y0[7])};
                *(u32x4*)(dst + dist) = (u32x4){cvtpk(y1[0], y1[1]), cvtpk(y1[2], y1[3]), cvtpk(y1[4], y1[5]), cvtpk(y1[6], y1[7])}; }
        } else { const size_t ro = ((size_t)(m / SEQ) * DEPTH + l) * SEQ + (m % SEQ);
            { const bf16x8 v = *reinterpret_cast<const bf16x8*>(pr + C_AK + lane * 8); float* o = a.out + O_AK + ro * 512 + lane * 8;
              *(f32x4*)o = (f32x4){bfe(v, 0), bfe(v, 1), bfe(v, 2), bfe(v, 3)}; *(f32x4*)(o + 4) = (f32x4){bfe(v, 4), bfe(v, 5), bfe(v, 6), bfe(v, 7)}; }
            { const bf16x8 v = *reinterpret_cast<const bf16x8*>(pr + C_AV + lane * 8); float* o = a.out + O_AV + ro * 512 + lane * 8;
              *(f32x4*)o = (f32x4){bfe(v, 0), bfe(v, 1), bfe(v, 2), bfe(v, 3)}; *(f32x4*)(o + 4) = (f32x4){bfe(v, 4), bfe(v, 5), bfe(v, 6), bfe(v, 7)}; }
            if (lane < 4) { const bf16x8 v = *reinterpret_cast<const bf16x8*>(pr + C_CKR + lane * 8); float* o = a.out + O_CKR + ro * 32 + lane * 8;
              *(f32x4*)o = (f32x4){bfe(v, 0), bfe(v, 1), bfe(v, 2), bfe(v, 3)}; *(f32x4*)(o + 4) = (f32x4){bfe(v, 4), bfe(v, 5), bfe(v, 6), bfe(v, 7)}; } }
    }
}


constexpr int NCHUNK = M / 64, GLA_UNITS = NCHUNK * 6;
constexpr int TS = 144;

__device__ __forceinline__ void gla_g1_unit(const Args& a, int l, int unit, LAS unsigned char* lds, int tid) {
    using namespace att;
    unsigned char* ws = a.ws; const bf16* P = (const bf16*)(ws + WS_P); bf16* QK4 = (bf16*)(ws + WS_QK4); float* U = (float*)(ws + WS_U); float* DD = (float*)(ws + WS_DD);
    const int gc = unit / 6, h = unit % 6, m0 = gc * 64;
    const int wave = tid >> 6, lane = tid & 63, r32 = lane & 31, hi = lane >> 5;
    LAS float* glr = (LAS float*)lds;
    LAS float* gw = (LAS float*)(lds + 8192);
    LAS float* gbs = (LAS float*)(lds + 16384);
    LAS float* segtot = (LAS float*)(lds + 16896);
    LAS unsigned char* KfT = lds + 20992;
    LAS unsigned char* KbT = lds + 30208;
    LAS unsigned char* Vt = lds + 39424;
    LAS float* Dl = (LAS float*)(lds + 55808);
    const float* gwt = a.in[I_BGW] + (size_t)l * 2 * 16 * 384; const float* gb = a.in[I_BGB] + l * 2 * 384;
    const int k = tid & 63, tq = tid >> 6;
    if (tid < 256) { const int t = tid >> 2, part = tid & 3; const bf16x8 v = *reinterpret_cast<const bf16x8*>(P + (size_t)(m0 + t) * NINP + C_BG + part * 8);
#pragma unroll
        for (int i = 0; i < 8; ++i) glr[t * 32 + part * 8 + i] = bfe(v, i); }
#pragma unroll
    for (int i = 0; i < 4; ++i) { const int idx = tid + NTH * i, dr = idx >> 6, kk = idx & 63; gw[idx] = gwt[(size_t)dr * 384 + h * 64 + kk]; }
    if (tid < 128) gbs[tid] = gb[(tid >> 6) * 384 + h * 64 + (tid & 63)];
    { const int sr = tid >> 4, sc = (tid & 15) * 8;
      const bf16x8 v0 = *reinterpret_cast<const bf16x8*>(P + (size_t)(m0 + sr) * NINP + C_BV + h * 128 + sc), v1 = *reinterpret_cast<const bf16x8*>(P + (size_t)(m0 + 32 + sr) * NINP + C_BV + h * 128 + sc);
      *(LAS bf16x8*)(Vt + v_st(sr, sc)) = v0; *(LAS bf16x8*)(Vt + v_st(32 + sr, sc)) = v1; }
    bf16 qv[8], kv[8];
#pragma unroll
    for (int j = 0; j < 8; ++j) { const bf16* pr = P + (size_t)(m0 + 8 * tq + j) * NINP + h * 64 + k; qv[j] = pr[C_BQ]; kv[j] = pr[C_BK]; }
    __syncthreads();
    float bf_[8], bb_[8];
#pragma unroll
    for (int dir = 0; dir < 2; ++dir) { float wr_[16];
#pragma unroll
        for (int r = 0; r < 16; ++r) wr_[r] = gw[(dir * 16 + r) * 64 + k];
        const float bias = gbs[dir * 64 + k];
#pragma unroll
        for (int j = 0; j < 8; ++j) { const LAS float* gp = glr + (8 * tq + j) * 32 + dir * 16; float pre = bias;
#pragma unroll
            for (int r4 = 0; r4 < 4; ++r4) { const f32x4 x = *(const LAS f32x4*)(gp + 4 * r4); pre += (x.x * wr_[4 * r4] + x.y * wr_[4 * r4 + 1]) + (x.z * wr_[4 * r4 + 2] + x.w * wr_[4 * r4 + 3]); }
            const float gl = (fminf(pre, 0.f) - __logf(1.f + __expf(-fabsf(pre)))) * (1.f / 16.f);
            if (dir == 0) bf_[j] = gl; else bb_[j] = gl; } }
#pragma unroll
    for (int j = 1; j < 8; ++j) bf_[j] += bf_[j - 1];
#pragma unroll
    for (int j = 6; j >= 0; --j) bb_[j] += bb_[j + 1];
    segtot[tq * 64 + k] = bf_[7]; segtot[(8 + tq) * 64 + k] = bb_[0];
    __syncthreads();
    { float of = 0.f, ob = 0.f;
#pragma unroll
      for (int q2 = 0; q2 < 8; ++q2) { const float sf = segtot[q2 * 64 + k], sb = segtot[(8 + q2) * 64 + k]; of += q2 < tq ? sf : 0.f; ob += q2 > tq ? sb : 0.f; }
      float kf[8], kb[8];
      bf16* dst = QK4 + (size_t)(m0 + 8 * tq) * 1536 + h * 64 + k;
#pragma unroll
      for (int j = 0; j < 8; ++j) { const float bfv = bf_[j] + of, bbv = bb_[j] + ob; const float ef = __expf(bfv), eb = __expf(bbv); const float q = bf2f(qv[j]) * 0.125f, kk = bf2f(kv[j]);
          kf[j] = kk * __expf(-bfv); kb[j] = kk * __expf(-bbv);
          dst[(size_t)j * 1536] = (bf16)f2bf(q * ef); dst[(size_t)j * 1536 + 384] = (bf16)f2bf(kf[j]); dst[(size_t)j * 1536 + 768] = (bf16)f2bf(q * eb); dst[(size_t)j * 1536 + 1152] = (bf16)f2bf(kb[j]);
          if (j == 7 && tq == 7) Dl[k] = ef;
          if (j == 0 && tq == 0) Dl[64 + k] = eb; }
      *(LAS u32x4*)(KfT + k * TS + tq * 16) = (u32x4){cvtpk(kf[0], kf[1]), cvtpk(kf[2], kf[3]), cvtpk(kf[4], kf[5]), cvtpk(kf[6], kf[7])};
      *(LAS u32x4*)(KbT + k * TS + tq * 16) = (u32x4){cvtpk(kb[0], kb[1]), cvtpk(kb[2], kb[3]), cvtpk(kb[4], kb[5]), cvtpk(kb[6], kb[7])}; }
    __syncthreads();
    { const int dir = wave >> 2, vb = wave & 3; const LAS unsigned char* KT = dir ? KbT : KfT;
      const int vbase = (int)(unsigned)(uintptr_t)Vt + v_rd_base(lane) + vb * 512;
      const s16x4 l0 = tr_read<v_rd_off(0, 0, 0)>(vbase), h0 = tr_read<v_rd_off(0, 0, 1)>(vbase), l1 = tr_read<v_rd_off(0, 1, 0)>(vbase), h1 = tr_read<v_rd_off(0, 1, 1)>(vbase);
      const s16x4 l2 = tr_read<v_rd_off(0, 2, 0)>(vbase), h2 = tr_read<v_rd_off(0, 2, 1)>(vbase), l3 = tr_read<v_rd_off(0, 3, 0)>(vbase), h3 = tr_read<v_rd_off(0, 3, 1)>(vbase);
      asm volatile("s_waitcnt lgkmcnt(0)" ::: "memory");
#define GLA_PK(L, H) (bf16x8){L[0], L[1], L[2], L[3], H[0], H[1], H[2], H[3]}
      const bf16x8 vf0 = GLA_PK(l0, h0), vf1 = GLA_PK(l1, h1), vf2 = GLA_PK(l2, h2), vf3 = GLA_PK(l3, h3);
      float* Ub = U + ((size_t)unit * 2 + dir) * 8192;
#pragma unroll
      for (int rb = 0; rb < 2; ++rb) { f32x16 acc = {};
          const LAS unsigned char* ar = KT + (rb * 32 + r32) * TS + hi * 16;
          acc = __builtin_amdgcn_mfma_f32_32x32x16_bf16(vf0, *(const LAS bf16x8*)(ar), acc, 0, 0, 0);
          acc = __builtin_amdgcn_mfma_f32_32x32x16_bf16(vf1, *(const LAS bf16x8*)(ar + 32), acc, 0, 0, 0);
          acc = __builtin_amdgcn_mfma_f32_32x32x16_bf16(vf2, *(const LAS bf16x8*)(ar + 64), acc, 0, 0, 0);
          acc = __builtin_amdgcn_mfma_f32_32x32x16_bf16(vf3, *(const LAS bf16x8*)(ar + 96), acc, 0, 0, 0);
          const int kr = rb * 32 + r32; const float dk = Dl[dir * 64 + kr];
#pragma unroll
          for (int g4 = 0; g4 < 4; ++g4) *(f32x4*)(Ub + kr * 128 + vb * 32 + 8 * g4 + 4 * hi) = (f32x4){acc[4 * g4] * dk, acc[4 * g4 + 1] * dk, acc[4 * g4 + 2] * dk, acc[4 * g4 + 3] * dk}; }
      if (tid < 128) DD[(size_t)unit * 128 + tid] = Dl[tid]; }
    __syncthreads();
}

constexpr int GLA_G2_ITEMS = (NPB + NDB) * 6 * 2 * 2;
__device__ __forceinline__ void gla_g2_item(const Args& a, int l, int item, int tid) {
    unsigned char* ws = a.ws; const float* U = (const float*)(ws + WS_U); const float* DD = (const float*)(ws + WS_DD); bf16* ST = (bf16*)(ws + WS_ST);
    const int half = item & 1, dir = (item >> 1) & 1, hs = item >> 2, h = hs % 6, sq = hs / 6;
    const bool smp = sq < NDB; const int b = smp ? sq : sq - NDB, nc = smp ? DSEQ / 64 : SEQ / 64, gc0 = smp ? (MP / 64) + b * (DSEQ / 64) : b * (SEQ / 64);
    const int v = tid & 127, k0 = ((tid >> 7) + 4 * half) * 8;
    float s[8];
#pragma unroll
    for (int i = 0; i < 8; ++i) s[i] = smp ? a.in[I_STB][((((size_t)b * DEPTH + l) * 2 + dir) * 6 + h) * 8192 + (k0 + i) * 128 + v] : 0.f;
    for (int ci = 0; ci < nc; ci += 4) {
        float u[4][8], d[4][8]; size_t ub[4];
#pragma unroll
        for (int j = 0; j < 4; ++j) { const int c = dir ? nc - 1 - (ci + j) : ci + j; ub[j] = ((size_t)(gc0 + c) * 6 + h) * 2 + dir;
#pragma unroll
            for (int i = 0; i < 8; ++i) { u[j][i] = U[ub[j] * 8192 + (k0 + i) * 128 + v]; d[j][i] = DD[ub[j] * 64 + k0 + i]; } }
#pragma unroll
        for (int j = 0; j < 4; ++j) {
            v4u w; w.x = pk2(s[0], s[1]); w.y = pk2(s[2], s[3]); w.z = pk2(s[4], s[5]); w.w = pk2(s[6], s[7]);
            *(v4u*)(ST + ub[j] * 8192 + v * 64 + k0) = w;
#pragma unroll
            for (int i = 0; i < 8; ++i) s[i] = d[j][i] * s[i] + u[j][i]; }
    }
    if (!smp) {
#pragma unroll
        for (int i = 0; i < 8; ++i) a.out[O_SB + ((((size_t)b * DEPTH + l) * 2 + dir) * 6 + h) * 8192 + (k0 + i) * 128 + v] = s[i];
    }
}

__device__ __forceinline__ void gla_g3_unit(const Args& a, int l, int unit, LAS unsigned char* lds, int tid) {
    using namespace att;
    unsigned char* ws = a.ws; const bf16* P = (const bf16*)(ws + WS_P); const bf16* QK4 = (const bf16*)(ws + WS_QK4); const bf16* ST = (const bf16*)(ws + WS_ST); bf16* MIX = (bf16*)(ws + WS_MIX);
    const int gc = unit / 6, h = unit % 6, m0 = gc * 64;
    const int wave = tid >> 6, lane = tid & 63, r32 = lane & 31, hi = lane >> 5;
    LAS unsigned char* T4 = lds;
    LAS unsigned char* Vt = lds + 36864;
    LAS unsigned char* AT = lds + 53248;
    LAS float* OT = (LAS float*)(lds + 71680);
    { const int row = tid >> 3, ch = tid & 7; const bf16* src = QK4 + (size_t)(m0 + row) * 1536 + h * 64 + ch * 8;
#pragma unroll
      for (int var = 0; var < 4; ++var) *(LAS bf16x8*)(T4 + var * 9216 + row * TS + ch * 16) = *reinterpret_cast<const bf16x8*>(src + var * 384);
      const int sr = tid >> 4, sc = (tid & 15) * 8;
      const bf16x8 v0 = *reinterpret_cast<const bf16x8*>(P + (size_t)(m0 + sr) * NINP + C_BV + h * 128 + sc), v1 = *reinterpret_cast<const bf16x8*>(P + (size_t)(m0 + 32 + sr) * NINP + C_BV + h * 128 + sc);
      *(LAS bf16x8*)(Vt + v_st(sr, sc)) = v0; *(LAS bf16x8*)(Vt + v_st(32 + sr, sc)) = v1; }
    __syncthreads();
    { const int dir = wave >> 2, tb = (wave >> 1) & 1, sb = wave & 1;
      const LAS unsigned char* Qt = T4 + (dir * 2) * 9216 + (tb * 32 + r32) * TS + hi * 16; const LAS unsigned char* Kt = T4 + (dir * 2 + 1) * 9216 + (sb * 32 + r32) * TS + hi * 16;
      f32x16 acc = {};
#pragma unroll
      for (int ks = 0; ks < 4; ++ks) acc = __builtin_amdgcn_mfma_f32_32x32x16_bf16(*(const LAS bf16x8*)(Kt + ks * 32), *(const LAS bf16x8*)(Qt + ks * 32), acc, 0, 0, 0);
      const int t = tb * 32 + r32;
#pragma unroll
      for (int r = 0; r < 16; ++r) { const int s = sb * 32 + crow(r, hi); const bool keep = dir ? (s >= t) : (s <= t); acc[r] = keep ? acc[r] : 0.f; }
#pragma unroll
      for (int g = 0; g < 4; ++g) { v2u w; w.x = cvtpk(acc[4 * g], acc[4 * g + 1]); w.y = cvtpk(acc[4 * g + 2], acc[4 * g + 3]);
          *(LAS v2u*)(AT + dir * 9216 + t * TS + (sb * 32 + 8 * g + 4 * hi) * 2) = w; } }
    __syncthreads();
    { const int tb = wave >> 2, vb = wave & 3; f32x16 o = {};
      const int vbase = (int)(unsigned)(uintptr_t)Vt + v_rd_base(lane) + vb * 512;
      const s16x4 l0 = tr_read<v_rd_off(0, 0, 0)>(vbase), h0 = tr_read<v_rd_off(0, 0, 1)>(vbase), l1 = tr_read<v_rd_off(0, 1, 0)>(vbase), h1 = tr_read<v_rd_off(0, 1, 1)>(vbase);
      const s16x4 l2 = tr_read<v_rd_off(0, 2, 0)>(vbase), h2 = tr_read<v_rd_off(0, 2, 1)>(vbase), l3 = tr_read<v_rd_off(0, 3, 0)>(vbase), h3 = tr_read<v_rd_off(0, 3, 1)>(vbase);
      asm volatile("s_waitcnt lgkmcnt(0)" ::: "memory");
      const bf16x8 vf0 = GLA_PK(l0, h0), vf1 = GLA_PK(l1, h1), vf2 = GLA_PK(l2, h2), vf3 = GLA_PK(l3, h3);
#pragma unroll
      for (int dir = 0; dir < 2; ++dir) {
          const bf16* Sd = ST + (((size_t)unit) * 2 + dir) * 8192 + (size_t)(vb * 32 + r32) * 64 + hi * 8;
          const bf16x8 s0 = *reinterpret_cast<const bf16x8*>(Sd), s1 = *reinterpret_cast<const bf16x8*>(Sd + 16), s2 = *reinterpret_cast<const bf16x8*>(Sd + 32), s3 = *reinterpret_cast<const bf16x8*>(Sd + 48);
          const LAS unsigned char* Qt = T4 + (dir * 2) * 9216 + (tb * 32 + r32) * TS + hi * 16; const LAS unsigned char* At = AT + dir * 9216 + (tb * 32 + r32) * TS + hi * 16;
          o = __builtin_amdgcn_mfma_f32_32x32x16_bf16(*(const LAS bf16x8*)(Qt), s0, o, 0, 0, 0);
          o = __builtin_amdgcn_mfma_f32_32x32x16_bf16(*(const LAS bf16x8*)(Qt + 32), s1, o, 0, 0, 0);
          o = __builtin_amdgcn_mfma_f32_32x32x16_bf16(*(const LAS bf16x8*)(Qt + 64), s2, o, 0, 0, 0);
          o = __builtin_amdgcn_mfma_f32_32x32x16_bf16(*(const LAS bf16x8*)(Qt + 96), s3, o, 0, 0, 0);
          o = __builtin_amdgcn_mfma_f32_32x32x16_bf16(*(const LAS bf16x8*)(At), vf0, o, 0, 0, 0);
          o = __builtin_amdgcn_mfma_f32_32x32x16_bf16(*(const LAS bf16x8*)(At + 32), vf1, o, 0, 0, 0);
          o = __builtin_amdgcn_mfma_f32_32x32x16_bf16(*(const LAS bf16x8*)(At + 64), vf2, o, 0, 0, 0);
          o = __builtin_amdgcn_mfma_f32_32x32x16_bf16(*(const LAS bf16x8*)(At + 96), vf3, o, 0, 0, 0); }
#pragma unroll
      for (int r = 0; r < 16; ++r) OT[(tb * 32 + crow(r, hi)) * 132 + vb * 32 + r32] = o[r]; }
    __syncthreads();
    { const int t = tid >> 3, c0 = (tid & 7) * 16; const float* bg = a.in[I_BNG] + l * 128 + c0;
      f32x4 x[4]; float ss = 0.f;
#pragma unroll
      for (int i = 0; i < 4; ++i) { x[i] = *(const LAS f32x4*)(OT + t * 132 + c0 + 4 * i); ss += (x[i].x * x[i].x + x[i].y * x[i].y) + (x[i].z * x[i].z + x[i].w * x[i].w); }
      ss += __shfl_xor(ss, 1); ss += __shfl_xor(ss, 2); ss += __shfl_xor(ss, 4);
      const float rs = 1.0f / sqrtf(ss * (1.f / 128.f) + EPS);
      const bf16* rg = P + (size_t)(m0 + t) * NINP + C_BR + h * 128 + c0; const bf16x8 r0 = *reinterpret_cast<const bf16x8*>(rg), r1 = *reinterpret_cast<const bf16x8*>(rg + 8);
      float y[16];
#pragma unroll
      for (int i = 0; i < 4; ++i) { const f32x4 gv = *(const f32x4*)(bg + 4 * i); y[4 * i] = x[i].x * rs * gv.x; y[4 * i + 1] = x[i].y * rs * gv.y; y[4 * i + 2] = x[i].z * rs * gv.z; y[4 * i + 3] = x[i].w * rs * gv.w; }
#pragma unroll
      for (int i = 0; i < 8; ++i) { y[i] *= siluf(bfe(r0, i)); y[8 + i] *= siluf(bfe(r1, i)); }
      bf16* dst = MIX + (size_t)(m0 + t) * DM + 512 + h * 128 + c0;
      *(u32x4*)(dst) = (u32x4){cvtpk(y[0], y[1]), cvtpk(y[2], y[3]), cvtpk(y[4], y[5]), cvtpk(y[6], y[7])};
      *(u32x4*)(dst + 8) = (u32x4){cvtpk(y[8], y[9]), cvtpk(y[10], y[11]), cvtpk(y[12], y[13]), cvtpk(y[14], y[15])}; }
    __syncthreads();
#undef GLA_PK
}

__device__ __forceinline__ void mixer_phase(const Args& a, int l, LAS unsigned char* lds, int tid_in, int bid, int G) {
    unsigned char* ws = a.ws;
    const bf16* P = (const bf16*)(ws + WS_P); const bf16* QC = (const bf16*)(ws + WS_QC); const bf16* KVC = (const bf16*)(ws + WS_KVC); const bf16* KRA = (const bf16*)(ws + WS_KRA); const bf16* KRC = (const bf16*)(ws + WS_KRC);
    const bf16* CAK = (const bf16*)(ws + WS_CAK); const bf16* CAV = (const bf16*)(ws + WS_CAV); const bf16* CKRX = (const bf16*)(ws + WS_CKRX); const bf16* KVCTX = (const bf16*)(ws + WS_KVCTX);
    const float* RTA = (const float*)(ws + WS_RTA); const float* RTC = (const float*)(ws + WS_RTC); float* OATT = (float*)(ws + WS_OATT); bf16* MIXB = (bf16*)(ws + WS_MIX);
    const float lam = ((const float*)(ws + WS_LAM))[l], li = ((const float*)(ws + WS_LAM))[4 + l]; const float* ag = a.in[I_ANG] + l * 128;
    constexpr int NAS = 256, NCS = 384, NAP = 64, NCP = 96, NFILL = NAP + NCP + GLA_UNITS;
    const bool tuned = G == 256;
    const int per = G / 8, vb = (bid % 8) * per + bid / 8, wx = vb % per, hx = per / 2;
    const bool heavy = wx < hx; const int hidx = (vb / per) * hx + wx, lidx = (vb / per) * hx + (wx - hx);
    const int nl = G / 2;
    const int nslots = tuned ? 3 + (!heavy ? (NFILL + nl - 1) / nl : 0) : (NAS + NCS + NFILL + G - 1) / G;
    for (int sl = 0; sl < nslots; ++sl) {
        int tid = tid_in; asm volatile("" : "+v"(tid));
        int kind, u, f = -1;
        if (!tuned) { const int g = bid + sl * G; if (g >= NAS + NCS + NFILL) continue; if (g < NAS) { kind = 0; u = g; } else if (g < NAS + NCS) { kind = 1; u = g - NAS; } else { kind = 5; u = 0; f = g - NAS - NCS; } }
        else if (sl == 0) { kind = 0; u = vb; }
        else if (sl == 1) { kind = 1; u = vb; }
        else if (sl == 2) { if (heavy) { kind = 1; u = G + hidx; } else continue; }
        else { kind = 5; u = 0; f = lidx + (sl - 3) * nl; if (f >= NFILL) continue; }
        if (kind == 5) { if (f < NAP) { kind = 2; u = f; } else if (f < NAP + NCP) { kind = 3; u = f - NAP; } else { kind = 4; u = f - NAP - NCP; } }
        if (kind == 0 && u >= NAS) continue;
        if (kind == 1 && u >= NCS) continue;
        if (kind == 4) { gla_g3_unit(a, l, u, lds, tid); continue; }
        if (kind == 0 || kind == 2) {
            int b, head, qb; size_t r0;
            if (kind == 0) { b = u >> 6; head = (u >> 4) & 3; qb = u & 15; r0 = (size_t)MP + (size_t)b * DSEQ; } else { b = u >> 2; head = u & 3; qb = 0; r0 = (size_t)b * SEQ; }
#pragma unroll 1
            for (int ps = 0; ps < 2; ++ps) { const int combo = head * 2 + ps; int tid2 = tid; asm volatile("" : "+v"(tid2));
                KSeg ctx{nullptr, 0, nullptr, 0, nullptr, 0, 0}, lat;
                if (kind == 0) { ctx = KSeg{CAK + ((size_t)(b * DEPTH + l) * PAST) * 512 + combo * 64, 512, nullptr, 0, CAV + ((size_t)(b * DEPTH + l) * PAST) * 512 + head * 128, 512, PAST};
                                 lat = KSeg{KRA + ((size_t)b * DSEQ) * 512 + combo * 64, 512, nullptr, 0, P + r0 * NINP + C_AV + head * 128, NINP, DSEQ}; }
                else lat = KSeg{P + r0 * NINP + C_AK + combo * 64, NINP, nullptr, 0, P + r0 * NINP + C_AV + head * 128, NINP, SEQ};
                attn_mfma_unit<64, 2, false>(lds, P + (r0 + qb * 256) * NINP + C_AQ + combo * 64, NINP, kind == 0, RTA, qb * 256, ctx, lat, 0.125f, OATT + (r0 + qb * 256) * NOATT + head * 128, tid2,
                                             ps == 1, lam, 1.f - li, ag, MIXB + (r0 + qb * 256) * DM + head * 128); }
        } else {
            KSeg ctx{nullptr, 0, nullptr, 0, nullptr, 0, 0}, lat; const bf16* Qp; int t0 = 0; bf16* Op;
            if (kind == 1) { const int b = u / 96, h = (u >> 4) % 6, qb = u & 15; const size_t r0 = (size_t)MP + (size_t)b * DSEQ; const size_t c0 = (size_t)(l * NDB + b) * PAST;
                ctx = KSeg{KVCTX + c0 * NKVP + h * 192, NKVP, CKRX + ((size_t)(b * DEPTH + l) * PAST) * 32, 32, KVCTX + c0 * NKVP + h * 192 + 64, NKVP, PAST};
                lat = KSeg{KVC + r0 * NKVP + h * 192, NKVP, KRC + ((size_t)b * DSEQ) * 32, 32, KVC + r0 * NKVP + h * 192 + 64, NKVP, DSEQ};
                Qp = QC + (r0 + qb * 256) * NQCP + h * 96; t0 = qb * 256; Op = MIXB + (r0 + qb * 256) * DM + 1280 + h * 128; }
            else { const int b = u / 6, h = u % 6; const size_t r0 = (size_t)b * SEQ;
                lat = KSeg{KVC + r0 * NKVP + h * 192, NKVP, P + r0 * NINP + C_CKR, NINP, KVC + r0 * NKVP + h * 192 + 64, NKVP, SEQ};
                Qp = QC + r0 * NQCP + h * 96; Op = MIXB + r0 * DM + 1280 + h * 128; }
            attn_mfma_unit<96, 1, true>(lds, Qp, NQCP, kind == 1, RTC, t0, ctx, lat, 0.10206207261596575f, Op, tid);
        }
    }
}

__device__ __forceinline__ void combine_phase(const Args& a, int l, int gw, int NGW, int lane) {
    using att::cvtpk; using att::u32x4;
    unsigned char* ws = a.ws; const float* OATT = (const float*)(ws + WS_OATT); bf16* MIX = (bf16*)(ws + WS_MIX);
    const float lam = ((const float*)(ws + WS_LAM))[l], li = ((const float*)(ws + WS_LAM))[4 + l];
    const int h = lane >> 4, c8 = (lane & 15) * 8; const float* ag = a.in[I_ANG] + l * 128 + c8;
    const f32x4 g0 = *(const f32x4*)ag * (1.f - li), g1 = *(const f32x4*)(ag + 4) * (1.f - li);
    for (int m = gw; m < M; m += NGW) {
        const float* oa = OATT + (size_t)m * NOATT + (2 * h) * 128 + c8;
        const f32x4 a0 = *(const f32x4*)oa, a1 = *(const f32x4*)(oa + 4), b0 = *(const f32x4*)(oa + 128), b1 = *(const f32x4*)(oa + 132);
        const f32x4 o0 = a0 - b0 * lam, o1 = a1 - b1 * lam;
        float ss = (o0.x * o0.x + o0.y * o0.y) + (o0.z * o0.z + o0.w * o0.w) + (o1.x * o1.x + o1.y * o1.y) + (o1.z * o1.z + o1.w * o1.w);
        ss += __shfl_xor(ss, 1); ss += __shfl_xor(ss, 2); ss += __shfl_xor(ss, 4); ss += __shfl_xor(ss, 8);
        const float r = 1.0f / sqrtf(ss * (1.f / 128.f) + EPS);
        const f32x4 y0 = o0 * r * g0, y1 = o1 * r * g1;
        *(u32x4*)(MIX + (size_t)m * DM + h * 128 + c8) = (u32x4){cvtpk(y0.x, y0.y), cvtpk(y0.z, y0.w), cvtpk(y1.x, y1.y), cvtpk(y1.z, y1.w)};
    }
}

__device__ __forceinline__ void convact_phase(const Args& a, int l, int gw, int NGW, int lane) {
    const bf16* GU = (const bf16*)(a.ws + WS_GU); bf16* ACT = (bf16*)(a.ws + WS_ACT);
    const float* cw = a.in[I_CONVW] + (size_t)l * 3 * DFF; const float* cb = a.in[I_CONVB] + (size_t)l * DFF;
    for (int m = gw; m < M; m += NGW) {
        int t, n; if (m < MP) { t = m % SEQ; n = SEQ; } else { t = (m - MP) % DSEQ; n = DSEQ; }
        const bool hp = t > 0, hn = t < n - 1;
        const bf16* g1 = GU + (size_t)m * (2 * DFF);
        for (int c = lane; c < DFF; c += 64) {
            const float gm = bf2f(g1[c]), gp = hp ? bf2f(g1[c - 2 * DFF]) : 0.f, gn = hn ? bf2f(g1[c + 2 * DFF]) : 0.f, uu = bf2f(g1[DFF + c]);
            const float gc = gp * cw[c] + gm * cw[DFF + c] + gn * cw[2 * DFF + c] + cb[c];
            ACT[(size_t)m * DFF + c] = (bf16)f2bf(siluf(gc) * uu);
        }
    }
}

__device__ __forceinline__ void ffn_fix_phase(const Args& a, int l, int gt, int NGT) {
    const float* side = (const float*)(a.ws + WS_SIDE); bf16* ACT = (bf16*)(a.ws + WS_ACT);
    const float* cw = a.in[I_CONVW] + (size_t)l * 3 * DFF;
    for (int i = gt; i < (MS / 256) * 2 * DFF; i += NGT) { const int j = i % DFF, w = (i / DFF) & 1, pm = 16 + i / (2 * DFF), q = (pm - 16) & 15;
        if (w == 0 ? q == 0 : q == 15) continue;
        const float* sp = side + ((size_t)(pm * 2 + w) * 3) * DFF + j;
        const float gnb = w == 0 ? side[((size_t)((pm - 1) * 2 + 1) * 3 + 2) * DFF + j] : side[((size_t)((pm + 1) * 2 + 0) * 3 + 2) * DFF + j];
        const float gc = sp[0] + cw[(w == 0 ? 0 : 2) * DFF + j] * gnb;
        ACT[(size_t)(pm * 256 + (w == 0 ? 0 : 255)) * DFF + j] = (bf16)f2bf(siluf(gc) * sp[DFF]); }
}

constexpr int PH_PER_LAYER = 11, PH_L0 = 3, PH_FIN = PH_L0 + DEPTH * PH_PER_LAYER, N_PHASES = PH_FIN + 1;
__global__ void __launch_bounds__(NTH, 2) mk_fwd(Args a) {
    extern __shared__ __attribute__((aligned(16))) unsigned char lds_raw[];
    LAS unsigned char* lds = (LAS unsigned char*)lds_raw;
    const int bid = blockIdx.x, G = gridDim.x, wave0 = __builtin_amdgcn_readfirstlane((int)threadIdx.x >> 6);
#define PH_BEGIN int tid = TID_NOW; asm volatile("" : "+v"(tid)); unsigned char* ws = a.ws; asm volatile("" : "+s"(ws)); \
    const int lane = tid & 63, wave = __builtin_amdgcn_readfirstlane(tid >> 6), gw = bid * NWV + wave, NGW = G * NWV, gt = bid * NTH + tid, NGT = G * NTH; (void)lane; (void)gw; (void)NGW; (void)gt; (void)NGT; (void)ws
    {
        volatile LAS unsigned* Z = (volatile LAS unsigned*)(lds + RING_BYTES);
        for (int u = threadIdx.x; u < (LDS_BYTES - RING_BYTES) / 4; u += NTH) Z[u] = 0u;
        __syncthreads();
    }
    if (a.use_bar) (void)xcd_barrier_post((unsigned*)(a.ws + WS_CTL) + 4096, (volatile LAS unsigned*)(lds + MISC_OFF) + 8);
#define bar (XcdBarrier{(unsigned*)(a.ws + WS_CTL) + 4096, xb_xcc_id(), (volatile LAS unsigned*)(lds + MISC_OFF) + 8})
    const int lo = a.ph_lo, hi = a.ph_hi;
#define IN(k) (lo <= (k) && (k) < hi)
#define TID_NOW (wave0 * 64 + (int)__builtin_amdgcn_mbcnt_hi(~0u, __builtin_amdgcn_mbcnt_lo(~0u, 0u)))
#define SEAM(k) do { if (IN(k) && IN((k) + 1)) xcd_barrier(bar, TID_NOW); } while (0)
#ifndef MK_DUP
#define MK_DUP 0
#endif
#define DUP(bit) _Pragma("unroll 1") for (int rep_ = 0; rep_ < (((MK_DUP) & (bit)) ? 2 : 1); ++rep_)

    if (IN(0)) DUP(512) { PH_BEGIN; pro0_phase(a, lds, tid, lane, wave, bid, G); SEAM(0); }
    if (IN(1)) { PH_BEGIN;
        modfin_phase(a, gt, NGT);
        pg8::Gemm g{(const bf16*)(ws + WS_CKVA), (const bf16*)(ws + WS_WKV), DEPTH * NDB * PAST, NKVP, 256, 256, 256, 4, (size_t)NKVP * 256}; pg8::StaticOrder S; S.init(DEPTH * NDB * PAST, NKVP, G, bid);
        pg8::EpiBf16<0> E{(bf16*)(ws + WS_KVCTX), NKVP, nullptr, 0, 0, 1.f};
        pg8::gemm_phase<pg8::EpiBf16<0>, pg8::StaticOrder, true, true>(lds, g, S, E, tid);
        SEAM(1);
    }
    if (IN(2)) DUP(8192) { PH_BEGIN; pro2_phase(a, lds, tid, bid, G, gt, NGT); SEAM(2); }
    for (int l = 0; l < DEPTH; ++l) {
        const int pb = PH_L0 + PH_PER_LAYER * l;
        if (pb + PH_PER_LAYER <= lo || pb >= hi) continue;
#define LAYER_PTRS const float* modl = (const float*)(ws + WS_MOD) + (size_t)l * 5 * 6 * DM; const float* xin0 = l == 0 ? a.in[I_XP] : (const float*)(ws + WS_X); \
        const float* xin1 = l == 0 ? a.in[I_XS] - (size_t)MP * DM : (const float*)(ws + WS_X); float* X = (float*)(ws + WS_X); (void)modl; (void)xin0; (void)xin1; (void)X
        if (IN(pb + 0) && l == 0) { PH_BEGIN; norm0_phase(a.in[I_XP], a.in[I_XS] - (size_t)MP * DM, (const float*)(ws + WS_GM), (bf16*)(ws + WS_H), (float*)(ws + WS_SSQP), gw, NGW, lane); SEAM(pb + 0); }
        if (IN(pb + 1)) DUP(2) { PH_BEGIN;
            pg8::Gemm g{(const bf16*)(ws + WS_H), (const bf16*)(ws + WS_WIN + l * SZ_WIN), M, NINP, DM, DM, DM, 1 << 20, 0}; pg8::StaticOrder S; S.init(M, NINP, G, bid);
            pg8::EpiBf16Norm E{(bf16*)(ws + WS_P), NINP, (const float*)(ws + WS_SSQP) + (size_t)(2 * l) * M * 32, (const float*)(ws + WS_SHWI) + (size_t)l * 5 * NINP, NINP, (LAS float*)(lds + RING_BYTES + 8192)};
            pg8::gemm_phase<pg8::EpiBf16Norm, pg8::StaticOrder, true, true>(lds, g, S, E, tid);
            SEAM(pb + 1);
        }
        if (IN(pb + 2)) DUP(4) { PH_BEGIN; post_phase(a, l, gw, NGW, lane);
#if 1
            __syncthreads();
            for (int u = bid; u < GLA_UNITS; u += G) { int t2 = tid; asm volatile("" : "+v"(t2)); gla_g1_unit(a, l, u, lds, t2); }
#endif
            SEAM(pb + 2); }
        if (IN(pb + 3)) DUP(8) {
            { PH_BEGIN; pg8::Gemm g{(const bf16*)(ws + WS_CQN), (const bf16*)(ws + WS_WQ + l * SZ_WQ), M, NQCP, 384, 384, 384, 1 << 20, 0}; pg8::StaticOrder S; S.init(M, NQCP, G, bid);
              pg8::EpiBf16<0> E{(bf16*)(ws + WS_QC), NQCP, nullptr, 0, 0, 1.f};
              pg8::gemm_phase<pg8::EpiBf16<0>, pg8::StaticOrder, true, true>(lds, g, S, E, tid); }
            __syncthreads();
            { PH_BEGIN; pg8::Gemm g{(const bf16*)(ws + WS_CKVN), (const bf16*)(ws + WS_WKV + l * SZ_WKV), M, NKVP, 256, 256, 256, 1 << 20, 0}; pg8::StaticOrder S; S.init(M, NKVP, G, bid);
              pg8::EpiBf16<0> E{(bf16*)(ws + WS_KVC), NKVP, nullptr, 0, 0, 1.f};
              pg8::gemm_phase<pg8::EpiBf16<0>, pg8::StaticOrder, true, true>(lds, g, S, E, tid); }
#if MK_MFMA_GLA
            { PH_BEGIN; for (int it = bid; it < GLA_G2_ITEMS; it += G) gla_g2_item(a, l, it, tid); }
#endif
            SEAM(pb + 3);
        }
        if (IN(pb + 4)) DUP(16) { PH_BEGIN; mixer_phase(a, l, lds, tid, bid, G); if (IN(pb + 6)) xcd_barrier(bar, TID_NOW); }
        if (IN(pb + 6)) { PH_BEGIN; LAYER_PTRS;
            constexpr int NFULL = 512;
            { pg8::Gemm g{(const bf16*)(ws + WS_MIX), (const bf16*)(ws + WS_WOUT + l * SZ_WOUT), M, DM, DM, DM, DM, 1 << 20, 0}; pg8::StaticOrder S; S.init(M, DM, G, bid); S.lim = (MK_SPLITK && G == 256) ? NFULL : S.nwg;
              pg8::EpiResid E{MK_SPLITK ? X : xin0, MK_SPLITK ? X : xin1, X, modl + 2 * DM, (bf16*)(ws + WS_H), (const float*)(ws + WS_GM) + (size_t)(l * 2 + 1) * 5 * DM, (float*)(ws + WS_SSQP) + (size_t)(2 * l + 1) * M * 32};
              pg8::gemm_phase<pg8::EpiResid, pg8::StaticOrder, true, true>(lds, g, S, E, tid); }
            if (MK_SPLITK && G == 256) { __syncthreads(); int t3 = tid; asm volatile("" : "+v"(t3)); (void)t3;
              pg8::Gemm g{(const bf16*)(ws + WS_MIX), (const bf16*)(ws + WS_WOUT + l * SZ_WOUT), M, DM, DM / 2, DM, DM, 1 << 20, 0}; pg8::TailOrder S; S.init(M, DM, G, bid); S.base = NFULL; S.nth = DM / 128;
              pg8::EpiResidTail E{X, modl + 2 * DM, (float*)(ws + WS_SPLITK), (unsigned*)(ws + WS_CTL) + CW_TICKET + (l * 2 + 0) * 128 * 64, (LAS unsigned*)(lds + RING_BYTES + 2048)};
              pg8::gemm_phase<pg8::EpiResidTail, pg8::TailOrder, true, true>(lds, g, S, E, tid); }
            SEAM(pb + 6);
        }
        if (IN(pb + 8)) DUP(128) { PH_BEGIN;
            pg8::Gemm g{(const bf16*)(ws + WS_H), (const bf16*)(ws + WS_WUP + l * SZ_WUP), M, 2 * DFF, DM, DM, DM, 1 << 20, 0}; pg8::StaticOrder S; S.init(M, 2 * DFF, G, bid);
            pg8::EpiConvAct E{(bf16*)(ws + WS_ACT), a.in[I_CONVW] + (size_t)l * 3 * DFF, a.in[I_CONVB] + (size_t)l * DFF, (float*)(ws + WS_SIDE), (LAS float*)(lds + RING_BYTES + 4096),
                               (const float*)(ws + WS_SSQP) + (size_t)(2 * l + 1) * M * 32, (const float*)(ws + WS_SHWU) + (size_t)l * 5 * 2 * DFF, (LAS float*)(lds + RING_BYTES + 8192)};
            pg8::gemm_phase<pg8::EpiConvAct, pg8::StaticOrder, true, true>(lds, g, S, E, tid);
            SEAM(pb + 8);
        }
        if (IN(pb + 9)) DUP(256) { PH_BEGIN; ffn_fix_phase(a, l, gt, NGT); SEAM(pb + 9); }
        if (IN(pb + 10)) { PH_BEGIN; LAYER_PTRS;
            constexpr int NFULL = 512;
            { pg8::Gemm g{(const bf16*)(ws + WS_ACT), (const bf16*)(ws + WS_WDN + l * SZ_WDN), M, DM, DFF, DFF, DFF, 1 << 20, 0}; pg8::StaticOrder S; S.init(M, DM, G, bid); S.lim = (MK_SPLITK && G == 256) ? NFULL : S.nwg;
              pg8::EpiResid E{X, X, X, modl + 5 * DM, l + 1 < DEPTH ? (bf16*)(ws + WS_H) : nullptr, (const float*)(ws + WS_GM) + (size_t)((l + 1 < DEPTH ? l + 1 : l) * 2) * 5 * DM, (float*)(ws + WS_SSQP) + (size_t)(2 * (l + 1 < DEPTH ? l + 1 : l)) * M * 32};
              pg8::gemm_phase<pg8::EpiResid, pg8::StaticOrder, true, true>(lds, g, S, E, tid); }
            if (MK_SPLITK && G == 256) { __syncthreads(); int t3 = tid; asm volatile("" : "+v"(t3)); (void)t3;
              pg8::Gemm g{(const bf16*)(ws + WS_ACT), (const bf16*)(ws + WS_WDN + l * SZ_WDN), M, DM, DFF / 2, DFF, DFF, 1 << 20, 0}; pg8::TailOrder S; S.init(M, DM, G, bid); S.base = NFULL; S.nth = DFF / 128;
              pg8::EpiResidTail E{X, modl + 5 * DM, (float*)(ws + WS_SPLITK), (unsigned*)(ws + WS_CTL) + CW_TICKET + (l * 2 + 1) * 128 * 64, (LAS unsigned*)(lds + RING_BYTES + 2048)};
              pg8::gemm_phase<pg8::EpiResidTail, pg8::TailOrder, true, true>(lds, g, S, E, tid); }
            SEAM(pb + 10);
        }
    }
    if (IN(PH_FIN)) { PH_BEGIN; final_norm_phase((const float*)(ws + WS_X), a.in[I_FING], a.out, gw, NGW, lane); }
#undef IN
#undef SEAM
#undef bar
}

#ifndef MK_ONE_LAUNCH
#define MK_ONE_LAUNCH 1
#endif
extern "C" void kernel_launch(void* const* d_in, const int* in_sizes, int n_in, void* d_out, int out_size, void* d_ws, size_t ws_size, hipStream_t stream) {
    static int grid = 0;
    if (grid == 0) {
        if (n_in != N_INPUTS || (size_t)out_size != O_END || ws_size < WS_END) { fprintf(stderr, "kernel_launch: shape mismatch: n_in %d out %d ws %zu (need %zu)\n", n_in, out_size, ws_size, (size_t)WS_END); grid = -1; return; }
        int dev = 0, cus = 0, per_cu = 0;
        if (hipGetDevice(&dev) != hipSuccess || hipDeviceGetAttribute(&cus, hipDeviceAttributeMultiprocessorCount, dev) != hipSuccess) { grid = -1; return; }
        if (hipFuncSetAttribute((const void*)mk_fwd, hipFuncAttributeMaxDynamicSharedMemorySize, LDS_BYTES) != hipSuccess) { fprintf(stderr, "kernel_launch: hipFuncSetAttribute failed\n"); grid = -1; return; }
        if (hipOccupancyMaxActiveBlocksPerMultiprocessor(&per_cu, (const void*)mk_fwd, NTH, LDS_BYTES) != hipSuccess || per_cu < 1) fprintf(stderr, "kernel_launch: occupancy query reports %d\n", per_cu);
        (void)hipGetLastError();
        grid = cus;
    }
    if (grid < 0) return;
    if (hipMemsetAsync((char*)d_ws + WS_CTL, 0, CTL_ZERO_BYTES, stream) != hipSuccess) return;
    Args a{};
    for (int i = 0; i < N_INPUTS; ++i) a.in[i] = (const float*)d_in[i];
    a.out = (float*)d_out; a.ws = (unsigned char*)d_ws; a.pad = 0;
#if MK_ONE_LAUNCH
    a.ph_lo = 0; a.ph_hi = N_PHASES; a.use_bar = 1;
    hipLaunchKernelGGL(mk_fwd, dim3(grid), dim3(NTH), LDS_BYTES, stream, a);
#else
    for (int p = 0; p < N_PHASES; ++p) { a.ph_lo = p; a.ph_hi = p + 1; a.use_bar = 0; hipLaunchKernelGGL(mk_fwd, dim3(grid), dim3(NTH), LDS_BYTES, stream, a); }
#endif
    const hipError_t le = hipPeekAtLastError();
    if (le != hipSuccess) fprintf(stderr, "kernel_launch: launch failed: %s\n", hipGetErrorName(le));
}
```

```cpp
#include <hip/hip_runtime.h>
#include <cstdio>
#include <cstdint>
#include <cmath>

namespace pg8 {
#define PG8_LAS __attribute__((address_space(3)))
typedef unsigned short bf16_t;
typedef short bf16x8 __attribute__((ext_vector_type(8)));
typedef float f32x4 __attribute__((ext_vector_type(4)));
typedef unsigned u32x4 __attribute__((ext_vector_type(4)));
constexpr int BM = 256, BK = 64, HALF = 128, HTB = HALF * BK * 2  , STAGE_BYTES = 8 * HTB, NXCD = 8, WGM = 8;

__host__ __device__ __forceinline__ int lds_byte(int r, int c) { const int st = (r >> 4) * 2 + (c >> 5), rr = r & 15, cc = c & 31, ob = rr * 64 + cc * 2; return st * 1024 + (ob ^ (((ob >> 9) & 1) << 5)); }
__host__ __device__ __forceinline__ void stage_rc(int b, int& R, int& C) { const int st = b / 1024, sb = b % 1024, swz = sb ^ (((sb >> 9) & 1) << 5); R = (st >> 1) * 16 + swz / 64; C = (st & 1) * 32 + (swz % 64) / 2; }
__host__ __device__ __forceinline__ int perm32(int rho) { const int n = rho >> 4, i = rho & 15; return 8 * (i >> 2) + 4 * n + (i & 3); }

struct Unit { int pm, pn, kt0; };
struct Gemm { const bf16_t* A; const bf16_t* Bt; int M, N, K, lda, ldb, bgrp; size_t bgrp_stride; };

struct StaticOrder {
    int nM, nN, nwg, G, c;
    __host__ __device__ void init(int M, int N, int G_, int c_) { nM = M / BM; nN = N / BM; nwg = nM * nN; G = G_; c = c_; lim = nwg; }
    int lim;
    __host__ __device__ void map(int wgid, Unit& u) const {
        { const int q = nwg / NXCD, r = nwg % NXCD, xcd = wgid % NXCD, off = wgid / NXCD; wgid = (xcd < r ? xcd * (q + 1) : r * (q + 1) + (xcd - r) * q) + off; }
        const int nig = WGM * nN, gid = wgid / nig, fm = gid * WGM, gsz = (nM - fm) < WGM ? (nM - fm) : WGM;
        u.pm = fm + ((wgid % nig) % gsz); u.pn = (wgid % nig) / gsz; u.kt0 = 0;
    }
    __host__ __device__ bool next(int i, Unit& u) const {
        const long L = (long)i * G + c; if (L >= lim) return false;
        map((int)L, u); return true;
    }
    __device__ __forceinline__ void a_ready(const Unit&) const {}
    __device__ __forceinline__ void done(const Unit&) const {}
};

struct TailOrder : StaticOrder {
    int base, nth;
    __host__ __device__ bool next(int i, Unit& u) const { if (i > 0) return false; const int L = base + (c >> 1); if (L >= nwg) return false; map(L, u); u.kt0 = (c & 1) * nth; return true; }
};

__device__ __forceinline__ unsigned cvt_pk_bf16(float lo, float hi) { unsigned r; asm volatile("v_cvt_pk_bf16_f32 %0, %1, %2" : "=v"(r) : "v"(lo), "v"(hi)); return r; }
typedef float f32x2 __attribute__((ext_vector_type(2)));
__device__ __forceinline__ f32x2 gelu_pk(f32x2 v) {
    const f32x2 av = __builtin_elementwise_abs(v), d = av * 0.2316418882f + 1.0f;
    f32x2 t; t.x = __builtin_amdgcn_rcpf(d.x); t.y = __builtin_amdgcn_rcpf(d.y);
    f32x2 q = t * 0.5307027145f + (-0.7265760135f); q = q * t + 0.7107068705f; q = q * t + (-0.142248368f); q = q * t + 0.127414796f; q = q * t;
    const f32x2 s = (v * v) * (-0.72134752044f);
    f32x2 e; e.x = __builtin_amdgcn_exp2f(s.x); e.y = __builtin_amdgcn_exp2f(s.y);
    const f32x2 m = v * (q * e), r = v - m;
    f32x2 o; o.x = v.x < 0.f ? m.x : r.x; o.y = v.y < 0.f ? m.y : r.y; return o;
}

template <int ACT  > struct EpiBf16 {
    static constexpr bool PERM = true, AFTER_DRAIN = false; static_assert(ACT == 0 || ACT == 1, "EpiBf16: ACT is 0 (none) or 1 (gelu_pk)");
    bf16_t* O; int ldc; const float* bias; int split_cols; size_t split_stride; float scale0;
    __device__ __forceinline__ void operator()(const f32x4 (&acc)[2][2][4][2], const Unit& u, int wr, int wc, int fr, int fq) const {
        const int row0 = u.pm * BM + wr * 64 + fr; int colt = u.pn * BM; bf16_t* base = O;
        float sc = 1.f; if (split_cols) { const int t = colt / split_cols; base += (size_t)t * split_stride; colt -= t * split_cols; if (t == 0) sc = scale0; }
        const int col0 = colt + wc * 32 + 8 * fq, bcol0 = u.pn * BM + wc * 32 + 8 * fq;
        f32x4 bv[2][2];
#pragma unroll
        for (int bj = 0; bj < 2; ++bj)
#pragma unroll
            for (int n = 0; n < 2; ++n) bv[bj][n] = bias ? *(const f32x4*)(bias + bcol0 + bj * HALF + 4 * n) : (f32x4){0.f, 0.f, 0.f, 0.f};
#pragma unroll
        for (int ai = 0; ai < 2; ++ai)
#pragma unroll
            for (int m = 0; m < 4; ++m) { bf16_t* rowp = base + (size_t)(row0 + ai * HALF + m * 16) * ldc + col0;
#pragma unroll
                for (int bj = 0; bj < 2; ++bj) { f32x4 v0 = acc[ai][bj][m][0] + bv[bj][0], v1 = acc[ai][bj][m][1] + bv[bj][1];
                    if (ACT == 1) { f32x2 a = gelu_pk((f32x2){v0[0], v0[1]}), b = gelu_pk((f32x2){v0[2], v0[3]}), c = gelu_pk((f32x2){v1[0], v1[1]}), d = gelu_pk((f32x2){v1[2], v1[3]});
                        v0 = (f32x4){a.x, a.y, b.x, b.y}; v1 = (f32x4){c.x, c.y, d.x, d.y}; }
                    v0 = v0 * sc; v1 = v1 * sc; u32x4 w; w.x = cvt_pk_bf16(v0[0], v0[1]); w.y = cvt_pk_bf16(v0[2], v0[3]); w.z = cvt_pk_bf16(v1[0], v1[1]); w.w = cvt_pk_bf16(v1[2], v1[3]);
                    *(u32x4*)(rowp + bj * HALF) = w; } }
    }
};

template <class Epi, class Sched, bool ALIGN_EPI = false, bool SP2 = false>
__device__ __forceinline__ void gemm_phase(PG8_LAS unsigned char* lds, const Gemm g, const Sched& S, const Epi& E, int tid_in) {
    int tid_ = tid_in; asm volatile("" : "+v"(tid_));
    const int tid = tid_, wid = __builtin_amdgcn_readfirstlane(tid >> 6), lane = tid & 63, wr = wid >> 2, wc = wid & 3, fr = lane & 15, fq = lane >> 4;
    const int K = g.K, nt = K / BK;
    unsigned voffA[2], voffB[2];
#pragma unroll
    for (int i = 0; i < 2; ++i) { int R, C; stage_rc(tid * 16 + i * 8192, R, C); const int Rb = Epi::PERM ? ((R & ~31) + perm32(R & 31)) : R;
        voffA[i] = (unsigned)(R * g.lda + C) * 2u; voffB[i] = (unsigned)(Rb * g.ldb + C) * 2u; }
    const size_t kstep = (size_t)(BK * 2);
    const size_t hstepA = (size_t)HALF * g.lda * 2, hstepB = (size_t)HALF * g.ldb * 2;
    const size_t tstepA = 2 * hstepA, tstepB = 2 * hstepB;
    const unsigned ldsw = (unsigned)wid * 1024u;
    const int aoff = lds_byte(wr * 64 + fr, fq * 8), boff = lds_byte(wc * 32 + fr, fq * 8);
#define PG8_SA(b, h) (((b) * 2 + (h)) * HTB)
#define PG8_SB(b, h) ((4 + (b) * 2 + (h)) * HTB)
#define PG8_STAGE(bufoff, gbase, voff) do { _Pragma("unroll") for (int _i = 0; _i < 2; ++_i) \
        __builtin_amdgcn_global_load_lds((const unsigned*)((const char*)(gbase) + (voff)[_i]), (PG8_LAS unsigned*)(lds + (bufoff) + ldsw + _i * 8192), 16, 0, 0); } while (0)
#define PG8_LDA(dst, b, h) do { _Pragma("unroll") for (int m = 0; m < 4; ++m) _Pragma("unroll") for (int k = 0; k < 2; ++k) dst[m][k] = *(const PG8_LAS bf16x8*)(lds + PG8_SA(b, h) + aoff + m * 2048 + k * 1024); } while (0)
#define PG8_LDB(dst, b, h) do { _Pragma("unroll") for (int n = 0; n < 2; ++n) _Pragma("unroll") for (int k = 0; k < 2; ++k) dst[n][k] = *(const PG8_LAS bf16x8*)(lds + PG8_SB(b, h) + boff + n * 2048 + k * 1024); } while (0)
#define PG8_MMA(ai, bj, At, Bt) do { __builtin_amdgcn_s_setprio(1); _Pragma("unroll") for (int m = 0; m < 4; ++m) _Pragma("unroll") for (int n = 0; n < 2; ++n) _Pragma("unroll") for (int k = 0; k < 2; ++k) \
        acc[ai][bj][m][n] = __builtin_amdgcn_mfma_f32_16x16x32_bf16(Bt[n][k], At[m][k], acc[ai][bj][m][n], 0, 0, 0); __builtin_amdgcn_s_setprio(0); } while (0)
#define PG8_WAIT_V(n) asm volatile("s_waitcnt vmcnt(" #n ")" ::: "memory")
#define PG8_WAIT_L(n) asm volatile("s_waitcnt lgkmcnt(" #n ")" ::: "memory")
#define PG8_BAR __builtin_amdgcn_s_barrier()
#define PG8_SCHED __builtin_amdgcn_sched_barrier(0)
    Unit cur, nxt; int ui = 0;
    if (!S.next(0, cur)) return;
    f32x4 acc[2][2][4][2];
#pragma unroll
    for (int a = 0; a < 2; ++a)
#pragma unroll
        for (int b = 0; b < 2; ++b)
#pragma unroll
            for (int m = 0; m < 4; ++m)
#pragma unroll
                for (int n = 0; n < 2; ++n) acc[a][b][m][n] = (f32x4){0.f, 0.f, 0.f, 0.f};
    bf16x8 At[4][2], B0[2][2], B1[2][2];
    const char* cA = (const char*)g.A + (size_t)cur.pm * tstepA + (size_t)cur.kt0 * kstep; const char* cB = (const char*)g.Bt + (size_t)(cur.pm / g.bgrp) * g.bgrp_stride * 2 + (size_t)cur.pn * tstepB + (size_t)cur.kt0 * kstep;
    S.a_ready(cur);
    if constexpr (SP2) {
        PG8_STAGE(PG8_SB(0, 0), cB, voffB); PG8_STAGE(PG8_SB(0, 1), cB + hstepB, voffB); PG8_STAGE(PG8_SA(0, 0), cA, voffA); PG8_STAGE(PG8_SA(0, 1), cA + hstepA, voffA);
        if (wr == 1) PG8_BAR;
        PG8_WAIT_V(2); PG8_BAR;
        PG8_STAGE(PG8_SB(1, 0), cB + kstep, voffB); PG8_STAGE(PG8_SA(1, 0), cA + kstep, voffA); PG8_STAGE(PG8_SB(1, 1), cB + hstepB + kstep, voffB);
        PG8_WAIT_V(6); PG8_BAR;
    } else {
        PG8_STAGE(PG8_SB(0, 0), cB, voffB); PG8_STAGE(PG8_SA(0, 0), cA, voffA); PG8_STAGE(PG8_SB(0, 1), cB + hstepB, voffB); PG8_STAGE(PG8_SA(0, 1), cA + hstepA, voffA);
        if (wr == 1) PG8_BAR;
        PG8_WAIT_V(4); PG8_BAR;
        PG8_STAGE(PG8_SB(1, 0), cB + kstep, voffB); PG8_STAGE(PG8_SA(1, 0), cA + kstep, voffA); PG8_STAGE(PG8_SB(1, 1), cB + hstepB + kstep, voffB);
        PG8_WAIT_V(6); PG8_BAR;
    }
    for (;;) {
        const bool has_next = S.next(ui + 1, nxt);
        const char* nA = has_next ? (const char*)g.A + (size_t)nxt.pm * tstepA + (size_t)nxt.kt0 * kstep : cA; const char* nB = has_next ? (const char*)g.Bt + (size_t)(nxt.pm / g.bgrp) * g.bgrp_stride * 2 + (size_t)nxt.pn * tstepB + (size_t)nxt.kt0 * kstep : cB;
        for (int t = 0; t < nt; t += 2) {
            const bool last = (t == nt - 2);
            const char* a1 = cA + (size_t)(t + 1) * kstep;
            const char* a2 = last ? nA : cA + (size_t)(t + 2) * kstep; const char* b2 = last ? nB : cB + (size_t)(t + 2) * kstep;
            const char* a3 = a2 + kstep; const char* b3 = b2 + kstep;
            if (last && has_next) S.a_ready(nxt);
            if constexpr (SP2) {
            PG8_LDB(B0, 0, 0); PG8_LDB(B1, 0, 1); PG8_SCHED; PG8_LDA(At, 0, 0); PG8_STAGE(PG8_SA(1, 1), a1 + hstepA, voffA);
            PG8_WAIT_V(8); PG8_WAIT_L(0); PG8_BAR; PG8_MMA(0, 0, At, B0); PG8_MMA(0, 1, At, B1); PG8_BAR; PG8_SCHED;
            PG8_LDA(At, 0, 1); PG8_STAGE(PG8_SB(0, 0), b2, voffB); PG8_STAGE(PG8_SB(0, 1), b2 + hstepB, voffB); PG8_STAGE(PG8_SA(0, 0), a2, voffA);
            PG8_WAIT_V(8); PG8_WAIT_L(0); PG8_BAR; PG8_MMA(1, 0, At, B0); PG8_MMA(1, 1, At, B1); PG8_BAR; PG8_SCHED;
            PG8_LDB(B0, 1, 0); PG8_LDB(B1, 1, 1); PG8_SCHED; PG8_LDA(At, 1, 0); PG8_STAGE(PG8_SA(0, 1), a2 + hstepA, voffA);
            PG8_WAIT_V(8); PG8_WAIT_L(0); PG8_BAR; PG8_MMA(0, 0, At, B0); PG8_MMA(0, 1, At, B1); PG8_BAR; PG8_SCHED;
            PG8_LDA(At, 1, 1); PG8_STAGE(PG8_SB(1, 0), b3, voffB); PG8_STAGE(PG8_SB(1, 1), b3 + hstepB, voffB); PG8_STAGE(PG8_SA(1, 0), a3, voffA);
            PG8_WAIT_V(8); PG8_WAIT_L(0); PG8_BAR; PG8_MMA(1, 0, At, B0); PG8_MMA(1, 1, At, B1); PG8_BAR; PG8_SCHED;
            } else {
            PG8_LDB(B0, 0, 0); PG8_SCHED; PG8_LDA(At, 0, 0); PG8_STAGE(PG8_SA(1, 1), a1 + hstepA, voffA);
            PG8_WAIT_L(8); PG8_BAR; PG8_WAIT_L(0); PG8_MMA(0, 0, At, B0); PG8_BAR; PG8_SCHED;
            PG8_LDB(B1, 0, 1); PG8_STAGE(PG8_SB(0, 0), b2, voffB);
            PG8_BAR; PG8_WAIT_L(0); PG8_MMA(0, 1, At, B1); PG8_BAR;
            PG8_LDA(At, 0, 1); PG8_STAGE(PG8_SA(0, 0), a2, voffA);
            PG8_BAR; PG8_WAIT_L(0); PG8_MMA(1, 0, At, B0); PG8_BAR; PG8_SCHED;
            PG8_STAGE(PG8_SB(0, 1), b2 + hstepB, voffB);
            PG8_WAIT_V(6); PG8_BAR; PG8_MMA(1, 1, At, B1); PG8_BAR;
            PG8_LDB(B0, 1, 0); PG8_SCHED; PG8_LDA(At, 1, 0); PG8_STAGE(PG8_SA(0, 1), a2 + hstepA, voffA);
            PG8_WAIT_L(8); PG8_BAR; PG8_WAIT_L(0); PG8_MMA(0, 0, At, B0); PG8_BAR; PG8_SCHED;
            PG8_LDB(B1, 1, 1); PG8_STAGE(PG8_SB(1, 0), b3, voffB);
            PG8_BAR; PG8_WAIT_L(0); PG8_MMA(0, 1, At, B1); PG8_BAR;
            PG8_LDA(At, 1, 1); PG8_STAGE(PG8_SA(1, 0), a3, voffA);
            PG8_BAR; PG8_WAIT_L(0); PG8_MMA(1, 0, At, B0); PG8_BAR; PG8_SCHED;
            PG8_STAGE(PG8_SB(1, 1), b3 + hstepB, voffB);
            PG8_WAIT_V(6); PG8_BAR; PG8_MMA(1, 1, At, B1); PG8_BAR;
            }
        }
        if constexpr (ALIGN_EPI) { if (wr == 0) PG8_BAR; }
        if constexpr (!Epi::AFTER_DRAIN) { E(acc, cur, wr, wc, fr, fq); S.done(cur); }
        if (!has_next) break;
#pragma unroll
        for (int a = 0; a < 2; ++a)
#pragma unroll
            for (int b = 0; b < 2; ++b)
#pragma unroll
                for (int m = 0; m < 4; ++m)
#pragma unroll
                    for (int n = 0; n < 2; ++n) acc[a][b][m][n] = (f32x4){0.f, 0.f, 0.f, 0.f};
        cur = nxt; cA = nA; cB = nB; ++ui;
        if constexpr (ALIGN_EPI) { if (wr == 1) PG8_BAR; }
    }
    PG8_WAIT_V(0);
    if constexpr (!ALIGN_EPI) { if (wr == 0) PG8_BAR; }
    PG8_BAR;
    if constexpr (Epi::AFTER_DRAIN) { E.fused(acc, cur, wr, wc, fr, fq, lds, wid, lane); S.done(cur); }
#undef PG8_SA
#undef PG8_SB
#undef PG8_STAGE
#undef PG8_LDA
#undef PG8_LDB
#undef PG8_MMA
#undef PG8_WAIT_V
#undef PG8_WAIT_L
#undef PG8_BAR
#undef PG8_SCHED
}
}

constexpr int DM = 2048, NPB = 16, SEQ = 256, DEPTH = 4, NDB = 4, DSEQ = 4096, PAST = 256;
constexpr int MP = NPB * SEQ, MS = NDB * DSEQ, M = MP + MS;
constexpr int NIN = 4544, NINP = 4608;
constexpr int C_AQ = 0, C_AK = 512, C_AV = 1024, C_BQ = 1536, C_BK = 1920, C_BV = 2304, C_BR = 3072, C_BG = 3840, C_CQ = 3872, C_CKV = 4256, C_CKR = 4512;
constexpr int DFF = 5632, NQC = 576, NQCP = 768, NKV = 1152, NKVP = 1280;
constexpr float EPS = 1e-6f;
constexpr int NOATT = 14 * 128, NOGLA = 2 * 768;
enum { I_XP = 0, I_XS, I_CAK, I_CAV, I_STB, I_CCKV, I_CCKR, I_C, I_CCTX, I_N1G, I_ADAW, I_ADAB, I_WIN, I_LQ1, I_LK1, I_LQ2, I_LK2, I_ANG, I_BGW, I_BGB, I_BNG, I_CQG, I_CQUP, I_CKVG, I_CKVUP, I_WOUT, I_N2G, I_WUP, I_CONVW, I_CONVB, I_WDOWN, I_FING, N_INPUTS };
constexpr size_t O_YP = 0, O_YS = O_YP + (size_t)MP * DM, O_AK = O_YS + (size_t)MS * DM, O_AV = O_AK + (size_t)NPB * DEPTH * SEQ * 512, O_SB = O_AV + (size_t)NPB * DEPTH * SEQ * 512,
                 O_CKV = O_SB + (size_t)NPB * DEPTH * 2 * 6 * 64 * 128, O_CKR = O_CKV + (size_t)NPB * DEPTH * SEQ * 256, O_END = O_CKR + (size_t)NPB * DEPTH * SEQ * 32;
static_assert(O_END == 69730304, "output size");

constexpr size_t al256(size_t x) { return (x + 255) & ~(size_t)255; }
constexpr size_t WS_CTL = 0, CTL_ZERO_BYTES = 2u << 20;
constexpr size_t WS_SSQ = 1u << 20;
constexpr size_t SZ_WIN = (size_t)NINP * DM * 2, SZ_WOUT = (size_t)DM * DM * 2, SZ_WUP = (size_t)2 * DFF * DM * 2, SZ_WDN = (size_t)DM * DFF * 2, SZ_WQ = (size_t)NQCP * 384 * 2, SZ_WKV = (size_t)NKVP * 256 * 2;
constexpr size_t WS_WIN = WS_CTL + CTL_ZERO_BYTES, WS_WOUT = WS_WIN + 4 * SZ_WIN, WS_WUP = WS_WOUT + 4 * SZ_WOUT, WS_WDN = WS_WUP + 4 * SZ_WUP, WS_WQ = WS_WDN + 4 * SZ_WDN, WS_WKV = WS_WQ + 4 * SZ_WQ;
constexpr size_t SZ_MOD = (size_t)DEPTH * 5 * 6 * DM * 4;
constexpr size_t WS_MOD = WS_WKV + 4 * SZ_WKV, WS_MODP = WS_MOD + SZ_MOD, WS_RTA = WS_MODP + 8 * SZ_MOD, WS_RTC = WS_RTA + (size_t)DSEQ * 64 * 4, WS_LAM = WS_RTC + (size_t)DSEQ * 32 * 4;
constexpr size_t WS_CAK = WS_LAM + 256, WS_CAV = WS_CAK + (size_t)NDB * DEPTH * PAST * 512 * 2, WS_CKRX = WS_CAV + (size_t)NDB * DEPTH * PAST * 512 * 2, WS_CKVA = WS_CKRX + (size_t)NDB * DEPTH * PAST * 32 * 2,
                 WS_KVCTX = WS_CKVA + (size_t)DEPTH * NDB * PAST * 256 * 2, WS_SIDE = WS_KVCTX + (size_t)DEPTH * NDB * PAST * NKVP * 2, WS_GM = WS_SIDE + (size_t)(M / 256) * 2 * 3 * DFF * 4, WS_SHWI = WS_GM + (size_t)DEPTH * 2 * 5 * DM * 4,
                 WS_SHWU = WS_SHWI + (size_t)DEPTH * 5 * NINP * 4, WS_SSQP = WS_SHWU + (size_t)DEPTH * 5 * 2 * DFF * 4, WS_X = WS_SSQP + (size_t)8 * M * 32 * 4;
constexpr size_t WS_H = WS_X + (size_t)M * DM * 4, WS_T0 = WS_H + (size_t)M * DM * 2;
constexpr size_t WS_P = WS_T0, WS_MIX = WS_P + (size_t)M * NINP * 2, WS_QC = WS_MIX + (size_t)M * DM * 2, WS_KVC = WS_QC + (size_t)M * NQCP * 2, WS_CQN = WS_KVC + (size_t)M * NKVP * 2, WS_CKVN = WS_CQN + (size_t)M * 384 * 2,
                 WS_KRA = WS_CKVN + (size_t)M * 256 * 2, WS_KRC = WS_KRA + (size_t)MS * 512 * 2, WS_OATT = WS_KRC + (size_t)MS * 32 * 2, WS_OGLA = WS_OATT + (size_t)M * NOATT * 4, WS_GATE = WS_OGLA + (size_t)M * NOGLA * 4,
                 WS_ST = WS_GATE + (size_t)M * 768 * 4, WS_DD = WS_ST + (size_t)(M / 64) * 12 * 8192 * 2, WS_END1 = WS_DD + (size_t)(M / 64) * 12 * 64 * 4;
constexpr size_t WS_U = WS_OGLA, WS_QK4 = WS_GATE;
constexpr size_t WS_GU = WS_T0, WS_ACT = WS_GU + (size_t)M * 2 * DFF * 2, WS_END2 = WS_ACT + (size_t)M * DFF * 2;


static_assert(WS_WIN % 256 == 0 && WS_X % 256 == 0 && WS_H % 256 == 0 && WS_T0 % 256 == 0 && WS_QC % 256 == 0 && WS_KVC % 256 == 0 && WS_CQN % 256 == 0 && WS_CKVN % 256 == 0 && WS_OATT % 256 == 0 && WS_ACT % 256 == 0, "alignment");

constexpr size_t WS_SPLITK = WS_END1 > WS_END2 ? WS_END1 : WS_END2, WS_END3 = WS_SPLITK + (size_t)128 * 2 * 65536 * 4;
constexpr size_t WS_END = WS_END3;
static_assert(WS_END <= (size_t)1536 << 20, "workspace map must fit 4 x the largest tensor");
constexpr int CW_TICKET = 65536;

constexpr int RING_BYTES = 131072, MISC_OFF = RING_BYTES + 320, LDS_BYTES = 147456;

#define GAS __attribute__((address_space(1)))
#define LAS __attribute__((address_space(3)))
typedef unsigned short bf16;
typedef unsigned v4u __attribute__((ext_vector_type(4)));
typedef unsigned v2u __attribute__((ext_vector_type(2)));
typedef float f32x4 __attribute__((ext_vector_type(4)));
#define LDS_WAIT() asm volatile("s_waitcnt lgkmcnt(0)" ::: "memory")
__device__ __forceinline__ unsigned f2bf(float f) { unsigned u = __builtin_bit_cast(unsigned, f); return (u + 0x7fffu + ((u >> 16) & 1u)) >> 16; }
__device__ __forceinline__ unsigned pk2(float lo, float hi) { return f2bf(lo) | (f2bf(hi) << 16); }
__device__ __forceinline__ float bf2f(bf16 b) { return __builtin_bit_cast(float, (unsigned)b << 16); }
__device__ __forceinline__ float wave_sum(float v) {
#pragma unroll
    for (int o = 1; o < 64; o <<= 1) v += __shfl_xor(v, o);
    return v;
}
__device__ __forceinline__ float siluf(float x) { return x / (1.f + __expf(-x)); }

namespace pg8 {
__device__ __forceinline__ void rstd_table(const float* ssq, int pm, PG8_LAS float* rtab, int tid) {
    const int row = tid >> 1, half = tid & 1; const float* p = ssq + ((size_t)(pm * BM + row) * 32 + half * 16);
    const f32x4 a = *(const f32x4*)p, b = *(const f32x4*)(p + 4), c = *(const f32x4*)(p + 8), d = *(const f32x4*)(p + 12);
    float s = (((a[0] + a[1]) + (a[2] + a[3])) + ((b[0] + b[1]) + (b[2] + b[3]))) + (((c[0] + c[1]) + (c[2] + c[3])) + ((d[0] + d[1]) + (d[2] + d[3])));
    s += __shfl_xor(s, 1);
    if (half == 0) rtab[row] = 1.0f / sqrtf(s * (1.f / 2048.f) + 1e-6f);
    asm volatile("s_waitcnt lgkmcnt(0)" ::: "memory"); __builtin_amdgcn_s_barrier(); asm volatile("" ::: "memory");
}
struct EpiResid {
    static constexpr bool PERM = true, AFTER_DRAIN = false;
    const float* xin0; const float* xin1;
    float* out; const float* gate;
    bf16_t* H; const float* gm; float* ssq;
    __device__ __forceinline__ void operator()(const f32x4 (&acc)[2][2][4][2], const Unit& u, int wr, int wc, int fr, int fq) const {
        const int mi = u.pm < 16 ? 0 : 1 + ((u.pm - 16) >> 4);
        const float* gp = gate + (size_t)mi * 6 * 2048; const float* xin = u.pm < 16 ? xin0 : xin1;
        const int col0 = u.pn * BM + wc * 32 + 8 * fq;
        f32x4 gv[2][2], gm4[2][2];
#pragma unroll
        for (int bj = 0; bj < 2; ++bj)
#pragma unroll
            for (int n = 0; n < 2; ++n) { gv[bj][n] = *(const f32x4*)(gp + col0 + bj * HALF + 4 * n); gm4[bj][n] = H ? *(const f32x4*)(gm + (size_t)mi * 2048 + col0 + bj * HALF + 4 * n) : (f32x4){0.f, 0.f, 0.f, 0.f}; }
#pragma unroll
        for (int ai = 0; ai < 2; ++ai)
#pragma unroll
            for (int m = 0; m < 4; ++m) { const int row = u.pm * BM + ai * HALF + wr * 64 + m * 16 + fr; const size_t off = (size_t)row * 2048 + col0; float ss = 0.f;
#pragma unroll
                for (int bj = 0; bj < 2; ++bj) { const f32x4 x0 = *(const f32x4*)(xin + off + bj * HALF), x1 = *(const f32x4*)(xin + off + bj * HALF + 4);
                    const f32x4 y0 = x0 + gv[bj][0] * acc[ai][bj][m][0], y1 = x1 + gv[bj][1] * acc[ai][bj][m][1];
                    *(f32x4*)(out + off + bj * HALF) = y0; *(f32x4*)(out + off + bj * HALF + 4) = y1;
                    ss += ((y0[0] * y0[0] + y0[1] * y0[1]) + (y0[2] * y0[2] + y0[3] * y0[3])) + ((y1[0] * y1[0] + y1[1] * y1[1]) + (y1[2] * y1[2] + y1[3] * y1[3]));
                    if (H) { const f32x4 h0 = y0 * gm4[bj][0], h1 = y1 * gm4[bj][1]; u32x4 w; w.x = cvt_pk_bf16(h0[0], h0[1]); w.y = cvt_pk_bf16(h0[2], h0[3]); w.z = cvt_pk_bf16(h1[0], h1[1]); w.w = cvt_pk_bf16(h1[2], h1[3]);
                        *(u32x4*)(H + off + bj * HALF) = w; } }
                if (H) { ss += __shfl_xor(ss, 16); ss += __shfl_xor(ss, 32); if (fq == 0) ssq[(size_t)row * 32 + u.pn * 4 + wc] = ss; } }
    }
};
struct EpiBf16Norm {
    static constexpr bool PERM = true, AFTER_DRAIN = false;
    bf16_t* O; int ldc; const float* ssq; const float* shw; int shw_ld; PG8_LAS float* rtab;
    static constexpr int qtiles = 2; static constexpr float qscale = 0.125f * 1.4426950408889634f;
    __device__ __forceinline__ void operator()(const f32x4 (&acc)[2][2][4][2], const Unit& u, int wr, int wc, int fr, int fq) const {
        const int mi = u.pm < 16 ? 0 : 1 + ((u.pm - 16) >> 4);
        rstd_table(ssq, u.pm, rtab, (wr * 4 + wc) * 64 + fq * 16 + fr);
        const int row0 = u.pm * BM + wr * 64 + fr, col0 = u.pn * BM + wc * 32 + 8 * fq; const float* sp = shw + (size_t)mi * shw_ld + col0;
        const float qs = u.pn < qtiles ? qscale : 1.f;
        f32x4 sv[2][2];
#pragma unroll
        for (int bj = 0; bj < 2; ++bj)
#pragma unroll
            for (int n = 0; n < 2; ++n) sv[bj][n] = *(const f32x4*)(sp + bj * HALF + 4 * n);
#pragma unroll
        for (int ai = 0; ai < 2; ++ai)
#pragma unroll
            for (int m = 0; m < 4; ++m) { const int row = row0 + ai * HALF + m * 16; const float rs = rtab[row - u.pm * BM];
                bf16_t* rowp = O + (size_t)row * ldc + col0;
#pragma unroll
                for (int bj = 0; bj < 2; ++bj) { const f32x4 v0 = (acc[ai][bj][m][0] * rs + sv[bj][0]) * qs, v1 = (acc[ai][bj][m][1] * rs + sv[bj][1]) * qs;
                    u32x4 w; w.x = cvt_pk_bf16(v0[0], v0[1]); w.y = cvt_pk_bf16(v0[2], v0[3]); w.z = cvt_pk_bf16(v1[0], v1[1]); w.w = cvt_pk_bf16(v1[2], v1[3]);
                    *(u32x4*)(rowp + bj * HALF) = w; } }
    }
};

struct EpiResidTail {
    static constexpr bool PERM = false, AFTER_DRAIN = false;
    float* X; const float* gate; float* scratch; unsigned* ticket; PG8_LAS unsigned* lw;
    __device__ __forceinline__ void operator()(const f32x4 (&acc)[2][2][4][2], const Unit& u, int wr, int wc, int fr, int fq) const {
        const int t = blockIdx.x >> 1, half = blockIdx.x & 1, tid = threadIdx.x;
        { const __amdgpu_buffer_rsrc_t rs = __builtin_amdgcn_make_buffer_rsrc(scratch + ((size_t)t * 2 + half) * 65536, 0, 65536 * 4, 0x00020000);
#pragma unroll
          for (int ai = 0; ai < 2; ++ai)
#pragma unroll
            for (int bj = 0; bj < 2; ++bj)
#pragma unroll
                for (int m = 0; m < 4; ++m)
#pragma unroll
                    for (int n = 0; n < 2; ++n) { const int j = ((ai * 2 + bj) * 4 + m) * 2 + n; __builtin_amdgcn_raw_buffer_store_b128(__builtin_bit_cast(u32x4, acc[ai][bj][m][n]), rs, (j * 512 + tid) * 16, 0, 16); } }
        asm volatile("s_waitcnt vmcnt(0)" ::: "memory"); __builtin_amdgcn_s_barrier(); asm volatile("" ::: "memory");
        if (tid == 0) { const unsigned old = __hip_atomic_fetch_add(ticket + 64 * t, 1u, __ATOMIC_RELAXED, __HIP_MEMORY_SCOPE_AGENT); *lw = old; }
        asm volatile("s_waitcnt vmcnt(0) lgkmcnt(0)" ::: "memory"); __builtin_amdgcn_s_barrier(); asm volatile("" ::: "memory");
        const unsigned old = *lw;
        if (old == 0u) return;
        __builtin_amdgcn_fence(__ATOMIC_ACQUIRE, "agent"); asm volatile("s_waitcnt vmcnt(0)" ::: "memory");
        const float* oth = scratch + ((size_t)t * 2 + (half ^ 1)) * 65536; const float* own = scratch + ((size_t)t * 2 + half) * 65536;
        const int mi = u.pm < 16 ? 0 : 1 + ((u.pm - 16) >> 4);
        const float* gp = gate + (size_t)mi * 6 * 2048;
        const int col0 = u.pn * BM + wc * 32 + 4 * fq;
#pragma unroll
        for (int ai = 0; ai < 2; ++ai)
#pragma unroll
            for (int m = 0; m < 4; ++m) { const size_t off = (size_t)(u.pm * BM + ai * HALF + wr * 64 + m * 16 + fr) * 2048 + col0;
#pragma unroll
                for (int bj = 0; bj < 2; ++bj)
#pragma unroll
                    for (int n = 0; n < 2; ++n) { const int j = ((ai * 2 + bj) * 4 + m) * 2 + n; const f32x4 pv = *(const f32x4*)(oth + (size_t)(j * 512 + tid) * 4) + *(const f32x4*)(own + (size_t)(j * 512 + tid) * 4);
                        const f32x4 gv = *(const f32x4*)(gp + col0 + bj * HALF + n * 16), xv = *(const f32x4*)(X + off + bj * HALF + n * 16);
                        *(f32x4*)(X + off + bj * HALF + n * 16) = xv + gv * pv; }
                asm volatile("" ::: "memory"); }
    }
};

__device__ __forceinline__ float dpp_ror1(float x) { return __builtin_bit_cast(float, __builtin_amdgcn_update_dpp(__builtin_bit_cast(int, x), __builtin_bit_cast(int, x), 0x121, 0xf, 0xf, false)); }
__device__ __forceinline__ float dpp_rol1(float x) { return __builtin_bit_cast(float, __builtin_amdgcn_update_dpp(__builtin_bit_cast(int, x), __builtin_bit_cast(int, x), 0x12F, 0xf, 0xf, false)); }
struct EpiConvAct {
    static constexpr bool PERM = true, AFTER_DRAIN = false;
    bf16_t* ACT; const float* cw; const float* cb; float* side; PG8_LAS float* ex;
    const float* ssq; const float* shw; PG8_LAS float* rtab;
    __device__ __forceinline__ void operator()(const f32x4 (&acc_)[2][2][4][2], const Unit& u, int wr, int wc, int fr, int fq) const {
        constexpr int FF = 5632;
        const int colw = wc * 32 + 8 * fq, j0 = u.pn * HALF + colw;
        f32x4 (&acc)[2][2][4][2] = const_cast<f32x4 (&)[2][2][4][2]>(acc_);
        rstd_table(ssq, u.pm, rtab, (wr * 4 + wc) * 64 + fq * 16 + fr);
        { const int mi = u.pm < 16 ? 0 : 1 + ((u.pm - 16) >> 4); const float* sp = shw + (size_t)mi * (2 * FF) + u.pn * BM + colw;
          f32x4 sv[2][2];
#pragma unroll
          for (int bj = 0; bj < 2; ++bj)
#pragma unroll
              for (int n = 0; n < 2; ++n) sv[bj][n] = *(const f32x4*)(sp + bj * HALF + 4 * n);
#pragma unroll
          for (int ai = 0; ai < 2; ++ai)
#pragma unroll
              for (int m = 0; m < 4; ++m) { const int row = u.pm * BM + ai * HALF + wr * 64 + m * 16 + fr; const float rs = rtab[row - u.pm * BM];
#pragma unroll
                  for (int bj = 0; bj < 2; ++bj)
#pragma unroll
                      for (int n = 0; n < 2; ++n) acc[ai][bj][m][n] = acc[ai][bj][m][n] * rs + sv[bj][n]; } }
        float w0[8], w1[8], w2[8], bb[8];
#pragma unroll
        for (int q = 0; q < 2; ++q) { const f32x4 a0 = *(const f32x4*)(cw + j0 + 4 * q), a1 = *(const f32x4*)(cw + FF + j0 + 4 * q), a2 = *(const f32x4*)(cw + 2 * FF + j0 + 4 * q), a3 = *(const f32x4*)(cb + j0 + 4 * q);
#pragma unroll
            for (int i = 0; i < 4; ++i) { w0[4 * q + i] = a0[i]; w1[4 * q + i] = a1[i]; w2[4 * q + i] = a2[i]; bb[4 * q + i] = a3[i]; } }
#pragma unroll
        for (int ai = 0; ai < 2; ++ai) { const int blk = 2 * ai + wr;
            if (fr == 0) {
#pragma unroll
                for (int n = 0; n < 2; ++n) *(PG8_LAS f32x4*)(ex + (blk * 2 + 0) * HALF + colw + 4 * n) = acc[ai][0][0][n]; }
            if (fr == 15) {
#pragma unroll
                for (int n = 0; n < 2; ++n) *(PG8_LAS f32x4*)(ex + (blk * 2 + 1) * HALF + colw + 4 * n) = acc[ai][0][3][n]; } }
        asm volatile("s_waitcnt lgkmcnt(0)" ::: "memory"); __builtin_amdgcn_s_barrier(); asm volatile("" ::: "memory");
#pragma unroll
        for (int ai = 0; ai < 2; ++ai) { const int blk = 2 * ai + wr;
#pragma unroll
            for (int m = 0; m < 4; ++m) { float ov[8]; float gcv[8]; float pe[8], ne[8];
                if (m == 0) {
#pragma unroll
                    for (int n = 0; n < 2; ++n) { const f32x4 p4 = blk > 0 ? *(const PG8_LAS f32x4*)(ex + ((blk - 1) * 2 + 1) * HALF + colw + 4 * n) : (f32x4){0.f, 0.f, 0.f, 0.f};
#pragma unroll
                        for (int i = 0; i < 4; ++i) pe[4 * n + i] = p4[i]; } }
                if (m == 3) {
#pragma unroll
                    for (int n = 0; n < 2; ++n) { const f32x4 n4 = blk < 3 ? *(const PG8_LAS f32x4*)(ex + ((blk + 1) * 2 + 0) * HALF + colw + 4 * n) : (f32x4){0.f, 0.f, 0.f, 0.f};
#pragma unroll
                        for (int i = 0; i < 4; ++i) ne[4 * n + i] = n4[i]; } }
#pragma unroll
                for (int k = 0; k < 8; ++k) { const int n = k >> 2, i = k & 3; const float g = acc[ai][0][m][n][i];
                    const float rs = dpp_ror1(g), ls = dpp_rol1(g);
                    const float rp = m > 0 ? dpp_ror1(acc[ai][0][m > 0 ? m - 1 : 0][n][i]) : pe[k];
                    const float ln = m < 3 ? dpp_rol1(acc[ai][0][m < 3 ? m + 1 : 3][n][i]) : ne[k];
                    const float gp = fr > 0 ? rs : rp, gn = fr < 15 ? ls : ln;
                    const float gc = w0[k] * gp + w1[k] * g + w2[k] * gn + bb[k];
                    gcv[k] = gc; ov[k] = gc * __builtin_amdgcn_rcpf(1.f + __expf(-gc)) * acc[ai][1][m][n][i]; }
                const int row = u.pm * BM + ai * HALF + wr * 64 + m * 16 + fr;
                u32x4 w; w.x = cvt_pk_bf16(ov[0], ov[1]); w.y = cvt_pk_bf16(ov[2], ov[3]); w.z = cvt_pk_bf16(ov[4], ov[5]); w.w = cvt_pk_bf16(ov[6], ov[7]);
                *(u32x4*)(ACT + (size_t)row * FF + j0) = w;
                const bool first = (ai == 0 && m == 0) && wr == 0 && fr == 0, last = (ai == 1 && m == 3) && wr == 1 && fr == 15;
                if ((ai == 0 && m == 0) || (ai == 1 && m == 3)) { if (first || last) { float* sp = side + ((size_t)(u.pm * 2 + (last ? 1 : 0)) * 3) * FF + j0;
#pragma unroll
                    for (int n = 0; n < 2; ++n) { *(f32x4*)(sp + 4 * n) = (f32x4){gcv[4 * n], gcv[4 * n + 1], gcv[4 * n + 2], gcv[4 * n + 3]}; *(f32x4*)(sp + FF + 4 * n) = acc[ai][1][m][n]; *(f32x4*)(sp + 2 * FF + 4 * n) = acc[ai][0][m][n]; } } }
            } }
    }
};
}

#define XB_TMO      128
#define XB_XCNT(j)  (256  + 64 * (j))
#define XB_XSUB(j)  (1280 + 64 * (j))
#define XB_XGEN(j)  (2304 + 64 * (j))
#define XB_TOP      3328
#define XB_TOPGEN   3392
#define XCD_BAR_WORDS 3456
#define XB_SPIN_CAP (1u << 18)
__device__ __forceinline__ unsigned xb_ld(unsigned* p)              { return __hip_atomic_load(p, __ATOMIC_RELAXED, __HIP_MEMORY_SCOPE_AGENT); }
__device__ __forceinline__ unsigned xb_add(unsigned* p, unsigned v) { return __hip_atomic_fetch_add(p, v, __ATOMIC_RELAXED, __HIP_MEMORY_SCOPE_AGENT); }
__device__ __forceinline__ unsigned xb_xcc_id() { return (unsigned)__builtin_amdgcn_s_getreg((3 << 11) | 20) & 0xFu; }
#define XB_SPIN(cond, bar) do { unsigned _sp = 0; while (cond) { __builtin_amdgcn_s_sleep(1); \
    if ((++_sp & 255u) == 0u) { if (xb_ld(&(bar)[XB_TMO])) break; if (_sp > XB_SPIN_CAP) { atomicAdd(&(bar)[XB_TMO], 1u); break; } } } } while (0)
struct XcdBarrier { unsigned* bar; unsigned x; volatile LAS unsigned* st; };
__device__ __forceinline__ XcdBarrier xcd_barrier_post(unsigned* bar, volatile LAS unsigned* st) {
    XcdBarrier b; b.bar = bar; b.x = xb_xcc_id(); b.st = st;
    if (threadIdx.x == 0) (void)xb_add(&bar[XB_XCNT(b.x)], 1u);
    return b;
}
__device__ __forceinline__ void xcd_barrier_complete(unsigned* bar, unsigned x, unsigned& nloc, unsigned& nx) {
    const unsigned G = gridDim.x * gridDim.y * gridDim.z;
    unsigned sum, cnt, mine, sp = 0u;
    for (;;) {
        sum = 0u; cnt = 0u; mine = 0u;
#pragma unroll
        for (unsigned j = 0; j < 16; ++j) { const unsigned c = xb_ld(&bar[XB_XCNT(j)]); sum += c; cnt += (c > 0u) ? 1u : 0u; mine = (j == x) ? c : mine; }
        if (sum == G) break;
        __builtin_amdgcn_s_sleep(1);
        if ((++sp & 255u) == 0u) { if (xb_ld(&bar[XB_TMO])) break; if (sp > XB_SPIN_CAP) { atomicAdd(&bar[XB_TMO], 1u); break; } }
    }
    nloc = mine > 0u ? mine : 1u; nx = cnt > 0u ? cnt : 1u;
}
__device__ __forceinline__ void xcd_barrier(const XcdBarrier& b, int tid) {
    asm volatile("s_waitcnt vmcnt(0)" ::: "memory");
    __syncthreads();
    if (tid == 0) {
        unsigned* bar = b.bar;
        __builtin_amdgcn_s_waitcnt(0);
        unsigned nloc = b.st[0], nx = b.st[1];
        if (nloc == 0u) { xcd_barrier_complete(bar, b.x, nloc, nx); b.st[0] = nloc; b.st[1] = nx; }
        const unsigned old = xb_add(&bar[XB_XSUB(b.x)], 1u);
        const unsigned gen = old / nloc;
        if (old + 1u == (gen + 1u) * nloc) {
            __builtin_amdgcn_fence(__ATOMIC_RELEASE, "agent");
            asm volatile("s_waitcnt vmcnt(0)" ::: "memory");
            const unsigned og = xb_add(&bar[XB_TOP], 1u);
            const unsigned tg = og / nx;
            if (og + 1u == (tg + 1u) * nx) xb_add(&bar[XB_TOPGEN], 1u);
            else XB_SPIN(xb_ld(&bar[XB_TOPGEN]) == tg, bar);
            __builtin_amdgcn_fence(__ATOMIC_ACQUIRE, "agent");
            xb_add(&bar[XB_XGEN(b.x)], 1u);
            asm volatile("s_waitcnt vmcnt(0)" ::: "memory");
        } else {
            XB_SPIN(xb_ld(&bar[XB_XGEN(b.x)]) == gen, bar);
            __builtin_amdgcn_fence(__ATOMIC_ACQUIRE, "agent");
            asm volatile("s_waitcnt vmcnt(0)" ::: "memory");
        }
    }
    __syncthreads();
}

#ifndef MK_MFMA_ATT
#define MK_MFMA_ATT 1
#endif
#ifndef MK_MFMA_GLA
#define MK_MFMA_GLA 1
#endif
#ifndef MK_SPLITK
#define MK_SPLITK 0
#endif
constexpr int NWV = 8, NTH = 512;

template <bool UPMAP = false>
__device__ __forceinline__ void transpose_item(const float* W, int K, int N, bf16* WT, LAS float* scr, int item, int lane) {
    const int nblk = N / 32, kb = item / nblk, nb = item % nblk, k0 = 64 * kb, n0 = 32 * nb;
    const int nd0 = UPMAP ? (n0 < DFF ? 256 * (n0 >> 7) + (n0 & 127) : 256 * ((n0 - DFF) >> 7) + 128 + ((n0 - DFF) & 127)) : n0;
    float wv[32];
#pragma unroll
    for (int i = 0; i < 32; ++i) wv[i] = __builtin_nontemporal_load(W + (size_t)(k0 + 2 * i + (lane >> 5)) * N + n0 + (lane & 31));
#pragma unroll
    for (int i = 0; i < 32; ++i) scr[(2 * i + (lane >> 5)) * 33 + (lane & 31)] = wv[i];
    LDS_WAIT(); asm volatile("" ::: "memory");
    const int c = lane & 7;
#pragma unroll
    for (int j = 0; j < 4; ++j) { const int n = (lane >> 3) + 8 * j; const LAS float* s = scr + (8 * c) * 33 + n;
        v4u o; o.x = pk2(s[0 * 33], s[1 * 33]); o.y = pk2(s[2 * 33], s[3 * 33]); o.z = pk2(s[4 * 33], s[5 * 33]); o.w = pk2(s[6 * 33], s[7 * 33]);
        *(v4u*)(WT + (size_t)(nd0 + n) * K + k0 + 8 * c) = o; }
    LDS_WAIT(); asm volatile("" ::: "memory");
}

struct Args { const float* in[N_INPUTS]; float* out; unsigned char* ws; int ph_lo, ph_hi, use_bar, pad; };

__device__ __forceinline__ void pro0_phase(const Args& a, LAS unsigned char* lds, int tid, int lane, int wave, int bid, int G) {
    unsigned char* ws = a.ws;
    const int gw = bid * NWV + wave, NGW = G * NWV;
    LAS float* scr = (LAS float*)(lds + wave * 16384);
    constexpr int IT_IN = (DM / 64) * (NIN / 32), IT_OUT = (DM / 64) * (DM / 32), IT_UP = (DM / 64) * (2 * DFF / 32), IT_DN = (DFF / 64) * (DM / 32), IT_Q = (384 / 64) * (NQC / 32), IT_KV = (256 / 64) * (NKV / 32);
    constexpr int IT_L = IT_IN + IT_OUT + IT_UP + IT_DN + IT_Q + IT_KV;
    for (int it = gw; it < DEPTH * IT_L; it += NGW) {
        const int l = it / IT_L; int r = it % IT_L;
        if (r < IT_IN) { transpose_item(a.in[I_WIN] + (size_t)l * DM * NIN, DM, NIN, (bf16*)(ws + WS_WIN + l * SZ_WIN), scr, r, lane); continue; } r -= IT_IN;
        if (r < IT_OUT) { transpose_item(a.in[I_WOUT] + (size_t)l * DM * DM, DM, DM, (bf16*)(ws + WS_WOUT + l * SZ_WOUT), scr, r, lane); continue; } r -= IT_OUT;
        if (r < IT_UP) { transpose_item<true>(a.in[I_WUP] + (size_t)l * DM * 2 * DFF, DM, 2 * DFF, (bf16*)(ws + WS_WUP + l * SZ_WUP), scr, r, lane); continue; } r -= IT_UP;
        if (r < IT_DN) { transpose_item(a.in[I_WDOWN] + (size_t)l * DFF * DM, DFF, DM, (bf16*)(ws + WS_WDN + l * SZ_WDN), scr, r, lane); continue; } r -= IT_DN;
        if (r < IT_Q) { transpose_item(a.in[I_CQUP] + (size_t)l * 384 * NQC, 384, NQC, (bf16*)(ws + WS_WQ + l * SZ_WQ), scr, r, lane); continue; } r -= IT_Q;
        transpose_item(a.in[I_CKVUP] + (size_t)l * 256 * NKV, 256, NKV, (bf16*)(ws + WS_WKV + l * SZ_WKV), scr, r, lane);
    }
    const int gt = bid * NTH + tid, NGT = G * NTH;
    for (int i = gt; i < DEPTH * (NINP - NIN) * DM / 8; i += NGT) { const int l = i / ((NINP - NIN) * DM / 8), r = i % ((NINP - NIN) * DM / 8); *(v4u*)(ws + WS_WIN + l * SZ_WIN + (size_t)NIN * DM * 2 + (size_t)r * 16) = (v4u){0u, 0u, 0u, 0u}; }
    for (int i = gt; i < DEPTH * (NQCP - NQC) * 384 / 8; i += NGT) { const int l = i / ((NQCP - NQC) * 384 / 8), r = i % ((NQCP - NQC) * 384 / 8); *(v4u*)(ws + WS_WQ + l * SZ_WQ + (size_t)NQC * 384 * 2 + (size_t)r * 16) = (v4u){0u, 0u, 0u, 0u}; }
    for (int i = gt; i < DEPTH * (NKVP - NKV) * 256 / 8; i += NGT) { const int l = i / ((NKVP - NKV) * 256 / 8), r = i % ((NKVP - NKV) * 256 / 8); *(v4u*)(ws + WS_WKV + l * SZ_WKV + (size_t)NKV * 256 * 2 + (size_t)r * 16) = (v4u){0u, 0u, 0u, 0u}; }
    {
        LAS float* sc = (LAS float*)lds;
        __syncthreads();
        for (int it = bid; it < DEPTH * 24 * 8; it += G) {
            const int l = it / 192, cb = (it / 8) % 24, ks = it % 8;
            __syncthreads();
            for (int e = tid; e < 5 * 256; e += NTH) { const int mi = e >> 8, k = ks * 256 + (e & 255); const float cv = mi == 0 ? a.in[I_CCTX][k] : a.in[I_C][(mi - 1) * DM + k]; sc[e] = cv / (1.f + expf(-cv)); }
            __syncthreads();
            const float* wp = a.in[I_ADAW] + ((size_t)l * DM + ks * 256) * (6 * DM) + cb * 512 + tid;
            float s0 = 0.f, s1 = 0.f, s2 = 0.f, s3 = 0.f, s4 = 0.f;
#pragma unroll 8
            for (int k = 0; k < 256; ++k) { const float w = __builtin_nontemporal_load(wp + (size_t)k * (6 * DM)); s0 += sc[k] * w; s1 += sc[256 + k] * w; s2 += sc[512 + k] * w; s3 += sc[768 + k] * w; s4 += sc[1024 + k] * w; }
            float* mp = (float*)(ws + WS_MODP) + ((size_t)ks * DEPTH + l) * 5 * 6 * DM + cb * 512 + tid;
            mp[0] = s0; mp[6 * DM] = s1; mp[2 * 6 * DM] = s2; mp[3 * 6 * DM] = s3; mp[4 * 6 * DM] = s4;
        }
        __syncthreads();
    }
    { const float* s = a.in[I_CAK]; bf16* d = (bf16*)(ws + WS_CAK); for (int i = gt; i < NDB * DEPTH * PAST * 512; i += NGT) d[i] = (bf16)f2bf(s[i]); }
    { const float* s = a.in[I_CAV]; bf16* d = (bf16*)(ws + WS_CAV); for (int i = gt; i < NDB * DEPTH * PAST * 512; i += NGT) d[i] = (bf16)f2bf(s[i]); }
    { const float* s = a.in[I_CCKR]; bf16* d = (bf16*)(ws + WS_CKRX); for (int i = gt; i < NDB * DEPTH * PAST * 32; i += NGT) d[i] = (bf16)f2bf(s[i]); }
    { const float* s = a.in[I_CCKV]; bf16* d = (bf16*)(ws + WS_CKVA);
      for (int i = gt; i < NDB * DEPTH * PAST * 256; i += NGT) { const int c = i & 255, j = (i >> 8) & 255, bl = i >> 16, b = bl >> 2, l = bl & 3; d[(((size_t)l * NDB + b) * PAST + j) * 256 + c] = (bf16)f2bf(s[i]); } }
    { float* ra = (float*)(ws + WS_RTA); float* rc = (float*)(ws + WS_RTC);
      for (int i = gt; i < DSEQ * 16; i += NGT) { const int t = i >> 4, j = i & 15; const float inv = powf(10000.f, -(float)j / 16.f); const float ar = (float)(t >> 6) * inv, ac = (float)(t & 63) * inv;
          ra[t * 64 + j] = cosf(ar); ra[t * 64 + 16 + j] = sinf(ar); ra[t * 64 + 32 + j] = cosf(ac); ra[t * 64 + 48 + j] = sinf(ac); }
      for (int i = gt; i < DSEQ * 8; i += NGT) { const int t = i >> 3, j = i & 7; const float inv = powf(10000.f, -(float)j / 8.f); const float ar = (float)(t >> 6) * inv, ac = (float)(t & 63) * inv;
          rc[t * 32 + j] = cosf(ar); rc[t * 32 + 8 + j] = sinf(ar); rc[t * 32 + 16 + j] = cosf(ac); rc[t * 32 + 24 + j] = sinf(ac); } }
    if (gt < DEPTH) { const int l = gt; float d1 = 0.f, d2 = 0.f;
        for (int i = 0; i < 64; ++i) { d1 += a.in[I_LQ1][l * 64 + i] * a.in[I_LK1][l * 64 + i]; d2 += a.in[I_LQ2][l * 64 + i] * a.in[I_LK2][l * 64 + i]; }
        const float li = 0.8f - 0.6f * expf(-0.3f * (float)l);
        float* lam = (float*)(ws + WS_LAM); lam[l] = expf(d1) - expf(d2) + li; lam[4 + l] = li; }
}

__device__ __forceinline__ void modfin_phase(const Args& a, int gt, int NGT) {
    const float* mp = (const float*)(a.ws + WS_MODP); float* mo = (float*)(a.ws + WS_MOD);
    for (int i = gt; i < DEPTH * 5 * 6 * DM; i += NGT) { const int l = i / (5 * 6 * DM), n = i % (6 * DM); float s = a.in[I_ADAB][l * 6 * DM + n];
#pragma unroll
        for (int ks = 0; ks < 8; ++ks) s += mp[(size_t)ks * DEPTH * 5 * 6 * DM + i];
        mo[i] = s; }
}


namespace att {
using bf16x8 = __attribute__((ext_vector_type(8))) short;
using s16x4  = __attribute__((ext_vector_type(4))) short;
using f32x16 = __attribute__((ext_vector_type(16))) float;
using u32x4  = __attribute__((ext_vector_type(4))) unsigned;
constexpr int SHM_V = 64 * 128 * 2;
#define ATT_SBAR() __builtin_amdgcn_sched_barrier(0)
#define ATT_LBAR() asm volatile("s_waitcnt lgkmcnt(0)\n\ts_barrier" ::: "memory")
__device__ __forceinline__ int crow(int r, int hi) { return (r & 3) + 8 * (r >> 2) + 4 * hi; }
__device__ __forceinline__ unsigned cvtpk(float lo, float hi) { unsigned r; asm volatile("v_cvt_pk_bf16_f32 %0, %1, %2" : "=v"(r) : "v"(lo), "v"(hi)); return r; }
template <bool TUP> __device__ __forceinline__ void partialSM(f32x16& p0, f32x16& p1, float& m_reg, f32x16& negm, float& alpha, float thr, bool first) {
  if constexpr (!TUP) {
    typedef float f32x2 __attribute__((ext_vector_type(2))); const f32x2 M2 = {-m_reg, -m_reg};
#pragma unroll
    for (int r = 0; r < 16; r += 2) { f32x2 v = {p0[r], p0[r + 1]}; v += M2; p0[r] = v.x; p0[r + 1] = v.y; f32x2 w = {p1[r], p1[r + 1]}; w += M2; p1[r] = w.x; p1[r + 1] = w.y; } }
  float pmax = fmaxf(fmaxf(p0[0], p0[1]), p0[2]);
#pragma unroll
  for (int r = 3; r < 15; r += 2) pmax = fmaxf(fmaxf(pmax, p0[r]), p0[r + 1]);
  pmax = fmaxf(pmax, p0[15]);
#pragma unroll
  for (int r = 0; r < 16; r += 2) pmax = fmaxf(fmaxf(pmax, p1[r]), p1[r + 1]);
  { auto rr = __builtin_amdgcn_permlane32_swap(__float_as_uint(pmax), __float_as_uint(pmax), false, false);
    pmax = fmaxf(__uint_as_float(rr[0]), __uint_as_float(rr[1])); }
  if (__builtin_expect(!first && __all(pmax <= thr), 1)) { alpha = 1.f; }
  else { const float delta = first ? pmax : fmaxf(pmax, 0.f); alpha = __builtin_amdgcn_exp2f(-delta); m_reg += delta;
#pragma unroll
    for (int r = 0; r < 16; ++r) { p0[r] -= delta; p1[r] -= delta; }
    if constexpr (TUP) { const float nm = -m_reg;
#pragma unroll
      for (int r = 0; r < 16; ++r) negm[r] = nm;
      asm volatile("" : "+v"(negm)); } }
#pragma unroll
  for (int r = 0; r < 16; ++r) p0[r] = __builtin_amdgcn_exp2f(p0[r]);
}
__device__ __forceinline__ void finishSM(f32x16& p0, f32x16& p1, float alpha, float& l_reg, bf16x8& pa0, bf16x8& pa1, bf16x8& pa2, bf16x8& pa3) {
#pragma unroll
  for (int r = 0; r < 16; ++r) p1[r] = __builtin_amdgcn_exp2f(p1[r]);
  float ps;
  { typedef float f32x2 __attribute__((ext_vector_type(2))); f32x2 s2 = {p0[0], p0[1]};
#pragma unroll
    for (int r = 2; r < 16; r += 2) s2 += (f32x2){p0[r], p0[r + 1]};
#pragma unroll
    for (int r = 0; r < 16; r += 2) s2 += (f32x2){p1[r], p1[r + 1]};
    ps = s2.x + s2.y; }
  { auto rr = __builtin_amdgcn_permlane32_swap(__float_as_uint(ps), __float_as_uint(ps), false, false);
    ps = __uint_as_float(rr[0]) + __uint_as_float(rr[1]); }
  l_reg = l_reg * alpha + ps;
#define ATT_PK4(P, BASE, OUT) do { unsigned a0 = cvtpk(P[BASE + 0], P[BASE + 1]), a1 = cvtpk(P[BASE + 2], P[BASE + 3]);   \
    unsigned b0 = cvtpk(P[BASE + 4], P[BASE + 5]), b1 = cvtpk(P[BASE + 6], P[BASE + 7]);                              \
    auto r0 = __builtin_amdgcn_permlane32_swap(a0, b0, false, false); auto r1 = __builtin_amdgcn_permlane32_swap(a1, b1, false, false); \
    u32x4 w = {r0[0], r1[0], r0[1], r1[1]}; OUT = __builtin_bit_cast(bf16x8, w); } while (0)
  ATT_PK4(p0, 0, pa0); ATT_PK4(p0, 8, pa1); ATT_PK4(p1, 0, pa2); ATT_PK4(p1, 8, pa3);
#undef ATT_PK4
}
template <int DQK, bool TUP>
__device__ __forceinline__ void qkt(f32x16& p0, f32x16& p1, const LAS unsigned char* Ks, const bf16x8* qr, int r32, int hi, const f32x16& negm) {
  constexpr int RS = DQK * 2 + 16;
  if constexpr (TUP) { p0 = negm; p1 = negm; } else { p0 = f32x16{}; p1 = f32x16{}; }
#pragma unroll
  for (int d0 = 0; d0 < DQK / 16; ++d0) { const int cb = d0 * 32 + hi * 16;
    const bf16x8 b0 = *(const LAS bf16x8*)(Ks + r32 * RS + cb);
    const bf16x8 b1 = *(const LAS bf16x8*)(Ks + (32 + r32) * RS + cb);
    p0 = __builtin_amdgcn_mfma_f32_32x32x16_bf16(b0, qr[d0], p0, 0, 0, 0);
    p1 = __builtin_amdgcn_mfma_f32_32x32x16_bf16(b1, qr[d0], p1, 0, 0, 0); }
}
__device__ __forceinline__ int v_st(int k, int c) { const int kk = (k & ~0xC) | ((k & 4) << 1) | ((k & 8) >> 1); return ((kk >> 3) * 4 + (c >> 5)) * 512 + ((kk & 7) * 32 + (c & 31)) * 2; }
__device__ __forceinline__ int v_rd_base(int lane) { return ((lane & 3) << 3) | (((lane >> 2) & 3) << 6) | (((lane >> 4) & 1) << 5) | (((lane >> 5) & 1) << 8); }
constexpr int v_rd_off(int d0, int ks, int half) { return d0 * 512 + ks * 4096 + half * 2048; }
template <int OFF> __device__ __forceinline__ s16x4 tr_read(int vb) {
  s16x4 r; asm volatile("ds_read_b64_tr_b16 %0, %1 offset:%2" : "=&v"(r) : "v"(vb), "i"(OFF) : "memory"); return r;
}
template <int D0> __device__ __forceinline__ void pv_one(f32x16& od, int vb, bf16x8 pa0, bf16x8 pa1, bf16x8 pa2, bf16x8 pa3) {
  const s16x4 l0 = tr_read<v_rd_off(D0, 0, 0)>(vb), h0 = tr_read<v_rd_off(D0, 0, 1)>(vb), l1 = tr_read<v_rd_off(D0, 1, 0)>(vb), h1 = tr_read<v_rd_off(D0, 1, 1)>(vb);
  const s16x4 l2 = tr_read<v_rd_off(D0, 2, 0)>(vb), h2 = tr_read<v_rd_off(D0, 2, 1)>(vb), l3 = tr_read<v_rd_off(D0, 3, 0)>(vb), h3 = tr_read<v_rd_off(D0, 3, 1)>(vb);
  asm volatile("s_waitcnt lgkmcnt(0)" ::: "memory"); ATT_SBAR();
#define ATT_PK(L, H) (bf16x8){L[0], L[1], L[2], L[3], H[0], H[1], H[2], H[3]}
  od = __builtin_amdgcn_mfma_f32_32x32x16_bf16(pa0, ATT_PK(l0, h0), od, 0, 0, 0);
  od = __builtin_amdgcn_mfma_f32_32x32x16_bf16(pa1, ATT_PK(l1, h1), od, 0, 0, 0);
  od = __builtin_amdgcn_mfma_f32_32x32x16_bf16(pa2, ATT_PK(l2, h2), od, 0, 0, 0);
  od = __builtin_amdgcn_mfma_f32_32x32x16_bf16(pa3, ATT_PK(l3, h3), od, 0, 0, 0);
#undef ATT_PK
}
__device__ __forceinline__ void pv_d0(f32x16* o, int vb, bf16x8 pa0, bf16x8 pa1, bf16x8 pa2, bf16x8 pa3) {
  pv_one<0>(o[0], vb, pa0, pa1, pa2, pa3); pv_one<1>(o[1], vb, pa0, pa1, pa2, pa3); pv_one<2>(o[2], vb, pa0, pa1, pa2, pa3); pv_one<3>(o[3], vb, pa0, pa1, pa2, pa3);
}
__device__ __forceinline__ float bfe(bf16x8 v, int e) { return __builtin_bit_cast(float, (unsigned)(unsigned short)v[e] << 16); }
}

struct KSeg { const bf16* kn; int ldn; const bf16* kr; int ldr; const bf16* v; int ldv; int n; };

template <int DQK, int SD, bool OUTBF>
__device__ __forceinline__ void attn_mfma_unit(LAS unsigned char* lds, const bf16* Qp, int ldq, bool rot, const float* rt, int t0, const KSeg& ctx, const KSeg& lat, float scale, void* Opv, int tid,
                                               bool fin = false, float lam = 0.f, float gsc = 0.f, const float* ag = nullptr, bf16* Mx = nullptr) {
  using namespace att;
  constexpr int NF = DQK / 16, RS = DQK * 2 + 16, SHM_K = 64 * RS;
  const int wid = tid >> 6, lane = tid & 63, r32 = lane & 31, hi = lane >> 5;
  LAS unsigned char* V_lds = lds; LAS unsigned char* K_lds = lds + 2 * SHM_V;
  LAS float* wsf = (LAS float*)(lds + 2 * SHM_V + 2 * SHM_K) + wid * 64; LAS float* li_l = wsf; LAS float* al_l = wsf + 32;
  (void)scale;
  const float thr = 8.f * 1.4426950408889634f;
  float m_reg = 0.f, l_reg = 0; f32x16 negm = {}; f32x16 o[4] = {}; bf16x8 qr[NF];
  const bf16* Qw = Qp + (size_t)(wid * 32 + r32) * ldq + hi * 8;
#pragma unroll
  for (int d0 = 0; d0 < NF; ++d0) qr[d0] = *reinterpret_cast<const bf16x8*>(Qw + d0 * 16);
  const int sr = tid >> 4, sc = (tid & 15) * 8, vst0 = v_st(sr, sc), vst1 = v_st(32 + sr, sc);
  const int krow = tid >> 3, kch = tid & 7, xrow = tid >> 2, xch = tid & 3; const bool xld = (DQK == 96) && tid < 256;
  const int vb0 = (int)(unsigned)(uintptr_t)V_lds + v_rd_base(lane);
  const int nct = ctx.n >> 6, NT = nct + (lat.n >> 6);
  constexpr int SE = 0, SO = SD - 1;
  struct { bf16x8 vs0, vs1, kn, kx; } st[SD];
#define ATT_SLOAD(i, j) do { const int j_ = (j); const bool c_ = j_ < nct; const KSeg& S_ = c_ ? ctx : lat; const int k0_ = (c_ ? j_ : j_ - nct) * 64; \
    st[i].vs0 = *reinterpret_cast<const bf16x8*>(S_.v + (size_t)(k0_ + sr) * S_.ldv + sc); st[i].vs1 = *reinterpret_cast<const bf16x8*>(S_.v + (size_t)(k0_ + 32 + sr) * S_.ldv + sc); \
    st[i].kn = *reinterpret_cast<const bf16x8*>(S_.kn + (size_t)(k0_ + krow) * S_.ldn + kch * 8); \
    if (xld) st[i].kx = *reinterpret_cast<const bf16x8*>(S_.kr + (size_t)(k0_ + xrow) * S_.ldr + xch * 8); } while (0)
#define ATT_SWRITE(b, i) do { *(LAS bf16x8*)(V_lds + (b) * SHM_V + vst0) = st[i].vs0; *(LAS bf16x8*)(V_lds + (b) * SHM_V + vst1) = st[i].vs1; \
    *(LAS bf16x8*)(K_lds + (b) * SHM_K + krow * RS + kch * 16) = st[i].kn; \
    if (xld) *(LAS bf16x8*)(K_lds + (b) * SHM_K + xrow * RS + 128 + xch * 16) = st[i].kx; } while (0)
#define ATT_SWAIT() do { if constexpr (SD == 2) asm volatile("s_waitcnt vmcnt(3)" ::: "memory"); else asm volatile("s_waitcnt vmcnt(0)" ::: "memory"); } while (0)
#define ATT_RESC(a) do { if (__any((a) < 1.f)) { if (hi == 0) al_l[r32] = (a); asm volatile("s_waitcnt lgkmcnt(0)" ::: "memory"); \
    _Pragma("unroll") for (int d = 0; d < 4; ++d) _Pragma("unroll") for (int r = 0; r < 16; ++r) o[d][r] *= al_l[crow(r, hi)]; } } while (0)
#define ATT_ROTQ() do { const int t_ = t0 + wid * 32 + r32; \
    if constexpr (DQK == 64) { const float* tb = rt + (size_t)t_ * 64 + hi * 8; u32x4 w0, w1, w2, w3; \
        float y0[8], y1[8], y2[8], y3[8]; \
        _Pragma("unroll") for (int e = 0; e < 8; ++e) { const float cr = tb[e], sn = tb[16 + e], cc = tb[32 + e], sc2 = tb[48 + e]; \
            const float x0 = bfe(qr[0], e), x1 = bfe(qr[1], e), x2 = bfe(qr[2], e), x3 = bfe(qr[3], e); \
            y0[e] = x0 * cr - x1 * sn; y1[e] = x1 * cr + x0 * sn; y2[e] = x2 * cc - x3 * sc2; y3[e] = x3 * cc + x2 * sc2; } \
        w0 = (u32x4){cvtpk(y0[0], y0[1]), cvtpk(y0[2], y0[3]), cvtpk(y0[4], y0[5]), cvtpk(y0[6], y0[7])}; w1 = (u32x4){cvtpk(y1[0], y1[1]), cvtpk(y1[2], y1[3]), cvtpk(y1[4], y1[5]), cvtpk(y1[6], y1[7])}; \
        w2 = (u32x4){cvtpk(y2[0], y2[1]), cvtpk(y2[2], y2[3]), cvtpk(y2[4], y2[5]), cvtpk(y2[6], y2[7])}; w3 = (u32x4){cvtpk(y3[0], y3[1]), cvtpk(y3[2], y3[3]), cvtpk(y3[4], y3[5]), cvtpk(y3[6], y3[7])}; \
        qr[0] = __builtin_bit_cast(bf16x8, w0); qr[1] = __builtin_bit_cast(bf16x8, w1); qr[2] = __builtin_bit_cast(bf16x8, w2); qr[3] = __builtin_bit_cast(bf16x8, w3); \
    } else { const float* tb = rt + (size_t)t_ * 32; const float sg = hi ? 1.f : -1.f; \
        const u32x4 a4 = __builtin_bit_cast(u32x4, qr[NF - 2]), a5 = __builtin_bit_cast(u32x4, qr[NF - 1]); u32x4 p4, p5; \
        _Pragma("unroll") for (int i = 0; i < 4; ++i) { p4[i] = (unsigned)__shfl_xor((int)a4[i], 32); p5[i] = (unsigned)__shfl_xor((int)a5[i], 32); } \
        const bf16x8 q4 = __builtin_bit_cast(bf16x8, p4), q5 = __builtin_bit_cast(bf16x8, p5); float y4[8], y5[8]; \
        _Pragma("unroll") for (int e = 0; e < 8; ++e) { const float cr = tb[e], sn = tb[8 + e], cc = tb[16 + e], sc2 = tb[24 + e]; \
            y4[e] = bfe(qr[NF - 2], e) * cr + sg * bfe(q4, e) * sn; y5[e] = bfe(qr[NF - 1], e) * cc + sg * bfe(q5, e) * sc2; } \
        const u32x4 w4 = {cvtpk(y4[0], y4[1]), cvtpk(y4[2], y4[3]), cvtpk(y4[4], y4[5]), cvtpk(y4[6], y4[7])}, w5 = {cvtpk(y5[0], y5[1]), cvtpk(y5[2], y5[3]), cvtpk(y5[4], y5[5]), cvtpk(y5[6], y5[7])}; \
        qr[NF - 2] = __builtin_bit_cast(bf16x8, w4); qr[NF - 1] = __builtin_bit_cast(bf16x8, w5); } } while (0)
  f32x16 pA0, pA1, pB0, pB1; float alA, alB; bf16x8 pa0, pa1, pa2, pa3;
  ATT_SLOAD(SE, 0); asm volatile("s_waitcnt vmcnt(0)" ::: "memory"); ATT_SWRITE(0, SE); ATT_LBAR();
  qkt<DQK, DQK == 64>(pA0, pA1, K_lds, qr, r32, hi, negm); partialSM<DQK == 64>(pA0, pA1, m_reg, negm, alA, thr, true);
  ATT_SLOAD(SO, 1); if constexpr (SD == 2) { if (2 < NT) ATT_SLOAD(SE, 2); }
  ATT_SWAIT(); ATT_SWRITE(1, SO); ATT_LBAR();
  for (int j = 1; j + 1 < NT; j += 2) {
    ATT_SBAR(); qkt<DQK, DQK == 64>(pB0, pB1, K_lds + SHM_K, qr, r32, hi, negm);
    finishSM(pA0, pA1, alA, l_reg, pa0, pa1, pa2, pa3); ATT_SBAR();
    ATT_SLOAD(SO, j + SD); ATT_SBAR();
    pv_d0(o, vb0, pa0, pa1, pa2, pa3); partialSM<DQK == 64>(pB0, pB1, m_reg, negm, alB, thr, false);
    ATT_LBAR(); ATT_SWAIT(); ATT_SWRITE(0, SE);
    ATT_RESC(alB); ATT_LBAR();
    if (rot && j + 1 == nct) ATT_ROTQ();
    ATT_SBAR(); qkt<DQK, DQK == 64>(pA0, pA1, K_lds, qr, r32, hi, negm);
    finishSM(pB0, pB1, alB, l_reg, pa0, pa1, pa2, pa3); ATT_SBAR();
    if (SD == 1 || j + 3 < NT) ATT_SLOAD(SE, j + 1 + SD); ATT_SBAR();
    pv_d0(o, vb0 + SHM_V, pa0, pa1, pa2, pa3); partialSM<DQK == 64>(pA0, pA1, m_reg, negm, alA, thr, false);
    ATT_LBAR(); ATT_SWAIT(); ATT_SWRITE(1, SO);
    ATT_RESC(alA); ATT_LBAR();
  }
  ATT_SBAR(); qkt<DQK, DQK == 64>(pB0, pB1, K_lds + SHM_K, qr, r32, hi, negm);
  finishSM(pA0, pA1, alA, l_reg, pa0, pa1, pa2, pa3); ATT_SBAR();
  pv_d0(o, vb0, pa0, pa1, pa2, pa3); partialSM<DQK == 64>(pB0, pB1, m_reg, negm, alB, thr, false);
  ATT_LBAR(); ATT_RESC(alB);
  finishSM(pB0, pB1, alB, l_reg, pa0, pa1, pa2, pa3); ATT_SBAR();
  pv_d0(o, vb0 + SHM_V, pa0, pa1, pa2, pa3);
  if (hi == 0) li_l[r32] = l_reg; asm volatile("s_waitcnt lgkmcnt(0)" ::: "memory");
  float rli[16];
#pragma unroll
  for (int r = 0; r < 16; ++r) rli[r] = __builtin_amdgcn_rcpf(li_l[crow(r, hi)]);
  if constexpr (OUTBF) { bf16* Ow = (bf16*)Opv + (size_t)(wid * 32) * DM;
#pragma unroll
    for (int r = 0; r < 16; ++r) { const int orow = crow(r, hi);
#pragma unroll
      for (int d0 = 0; d0 < 4; ++d0) Ow[(size_t)orow * DM + d0 * 32 + r32] = (bf16)f2bf(o[d0][r] * rli[r]); }
  } else { float* Ow = (float*)Opv + (size_t)(wid * 32) * NOATT;
    if (!fin) {
#pragma unroll
      for (int r = 0; r < 16; ++r) { const int orow = crow(r, hi);
#pragma unroll
        for (int d0 = 0; d0 < 4; ++d0) Ow[(size_t)orow * NOATT + d0 * 32 + r32] = o[d0][r] * rli[r]; }
    } else {
      bf16* Mw = Mx + (size_t)(wid * 32) * DM; float gv[4];
#pragma unroll
      for (int d0 = 0; d0 < 4; ++d0) gv[d0] = ag[d0 * 32 + r32] * gsc;
#pragma unroll
      for (int r = 0; r < 16; ++r) { const int orow = crow(r, hi); float v[4]; float ss = 0.f;
#pragma unroll
        for (int d0 = 0; d0 < 4; ++d0) { v[d0] = Ow[(size_t)orow * NOATT + d0 * 32 + r32] - lam * (o[d0][r] * rli[r]); ss += v[d0] * v[d0]; }
        ss += __shfl_xor(ss, 1); ss += __shfl_xor(ss, 2); ss += __shfl_xor(ss, 4); ss += __shfl_xor(ss, 8); ss += __shfl_xor(ss, 16);
        const float rs = 1.0f / sqrtf(ss * (1.f / 128.f) + EPS);
#pragma unroll
        for (int d0 = 0; d0 < 4; ++d0) Mw[(size_t)orow * DM + d0 * 32 + r32] = (bf16)f2bf(v[d0] * rs * gv[d0]); } } }
  __syncthreads();
#undef ATT_SLOAD
#undef ATT_SWRITE
#undef ATT_SWAIT
#undef ATT_RESC
#undef ATT_ROTQ
}

__device__ __forceinline__ void norm0_phase(const float* xp, const float* xs_off, const float* gm, bf16* H, float* ssq, int gw, int NGW, int lane) {
    for (int m = gw; m < M; m += NGW) {
        const float* xr = (m < MP ? xp : xs_off) + (size_t)m * DM;
        const int mi = m < MP ? 0 : 1 + (m - MP) / DSEQ; const float* g = gm + (size_t)mi * DM;
        f32x4 v[8]; float s = 0.f;
#pragma unroll
        for (int j = 0; j < 8; ++j) { v[j] = ((const f32x4*)xr)[lane + 64 * j]; s += (v[j].x * v[j].x + v[j].y * v[j].y) + (v[j].z * v[j].z + v[j].w * v[j].w); }
        s = wave_sum(s); if (lane < 32) ssq[(size_t)m * 32 + lane] = lane == 0 ? s : 0.f;
#pragma unroll
        for (int j = 0; j < 8; ++j) { const int c = (lane + 64 * j) * 4; const f32x4 y = v[j] * *(const f32x4*)(g + c); v2u o; o.x = pk2(y.x, y.y); o.y = pk2(y.z, y.w); *(v2u*)(H + (size_t)m * DM + c) = o; }
    }
}
__device__ __forceinline__ void pro2_phase(const Args& a, LAS unsigned char* lds, int tid, int bid, int G, int gt, int NGT) {
    using att::bf16x8; using att::f32x16; using att::crow;
    unsigned char* ws = a.ws; const float* MOD = (const float*)(ws + WS_MOD); float* GM = (float*)(ws + WS_GM);
    for (int i = gt; i < DEPTH * 2 * 5 * DM; i += NGT) { const int c = i % DM, mi = (i / DM) % 5, w = (i / (5 * DM)) & 1, l = i / (2 * 5 * DM);
        const float g = a.in[w ? I_N2G : I_N1G][l * DM + c]; GM[i] = g * (1.f + MOD[((size_t)(l * 5 + mi) * 6 + (w ? 4 : 1)) * DM + c]); }
    const int wave = tid >> 6, lane = tid & 63, r32 = lane & 31, hi = lane >> 5;
    LAS bf16* T = (LAS bf16*)lds;
#pragma unroll 1
    for (int kind = 0; kind < 2; ++kind) {
        __syncthreads();
        for (int e = tid; e < DEPTH * 5 * DM; e += NTH) { const int l = e / (5 * DM), mi = (e / DM) % 5, k = e % DM; T[e] = (bf16)f2bf(MOD[((size_t)(l * 5 + mi) * 6 + (kind ? 3 : 0)) * DM + k]); }
        __syncthreads();
        const int ld = kind ? 2 * DFF : NINP, items_l = ld / 32;
        for (int it = bid * NWV + wave; it < DEPTH * items_l; it += G * NWV) { const int l = it / items_l, rb = it % items_l;
            const bf16* Wr = (kind ? (const bf16*)(ws + WS_WUP + l * SZ_WUP) : (const bf16*)(ws + WS_WIN + l * SZ_WIN)) + (size_t)(rb * 32 + r32) * DM + hi * 8;
            const LAS bf16* Tb = T + (size_t)(l * 5 + (r32 < 5 ? r32 : 4)) * DM + hi * 8;
            f32x16 acc = {};
#pragma unroll 1
            for (int ks = 0; ks < DM / 16; ks += 8) { bf16x8 af[8];
#pragma unroll
                for (int j = 0; j < 8; ++j) af[j] = *reinterpret_cast<const bf16x8*>(Wr + (ks + j) * 16);
#pragma unroll
                for (int j = 0; j < 8; ++j) { bf16x8 bfv = *(const LAS bf16x8*)(Tb + (ks + j) * 16); if (r32 >= 5) bfv = (bf16x8){0, 0, 0, 0, 0, 0, 0, 0};
                    acc = __builtin_amdgcn_mfma_f32_32x32x16_bf16(af[j], bfv, acc, 0, 0, 0); } }
            if (r32 < 5) { float* dst = (kind ? (float*)(ws + WS_SHWU) + (size_t)l * 5 * 2 * DFF : (float*)(ws + WS_SHWI) + (size_t)l * 5 * NINP) + (size_t)r32 * ld + rb * 32;
#pragma unroll
                for (int r = 0; r < 16; ++r) dst[crow(r, hi)] = acc[r]; }
        }
    }
    __syncthreads();
}
__device__ __forceinline__ void final_norm_phase(const float* X, const float* g, float* out, int gw, int NGW, int lane) {
    for (int m = gw; m < M; m += NGW) {
        const float* xr = X + (size_t)m * DM; f32x4 v[8]; float s = 0.f;
#pragma unroll
        for (int j = 0; j < 8; ++j) { v[j] = ((const f32x4*)xr)[lane + 64 * j]; s += (v[j].x * v[j].x + v[j].y * v[j].y) + (v[j].z * v[j].z + v[j].w * v[j].w); }
        const float rstd = 1.0f / sqrtf(wave_sum(s) * (1.f / DM) + EPS);
#pragma unroll
        for (int j = 0; j < 8; ++j) { const int c = (lane + 64 * j) * 4; *(f32x4*)(out + (size_t)m * DM + c) = v[j] * rstd * *(const f32x4*)(g + c); }
    }
}

__device__ __forceinline__ void post_phase(const Args& a, int l, int gw, int NGW, int lane) {
    using att::bf16x8; using att::bfe; using att::cvtpk; using att::u32x4;
    unsigned char* ws = a.ws;
    const bf16* P = (const bf16*)(ws + WS_P); bf16* KRA = (bf16*)(ws + WS_KRA); bf16* KRC = (bf16*)(ws + WS_KRC); bf16* CQN = (bf16*)(ws + WS_CQN); bf16* CKVN = (bf16*)(ws + WS_CKVN);
    const float* RTA = (const float*)(ws + WS_RTA); const float* RTC = (const float*)(ws + WS_RTC);
    const float* gq = a.in[I_CQG] + l * 384; const float* gkv = a.in[I_CKVG] + l * 256;
    for (int m = gw; m < M; m += NGW) {
        const bf16* pr = P + (size_t)m * NINP;
        float xq[8], xk[8]; float sq = 0.f, sk = 0.f;
        if (lane < 48) { const bf16x8 v = *reinterpret_cast<const bf16x8*>(pr + C_CQ + lane * 8);
#pragma unroll
            for (int i = 0; i < 8; ++i) { xq[i] = bfe(v, i); sq += xq[i] * xq[i]; } }
        if (lane < 32) { const bf16x8 v = *reinterpret_cast<const bf16x8*>(pr + C_CKV + lane * 8);
#pragma unroll
            for (int i = 0; i < 8; ++i) { xk[i] = bfe(v, i); sk += xk[i] * xk[i]; } }
        const float rq = 1.0f / sqrtf(wave_sum(sq) * (1.f / 384.f) + EPS), rk = 1.0f / sqrtf(wave_sum(sk) * (1.f / 256.f) + EPS);
        if (lane < 48) { const f32x4 g0 = *(const f32x4*)(gq + lane * 8), g1 = *(const f32x4*)(gq + lane * 8 + 4);
            *(u32x4*)(CQN + (size_t)m * 384 + lane * 8) = (u32x4){cvtpk(xq[0] * rq * g0.x, xq[1] * rq * g0.y), cvtpk(xq[2] * rq * g0.z, xq[3] * rq * g0.w), cvtpk(xq[4] * rq * g1.x, xq[5] * rq * g1.y), cvtpk(xq[6] * rq * g1.z, xq[7] * rq * g1.w)}; }
        if (lane < 32) { const f32x4 g0 = *(const f32x4*)(gkv + lane * 8), g1 = *(const f32x4*)(gkv + lane * 8 + 4);
            const f32x4 y0 = {xk[0] * rk * g0.x, xk[1] * rk * g0.y, xk[2] * rk * g0.z, xk[3] * rk * g0.w}, y1 = {xk[4] * rk * g1.x, xk[5] * rk * g1.y, xk[6] * rk * g1.z, xk[7] * rk * g1.w};
            *(u32x4*)(CKVN + (size_t)m * 256 + lane * 8) = (u32x4){cvtpk(y0.x, y0.y), cvtpk(y0.z, y0.w), cvtpk(y1.x, y1.y), cvtpk(y1.z, y1.w)};
            if (m < MP) { float* o = a.out + O_CKV + (((size_t)(m / SEQ) * DEPTH + l) * SEQ + (m % SEQ)) * 256 + lane * 8; *(f32x4*)o = y0; *(f32x4*)(o + 4) = y1; } }
        if (m >= MP) { const int ms = m - MP, t = ms % DSEQ;
            if (lane < 34) { const bool isa = lane < 32; const int hh = isa ? (lane >> 1) & 1 : lane - 32;
                const int base = isa ? (lane >> 2) * 64 + hh * 32 + (lane & 1) * 8 : hh * 16, dist = isa ? 16 : 8;
                const bf16* src = pr + (isa ? C_AK : C_CKR) + base; const float* tb = isa ? RTA + (size_t)t * 64 + hh * 32 + (lane & 1) * 8 : RTC + (size_t)t * 32 + hh * 16;
                const bf16x8 v0 = *reinterpret_cast<const bf16x8*>(src), v1 = *reinterpret_cast<const bf16x8*>(src + dist);
                const f32x4 c0 = *(const f32x4*)(tb), c1 = *(const f32x4*)(tb + 4), s0 = *(const f32x4*)(tb + dist), s1 = *(const f32x4*)(tb + dist + 4);
                float y0[8], y1[8];
#pragma unroll
                for (int i = 0; i < 8; ++i) { const float cs = i < 4 ? c0[i & 3] : c1[i & 3], sn = i < 4 ? s0[i & 3] : s1[i & 3]; const float x0 = bfe(v0, i), x1 = bfe(v1, i); y0[i] = x0 * cs - x1 * sn; y1[i] = x1 * cs + x0 * sn; }
                bf16* dst = isa ? KRA + (size_t)ms * 512 + base : KRC + (size_t)ms * 32 + base;
                *(u32x4*)dst = (u32x4){cvtpk(y0[0], y0[1]), cvtpk(y0[2], y0[3]), cvtpk(y0[4], y0[5]), cvtpk(y0[6], y0[7])};
                *(u32x4*)(dst + dist) = (u32x4){cvtpk(y1[0], y1[1]), cvtpk(y1[2], y1[3]), cvtpk(y1[4], y1[5]), cvtpk(y1[6], y1[7])}; }
        } else { const size_t ro = ((size_t)(m / SEQ) * DEPTH + l) * SEQ + (m % SEQ);
            { const bf16x8 v = *reinterpret_cast<const bf16x8*>(pr + C_AK + lane * 8); float* o = a.out + O_AK + ro * 512 + lane * 8;
              *(f32x4*)o = (f32x4){bfe(v, 0), bfe(v, 1), bfe(v, 2), bfe(v, 3)}; *(f32x4*)(o + 4) = (f32x4){bfe(v, 4), bfe(v, 5), bfe(v, 6), bfe(v, 7)}; }
            { const bf16x8 v = *reinterpret_cast<const bf16x8*>(pr + C_AV + lane * 8); float* o = a.out + O_AV + ro * 512 + lane * 8;
              *(f32x4*)o = (f32x4){bfe(v, 0), bfe(v, 1), bfe(v, 2), bfe(v, 3)}; *(f32x4*)(o + 4) = (f32x4){bfe(v, 4), bfe(v, 5), bfe(v, 6), bfe(v, 7)}; }
            if (lane < 4) { const bf16x8 v = *reinterpret_cast<const bf16x8*>(pr + C_CKR + lane * 8); float* o = a.out + O_CKR + ro * 32 + lane * 8;
              *(f32x4*)o = (f32x4){bfe(v, 0), bfe(v, 1), bfe(v, 2), bfe(v, 3)}; *(f32x4*)(o + 4) = (f32x4){bfe(v, 4), bfe(v, 5), bfe(v, 6), bfe(v, 7)}; } }
    }
}


constexpr int NCHUNK = M / 64, GLA_UNITS = NCHUNK * 6;
constexpr int TS = 144;

__device__ __forceinline__ void gla_g1_unit(const Args& a, int l, int unit, LAS unsigned char* lds, int tid) {
    using namespace att;
    unsigned char* ws = a.ws; const bf16* P = (const bf16*)(ws + WS_P); bf16* QK4 = (bf16*)(ws + WS_QK4); float* U = (float*)(ws + WS_U); float* DD = (float*)(ws + WS_DD);
    const int gc = unit / 6, h = unit % 6, m0 = gc * 64;
    const int wave = tid >> 6, lane = tid & 63, r32 = lane & 31, hi = lane >> 5;
    LAS float* glr = (LAS float*)lds;
    LAS float* gw = (LAS float*)(lds + 8192);
    LAS float* gbs = (LAS float*)(lds + 16384);
    LAS float* segtot = (LAS float*)(lds + 16896);
    LAS unsigned char* KfT = lds + 20992;
    LAS unsigned char* KbT = lds + 30208;
    LAS unsigned char* Vt = lds + 39424;
    LAS float* Dl = (LAS float*)(lds + 55808);
    const float* gwt = a.in[I_BGW] + (size_t)l * 2 * 16 * 384; const float* gb = a.in[I_BGB] + l * 2 * 384;
    const int k = tid & 63, tq = tid >> 6;
    if (tid < 256) { const int t = tid >> 2, part = tid & 3; const bf16x8 v = *reinterpret_cast<const bf16x8*>(P + (size_t)(m0 + t) * NINP + C_BG + part * 8);
#pragma unroll
        for (int i = 0; i < 8; ++i) glr[t * 32 + part * 8 + i] = bfe(v, i); }
#pragma unroll
    for (int i = 0; i < 4; ++i) { const int idx = tid + NTH * i, dr = idx >> 6, kk = idx & 63; gw[idx] = gwt[(size_t)dr * 384 + h * 64 + kk]; }
    if (tid < 128) gbs[tid] = gb[(tid >> 6) * 384 + h * 64 + (tid & 63)];
    { const int sr = tid >> 4, sc = (tid & 15) * 8;
      const bf16x8 v0 = *reinterpret_cast<const bf16x8*>(P + (size_t)(m0 + sr) * NINP + C_BV + h * 128 + sc), v1 = *reinterpret_cast<const bf16x8*>(P + (size_t)(m0 + 32 + sr) * NINP + C_BV + h * 128 + sc);
      *(LAS bf16x8*)(Vt + v_st(sr, sc)) = v0; *(LAS bf16x8*)(Vt + v_st(32 + sr, sc)) = v1; }
    bf16 qv[8], kv[8];
#pragma unroll
    for (int j = 0; j < 8; ++j) { const bf16* pr = P + (size_t)(m0 + 8 * tq + j) * NINP + h * 64 + k; qv[j] = pr[C_BQ]; kv[j] = pr[C_BK]; }
    __syncthreads();
    float bf_[8], bb_[8];
#pragma unroll
    for (int dir = 0; dir < 2; ++dir) { float wr_[16];
#pragma unroll
        for (int r = 0; r < 16; ++r) wr_[r] = gw[(dir * 16 + r) * 64 + k];
        const float bias = gbs[dir * 64 + k];
#pragma unroll
        for (int j = 0; j < 8; ++j) { const LAS float* gp = glr + (8 * tq + j) * 32 + dir * 16; float pre = bias;
#pragma unroll
            for (int r4 = 0; r4 < 4; ++r4) { const f32x4 x = *(const LAS f32x4*)(gp + 4 * r4); pre += (x.x * wr_[4 * r4] + x.y * wr_[4 * r4 + 1]) + (x.z * wr_[4 * r4 + 2] + x.w * wr_[4 * r4 + 3]); }
            const float gl = (fminf(pre, 0.f) - __logf(1.f + __expf(-fabsf(pre)))) * (1.f / 16.f);
            if (dir == 0) bf_[j] = gl; else bb_[j] = gl; } }
#pragma unroll
    for (int j = 1; j < 8; ++j) bf_[j] += bf_[j - 1];
#pragma unroll
    for (int j = 6; j >= 0; --j) bb_[j] += bb_[j + 1];
    segtot[tq * 64 + k] = bf_[7]; segtot[(8 + tq) * 64 + k] = bb_[0];
    __syncthreads();
    { float of = 0.f, ob = 0.f;
#pragma unroll
      for (int q2 = 0; q2 < 8; ++q2) { const float sf = segtot[q2 * 64 + k], sb = segtot[(8 + q2) * 64 + k]; of += q2 < tq ? sf : 0.f; ob += q2 > tq ? sb : 0.f; }
      float kf[8], kb[8];
      bf16* dst = QK4 + (size_t)(m0 + 8 * tq) * 1536 + h * 64 + k;
#pragma unroll
      for (int j = 0; j < 8; ++j) { const float bfv = bf_[j] + of, bbv = bb_[j] + ob; const float ef = __expf(bfv), eb = __expf(bbv); const float q = bf2f(qv[j]) * 0.125f, kk = bf2f(kv[j]);
          kf[j] = kk * __expf(-bfv); kb[j] = kk * __expf(-bbv);
          dst[(size_t)j * 1536] = (bf16)f2bf(q * ef); dst[(size_t)j * 1536 + 384] = (bf16)f2bf(kf[j]); dst[(size_t)j * 1536 + 768] = (bf16)f2bf(q * eb); dst[(size_t)j * 1536 + 1152] = (bf16)f2bf(kb[j]);
          if (j == 7 && tq == 7) Dl[k] = ef;
          if (j == 0 && tq == 0) Dl[64 + k] = eb; }
      *(LAS u32x4*)(KfT + k * TS + tq * 16) = (u32x4){cvtpk(kf[0], kf[1]), cvtpk(kf[2], kf[3]), cvtpk(kf[4], kf[5]), cvtpk(kf[6], kf[7])};
      *(LAS u32x4*)(KbT + k * TS + tq * 16) = (u32x4){cvtpk(kb[0], kb[1]), cvtpk(kb[2], kb[3]), cvtpk(kb[4], kb[5]), cvtpk(kb[6], kb[7])}; }
    __syncthreads();
    { const int dir = wave >> 2, vb = wave & 3; const LAS unsigned char* KT = dir ? KbT : KfT;
      const int vbase = (int)(unsigned)(uintptr_t)Vt + v_rd_base(lane) + vb * 512;
      const s16x4 l0 = tr_read<v_rd_off(0, 0, 0)>(vbase), h0 = tr_read<v_rd_off(0, 0, 1)>(vbase), l1 = tr_read<v_rd_off(0, 1, 0)>(vbase), h1 = tr_read<v_rd_off(0, 1, 1)>(vbase);
      const s16x4 l2 = tr_read<v_rd_off(0, 2, 0)>(vbase), h2 = tr_read<v_rd_off(0, 2, 1)>(vbase), l3 = tr_read<v_rd_off(0, 3, 0)>(vbase), h3 = tr_read<v_rd_off(0, 3, 1)>(vbase);
      asm volatile("s_waitcnt lgkmcnt(0)" ::: "memory");
#define GLA_PK(L, H) (bf16x8){L[0], L[1], L[2], L[3], H[0], H[1], H[2], H[3]}
      const bf16x8 vf0 = GLA_PK(l0, h0), vf1 = GLA_PK(l1, h1), vf2 = GLA_PK(l2, h2), vf3 = GLA_PK(l3, h3);
      float* Ub = U + ((size_t)unit * 2 + dir) * 8192;
#pragma unroll
      for (int rb = 0; rb < 2; ++rb) { f32x16 acc = {};
          const LAS unsigned char* ar = KT + (rb * 32 + r32) * TS + hi * 16;
          acc = __builtin_amdgcn_mfma_f32_32x32x16_bf16(vf0, *(const LAS bf16x8*)(ar), acc, 0, 0, 0);
          acc = __builtin_amdgcn_mfma_f32_32x32x16_bf16(vf1, *(const LAS bf16x8*)(ar + 32), acc, 0, 0, 0);
          acc = __builtin_amdgcn_mfma_f32_32x32x16_bf16(vf2, *(const LAS bf16x8*)(ar + 64), acc, 0, 0, 0);
          acc = __builtin_amdgcn_mfma_f32_32x32x16_bf16(vf3, *(const LAS bf16x8*)(ar + 96), acc, 0, 0, 0);
          const int kr = rb * 32 + r32; const float dk = Dl[dir * 64 + kr];
#pragma unroll
          for (int g4 = 0; g4 < 4; ++g4) *(f32x4*)(Ub + kr * 128 + vb * 32 + 8 * g4 + 4 * hi) = (f32x4){acc[4 * g4] * dk, acc[4 * g4 + 1] * dk, acc[4 * g4 + 2] * dk, acc[4 * g4 + 3] * dk}; }
      if (tid < 128) DD[(size_t)unit * 128 + tid] = Dl[tid]; }
    __syncthreads();
}

constexpr int GLA_G2_ITEMS = (NPB + NDB) * 6 * 2 * 2;
__device__ __forceinline__ void gla_g2_item(const Args& a, int l, int item, int tid) {
    unsigned char* ws = a.ws; const float* U = (const float*)(ws + WS_U); const float* DD = (const float*)(ws + WS_DD); bf16* ST = (bf16*)(ws + WS_ST);
    const int half = item & 1, dir = (item >> 1) & 1, hs = item >> 2, h = hs % 6, sq = hs / 6;
    const bool smp = sq < NDB; const int b = smp ? sq : sq - NDB, nc = smp ? DSEQ / 64 : SEQ / 64, gc0 = smp ? (MP / 64) + b * (DSEQ / 64) : b * (SEQ / 64);
    const int v = tid & 127, k0 = ((tid >> 7) + 4 * half) * 8;
    float s[8];
#pragma unroll
    for (int i = 0; i < 8; ++i) s[i] = smp ? a.in[I_STB][((((size_t)b * DEPTH + l) * 2 + dir) * 6 + h) * 8192 + (k0 + i) * 128 + v] : 0.f;
    for (int ci = 0; ci < nc; ci += 4) {
        float u[4][8], d[4][8]; size_t ub[4];
#pragma unroll
        for (int j = 0; j < 4; ++j) { const int c = dir ? nc - 1 - (ci + j) : ci + j; ub[j] = ((size_t)(gc0 + c) * 6 + h) * 2 + dir;
#pragma unroll
            for (int i = 0; i < 8; ++i) { u[j][i] = U[ub[j] * 8192 + (k0 + i) * 128 + v]; d[j][i] = DD[ub[j] * 64 + k0 + i]; } }
#pragma unroll
        for (int j = 0; j < 4; ++j) {
            v4u w; w.x = pk2(s[0], s[1]); w.y = pk2(s[2], s[3]); w.z = pk2(s[4], s[5]); w.w = pk2(s[6], s[7]);
            *(v4u*)(ST + ub[j] * 8192 + v * 64 + k0) = w;
#pragma unroll
            for (int i = 0; i < 8; ++i) s[i] = d[j][i] * s[i] + u[j][i]; }
    }
    if (!smp) {
#pragma unroll
        for (int i = 0; i < 8; ++i) a.out[O_SB + ((((size_t)b * DEPTH + l) * 2 + dir) * 6 + h) * 8192 + (k0 + i) * 128 + v] = s[i];
    }
}

__device__ __forceinline__ void gla_g3_unit(const Args& a, int l, int unit, LAS unsigned char* lds, int tid) {
    using namespace att;
    unsigned char* ws = a.ws; const bf16* P = (const bf16*)(ws + WS_P); const bf16* QK4 = (const bf16*)(ws + WS_QK4); const bf16* ST = (const bf16*)(ws + WS_ST); bf16* MIX = (bf16*)(ws + WS_MIX);
    const int gc = unit / 6, h = unit % 6, m0 = gc * 64;
    const int wave = tid >> 6, lane = tid & 63, r32 = lane & 31, hi = lane >> 5;
    LAS unsigned char* T4 = lds;
    LAS unsigned char* Vt = lds + 36864;
    LAS unsigned char* AT = lds + 53248;
    LAS float* OT = (LAS float*)(lds + 71680);
    { const int row = tid >> 3, ch = tid & 7; const bf16* src = QK4 + (size_t)(m0 + row) * 1536 + h * 64 + ch * 8;
#pragma unroll
      for (int var = 0; var < 4; ++var) *(LAS bf16x8*)(T4 + var * 9216 + row * TS + ch * 16) = *reinterpret_cast<const bf16x8*>(src + var * 384);
      const int sr = tid >> 4, sc = (tid & 15) * 8;
      const bf16x8 v0 = *reinterpret_cast<const bf16x8*>(P + (size_t)(m0 + sr) * NINP + C_BV + h * 128 + sc), v1 = *reinterpret_cast<const bf16x8*>(P + (size_t)(m0 + 32 + sr) * NINP + C_BV + h * 128 + sc);
      *(LAS bf16x8*)(Vt + v_st(sr, sc)) = v0; *(LAS bf16x8*)(Vt + v_st(32 + sr, sc)) = v1; }
    __syncthreads();
    { const int dir = wave >> 2, tb = (wave >> 1) & 1, sb = wave & 1;
      const LAS unsigned char* Qt = T4 + (dir * 2) * 9216 + (tb * 32 + r32) * TS + hi * 16; const LAS unsigned char* Kt = T4 + (dir * 2 + 1) * 9216 + (sb * 32 + r32) * TS + hi * 16;
      f32x16 acc = {};
#pragma unroll
      for (int ks = 0; ks < 4; ++ks) acc = __builtin_amdgcn_mfma_f32_32x32x16_bf16(*(const LAS bf16x8*)(Kt + ks * 32), *(const LAS bf16x8*)(Qt + ks * 32), acc, 0, 0, 0);
      const int t = tb * 32 + r32;
#pragma unroll
      for (int r = 0; r < 16; ++r) { const int s = sb * 32 + crow(r, hi); const bool keep = dir ? (s >= t) : (s <= t); acc[r] = keep ? acc[r] : 0.f; }
#pragma unroll
      for (int g = 0; g < 4; ++g) { v2u w; w.x = cvtpk(acc[4 * g], acc[4 * g + 1]); w.y = cvtpk(acc[4 * g + 2], acc[4 * g + 3]);
          *(LAS v2u*)(AT + dir * 9216 + t * TS + (sb * 32 + 8 * g + 4 * hi) * 2) = w; } }
    __syncthreads();
    { const int tb = wave >> 2, vb = wave & 3; f32x16 o = {};
      const int vbase = (int)(unsigned)(uintptr_t)Vt + v_rd_base(lane) + vb * 512;
      const s16x4 l0 = tr_read<v_rd_off(0, 0, 0)>(vbase), h0 = tr_read<v_rd_off(0, 0, 1)>(vbase), l1 = tr_read<v_rd_off(0, 1, 0)>(vbase), h1 = tr_read<v_rd_off(0, 1, 1)>(vbase);
      const s16x4 l2 = tr_read<v_rd_off(0, 2, 0)>(vbase), h2 = tr_read<v_rd_off(0, 2, 1)>(vbase), l3 = tr_read<v_rd_off(0, 3, 0)>(vbase), h3 = tr_read<v_rd_off(0, 3, 1)>(vbase);
      asm volatile("s_waitcnt lgkmcnt(0)" ::: "memory");
      const bf16x8 vf0 = GLA_PK(l0, h0), vf1 = GLA_PK(l1, h1), vf2 = GLA_PK(l2, h2), vf3 = GLA_PK(l3, h3);
#pragma unroll
      for (int dir = 0; dir < 2; ++dir) {
          const bf16* Sd = ST + (((size_t)unit) * 2 + dir) * 8192 + (size_t)(vb * 32 + r32) * 64 + hi * 8;
          const bf16x8 s0 = *reinterpret_cast<const bf16x8*>(Sd), s1 = *reinterpret_cast<const bf16x8*>(Sd + 16), s2 = *reinterpret_cast<const bf16x8*>(Sd + 32), s3 = *reinterpret_cast<const bf16x8*>(Sd + 48);
          const LAS unsigned char* Qt = T4 + (dir * 2) * 9216 + (tb * 32 + r32) * TS + hi * 16; const LAS unsigned char* At = AT + dir * 9216 + (tb * 32 + r32) * TS + hi * 16;
          o = __builtin_amdgcn_mfma_f32_32x32x16_bf16(*(const LAS bf16x8*)(Qt), s0, o, 0, 0, 0);
          o = __builtin_amdgcn_mfma_f32_32x32x16_bf16(*(const LAS bf16x8*)(Qt + 32), s1, o, 0, 0, 0);
          o = __builtin_amdgcn_mfma_f32_32x32x16_bf16(*(const LAS bf16x8*)(Qt + 64), s2, o, 0, 0, 0);
          o = __builtin_amdgcn_mfma_f32_32x32x16_bf16(*(const LAS bf16x8*)(Qt + 96), s3, o, 0, 0, 0);
          o = __builtin_amdgcn_mfma_f32_32x32x16_bf16(*(const LAS bf16x8*)(At), vf0, o, 0, 0, 0);
          o = __builtin_amdgcn_mfma_f32_32x32x16_bf16(*(const LAS bf16x8*)(At + 32), vf1, o, 0, 0, 0);
          o = __builtin_amdgcn_mfma_f32_32x32x16_bf16(*(const LAS bf16x8*)(At + 64), vf2, o, 0, 0, 0);
          o = __builtin_amdgcn_mfma_f32_32x32x16_bf16(*(const LAS bf16x8*)(At + 96), vf3, o, 0, 0, 0); }
#pragma unroll
      for (int r = 0; r < 16; ++r) OT[(tb * 32 + crow(r, hi)) * 132 + vb * 32 + r32] = o[r]; }
    __syncthreads();
    { const int t = tid >> 3, c0 = (tid & 7) * 16; const float* bg = a.in[I_BNG] + l * 128 + c0;
      f32x4 x[4]; float ss = 0.f;
#pragma unroll
      for (int i = 0; i < 4; ++i) { x[i] = *(const LAS f32x4*)(OT + t * 132 + c0 + 4 * i); ss += (x[i].x * x[i].x + x[i].y * x[i].y) + (x[i].z * x[i].z + x[i].w * x[i].w); }
      ss += __shfl_xor(ss, 1); ss += __shfl_xor(ss, 2); ss += __shfl_xor(ss, 4);
      const float rs = 1.0f / sqrtf(ss * (1.f / 128.f) + EPS);
      const bf16* rg = P + (size_t)(m0 + t) * NINP + C_BR + h * 128 + c0; const bf16x8 r0 = *reinterpret_cast<const bf16x8*>(rg), r1 = *reinterpret_cast<const bf16x8*>(rg + 8);
      float y[16];
#pragma unroll
      for (int i = 0; i < 4; ++i) { const f32x4 gv = *(const f32x4*)(bg + 4 * i); y[4 * i] = x[i].x * rs * gv.x; y[4 * i + 1] = x[i].y * rs * gv.y; y[4 * i + 2] = x[i].z * rs * gv.z; y[4 * i + 3] = x[i].w * rs * gv.w; }
#pragma unroll
      for (int i = 0; i < 8; ++i) { y[i] *= siluf(bfe(r0, i)); y[8 + i] *= siluf(bfe(r1, i)); }
      bf16* dst = MIX + (size_t)(m0 + t) * DM + 512 + h * 128 + c0;
      *(u32x4*)(dst) = (u32x4){cvtpk(y[0], y[1]), cvtpk(y[2], y[3]), cvtpk(y[4], y[5]), cvtpk(y[6], y[7])};
      *(u32x4*)(dst + 8) = (u32x4){cvtpk(y[8], y[9]), cvtpk(y[10], y[11]), cvtpk(y[12], y[13]), cvtpk(y[14], y[15])}; }
    __syncthreads();
#undef GLA_PK
}

__device__ __forceinline__ void mixer_phase(const Args& a, int l, LAS unsigned char* lds, int tid_in, int bid, int G) {
    unsigned char* ws = a.ws;
    const bf16* P = (const bf16*)(ws + WS_P); const bf16* QC = (const bf16*)(ws + WS_QC); const bf16* KVC = (const bf16*)(ws + WS_KVC); const bf16* KRA = (const bf16*)(ws + WS_KRA); const bf16* KRC = (const bf16*)(ws + WS_KRC);
    const bf16* CAK = (const bf16*)(ws + WS_CAK); const bf16* CAV = (const bf16*)(ws + WS_CAV); const bf16* CKRX = (const bf16*)(ws + WS_CKRX); const bf16* KVCTX = (const bf16*)(ws + WS_KVCTX);
    const float* RTA = (const float*)(ws + WS_RTA); const float* RTC = (const float*)(ws + WS_RTC); float* OATT = (float*)(ws + WS_OATT); bf16* MIXB = (bf16*)(ws + WS_MIX);
    const float lam = ((const float*)(ws + WS_LAM))[l], li = ((const float*)(ws + WS_LAM))[4 + l]; const float* ag = a.in[I_ANG] + l * 128;
    constexpr int NAS = 256, NCS = 384, NAP = 64, NCP = 96, NFILL = NAP + NCP + GLA_UNITS;
    const bool tuned = G == 256;
    const int per = G / 8, vb = (bid % 8) * per + bid / 8, wx = vb % per, hx = per / 2;
    const bool heavy = wx < hx; const int hidx = (vb / per) * hx + wx, lidx = (vb / per) * hx + (wx - hx);
    const int nl = G / 2;
    const int nslots = tuned ? 3 + (!heavy ? (NFILL + nl - 1) / nl : 0) : (NAS + NCS + NFILL + G - 1) / G;
    for (int sl = 0; sl < nslots; ++sl) {
        int tid = tid_in; asm volatile("" : "+v"(tid));
        int kind, u, f = -1;
        if (!tuned) { const int g = bid + sl * G; if (g >= NAS + NCS + NFILL) continue; if (g < NAS) { kind = 0; u = g; } else if (g < NAS + NCS) { kind = 1; u = g - NAS; } else { kind = 5; u = 0; f = g - NAS - NCS; } }
        else if (sl == 0) { kind = 0; u = vb; }
        else if (sl == 1) { kind = 1; u = vb; }
        else if (sl == 2) { if (heavy) { kind = 1; u = G + hidx; } else continue; }
        else { kind = 5; u = 0; f = lidx + (sl - 3) * nl; if (f >= NFILL) continue; }
        if (kind == 5) { if (f < NAP) { kind = 2; u = f; } else if (f < NAP + NCP) { kind = 3; u = f - NAP; } else { kind = 4; u = f - NAP - NCP; } }
        if (kind == 0 && u >= NAS) continue;
        if (kind == 1 && u >= NCS) continue;
        if (kind == 4) { gla_g3_unit(a, l, u, lds, tid); continue; }
        if (kind == 0 || kind == 2) {
            int b, head, qb; size_t r0;
            if (kind == 0) { b = u >> 6; head = (u >> 4) & 3; qb = u & 15; r0 = (size_t)MP + (size_t)b * DSEQ; } else { b = u >> 2; head = u & 3; qb = 0; r0 = (size_t)b * SEQ; }
#pragma unroll 1
            for (int ps = 0; ps < 2; ++ps) { const int combo = head * 2 + ps; int tid2 = tid; asm volatile("" : "+v"(tid2));
                KSeg ctx{nullptr, 0, nullptr, 0, nullptr, 0, 0}, lat;
                if (kind == 0) { ctx = KSeg{CAK + ((size_t)(b * DEPTH + l) * PAST) * 512 + combo * 64, 512, nullptr, 0, CAV + ((size_t)(b * DEPTH + l) * PAST) * 512 + head * 128, 512, PAST};
                                 lat = KSeg{KRA + ((size_t)b * DSEQ) * 512 + combo * 64, 512, nullptr, 0, P + r0 * NINP + C_AV + head * 128, NINP, DSEQ}; }
                else lat = KSeg{P + r0 * NINP + C_AK + combo * 64, NINP, nullptr, 0, P + r0 * NINP + C_AV + head * 128, NINP, SEQ};
                attn_mfma_unit<64, 1, false>(lds, P + (r0 + qb * 256) * NINP + C_AQ + combo * 64, NINP, kind == 0, RTA, qb * 256, ctx, lat, 0.125f, OATT + (r0 + qb * 256) * NOATT + head * 128, tid2,
                                             ps == 1, lam, 1.f - li, ag, MIXB + (r0 + qb * 256) * DM + head * 128); }
        } else {
            KSeg ctx{nullptr, 0, nullptr, 0, nullptr, 0, 0}, lat; const bf16* Qp; int t0 = 0; bf16* Op;
            if (kind == 1) { const int b = u / 96, h = (u >> 4) % 6, qb = u & 15; const size_t r0 = (size_t)MP + (size_t)b * DSEQ; const size_t c0 = (size_t)(l * NDB + b) * PAST;
                ctx = KSeg{KVCTX + c0 * NKVP + h * 192, NKVP, CKRX + ((size_t)(b * DEPTH + l) * PAST) * 32, 32, KVCTX + c0 * NKVP + h * 192 + 64, NKVP, PAST};
                lat = KSeg{KVC + r0 * NKVP + h * 192, NKVP, KRC + ((size_t)b * DSEQ) * 32, 32, KVC + r0 * NKVP + h * 192 + 64, NKVP, DSEQ};
                Qp = QC + (r0 + qb * 256) * NQCP + h * 96; t0 = qb * 256; Op = MIXB + (r0 + qb * 256) * DM + 1280 + h * 128; }
            else { const int b = u / 6, h = u % 6; const size_t r0 = (size_t)b * SEQ;
                lat = KSeg{KVC + r0 * NKVP + h * 192, NKVP, P + r0 * NINP + C_CKR, NINP, KVC + r0 * NKVP + h * 192 + 64, NKVP, SEQ};
                Qp = QC + r0 * NQCP + h * 96; Op = MIXB + r0 * DM + 1280 + h * 128; }
            attn_mfma_unit<96, 1, true>(lds, Qp, NQCP, kind == 1, RTC, t0, ctx, lat, 0.10206207261596575f, Op, tid);
        }
    }
}

__device__ __forceinline__ void combine_phase(const Args& a, int l, int gw, int NGW, int lane) {
    using att::cvtpk; using att::u32x4;
    unsigned char* ws = a.ws; const float* OATT = (const float*)(ws + WS_OATT); bf16* MIX = (bf16*)(ws + WS_MIX);
    const float lam = ((const float*)(ws + WS_LAM))[l], li = ((const float*)(ws + WS_LAM))[4 + l];
    const int h = lane >> 4, c8 = (lane & 15) * 8; const float* ag = a.in[I_ANG] + l * 128 + c8;
    const f32x4 g0 = *(const f32x4*)ag * (1.f - li), g1 = *(const f32x4*)(ag + 4) * (1.f - li);
    for (int m = gw; m < M; m += NGW) {
        const float* oa = OATT + (size_t)m * NOATT + (2 * h) * 128 + c8;
        const f32x4 a0 = *(const f32x4*)oa, a1 = *(const f32x4*)(oa + 4), b0 = *(const f32x4*)(oa + 128), b1 = *(const f32x4*)(oa + 132);
        const f32x4 o0 = a0 - b0 * lam, o1 = a1 - b1 * lam;
        float ss = (o0.x * o0.x + o0.y * o0.y) + (o0.z * o0.z + o0.w * o0.w) + (o1.x * o1.x + o1.y * o1.y) + (o1.z * o1.z + o1.w * o1.w);
        ss += __shfl_xor(ss, 1); ss += __shfl_xor(ss, 2); ss += __shfl_xor(ss, 4); ss += __shfl_xor(ss, 8);
        const float r = 1.0f / sqrtf(ss * (1.f / 128.f) + EPS);
        const f32x4 y0 = o0 * r * g0, y1 = o1 * r * g1;
        *(u32x4*)(MIX + (size_t)m * DM + h * 128 + c8) = (u32x4){cvtpk(y0.x, y0.y), cvtpk(y0.z, y0.w), cvtpk(y1.x, y1.y), cvtpk(y1.z, y1.w)};
    }
}

__device__ __forceinline__ void convact_phase(const Args& a, int l, int gw, int NGW, int lane) {
    const bf16* GU = (const bf16*)(a.ws + WS_GU); bf16* ACT = (bf16*)(a.ws + WS_ACT);
    const float* cw = a.in[I_CONVW] + (size_t)l * 3 * DFF; const float* cb = a.in[I_CONVB] + (size_t)l * DFF;
    for (int m = gw; m < M; m += NGW) {
        int t, n; if (m < MP) { t = m % SEQ; n = SEQ; } else { t = (m - MP) % DSEQ; n = DSEQ; }
        const bool hp = t > 0, hn = t < n - 1;
        const bf16* g1 = GU + (size_t)m * (2 * DFF);
        for (int c = lane; c < DFF; c += 64) {
            const float gm = bf2f(g1[c]), gp = hp ? bf2f(g1[c - 2 * DFF]) : 0.f, gn = hn ? bf2f(g1[c + 2 * DFF]) : 0.f, uu = bf2f(g1[DFF + c]);
            const float gc = gp * cw[c] + gm * cw[DFF + c] + gn * cw[2 * DFF + c] + cb[c];
            ACT[(size_t)m * DFF + c] = (bf16)f2bf(siluf(gc) * uu);
        }
    }
}

__device__ __forceinline__ void ffn_fix_phase(const Args& a, int l, int gt, int NGT) {
    const float* side = (const float*)(a.ws + WS_SIDE); bf16* ACT = (bf16*)(a.ws + WS_ACT);
    const float* cw = a.in[I_CONVW] + (size_t)l * 3 * DFF;
    for (int i = gt; i < (MS / 256) * 2 * DFF; i += NGT) { const int j = i % DFF, w = (i / DFF) & 1, pm = 16 + i / (2 * DFF), q = (pm - 16) & 15;
        if (w == 0 ? q == 0 : q == 15) continue;
        const float* sp = side + ((size_t)(pm * 2 + w) * 3) * DFF + j;
        const float gnb = w == 0 ? side[((size_t)((pm - 1) * 2 + 1) * 3 + 2) * DFF + j] : side[((size_t)((pm + 1) * 2 + 0) * 3 + 2) * DFF + j];
        const float gc = sp[0] + cw[(w == 0 ? 0 : 2) * DFF + j] * gnb;
        ACT[(size_t)(pm * 256 + (w == 0 ? 0 : 255)) * DFF + j] = (bf16)f2bf(siluf(gc) * sp[DFF]); }
}

constexpr int PH_PER_LAYER = 11, PH_L0 = 3, PH_FIN = PH_L0 + DEPTH * PH_PER_LAYER, N_PHASES = PH_FIN + 1;
__global__ void __launch_bounds__(NTH, 2) mk_fwd(Args a) {
    extern __shared__ __attribute__((aligned(16))) unsigned char lds_raw[];
    LAS unsigned char* lds = (LAS unsigned char*)lds_raw;
    const int bid = blockIdx.x, G = gridDim.x, wave0 = __builtin_amdgcn_readfirstlane((int)threadIdx.x >> 6);
#define PH_BEGIN int tid = TID_NOW; asm volatile("" : "+v"(tid)); unsigned char* ws = a.ws; asm volatile("" : "+s"(ws)); \
    const int lane = tid & 63, wave = __builtin_amdgcn_readfirstlane(tid >> 6), gw = bid * NWV + wave, NGW = G * NWV, gt = bid * NTH + tid, NGT = G * NTH; (void)lane; (void)gw; (void)NGW; (void)gt; (void)NGT; (void)ws
    {
        volatile LAS unsigned* Z = (volatile LAS unsigned*)(lds + RING_BYTES);
        for (int u = threadIdx.x; u < (LDS_BYTES - RING_BYTES) / 4; u += NTH) Z[u] = 0u;
        __syncthreads();
    }
    if (a.use_bar) (void)xcd_barrier_post((unsigned*)(a.ws + WS_CTL) + 4096, (volatile LAS unsigned*)(lds + MISC_OFF) + 8);
#define bar (XcdBarrier{(unsigned*)(a.ws + WS_CTL) + 4096, xb_xcc_id(), (volatile LAS unsigned*)(lds + MISC_OFF) + 8})
    const int lo = a.ph_lo, hi = a.ph_hi;
#define IN(k) (lo <= (k) && (k) < hi)
#define TID_NOW (wave0 * 64 + (int)__builtin_amdgcn_mbcnt_hi(~0u, __builtin_amdgcn_mbcnt_lo(~0u, 0u)))
#define SEAM(k) do { if (IN(k) && IN((k) + 1)) xcd_barrier(bar, TID_NOW); } while (0)
#ifndef MK_DUP
#define MK_DUP 0
#endif
#define DUP(bit) _Pragma("unroll 1") for (int rep_ = 0; rep_ < (((MK_DUP) & (bit)) ? 2 : 1); ++rep_)

    if (IN(0)) DUP(512) { PH_BEGIN; pro0_phase(a, lds, tid, lane, wave, bid, G); SEAM(0); }
    if (IN(1)) { PH_BEGIN;
        modfin_phase(a, gt, NGT);
        pg8::Gemm g{(const bf16*)(ws + WS_CKVA), (const bf16*)(ws + WS_WKV), DEPTH * NDB * PAST, NKVP, 256, 256, 256, 4, (size_t)NKVP * 256}; pg8::StaticOrder S; S.init(DEPTH * NDB * PAST, NKVP, G, bid);
        pg8::EpiBf16<0> E{(bf16*)(ws + WS_KVCTX), NKVP, nullptr, 0, 0, 1.f};
        pg8::gemm_phase<pg8::EpiBf16<0>, pg8::StaticOrder, true, true>(lds, g, S, E, tid);
        SEAM(1);
    }
    if (IN(2)) DUP(8192) { PH_BEGIN; pro2_phase(a, lds, tid, bid, G, gt, NGT); SEAM(2); }
    for (int l = 0; l < DEPTH; ++l) {
        const int pb = PH_L0 + PH_PER_LAYER * l;
        if (pb + PH_PER_LAYER <= lo || pb >= hi) continue;
#define LAYER_PTRS const float* modl = (const float*)(ws + WS_MOD) + (size_t)l * 5 * 6 * DM; const float* xin0 = l == 0 ? a.in[I_XP] : (const float*)(ws + WS_X); \
        const float* xin1 = l == 0 ? a.in[I_XS] - (size_t)MP * DM : (const float*)(ws + WS_X); float* X = (float*)(ws + WS_X); (void)modl; (void)xin0; (void)xin1; (void)X
        if (IN(pb + 0) && l == 0) { PH_BEGIN; norm0_phase(a.in[I_XP], a.in[I_XS] - (size_t)MP * DM, (const float*)(ws + WS_GM), (bf16*)(ws + WS_H), (float*)(ws + WS_SSQP), gw, NGW, lane); SEAM(pb + 0); }
        if (IN(pb + 1)) DUP(2) { PH_BEGIN;
            pg8::Gemm g{(const bf16*)(ws + WS_H), (const bf16*)(ws + WS_WIN + l * SZ_WIN), M, NINP, DM, DM, DM, 1 << 20, 0}; pg8::StaticOrder S; S.init(M, NINP, G, bid);
            pg8::EpiBf16Norm E{(bf16*)(ws + WS_P), NINP, (const float*)(ws + WS_SSQP) + (size_t)(2 * l) * M * 32, (const float*)(ws + WS_SHWI) + (size_t)l * 5 * NINP, NINP, (LAS float*)(lds + RING_BYTES + 8192)};
            pg8::gemm_phase<pg8::EpiBf16Norm, pg8::StaticOrder, true, true>(lds, g, S, E, tid);
            SEAM(pb + 1);
        }
        if (IN(pb + 2)) DUP(4) { PH_BEGIN; post_phase(a, l, gw, NGW, lane);
#if 1
            __syncthreads();
            for (int u = bid; u < GLA_UNITS; u += G) { int t2 = tid; asm volatile("" : "+v"(t2)); gla_g1_unit(a, l, u, lds, t2); }
#endif
            SEAM(pb + 2); }
        if (IN(pb + 3)) DUP(8) {
            { PH_BEGIN; pg8::Gemm g{(const bf16*)(ws + WS_CQN), (const bf16*)(ws + WS_WQ + l * SZ_WQ), M, NQCP, 384, 384, 384, 1 << 20, 0}; pg8::StaticOrder S; S.init(M, NQCP, G, bid);
              pg8::EpiBf16<0> E{(bf16*)(ws + WS_QC), NQCP, nullptr, NQCP, 0, 0.10206207261596575f * 1.4426950408889634f};
              pg8::gemm_phase<pg8::EpiBf16<0>, pg8::StaticOrder, true, true>(lds, g, S, E, tid); }
            __syncthreads();
            { PH_BEGIN; pg8::Gemm g{(const bf16*)(ws + WS_CKVN), (const bf16*)(ws + WS_WKV + l * SZ_WKV), M, NKVP, 256, 256, 256, 1 << 20, 0}; pg8::StaticOrder S; S.init(M, NKVP, G, bid);
              pg8::EpiBf16<0> E{(bf16*)(ws + WS_KVC), NKVP, nullptr, 0, 0, 1.f};
              pg8::gemm_phase<pg8::EpiBf16<0>, pg8::StaticOrder, true, true>(lds, g, S, E, tid); }
#if MK_MFMA_GLA
            { PH_BEGIN; for (int it = bid; it < GLA_G2_ITEMS; it += G) gla_g2_item(a, l, it, tid); }
#endif
            SEAM(pb + 3);
        }
        if (IN(pb + 4)) DUP(16) { PH_BEGIN; mixer_phase(a, l, lds, tid, bid, G); if (IN(pb + 6)) xcd_barrier(bar, TID_NOW); }
        if (IN(pb + 6)) { PH_BEGIN; LAYER_PTRS;
            constexpr int NFULL = 512;
            { pg8::Gemm g{(const bf16*)(ws + WS_MIX), (const bf16*)(ws + WS_WOUT + l * SZ_WOUT), M, DM, DM, DM, DM, 1 << 20, 0}; pg8::StaticOrder S; S.init(M, DM, G, bid); S.lim = (MK_SPLITK && G == 256) ? NFULL : S.nwg;
              pg8::EpiResid E{MK_SPLITK ? X : xin0, MK_SPLITK ? X : xin1, X, modl + 2 * DM, (bf16*)(ws + WS_H), (const float*)(ws + WS_GM) + (size_t)(l * 2 + 1) * 5 * DM, (float*)(ws + WS_SSQP) + (size_t)(2 * l + 1) * M * 32};
              pg8::gemm_phase<pg8::EpiResid, pg8::StaticOrder, true, true>(lds, g, S, E, tid); }
            if (MK_SPLITK && G == 256) { __syncthreads(); int t3 = tid; asm volatile("" : "+v"(t3)); (void)t3;
              pg8::Gemm g{(const bf16*)(ws + WS_MIX), (const bf16*)(ws + WS_WOUT + l * SZ_WOUT), M, DM, DM / 2, DM, DM, 1 << 20, 0}; pg8::TailOrder S; S.init(M, DM, G, bid); S.base = NFULL; S.nth = DM / 128;
              pg8::EpiResidTail E{X, modl + 2 * DM, (float*)(ws + WS_SPLITK), (unsigned*)(ws + WS_CTL) + CW_TICKET + (l * 2 + 0) * 128 * 64, (LAS unsigned*)(lds + RING_BYTES + 2048)};
              pg8::gemm_phase<pg8::EpiResidTail, pg8::TailOrder, true, true>(lds, g, S, E, tid); }
            SEAM(pb + 6);
        }
        if (IN(pb + 8)) DUP(128) { PH_BEGIN;
            pg8::Gemm g{(const bf16*)(ws + WS_H), (const bf16*)(ws + WS_WUP + l * SZ_WUP), M, 2 * DFF, DM, DM, DM, 1 << 20, 0}; pg8::StaticOrder S; S.init(M, 2 * DFF, G, bid);
            pg8::EpiConvAct E{(bf16*)(ws + WS_ACT), a.in[I_CONVW] + (size_t)l * 3 * DFF, a.in[I_CONVB] + (size_t)l * DFF, (float*)(ws + WS_SIDE), (LAS float*)(lds + RING_BYTES + 4096),
                               (const float*)(ws + WS_SSQP) + (size_t)(2 * l + 1) * M * 32, (const float*)(ws + WS_SHWU) + (size_t)l * 5 * 2 * DFF, (LAS float*)(lds + RING_BYTES + 8192)};
            pg8::gemm_phase<pg8::EpiConvAct, pg8::StaticOrder, true, true>(lds, g, S, E, tid);
            SEAM(pb + 8);
        }
        if (IN(pb + 9)) DUP(256) { PH_BEGIN; ffn_fix_phase(a, l, gt, NGT); SEAM(pb + 9); }
        if (IN(pb + 10)) { PH_BEGIN; LAYER_PTRS;
            constexpr int NFULL = 512;
            { pg8::Gemm g{(const bf16*)(ws + WS_ACT), (const bf16*)(ws + WS_WDN + l * SZ_WDN), M, DM, DFF, DFF, DFF, 1 << 20, 0}; pg8::StaticOrder S; S.init(M, DM, G, bid); S.lim = (MK_SPLITK && G == 256) ? NFULL : S.nwg;
              pg8::EpiResid E{X, X, X, modl + 5 * DM, l + 1 < DEPTH ? (bf16*)(ws + WS_H) : nullptr, (const float*)(ws + WS_GM) + (size_t)((l + 1 < DEPTH ? l + 1 : l) * 2) * 5 * DM, (float*)(ws + WS_SSQP) + (size_t)(2 * (l + 1 < DEPTH ? l + 1 : l)) * M * 32};
              pg8::gemm_phase<pg8::EpiResid, pg8::StaticOrder, true, true>(lds, g, S, E, tid); }
            if (MK_SPLITK && G == 256) { __syncthreads(); int t3 = tid; asm volatile("" : "+v"(t3)); (void)t3;
              pg8::Gemm g{(const bf16*)(ws + WS_ACT), (const bf16*)(ws + WS_WDN + l * SZ_WDN), M, DM, DFF / 2, DFF, DFF, 1 << 20, 0}; pg8::TailOrder S; S.init(M, DM, G, bid); S.base = NFULL; S.nth = DFF / 128;
              pg8::EpiResidTail E{X, modl + 5 * DM, (float*)(ws + WS_SPLITK), (unsigned*)(ws + WS_CTL) + CW_TICKET + (l * 2 + 1) * 128 * 64, (LAS unsigned*)(lds + RING_BYTES + 2048)};
              pg8::gemm_phase<pg8::EpiResidTail, pg8::TailOrder, true, true>(lds, g, S, E, tid); }
            SEAM(pb + 10);
        }
    }
    if (IN(PH_FIN)) { PH_BEGIN; final_norm_phase((const float*)(ws + WS_X), a.in[I_FING], a.out, gw, NGW, lane); }
#undef IN
#undef SEAM
#undef bar
}

#ifndef MK_ONE_LAUNCH
#define MK_ONE_LAUNCH 1
#endif
extern "C" void kernel_launch(void* const* d_in, const int* in_sizes, int n_in, void* d_out, int out_size, void* d_ws, size_t ws_size, hipStream_t stream) {
    static int grid = 0;
    if (grid == 0) {
        if (n_in != N_INPUTS || (size_t)out_size != O_END || ws_size < WS_END) { fprintf(stderr, "kernel_launch: shape mismatch: n_in %d out %d ws %zu (need %zu)\n", n_in, out_size, ws_size, (size_t)WS_END); grid = -1; return; }
        int dev = 0, cus = 0, per_cu = 0;
        if (hipGetDevice(&dev) != hipSuccess || hipDeviceGetAttribute(&cus, hipDeviceAttributeMultiprocessorCount, dev) != hipSuccess) { grid = -1; return; }
        if (hipFuncSetAttribute((const void*)mk_fwd, hipFuncAttributeMaxDynamicSharedMemorySize, LDS_BYTES) != hipSuccess) { fprintf(stderr, "kernel_launch: hipFuncSetAttribute failed\n"); grid = -1; return; }
        if (hipOccupancyMaxActiveBlocksPerMultiprocessor(&per_cu, (const void*)mk_fwd, NTH, LDS_BYTES) != hipSuccess || per_cu < 1) fprintf(stderr, "kernel_launch: occupancy query reports %d\n", per_cu);
        (void)hipGetLastError();
        grid = cus;
    }
    if (grid < 0) return;
    if (hipMemsetAsync((char*)d_ws + WS_CTL, 0, CTL_ZERO_BYTES, stream) != hipSuccess) return;
    Args a{};
    for (int i = 0; i < N_INPUTS; ++i) a.in[i] = (const float*)d_in[i];
    a.out = (float*)d_out; a.ws = (unsigned char*)d_ws; a.pad = 0;
#if MK_ONE_LAUNCH
    a.ph_lo = 0; a.ph_hi = N_PHASES; a.use_bar = 1;
    hipLaunchKernelGGL(mk_fwd, dim3(grid), dim3(NTH), LDS_BYTES, stream, a);
#else
    for (int p = 0; p < N_PHASES; ++p) { a.ph_lo = p; a.ph_hi = p + 1; a.use_bar = 0; hipLaunchKernelGGL(mk_fwd, dim3(grid), dim3(NTH), LDS_BYTES, stream, a); }
#endif
    const hipError_t le = hipPeekAtLastError();
    if (le != hipSuccess) fprintf(stderr, "kernel_launch: launch failed: %s\n", hipGetErrorName(le));
}
```

```cpp
#include <hip/hip_runtime.h>
#include <cstdio>
#include <cstdint>
#include <cmath>

namespace pg8 {
#define PG8_LAS __attribute__((address_space(3)))
typedef unsigned short bf16_t;
typedef short bf16x8 __attribute__((ext_vector_type(8)));
typedef float f32x4 __attribute__((ext_vector_type(4)));
typedef unsigned u32x4 __attribute__((ext_vector_type(4)));
constexpr int BM = 256, BK = 64, HALF = 128, HTB = HALF * BK * 2  , STAGE_BYTES = 8 * HTB, NXCD = 8, WGM = 8;

__host__ __device__ __forceinline__ int lds_byte(int r, int c) { const int st = (r >> 4) * 2 + (c >> 5), rr = r & 15, cc = c & 31, ob = rr * 64 + cc * 2; return st * 1024 + (ob ^ (((ob >> 9) & 1) << 5)); }
__host__ __device__ __forceinline__ void stage_rc(int b, int& R, int& C) { const int st = b / 1024, sb = b % 1024, swz = sb ^ (((sb >> 9) & 1) << 5); R = (st >> 1) * 16 + swz / 64; C = (st & 1) * 32 + (swz % 64) / 2; }
__host__ __device__ __forceinline__ int perm32(int rho) { const int n = rho >> 4, i = rho & 15; return 8 * (i >> 2) + 4 * n + (i & 3); }

struct Unit { int pm, pn, kt0; };
struct Gemm { const bf16_t* A; const bf16_t* Bt; int M, N, K, lda, ldb, bgrp; size_t bgrp_stride; };

struct StaticOrder {
    int nM, nN, nwg, G, c;
    __host__ __device__ void init(int M, int N, int G_, int c_) { nM = M / BM; nN = N / BM; nwg = nM * nN; G = G_; c = c_; lim = nwg; }
    int lim;
    __host__ __device__ void map(int wgid, Unit& u) const {
        { const int q = nwg / NXCD, r = nwg % NXCD, xcd = wgid % NXCD, off = wgid / NXCD; wgid = (xcd < r ? xcd * (q + 1) : r * (q + 1) + (xcd - r) * q) + off; }
        const int nig = WGM * nN, gid = wgid / nig, fm = gid * WGM, gsz = (nM - fm) < WGM ? (nM - fm) : WGM;
        u.pm = fm + ((wgid % nig) % gsz); u.pn = (wgid % nig) / gsz; u.kt0 = 0;
    }
    __host__ __device__ bool next(int i, Unit& u) const {
        const long L = (long)i * G + c; if (L >= lim) return false;
        map((int)L, u); return true;
    }
    __device__ __forceinline__ void a_ready(const Unit&) const {}
    __device__ __forceinline__ void done(const Unit&) const {}
};

struct TailOrder : StaticOrder {
    int base, nth;
    __host__ __device__ bool next(int i, Unit& u) const { if (i > 0) return false; const int L = base + (c >> 1); if (L >= nwg) return false; map(L, u); u.kt0 = (c & 1) * nth; return true; }
};

__device__ __forceinline__ unsigned cvt_pk_bf16(float lo, float hi) { unsigned r; asm volatile("v_cvt_pk_bf16_f32 %0, %1, %2" : "=v"(r) : "v"(lo), "v"(hi)); return r; }
typedef float f32x2 __attribute__((ext_vector_type(2)));
__device__ __forceinline__ f32x2 gelu_pk(f32x2 v) {
    const f32x2 av = __builtin_elementwise_abs(v), d = av * 0.2316418882f + 1.0f;
    f32x2 t; t.x = __builtin_amdgcn_rcpf(d.x); t.y = __builtin_amdgcn_rcpf(d.y);
    f32x2 q = t * 0.5307027145f + (-0.7265760135f); q = q * t + 0.7107068705f; q = q * t + (-0.142248368f); q = q * t + 0.127414796f; q = q * t;
    const f32x2 s = (v * v) * (-0.72134752044f);
    f32x2 e; e.x = __builtin_amdgcn_exp2f(s.x); e.y = __builtin_amdgcn_exp2f(s.y);
    const f32x2 m = v * (q * e), r = v - m;
    f32x2 o; o.x = v.x < 0.f ? m.x : r.x; o.y = v.y < 0.f ? m.y : r.y; return o;
}

template <int ACT  > struct EpiBf16 {
    static constexpr bool PERM = true, AFTER_DRAIN = false; static_assert(ACT == 0 || ACT == 1, "EpiBf16: ACT is 0 (none) or 1 (gelu_pk)");
    bf16_t* O; int ldc; const float* bias; int split_cols; size_t split_stride; float scale0;
    __device__ __forceinline__ void operator()(const f32x4 (&acc)[2][2][4][2], const Unit& u, int wr, int wc, int fr, int fq) const {
        const int row0 = u.pm * BM + wr * 64 + fr; int colt = u.pn * BM; bf16_t* base = O;
        float sc = 1.f; if (split_cols) { const int t = colt / split_cols; base += (size_t)t * split_stride; colt -= t * split_cols; if (t == 0) sc = scale0; }
        const int col0 = colt + wc * 32 + 8 * fq, bcol0 = u.pn * BM + wc * 32 + 8 * fq;
        f32x4 bv[2][2];
#pragma unroll
        for (int bj = 0; bj < 2; ++bj)
#pragma unroll
            for (int n = 0; n < 2; ++n) bv[bj][n] = bias ? *(const f32x4*)(bias + bcol0 + bj * HALF + 4 * n) : (f32x4){0.f, 0.f, 0.f, 0.f};
#pragma unroll
        for (int ai = 0; ai < 2; ++ai)
#pragma unroll
            for (int m = 0; m < 4; ++m) { bf16_t* rowp = base + (size_t)(row0 + ai * HALF + m * 16) * ldc + col0;
#pragma unroll
                for (int bj = 0; bj < 2; ++bj) { f32x4 v0 = acc[ai][bj][m][0] + bv[bj][0], v1 = acc[ai][bj][m][1] + bv[bj][1];
                    if (ACT == 1) { f32x2 a = gelu_pk((f32x2){v0[0], v0[1]}), b = gelu_pk((f32x2){v0[2], v0[3]}), c = gelu_pk((f32x2){v1[0], v1[1]}), d = gelu_pk((f32x2){v1[2], v1[3]});
                        v0 = (f32x4){a.x, a.y, b.x, b.y}; v1 = (f32x4){c.x, c.y, d.x, d.y}; }
                    v0 = v0 * sc; v1 = v1 * sc; u32x4 w; w.x = cvt_pk_bf16(v0[0], v0[1]); w.y = cvt_pk_bf16(v0[2], v0[3]); w.z = cvt_pk_bf16(v1[0], v1[1]); w.w = cvt_pk_bf16(v1[2], v1[3]);
                    *(u32x4*)(rowp + bj * HALF) = w; } }
    }
};

template <class Epi, class Sched, bool ALIGN_EPI = false, bool SP2 = false>
__device__ __forceinline__ void gemm_phase(PG8_LAS unsigned char* lds, const Gemm g, const Sched& S, const Epi& E, int tid_in) {
    int tid_ = tid_in; asm volatile("" : "+v"(tid_));
    const int tid = tid_, wid = __builtin_amdgcn_readfirstlane(tid >> 6), lane = tid & 63, wr = wid >> 2, wc = wid & 3, fr = lane & 15, fq = lane >> 4;
    const int K = g.K, nt = K / BK;
    unsigned voffA[2], voffB[2];
#pragma unroll
    for (int i = 0; i < 2; ++i) { int R, C; stage_rc(tid * 16 + i * 8192, R, C); const int Rb = Epi::PERM ? ((R & ~31) + perm32(R & 31)) : R;
        voffA[i] = (unsigned)(R * g.lda + C) * 2u; voffB[i] = (unsigned)(Rb * g.ldb + C) * 2u; }
    const size_t kstep = (size_t)(BK * 2);
    const size_t hstepA = (size_t)HALF * g.lda * 2, hstepB = (size_t)HALF * g.ldb * 2;
    const size_t tstepA = 2 * hstepA, tstepB = 2 * hstepB;
    const unsigned ldsw = (unsigned)wid * 1024u;
    const int aoff = lds_byte(wr * 64 + fr, fq * 8), boff = lds_byte(wc * 32 + fr, fq * 8);
#define PG8_SA(b, h) (((b) * 2 + (h)) * HTB)
#define PG8_SB(b, h) ((4 + (b) * 2 + (h)) * HTB)
#define PG8_STAGE(bufoff, gbase, voff) do { _Pragma("unroll") for (int _i = 0; _i < 2; ++_i) \
        __builtin_amdgcn_global_load_lds((const unsigned*)((const char*)(gbase) + (voff)[_i]), (PG8_LAS unsigned*)(lds + (bufoff) + ldsw + _i * 8192), 16, 0, 0); } while (0)
#define PG8_LDA(dst, b, h) do { _Pragma("unroll") for (int m = 0; m < 4; ++m) _Pragma("unroll") for (int k = 0; k < 2; ++k) dst[m][k] = *(const PG8_LAS bf16x8*)(lds + PG8_SA(b, h) + aoff + m * 2048 + k * 1024); } while (0)
#define PG8_LDB(dst, b, h) do { _Pragma("unroll") for (int n = 0; n < 2; ++n) _Pragma("unroll") for (int k = 0; k < 2; ++k) dst[n][k] = *(const PG8_LAS bf16x8*)(lds + PG8_SB(b, h) + boff + n * 2048 + k * 1024); } while (0)
#define PG8_MMA(ai, bj, At, Bt) do { __builtin_amdgcn_s_setprio(1); _Pragma("unroll") for (int m = 0; m < 4; ++m) _Pragma("unroll") for (int n = 0; n < 2; ++n) _Pragma("unroll") for (int k = 0; k < 2; ++k) \
        acc[ai][bj][m][n] = __builtin_amdgcn_mfma_f32_16x16x32_bf16(Bt[n][k], At[m][k], acc[ai][bj][m][n], 0, 0, 0); __builtin_amdgcn_s_setprio(0); } while (0)
#define PG8_WAIT_V(n) asm volatile("s_waitcnt vmcnt(" #n ")" ::: "memory")
#define PG8_WAIT_L(n) asm volatile("s_waitcnt lgkmcnt(" #n ")" ::: "memory")
#define PG8_BAR __builtin_amdgcn_s_barrier()
#define PG8_SCHED __builtin_amdgcn_sched_barrier(0)
    Unit cur, nxt; int ui = 0;
    if (!S.next(0, cur)) return;
    f32x4 acc[2][2][4][2];
#pragma unroll
    for (int a = 0; a < 2; ++a)
#pragma unroll
        for (int b = 0; b < 2; ++b)
#pragma unroll
            for (int m = 0; m < 4; ++m)
#pragma unroll
                for (int n = 0; n < 2; ++n) acc[a][b][m][n] = (f32x4){0.f, 0.f, 0.f, 0.f};
    bf16x8 At[4][2], B0[2][2], B1[2][2];
    const char* cA = (const char*)g.A + (size_t)cur.pm * tstepA + (size_t)cur.kt0 * kstep; const char* cB = (const char*)g.Bt + (size_t)(cur.pm / g.bgrp) * g.bgrp_stride * 2 + (size_t)cur.pn * tstepB + (size_t)cur.kt0 * kstep;
    S.a_ready(cur);
    if constexpr (SP2) {
        PG8_STAGE(PG8_SB(0, 0), cB, voffB); PG8_STAGE(PG8_SB(0, 1), cB + hstepB, voffB); PG8_STAGE(PG8_SA(0, 0), cA, voffA); PG8_STAGE(PG8_SA(0, 1), cA + hstepA, voffA);
        if (wr == 1) PG8_BAR;
        PG8_WAIT_V(2); PG8_BAR;
        PG8_STAGE(PG8_SB(1, 0), cB + kstep, voffB); PG8_STAGE(PG8_SA(1, 0), cA + kstep, voffA); PG8_STAGE(PG8_SB(1, 1), cB + hstepB + kstep, voffB);
        PG8_WAIT_V(6); PG8_BAR;
    } else {
        PG8_STAGE(PG8_SB(0, 0), cB, voffB); PG8_STAGE(PG8_SA(0, 0), cA, voffA); PG8_STAGE(PG8_SB(0, 1), cB + hstepB, voffB); PG8_STAGE(PG8_SA(0, 1), cA + hstepA, voffA);
        if (wr == 1) PG8_BAR;
        PG8_WAIT_V(4); PG8_BAR;
        PG8_STAGE(PG8_SB(1, 0), cB + kstep, voffB); PG8_STAGE(PG8_SA(1, 0), cA + kstep, voffA); PG8_STAGE(PG8_SB(1, 1), cB + hstepB + kstep, voffB);
        PG8_WAIT_V(6); PG8_BAR;
    }
    for (;;) {
        const bool has_next = S.next(ui + 1, nxt);
        const char* nA = has_next ? (const char*)g.A + (size_t)nxt.pm * tstepA + (size_t)nxt.kt0 * kstep : cA; const char* nB = has_next ? (const char*)g.Bt + (size_t)(nxt.pm / g.bgrp) * g.bgrp_stride * 2 + (size_t)nxt.pn * tstepB + (size_t)nxt.kt0 * kstep : cB;
        for (int t = 0; t < nt; t += 2) {
            const bool last = (t == nt - 2);
            const char* a1 = cA + (size_t)(t + 1) * kstep;
            const char* a2 = last ? nA : cA + (size_t)(t + 2) * kstep; const char* b2 = last ? nB : cB + (size_t)(t + 2) * kstep;
            const char* a3 = a2 + kstep; const char* b3 = b2 + kstep;
            if (last && has_next) S.a_ready(nxt);
            if constexpr (SP2) {
            PG8_LDB(B0, 0, 0); PG8_LDB(B1, 0, 1); PG8_SCHED; PG8_LDA(At, 0, 0); PG8_STAGE(PG8_SA(1, 1), a1 + hstepA, voffA);
            PG8_WAIT_V(8); PG8_WAIT_L(0); PG8_BAR; PG8_MMA(0, 0, At, B0); PG8_MMA(0, 1, At, B1); PG8_BAR; PG8_SCHED;
            PG8_LDA(At, 0, 1); PG8_STAGE(PG8_SB(0, 0), b2, voffB); PG8_STAGE(PG8_SB(0, 1), b2 + hstepB, voffB); PG8_STAGE(PG8_SA(0, 0), a2, voffA);
            PG8_WAIT_V(8); PG8_WAIT_L(0); PG8_BAR; PG8_MMA(1, 0, At, B0); PG8_MMA(1, 1, At, B1); PG8_BAR; PG8_SCHED;
            PG8_LDB(B0, 1, 0); PG8_LDB(B1, 1, 1); PG8_SCHED; PG8_LDA(At, 1, 0); PG8_STAGE(PG8_SA(0, 1), a2 + hstepA, voffA);
            PG8_WAIT_V(8); PG8_WAIT_L(0); PG8_BAR; PG8_MMA(0, 0, At, B0); PG8_MMA(0, 1, At, B1); PG8_BAR; PG8_SCHED;
            PG8_LDA(At, 1, 1); PG8_STAGE(PG8_SB(1, 0), b3, voffB); PG8_STAGE(PG8_SB(1, 1), b3 + hstepB, voffB); PG8_STAGE(PG8_SA(1, 0), a3, voffA);
            PG8_WAIT_V(8); PG8_WAIT_L(0); PG8_BAR; PG8_MMA(1, 0, At, B0); PG8_MMA(1, 1, At, B1); PG8_BAR; PG8_SCHED;
            } else {
            PG8_LDB(B0, 0, 0); PG8_SCHED; PG8_LDA(At, 0, 0); PG8_STAGE(PG8_SA(1, 1), a1 + hstepA, voffA);
            PG8_WAIT_L(8); PG8_BAR; PG8_WAIT_L(0); PG8_MMA(0, 0, At, B0); PG8_BAR; PG8_SCHED;
            PG8_LDB(B1, 0, 1); PG8_STAGE(PG8_SB(0, 0), b2, voffB);
            PG8_BAR; PG8_WAIT_L(0); PG8_MMA(0, 1, At, B1); PG8_BAR;
            PG8_LDA(At, 0, 1); PG8_STAGE(PG8_SA(0, 0), a2, voffA);
            PG8_BAR; PG8_WAIT_L(0); PG8_MMA(1, 0, At, B0); PG8_BAR; PG8_SCHED;
            PG8_STAGE(PG8_SB(0, 1), b2 + hstepB, voffB);
            PG8_WAIT_V(6); PG8_BAR; PG8_MMA(1, 1, At, B1); PG8_BAR;
            PG8_LDB(B0, 1, 0); PG8_SCHED; PG8_LDA(At, 1, 0); PG8_STAGE(PG8_SA(0, 1), a2 + hstepA, voffA);
            PG8_WAIT_L(8); PG8_BAR; PG8_WAIT_L(0); PG8_MMA(0, 0, At, B0); PG8_BAR; PG8_SCHED;
            PG8_LDB(B1, 1, 1); PG8_STAGE(PG8_SB(1, 0), b3, voffB);
            PG8_BAR; PG8_WAIT_L(0); PG8_MMA(0, 1, At, B1); PG8_BAR;
            PG8_LDA(At, 1, 1); PG8_STAGE(PG8_SA(1, 0), a3, voffA);
            PG8_BAR; PG8_WAIT_L(0); PG8_MMA(1, 0, At, B0); PG8_BAR; PG8_SCHED;
            PG8_STAGE(PG8_SB(1, 1), b3 + hstepB, voffB);
            PG8_WAIT_V(6); PG8_BAR; PG8_MMA(1, 1, At, B1); PG8_BAR;
            }
        }
        if constexpr (ALIGN_EPI) { if (wr == 0) PG8_BAR; }
        if constexpr (!Epi::AFTER_DRAIN) { E(acc, cur, wr, wc, fr, fq); S.done(cur); }
        if (!has_next) break;
#pragma unroll
        for (int a = 0; a < 2; ++a)
#pragma unroll
            for (int b = 0; b < 2; ++b)
#pragma unroll
                for (int m = 0; m < 4; ++m)
#pragma unroll
                    for (int n = 0; n < 2; ++n) acc[a][b][m][n] = (f32x4){0.f, 0.f, 0.f, 0.f};
        cur = nxt; cA = nA; cB = nB; ++ui;
        if constexpr (ALIGN_EPI) { if (wr == 1) PG8_BAR; }
    }
    PG8_WAIT_V(0);
    if constexpr (!ALIGN_EPI) { if (wr == 0) PG8_BAR; }
    PG8_BAR;
    if constexpr (Epi::AFTER_DRAIN) { E.fused(acc, cur, wr, wc, fr, fq, lds, wid, lane); S.done(cur); }
#undef PG8_SA
#undef PG8_SB
#undef PG8_STAGE
#undef PG8_LDA
#undef PG8_LDB
#undef PG8_MMA
#undef PG8_WAIT_V
#undef PG8_WAIT_L
#undef PG8_BAR
#undef PG8_SCHED
}
}

constexpr int DM = 2048, NPB = 16, SEQ = 256, DEPTH = 4, NDB = 4, DSEQ = 4096, PAST = 256;
constexpr int MP = NPB * SEQ, MS = NDB * DSEQ, M = MP + MS;
constexpr int NIN = 4544, NINP = 4608;
constexpr int C_AQ = 0, C_AK = 512, C_AV = 1024, C_BQ = 1536, C_BK = 1920, C_BV = 2304, C_BR = 3072, C_BG = 3840, C_CQ = 3872, C_CKV = 4256, C_CKR = 4512;
constexpr int DFF = 5632, NQC = 576, NQCP = 768, NKV = 1152, NKVP = 1280;
constexpr float EPS = 1e-6f;
constexpr int NOATT = 14 * 128, NOGLA = 2 * 768;
enum { I_XP = 0, I_XS, I_CAK, I_CAV, I_STB, I_CCKV, I_CCKR, I_C, I_CCTX, I_N1G, I_ADAW, I_ADAB, I_WIN, I_LQ1, I_LK1, I_LQ2, I_LK2, I_ANG, I_BGW, I_BGB, I_BNG, I_CQG, I_CQUP, I_CKVG, I_CKVUP, I_WOUT, I_N2G, I_WUP, I_CONVW, I_CONVB, I_WDOWN, I_FING, N_INPUTS };
constexpr size_t O_YP = 0, O_YS = O_YP + (size_t)MP * DM, O_AK = O_YS + (size_t)MS * DM, O_AV = O_AK + (size_t)NPB * DEPTH * SEQ * 512, O_SB = O_AV + (size_t)NPB * DEPTH * SEQ * 512,
                 O_CKV = O_SB + (size_t)NPB * DEPTH * 2 * 6 * 64 * 128, O_CKR = O_CKV + (size_t)NPB * DEPTH * SEQ * 256, O_END = O_CKR + (size_t)NPB * DEPTH * SEQ * 32;
static_assert(O_END == 69730304, "output size");

constexpr size_t al256(size_t x) { return (x + 255) & ~(size_t)255; }
constexpr size_t WS_CTL = 0, CTL_ZERO_BYTES = 2u << 20;
constexpr size_t WS_SSQ = 1u << 20;
constexpr size_t SZ_WIN = (size_t)NINP * DM * 2, SZ_WOUT = (size_t)DM * DM * 2, SZ_WUP = (size_t)2 * DFF * DM * 2, SZ_WDN = (size_t)DM * DFF * 2, SZ_WQ = (size_t)NQCP * 384 * 2, SZ_WKV = (size_t)NKVP * 256 * 2;
constexpr size_t WS_WIN = WS_CTL + CTL_ZERO_BYTES, WS_WOUT = WS_WIN + 4 * SZ_WIN, WS_WUP = WS_WOUT + 4 * SZ_WOUT, WS_WDN = WS_WUP + 4 * SZ_WUP, WS_WQ = WS_WDN + 4 * SZ_WDN, WS_WKV = WS_WQ + 4 * SZ_WQ;
constexpr size_t SZ_MOD = (size_t)DEPTH * 5 * 6 * DM * 4;
constexpr size_t WS_MOD = WS_WKV + 4 * SZ_WKV, WS_MODP = WS_MOD + SZ_MOD, WS_RTA = WS_MODP + 8 * SZ_MOD, WS_RTC = WS_RTA + (size_t)DSEQ * 64 * 4, WS_LAM = WS_RTC + (size_t)DSEQ * 32 * 4;
constexpr size_t WS_CAK = WS_LAM + 256, WS_CAV = WS_CAK + (size_t)NDB * DEPTH * PAST * 512 * 2, WS_CKRX = WS_CAV + (size_t)NDB * DEPTH * PAST * 512 * 2, WS_CKVA = WS_CKRX + (size_t)NDB * DEPTH * PAST * 32 * 2,
                 WS_KVCTX = WS_CKVA + (size_t)DEPTH * NDB * PAST * 256 * 2, WS_SIDE = WS_KVCTX + (size_t)DEPTH * NDB * PAST * NKVP * 2, WS_GM = WS_SIDE + (size_t)(M / 256) * 2 * 3 * DFF * 4, WS_SHWI = WS_GM + (size_t)DEPTH * 2 * 5 * DM * 4,
                 WS_SHWU = WS_SHWI + (size_t)DEPTH * 5 * NINP * 4, WS_SSQP = WS_SHWU + (size_t)DEPTH * 5 * 2 * DFF * 4, WS_X = WS_SSQP + (size_t)8 * M * 32 * 4;
constexpr size_t WS_H = WS_X + (size_t)M * DM * 4, WS_T0 = WS_H + (size_t)M * DM * 2;
constexpr size_t WS_P = WS_T0, WS_MIX = WS_P + (size_t)M * NINP * 2, WS_QC = WS_MIX + (size_t)M * DM * 2, WS_KVC = WS_QC + (size_t)M * NQCP * 2, WS_CQN = WS_KVC + (size_t)M * NKVP * 2, WS_CKVN = WS_CQN + (size_t)M * 384 * 2,
                 WS_KRA = WS_CKVN + (size_t)M * 256 * 2, WS_KRC = WS_KRA + (size_t)MS * 512 * 2, WS_OATT = WS_KRC + (size_t)MS * 32 * 2, WS_OGLA = WS_OATT + (size_t)M * NOATT * 4, WS_GATE = WS_OGLA + (size_t)M * NOGLA * 4,
                 WS_ST = WS_GATE + (size_t)M * 768 * 4, WS_DD = WS_ST + (size_t)(M / 64) * 12 * 8192 * 2, WS_END1 = WS_DD + (size_t)(M / 64) * 12 * 64 * 4;
constexpr size_t WS_U = WS_OGLA, WS_QK4 = WS_GATE;
constexpr size_t WS_GU = WS_T0, WS_ACT = WS_GU + (size_t)M * 2 * DFF * 2, WS_END2 = WS_ACT + (size_t)M * DFF * 2;


static_assert(WS_WIN % 256 == 0 && WS_X % 256 == 0 && WS_H % 256 == 0 && WS_T0 % 256 == 0 && WS_QC % 256 == 0 && WS_KVC % 256 == 0 && WS_CQN % 256 == 0 && WS_CKVN % 256 == 0 && WS_OATT % 256 == 0 && WS_ACT % 256 == 0, "alignment");

constexpr size_t WS_SPLITK = WS_END1 > WS_END2 ? WS_END1 : WS_END2, WS_END3 = WS_SPLITK + (size_t)128 * 2 * 65536 * 4;
constexpr size_t WS_END = WS_END3;
static_assert(WS_END <= (size_t)1536 << 20, "workspace map must fit 4 x the largest tensor");
constexpr int CW_TICKET = 65536;

constexpr int RING_BYTES = 131072, MISC_OFF = RING_BYTES + 320, LDS_BYTES = 147456;

#define GAS __attribute__((address_space(1)))
#define LAS __attribute__((address_space(3)))
typedef unsigned short bf16;
typedef unsigned v4u __attribute__((ext_vector_type(4)));
typedef unsigned v2u __attribute__((ext_vector_type(2)));
typedef float f32x4 __attribute__((ext_vector_type(4)));
#define LDS_WAIT() asm volatile("s_waitcnt lgkmcnt(0)" ::: "memory")
__device__ __forceinline__ unsigned f2bf(float f) { unsigned u = __builtin_bit_cast(unsigned, f); return (u + 0x7fffu + ((u >> 16) & 1u)) >> 16; }
__device__ __forceinline__ unsigned pk2(float lo, float hi) { return f2bf(lo) | (f2bf(hi) << 16); }
__device__ __forceinline__ float bf2f(bf16 b) { return __builtin_bit_cast(float, (unsigned)b << 16); }
__device__ __forceinline__ float wave_sum(float v) {
#pragma unroll
    for (int o = 1; o < 64; o <<= 1) v += __shfl_xor(v, o);
    return v;
}
__device__ __forceinline__ float siluf(float x) { return x / (1.f + __expf(-x)); }

namespace pg8 {
__device__ __forceinline__ void rstd_table(const float* ssq, int pm, PG8_LAS float* rtab, int tid) {
    const int row = tid >> 1, half = tid & 1; const float* p = ssq + ((size_t)(pm * BM + row) * 32 + half * 16);
    const f32x4 a = *(const f32x4*)p, b = *(const f32x4*)(p + 4), c = *(const f32x4*)(p + 8), d = *(const f32x4*)(p + 12);
    float s = (((a[0] + a[1]) + (a[2] + a[3])) + ((b[0] + b[1]) + (b[2] + b[3]))) + (((c[0] + c[1]) + (c[2] + c[3])) + ((d[0] + d[1]) + (d[2] + d[3])));
    s += __shfl_xor(s, 1);
    if (half == 0) rtab[row] = 1.0f / sqrtf(s * (1.f / 2048.f) + 1e-6f);
    asm volatile("s_waitcnt lgkmcnt(0)" ::: "memory"); __builtin_amdgcn_s_barrier(); asm volatile("" ::: "memory");
}
struct EpiResid {
    static constexpr bool PERM = true, AFTER_DRAIN = false;
    const float* xin0; const float* xin1;
    float* out; const float* gate;
    bf16_t* H; const float* gm; float* ssq;
    __device__ __forceinline__ void operator()(const f32x4 (&acc)[2][2][4][2], const Unit& u, int wr, int wc, int fr, int fq) const {
        const int mi = u.pm < 16 ? 0 : 1 + ((u.pm - 16) >> 4);
        const float* gp = gate + (size_t)mi * 6 * 2048; const float* xin = u.pm < 16 ? xin0 : xin1;
        const int col0 = u.pn * BM + wc * 32 + 8 * fq;
        f32x4 gv[2][2], gm4[2][2];
#pragma unroll
        for (int bj = 0; bj < 2; ++bj)
#pragma unroll
            for (int n = 0; n < 2; ++n) { gv[bj][n] = *(const f32x4*)(gp + col0 + bj * HALF + 4 * n); gm4[bj][n] = H ? *(const f32x4*)(gm + (size_t)mi * 2048 + col0 + bj * HALF + 4 * n) : (f32x4){0.f, 0.f, 0.f, 0.f}; }
#pragma unroll
        for (int ai = 0; ai < 2; ++ai)
#pragma unroll
            for (int m = 0; m < 4; ++m) { const int row = u.pm * BM + ai * HALF + wr * 64 + m * 16 + fr; const size_t off = (size_t)row * 2048 + col0; float ss = 0.f;
#pragma unroll
                for (int bj = 0; bj < 2; ++bj) { const f32x4 x0 = *(const f32x4*)(xin + off + bj * HALF), x1 = *(const f32x4*)(xin + off + bj * HALF + 4);
                    const f32x4 y0 = x0 + gv[bj][0] * acc[ai][bj][m][0], y1 = x1 + gv[bj][1] * acc[ai][bj][m][1];
                    *(f32x4*)(out + off + bj * HALF) = y0; *(f32x4*)(out + off + bj * HALF + 4) = y1;
                    ss += ((y0[0] * y0[0] + y0[1] * y0[1]) + (y0[2] * y0[2] + y0[3] * y0[3])) + ((y1[0] * y1[0] + y1[1] * y1[1]) + (y1[2] * y1[2] + y1[3] * y1[3]));
                    if (H) { const f32x4 h0 = y0 * gm4[bj][0], h1 = y1 * gm4[bj][1]; u32x4 w; w.x = cvt_pk_bf16(h0[0], h0[1]); w.y = cvt_pk_bf16(h0[2], h0[3]); w.z = cvt_pk_bf16(h1[0], h1[1]); w.w = cvt_pk_bf16(h1[2], h1[3]);
                        *(u32x4*)(H + off + bj * HALF) = w; } }
                if (H) { ss += __shfl_xor(ss, 16); ss += __shfl_xor(ss, 32); if (fq == 0) ssq[(size_t)row * 32 + u.pn * 4 + wc] = ss; } }
    }
};
struct EpiBf16Norm {
    static constexpr bool PERM = true, AFTER_DRAIN = false;
    bf16_t* O; int ldc; const float* ssq; const float* shw; int shw_ld; PG8_LAS float* rtab;
    static constexpr int qtiles = 2; static constexpr float qscale = 0.125f * 1.4426950408889634f;
    __device__ __forceinline__ void operator()(const f32x4 (&acc)[2][2][4][2], const Unit& u, int wr, int wc, int fr, int fq) const {
        const int mi = u.pm < 16 ? 0 : 1 + ((u.pm - 16) >> 4);
        rstd_table(ssq, u.pm, rtab, (wr * 4 + wc) * 64 + fq * 16 + fr);
        const int row0 = u.pm * BM + wr * 64 + fr, col0 = u.pn * BM + wc * 32 + 8 * fq; const float* sp = shw + (size_t)mi * shw_ld + col0;
        const float qs = u.pn < qtiles ? qscale : 1.f;
        f32x4 sv[2][2];
#pragma unroll
        for (int bj = 0; bj < 2; ++bj)
#pragma unroll
            for (int n = 0; n < 2; ++n) sv[bj][n] = *(const f32x4*)(sp + bj * HALF + 4 * n);
#pragma unroll
        for (int ai = 0; ai < 2; ++ai)
#pragma unroll
            for (int m = 0; m < 4; ++m) { const int row = row0 + ai * HALF + m * 16; const float rs = rtab[row - u.pm * BM];
                bf16_t* rowp = O + (size_t)row * ldc + col0;
#pragma unroll
                for (int bj = 0; bj < 2; ++bj) { const f32x4 v0 = (acc[ai][bj][m][0] * rs + sv[bj][0]) * qs, v1 = (acc[ai][bj][m][1] * rs + sv[bj][1]) * qs;
                    u32x4 w; w.x = cvt_pk_bf16(v0[0], v0[1]); w.y = cvt_pk_bf16(v0[2], v0[3]); w.z = cvt_pk_bf16(v1[0], v1[1]); w.w = cvt_pk_bf16(v1[2], v1[3]);
                    *(u32x4*)(rowp + bj * HALF) = w; } }
    }
};

struct EpiResidTail {
    static constexpr bool PERM = false, AFTER_DRAIN = false;
    float* X; const float* gate; float* scratch; unsigned* ticket; PG8_LAS unsigned* lw;
    __device__ __forceinline__ void operator()(const f32x4 (&acc)[2][2][4][2], const Unit& u, int wr, int wc, int fr, int fq) const {
        const int t = blockIdx.x >> 1, half = blockIdx.x & 1, tid = threadIdx.x;
        { const __amdgpu_buffer_rsrc_t rs = __builtin_amdgcn_make_buffer_rsrc(scratch + ((size_t)t * 2 + half) * 65536, 0, 65536 * 4, 0x00020000);
#pragma unroll
          for (int ai = 0; ai < 2; ++ai)
#pragma unroll
            for (int bj = 0; bj < 2; ++bj)
#pragma unroll
                for (int m = 0; m < 4; ++m)
#pragma unroll
                    for (int n = 0; n < 2; ++n) { const int j = ((ai * 2 + bj) * 4 + m) * 2 + n; __builtin_amdgcn_raw_buffer_store_b128(__builtin_bit_cast(u32x4, acc[ai][bj][m][n]), rs, (j * 512 + tid) * 16, 0, 16); } }
        asm volatile("s_waitcnt vmcnt(0)" ::: "memory"); __builtin_amdgcn_s_barrier(); asm volatile("" ::: "memory");
        if (tid == 0) { const unsigned old = __hip_atomic_fetch_add(ticket + 64 * t, 1u, __ATOMIC_RELAXED, __HIP_MEMORY_SCOPE_AGENT); *lw = old; }
        asm volatile("s_waitcnt vmcnt(0) lgkmcnt(0)" ::: "memory"); __builtin_amdgcn_s_barrier(); asm volatile("" ::: "memory");
        const unsigned old = *lw;
        if (old == 0u) return;
        __builtin_amdgcn_fence(__ATOMIC_ACQUIRE, "agent"); asm volatile("s_waitcnt vmcnt(0)" ::: "memory");
        const float* oth = scratch + ((size_t)t * 2 + (half ^ 1)) * 65536; const float* own = scratch + ((size_t)t * 2 + half) * 65536;
        const int mi = u.pm < 16 ? 0 : 1 + ((u.pm - 16) >> 4);
        const float* gp = gate + (size_t)mi * 6 * 2048;
        const int col0 = u.pn * BM + wc * 32 + 4 * fq;
#pragma unroll
        for (int ai = 0; ai < 2; ++ai)
#pragma unroll
            for (int m = 0; m < 4; ++m) { const size_t off = (size_t)(u.pm * BM + ai * HALF + wr * 64 + m * 16 + fr) * 2048 + col0;
#pragma unroll
                for (int bj = 0; bj < 2; ++bj)
#pragma unroll
                    for (int n = 0; n < 2; ++n) { const int j = ((ai * 2 + bj) * 4 + m) * 2 + n; const f32x4 pv = *(const f32x4*)(oth + (size_t)(j * 512 + tid) * 4) + *(const f32x4*)(own + (size_t)(j * 512 + tid) * 4);
                        const f32x4 gv = *(const f32x4*)(gp + col0 + bj * HALF + n * 16), xv = *(const f32x4*)(X + off + bj * HALF + n * 16);
                        *(f32x4*)(X + off + bj * HALF + n * 16) = xv + gv * pv; }
                asm volatile("" ::: "memory"); }
    }
};

__device__ __forceinline__ float dpp_ror1(float x) { return __builtin_bit_cast(float, __builtin_amdgcn_update_dpp(__builtin_bit_cast(int, x), __builtin_bit_cast(int, x), 0x121, 0xf, 0xf, false)); }
__device__ __forceinline__ float dpp_rol1(float x) { return __builtin_bit_cast(float, __builtin_amdgcn_update_dpp(__builtin_bit_cast(int, x), __builtin_bit_cast(int, x), 0x12F, 0xf, 0xf, false)); }
struct EpiConvAct {
    static constexpr bool PERM = true, AFTER_DRAIN = false;
    bf16_t* ACT; const float* cw; const float* cb; float* side; PG8_LAS float* ex;
    const float* ssq; const float* shw; PG8_LAS float* rtab;
    __device__ __forceinline__ void operator()(const f32x4 (&acc_)[2][2][4][2], const Unit& u, int wr, int wc, int fr, int fq) const {
        constexpr int FF = 5632;
        const int colw = wc * 32 + 8 * fq, j0 = u.pn * HALF + colw;
        f32x4 (&acc)[2][2][4][2] = const_cast<f32x4 (&)[2][2][4][2]>(acc_);
        rstd_table(ssq, u.pm, rtab, (wr * 4 + wc) * 64 + fq * 16 + fr);
        { const int mi = u.pm < 16 ? 0 : 1 + ((u.pm - 16) >> 4); const float* sp = shw + (size_t)mi * (2 * FF) + u.pn * BM + colw;
          f32x4 sv[2][2];
#pragma unroll
          for (int bj = 0; bj < 2; ++bj)
#pragma unroll
              for (int n = 0; n < 2; ++n) sv[bj][n] = *(const f32x4*)(sp + bj * HALF + 4 * n);
#pragma unroll
          for (int ai = 0; ai < 2; ++ai)
#pragma unroll
              for (int m = 0; m < 4; ++m) { const int row = u.pm * BM + ai * HALF + wr * 64 + m * 16 + fr; const float rs = rtab[row - u.pm * BM];
#pragma unroll
                  for (int bj = 0; bj < 2; ++bj)
#pragma unroll
                      for (int n = 0; n < 2; ++n) acc[ai][bj][m][n] = acc[ai][bj][m][n] * rs + sv[bj][n]; } }
        float w0[8], w1[8], w2[8], bb[8];
#pragma unroll
        for (int q = 0; q < 2; ++q) { const f32x4 a0 = *(const f32x4*)(cw + j0 + 4 * q), a1 = *(const f32x4*)(cw + FF + j0 + 4 * q), a2 = *(const f32x4*)(cw + 2 * FF + j0 + 4 * q), a3 = *(const f32x4*)(cb + j0 + 4 * q);
#pragma unroll
            for (int i = 0; i < 4; ++i) { w0[4 * q + i] = a0[i]; w1[4 * q + i] = a1[i]; w2[4 * q + i] = a2[i]; bb[4 * q + i] = a3[i]; } }
#pragma unroll
        for (int ai = 0; ai < 2; ++ai) { const int blk = 2 * ai + wr;
            if (fr == 0) {
#pragma unroll
                for (int n = 0; n < 2; ++n) *(PG8_LAS f32x4*)(ex + (blk * 2 + 0) * HALF + colw + 4 * n) = acc[ai][0][0][n]; }
            if (fr == 15) {
#pragma unroll
                for (int n = 0; n < 2; ++n) *(PG8_LAS f32x4*)(ex + (blk * 2 + 1) * HALF + colw + 4 * n) = acc[ai][0][3][n]; } }
        asm volatile("s_waitcnt lgkmcnt(0)" ::: "memory"); __builtin_amdgcn_s_barrier(); asm volatile("" ::: "memory");
#pragma unroll
        for (int ai = 0; ai < 2; ++ai) { const int blk = 2 * ai + wr;
#pragma unroll
            for (int m = 0; m < 4; ++m) { float ov[8]; float gcv[8]; float pe[8], ne[8];
                if (m == 0) {
#pragma unroll
                    for (int n = 0; n < 2; ++n) { const f32x4 p4 = blk > 0 ? *(const PG8_LAS f32x4*)(ex + ((blk - 1) * 2 + 1) * HALF + colw + 4 * n) : (f32x4){0.f, 0.f, 0.f, 0.f};
#pragma unroll
                        for (int i = 0; i < 4; ++i) pe[4 * n + i] = p4[i]; } }
                if (m == 3) {
#pragma unroll
                    for (int n = 0; n < 2; ++n) { const f32x4 n4 = blk < 3 ? *(const PG8_LAS f32x4*)(ex + ((blk + 1) * 2 + 0) * HALF + colw + 4 * n) : (f32x4){0.f, 0.f, 0.f, 0.f};
#pragma unroll
                        for (int i = 0; i < 4; ++i) ne[4 * n + i] = n4[i]; } }
#pragma unroll
                for (int k = 0; k < 8; ++k) { const int n = k >> 2, i = k & 3; const float g = acc[ai][0][m][n][i];
                    const float rs = dpp_ror1(g), ls = dpp_rol1(g);
                    const float rp = m > 0 ? dpp_ror1(acc[ai][0][m > 0 ? m - 1 : 0][n][i]) : pe[k];
                    const float ln = m < 3 ? dpp_rol1(acc[ai][0][m < 3 ? m + 1 : 3][n][i]) : ne[k];
                    const float gp = fr > 0 ? rs : rp, gn = fr < 15 ? ls : ln;
                    const float gc = w0[k] * gp + w1[k] * g + w2[k] * gn + bb[k];
                    gcv[k] = gc; ov[k] = gc * __builtin_amdgcn_rcpf(1.f + __expf(-gc)) * acc[ai][1][m][n][i]; }
                const int row = u.pm * BM + ai * HALF + wr * 64 + m * 16 + fr;
                u32x4 w; w.x = cvt_pk_bf16(ov[0], ov[1]); w.y = cvt_pk_bf16(ov[2], ov[3]); w.z = cvt_pk_bf16(ov[4], ov[5]); w.w = cvt_pk_bf16(ov[6], ov[7]);
                *(u32x4*)(ACT + (size_t)row * FF + j0) = w;
                const bool first = (ai == 0 && m == 0) && wr == 0 && fr == 0, last = (ai == 1 && m == 3) && wr == 1 && fr == 15;
                if ((ai == 0 && m == 0) || (ai == 1 && m == 3)) { if (first || last) { float* sp = side + ((size_t)(u.pm * 2 + (last ? 1 : 0)) * 3) * FF + j0;
#pragma unroll
                    for (int n = 0; n < 2; ++n) { *(f32x4*)(sp + 4 * n) = (f32x4){gcv[4 * n], gcv[4 * n + 1], gcv[4 * n + 2], gcv[4 * n + 3]}; *(f32x4*)(sp + FF + 4 * n) = acc[ai][1][m][n]; *(f32x4*)(sp + 2 * FF + 4 * n) = acc[ai][0][m][n]; } } }
            } }
    }
};
}

#define XB_TMO      128
#define XB_XCNT(j)  (256  + 64 * (j))
#define XB_XSUB(j)  (1280 + 64 * (j))
#define XB_XGEN(j)  (2304 + 64 * (j))
#define XB_TOP      3328
#define XB_TOPGEN   3392
#define XCD_BAR_WORDS 3456
#define XB_SPIN_CAP (1u << 18)
__device__ __forceinline__ unsigned xb_ld(unsigned* p)              { return __hip_atomic_load(p, __ATOMIC_RELAXED, __HIP_MEMORY_SCOPE_AGENT); }
__device__ __forceinline__ unsigned xb_add(unsigned* p, unsigned v) { return __hip_atomic_fetch_add(p, v, __ATOMIC_RELAXED, __HIP_MEMORY_SCOPE_AGENT); }
__device__ __forceinline__ unsigned xb_xcc_id() { return (unsigned)__builtin_amdgcn_s_getreg((3 << 11) | 20) & 0xFu; }
#define XB_SPIN(cond, bar) do { unsigned _sp = 0; while (cond) { __builtin_amdgcn_s_sleep(1); \
    if ((++_sp & 255u) == 0u) { if (xb_ld(&(bar)[XB_TMO])) break; if (_sp > XB_SPIN_CAP) { atomicAdd(&(bar)[XB_TMO], 1u); break; } } } } while (0)
struct XcdBarrier { unsigned* bar; unsigned x; volatile LAS unsigned* st; };
__device__ __forceinline__ XcdBarrier xcd_barrier_post(unsigned* bar, volatile LAS unsigned* st) {
    XcdBarrier b; b.bar = bar; b.x = xb_xcc_id(); b.st = st;
    if (threadIdx.x == 0) (void)xb_add(&bar[XB_XCNT(b.x)], 1u);
    return b;
}
__device__ __forceinline__ void xcd_barrier_complete(unsigned* bar, unsigned x, unsigned& nloc, unsigned& nx) {
    const unsigned G = gridDim.x * gridDim.y * gridDim.z;
    unsigned sum, cnt, mine, sp = 0u;
    for (;;) {
        sum = 0u; cnt = 0u; mine = 0u;
#pragma unroll
        for (unsigned j = 0; j < 16; ++j) { const unsigned c = xb_ld(&bar[XB_XCNT(j)]); sum += c; cnt += (c > 0u) ? 1u : 0u; mine = (j == x) ? c : mine; }
        if (sum == G) break;
        __builtin_amdgcn_s_sleep(1);
        if ((++sp & 255u) == 0u) { if (xb_ld(&bar[XB_TMO])) break; if (sp > XB_SPIN_CAP) { atomicAdd(&bar[XB_TMO], 1u); break; } }
    }
    nloc = mine > 0u ? mine : 1u; nx = cnt > 0u ? cnt : 1u;
}
__device__ __forceinline__ void xcd_barrier(const XcdBarrier& b, int tid) {
    asm volatile("s_waitcnt vmcnt(0)" ::: "memory");
    __syncthreads();
    if (tid == 0) {
        unsigned* bar = b.bar;
        __builtin_amdgcn_s_waitcnt(0);
        unsigned nloc = b.st[0], nx = b.st[1];
        if (nloc == 0u) { xcd_barrier_complete(bar, b.x, nloc, nx); b.st[0] = nloc; b.st[1] = nx; }
        const unsigned old = xb_add(&bar[XB_XSUB(b.x)], 1u);
        const unsigned gen = old / nloc;
        if (old + 1u == (gen + 1u) * nloc) {
            __builtin_amdgcn_fence(__ATOMIC_RELEASE, "agent");
            asm volatile("s_waitcnt vmcnt(0)" ::: "memory");
            const unsigned og = xb_add(&bar[XB_TOP], 1u);
            const unsigned tg = og / nx;
            if (og + 1u == (tg + 1u) * nx) xb_add(&bar[XB_TOPGEN], 1u);
            else XB_SPIN(xb_ld(&bar[XB_TOPGEN]) == tg, bar);
            __builtin_amdgcn_fence(__ATOMIC_ACQUIRE, "agent");
            xb_add(&bar[XB_XGEN(b.x)], 1u);
            asm volatile("s_waitcnt vmcnt(0)" ::: "memory");
        } else {
            XB_SPIN(xb_ld(&bar[XB_XGEN(b.x)]) == gen, bar);
            __builtin_amdgcn_fence(__ATOMIC_ACQUIRE, "agent");
            asm volatile("s_waitcnt vmcnt(0)" ::: "memory");
        }
    }
    __syncthreads();
}

#ifndef MK_MFMA_ATT
#define MK_MFMA_ATT 1
#endif
#ifndef MK_MFMA_GLA
#define MK_MFMA_GLA 1
#endif
#ifndef MK_SPLITK
#define MK_SPLITK 0
#endif
constexpr int NWV = 8, NTH = 512;

template <bool UPMAP = false>
__device__ __forceinline__ void transpose_item(const float* W, int K, int N, bf16* WT, LAS float* scr, int item, int lane) {
    const int nblk = N / 32, kb = item / nblk, nb = item % nblk, k0 = 64 * kb, n0 = 32 * nb;
    const int nd0 = UPMAP ? (n0 < DFF ? 256 * (n0 >> 7) + (n0 & 127) : 256 * ((n0 - DFF) >> 7) + 128 + ((n0 - DFF) & 127)) : n0;
    float wv[32];
#pragma unroll
    for (int i = 0; i < 32; ++i) wv[i] = __builtin_nontemporal_load(W + (size_t)(k0 + 2 * i + (lane >> 5)) * N + n0 + (lane & 31));
#pragma unroll
    for (int i = 0; i < 32; ++i) scr[(2 * i + (lane >> 5)) * 33 + (lane & 31)] = wv[i];
    LDS_WAIT(); asm volatile("" ::: "memory");
    const int c = lane & 7;
#pragma unroll
    for (int j = 0; j < 4; ++j) { const int n = (lane >> 3) + 8 * j; const LAS float* s = scr + (8 * c) * 33 + n;
        v4u o; o.x = pk2(s[0 * 33], s[1 * 33]); o.y = pk2(s[2 * 33], s[3 * 33]); o.z = pk2(s[4 * 33], s[5 * 33]); o.w = pk2(s[6 * 33], s[7 * 33]);
        *(v4u*)(WT + (size_t)(nd0 + n) * K + k0 + 8 * c) = o; }
    LDS_WAIT(); asm volatile("" ::: "memory");
}

struct Args { const float* in[N_INPUTS]; float* out; unsigned char* ws; int ph_lo, ph_hi, use_bar, pad; };

__device__ __forceinline__ void pro0_phase(const Args& a, LAS unsigned char* lds, int tid, int lane, int wave, int bid, int G) {
    unsigned char* ws = a.ws;
    const int gw = bid * NWV + wave, NGW = G * NWV;
    LAS float* scr = (LAS float*)(lds + wave * 16384);
    constexpr int IT_IN = (DM / 64) * (NIN / 32), IT_OUT = (DM / 64) * (DM / 32), IT_UP = (DM / 64) * (2 * DFF / 32), IT_DN = (DFF / 64) * (DM / 32), IT_Q = (384 / 64) * (NQC / 32), IT_KV = (256 / 64) * (NKV / 32);
    constexpr int IT_L = IT_IN + IT_OUT + IT_UP + IT_DN + IT_Q + IT_KV;
    for (int it = gw; it < DEPTH * IT_L; it += NGW) {
        const int l = it / IT_L; int r = it % IT_L;
        if (r < IT_IN) { transpose_item(a.in[I_WIN] + (size_t)l * DM * NIN, DM, NIN, (bf16*)(ws + WS_WIN + l * SZ_WIN), scr, r, lane); continue; } r -= IT_IN;
        if (r < IT_OUT) { transpose_item(a.in[I_WOUT] + (size_t)l * DM * DM, DM, DM, (bf16*)(ws + WS_WOUT + l * SZ_WOUT), scr, r, lane); continue; } r -= IT_OUT;
        if (r < IT_UP) { transpose_item<true>(a.in[I_WUP] + (size_t)l * DM * 2 * DFF, DM, 2 * DFF, (bf16*)(ws + WS_WUP + l * SZ_WUP), scr, r, lane); continue; } r -= IT_UP;
        if (r < IT_DN) { transpose_item(a.in[I_WDOWN] + (size_t)l * DFF * DM, DFF, DM, (bf16*)(ws + WS_WDN + l * SZ_WDN), scr, r, lane); continue; } r -= IT_DN;
        if (r < IT_Q) { transpose_item(a.in[I_CQUP] + (size_t)l * 384 * NQC, 384, NQC, (bf16*)(ws + WS_WQ + l * SZ_WQ), scr, r, lane); continue; } r -= IT_Q;
        transpose_item(a.in[I_CKVUP] + (size_t)l * 256 * NKV, 256, NKV, (bf16*)(ws + WS_WKV + l * SZ_WKV), scr, r, lane);
    }
    const int gt = bid * NTH + tid, NGT = G * NTH;
    for (int i = gt; i < DEPTH * (NINP - NIN) * DM / 8; i += NGT) { const int l = i / ((NINP - NIN) * DM / 8), r = i % ((NINP - NIN) * DM / 8); *(v4u*)(ws + WS_WIN + l * SZ_WIN + (size_t)NIN * DM * 2 + (size_t)r * 16) = (v4u){0u, 0u, 0u, 0u}; }
    for (int i = gt; i < DEPTH * (NQCP - NQC) * 384 / 8; i += NGT) { const int l = i / ((NQCP - NQC) * 384 / 8), r = i % ((NQCP - NQC) * 384 / 8); *(v4u*)(ws + WS_WQ + l * SZ_WQ + (size_t)NQC * 384 * 2 + (size_t)r * 16) = (v4u){0u, 0u, 0u, 0u}; }
    for (int i = gt; i < DEPTH * (NKVP - NKV) * 256 / 8; i += NGT) { const int l = i / ((NKVP - NKV) * 256 / 8), r = i % ((NKVP - NKV) * 256 / 8); *(v4u*)(ws + WS_WKV + l * SZ_WKV + (size_t)NKV * 256 * 2 + (size_t)r * 16) = (v4u){0u, 0u, 0u, 0u}; }
    {
        LAS float* sc = (LAS float*)lds;
        __syncthreads();
        for (int it = bid; it < DEPTH * 24 * 8; it += G) {
            const int l = it / 192, cb = (it / 8) % 24, ks = it % 8;
            __syncthreads();
            for (int e = tid; e < 5 * 256; e += NTH) { const int mi = e >> 8, k = ks * 256 + (e & 255); const float cv = mi == 0 ? a.in[I_CCTX][k] : a.in[I_C][(mi - 1) * DM + k]; sc[e] = cv / (1.f + expf(-cv)); }
            __syncthreads();
            const float* wp = a.in[I_ADAW] + ((size_t)l * DM + ks * 256) * (6 * DM) + cb * 512 + tid;
            float s0 = 0.f, s1 = 0.f, s2 = 0.f, s3 = 0.f, s4 = 0.f;
#pragma unroll 8
            for (int k = 0; k < 256; ++k) { const float w = __builtin_nontemporal_load(wp + (size_t)k * (6 * DM)); s0 += sc[k] * w; s1 += sc[256 + k] * w; s2 += sc[512 + k] * w; s3 += sc[768 + k] * w; s4 += sc[1024 + k] * w; }
            float* mp = (float*)(ws + WS_MODP) + ((size_t)ks * DEPTH + l) * 5 * 6 * DM + cb * 512 + tid;
            mp[0] = s0; mp[6 * DM] = s1; mp[2 * 6 * DM] = s2; mp[3 * 6 * DM] = s3; mp[4 * 6 * DM] = s4;
        }
        __syncthreads();
    }
    { const float* s = a.in[I_CAK]; bf16* d = (bf16*)(ws + WS_CAK); for (int i = gt; i < NDB * DEPTH * PAST * 512; i += NGT) d[i] = (bf16)f2bf(s[i]); }
    { const float* s = a.in[I_CAV]; bf16* d = (bf16*)(ws + WS_CAV); for (int i = gt; i < NDB * DEPTH * PAST * 512; i += NGT) d[i] = (bf16)f2bf(s[i]); }
    { const float* s = a.in[I_CCKR]; bf16* d = (bf16*)(ws + WS_CKRX); for (int i = gt; i < NDB * DEPTH * PAST * 32; i += NGT) d[i] = (bf16)f2bf(s[i]); }
    { const float* s = a.in[I_CCKV]; bf16* d = (bf16*)(ws + WS_CKVA);
      for (int i = gt; i < NDB * DEPTH * PAST * 256; i += NGT) { const int c = i & 255, j = (i >> 8) & 255, bl = i >> 16, b = bl >> 2, l = bl & 3; d[(((size_t)l * NDB + b) * PAST + j) * 256 + c] = (bf16)f2bf(s[i]); } }
    { float* ra = (float*)(ws + WS_RTA); float* rc = (float*)(ws + WS_RTC);
      for (int i = gt; i < DSEQ * 16; i += NGT) { const int t = i >> 4, j = i & 15; const float inv = powf(10000.f, -(float)j / 16.f); const float ar = (float)(t >> 6) * inv, ac = (float)(t & 63) * inv;
          ra[t * 64 + j] = cosf(ar); ra[t * 64 + 16 + j] = sinf(ar); ra[t * 64 + 32 + j] = cosf(ac); ra[t * 64 + 48 + j] = sinf(ac); }
      for (int i = gt; i < DSEQ * 8; i += NGT) { const int t = i >> 3, j = i & 7; const float inv = powf(10000.f, -(float)j / 8.f); const float ar = (float)(t >> 6) * inv, ac = (float)(t & 63) * inv;
          rc[t * 32 + j] = cosf(ar); rc[t * 32 + 8 + j] = sinf(ar); rc[t * 32 + 16 + j] = cosf(ac); rc[t * 32 + 24 + j] = sinf(ac); } }
    if (gt < DEPTH) { const int l = gt; float d1 = 0.f, d2 = 0.f;
        for (int i = 0; i < 64; ++i) { d1 += a.in[I_LQ1][l * 64 + i] * a.in[I_LK1][l * 64 + i]; d2 += a.in[I_LQ2][l * 64 + i] * a.in[I_LK2][l * 64 + i]; }
        const float li = 0.8f - 0.6f * expf(-0.3f * (float)l);
        float* lam = (float*)(ws + WS_LAM); lam[l] = expf(d1) - expf(d2) + li; lam[4 + l] = li; }
}

__device__ __forceinline__ void modfin_phase(const Args& a, int gt, int NGT) {
    const float* mp = (const float*)(a.ws + WS_MODP); float* mo = (float*)(a.ws + WS_MOD);
    for (int i = gt; i < DEPTH * 5 * 6 * DM; i += NGT) { const int l = i / (5 * 6 * DM), n = i % (6 * DM); float s = a.in[I_ADAB][l * 6 * DM + n];
#pragma unroll
        for (int ks = 0; ks < 8; ++ks) s += mp[(size_t)ks * DEPTH * 5 * 6 * DM + i];
        mo[i] = s; }
}


namespace att {
using bf16x8 = __attribute__((ext_vector_type(8))) short;
using s16x4  = __attribute__((ext_vector_type(4))) short;
using f32x16 = __attribute__((ext_vector_type(16))) float;
using u32x4  = __attribute__((ext_vector_type(4))) unsigned;
constexpr int SHM_V = 64 * 128 * 2;
#define ATT_SBAR() __builtin_amdgcn_sched_barrier(0)
#define ATT_LBAR() asm volatile("s_waitcnt lgkmcnt(0)\n\ts_barrier" ::: "memory")
__device__ __forceinline__ int crow(int r, int hi) { return (r & 3) + 8 * (r >> 2) + 4 * hi; }
__device__ __forceinline__ float max3f(float a, float b, float c) { return fmaxf(fmaxf(a, b), c); }
__device__ __forceinline__ float max2f(float a, float b) { return fmaxf(a, b); }
__device__ __forceinline__ unsigned cvtpk(float lo, float hi) { unsigned r; asm volatile("v_cvt_pk_bf16_f32 %0, %1, %2" : "=v"(r) : "v"(lo), "v"(hi)); return r; }
template <bool TUP> __device__ __forceinline__ void partialSM(f32x16& p0, f32x16& p1, float& m_reg, f32x16& negm, float& alpha, float thr, bool first, float pmax) {
  if constexpr (!TUP) {
    typedef float f32x2 __attribute__((ext_vector_type(2))); const f32x2 M2 = {-m_reg, -m_reg};
#pragma unroll
    for (int r = 0; r < 16; r += 2) { f32x2 v = {p0[r], p0[r + 1]}; v += M2; p0[r] = v.x; p0[r + 1] = v.y; f32x2 w = {p1[r], p1[r + 1]}; w += M2; p1[r] = w.x; p1[r + 1] = w.y; }
    pmax -= m_reg; }
  { auto rr = __builtin_amdgcn_permlane32_swap(__float_as_uint(pmax), __float_as_uint(pmax), false, false);
    pmax = max2f(__uint_as_float(rr[0]), __uint_as_float(rr[1])); }
  if (__builtin_expect(!first && __all(pmax <= thr), 1)) { alpha = 1.f; }
  else { const float delta = first ? pmax : max2f(pmax, 0.f); alpha = __builtin_amdgcn_exp2f(-delta); m_reg += delta;
#pragma unroll
    for (int r = 0; r < 16; ++r) { p0[r] -= delta; p1[r] -= delta; }
    if constexpr (TUP) { const float nm = -m_reg;
#pragma unroll
      for (int r = 0; r < 16; ++r) negm[r] = nm;
      asm volatile("" : "+v"(negm)); } }
#pragma unroll
  for (int r = 0; r < 16; ++r) p0[r] = __builtin_amdgcn_exp2f(p0[r]);
}
__device__ __forceinline__ void finishSM(f32x16& p0, f32x16& p1, float alpha, float& l_reg, bf16x8& pa0, bf16x8& pa1, bf16x8& pa2, bf16x8& pa3) {
#pragma unroll
  for (int r = 0; r < 16; ++r) p1[r] = __builtin_amdgcn_exp2f(p1[r]);
  float ps;
  { typedef float f32x2 __attribute__((ext_vector_type(2))); f32x2 s2 = {p0[0], p0[1]};
#pragma unroll
    for (int r = 2; r < 16; r += 2) s2 += (f32x2){p0[r], p0[r + 1]};
#pragma unroll
    for (int r = 0; r < 16; r += 2) s2 += (f32x2){p1[r], p1[r + 1]};
    ps = s2.x + s2.y; }
  { auto rr = __builtin_amdgcn_permlane32_swap(__float_as_uint(ps), __float_as_uint(ps), false, false);
    ps = __uint_as_float(rr[0]) + __uint_as_float(rr[1]); }
  l_reg = l_reg * alpha + ps;
#define ATT_PKD(P, BASE) __builtin_bit_cast(bf16x8, (u32x4){cvtpk(P[BASE + 0], P[BASE + 1]), cvtpk(P[BASE + 2], P[BASE + 3]), cvtpk(P[BASE + 4], P[BASE + 5]), cvtpk(P[BASE + 6], P[BASE + 7])})
  pa0 = ATT_PKD(p0, 0); pa1 = ATT_PKD(p0, 8); pa2 = ATT_PKD(p1, 0); pa3 = ATT_PKD(p1, 8);
#undef ATT_PKD
}
template <int DQK, bool TUP>
__device__ __forceinline__ void qkt(f32x16& p0, f32x16& p1, const LAS unsigned char* Ks, const bf16x8* qr, int r32, int hi, const f32x16& negm) {
  constexpr int RS = DQK * 2 + 16;
  if constexpr (TUP) { p0 = negm; p1 = negm; } else { p0 = f32x16{}; p1 = f32x16{}; }
#pragma unroll
  for (int d0 = 0; d0 < DQK / 16; ++d0) { const int cb = d0 * 32 + hi * 16;
    const bf16x8 b0 = *(const LAS bf16x8*)(Ks + r32 * RS + cb);
    const bf16x8 b1 = *(const LAS bf16x8*)(Ks + (32 + r32) * RS + cb);
    p0 = __builtin_amdgcn_mfma_f32_32x32x16_bf16(b0, qr[d0], p0, 0, 0, 0);
    p1 = __builtin_amdgcn_mfma_f32_32x32x16_bf16(b1, qr[d0], p1, 0, 0, 0); }
}
__device__ __forceinline__ int v_st(int k, int c) { const int kk = (k & ~0xC) | ((k & 4) << 1) | ((k & 8) >> 1); return ((kk >> 3) * 4 + (c >> 5)) * 512 + ((kk & 7) * 32 + (c & 31)) * 2; }
__device__ __forceinline__ int v_rd_base(int lane) { return ((lane & 3) << 3) | (((lane >> 2) & 3) << 6) | (((lane >> 4) & 1) << 5) | (((lane >> 5) & 1) << 8); }
constexpr int v_rd_off(int d0, int ks, int half) { return d0 * 512 + ks * 4096 + half * 2048; }
__device__ __forceinline__ int v_st_n(int k, int c) { return (c >> 5) * 4096 + k * 64 + (c & 31) * 2; }
__device__ __forceinline__ int v_rd_base_n(int lane) { return ((lane >> 4) & 1) * 32 + (lane & 3) * 8 + (4 * (lane >> 5) + ((lane & 15) >> 2)) * 64; }
constexpr int v_rd_off_n(int d0, int ks, int half) { return d0 * 4096 + ks * 1024 + half * 512; }
template <int OFF> __device__ __forceinline__ s16x4 tr_read(int vb) {
  s16x4 r; asm volatile("ds_read_b64_tr_b16 %0, %1 offset:%2" : "=&v"(r) : "v"(vb), "i"(OFF) : "memory"); return r;
}
template <int D0> __device__ __forceinline__ void pv_one(f32x16& od, int vb, bf16x8 pa0, bf16x8 pa1, bf16x8 pa2, bf16x8 pa3, const f32x16& s, float& mq) {
  const s16x4 l0 = tr_read<v_rd_off_n(D0, 0, 0)>(vb), h0 = tr_read<v_rd_off_n(D0, 0, 1)>(vb), l1 = tr_read<v_rd_off_n(D0, 1, 0)>(vb), h1 = tr_read<v_rd_off_n(D0, 1, 1)>(vb);
  const s16x4 l2 = tr_read<v_rd_off_n(D0, 2, 0)>(vb), h2 = tr_read<v_rd_off_n(D0, 2, 1)>(vb), l3 = tr_read<v_rd_off_n(D0, 3, 0)>(vb), h3 = tr_read<v_rd_off_n(D0, 3, 1)>(vb);
  asm volatile("s_waitcnt lgkmcnt(0)" ::: "memory"); ATT_SBAR();
#define ATT_PK(L, H) (bf16x8){L[0], L[1], L[2], L[3], H[0], H[1], H[2], H[3]}
  constexpr int B = (D0 & 1) * 8;
  od = __builtin_amdgcn_mfma_f32_32x32x16_bf16(pa0, ATT_PK(l0, h0), od, 0, 0, 0);
  float t = max3f(s[B], s[B + 1], s[B + 2]);
  od = __builtin_amdgcn_mfma_f32_32x32x16_bf16(pa1, ATT_PK(l1, h1), od, 0, 0, 0);
  t = max3f(t, s[B + 3], s[B + 4]);
  od = __builtin_amdgcn_mfma_f32_32x32x16_bf16(pa2, ATT_PK(l2, h2), od, 0, 0, 0);
  t = max3f(t, s[B + 5], s[B + 6]);
  od = __builtin_amdgcn_mfma_f32_32x32x16_bf16(pa3, ATT_PK(l3, h3), od, 0, 0, 0);
  mq = max2f(t, s[B + 7]); asm volatile("" : "+v"(mq));
#undef ATT_PK
}
__device__ __forceinline__ float pv_d0(f32x16* o, int vb, bf16x8 pa0, bf16x8 pa1, bf16x8 pa2, bf16x8 pa3, const f32x16& s0, const f32x16& s1) {
  float m0, m1, m2, m3;
  pv_one<0>(o[0], vb, pa0, pa1, pa2, pa3, s0, m0); pv_one<1>(o[1], vb, pa0, pa1, pa2, pa3, s0, m1); pv_one<2>(o[2], vb, pa0, pa1, pa2, pa3, s1, m2); pv_one<3>(o[3], vb, pa0, pa1, pa2, pa3, s1, m3);
  return max2f(max3f(m0, m1, m2), m3);
}
__device__ __forceinline__ void pv_last(f32x16* o, int vb, bf16x8 pa0, bf16x8 pa1, bf16x8 pa2, bf16x8 pa3) { const f32x16 z = {}; (void)pv_d0(o, vb, pa0, pa1, pa2, pa3, z, z); }
__device__ __forceinline__ float bfe(bf16x8 v, int e) { return __builtin_bit_cast(float, (unsigned)(unsigned short)v[e] << 16); }
}

struct KSeg { const bf16* kn; int ldn; const bf16* kr; int ldr; const bf16* v; int ldv; int n; };

template <int DQK, int SD, bool OUTBF>
__device__ __forceinline__ void attn_mfma_unit(LAS unsigned char* lds, const bf16* Qp, int ldq, bool rot, const float* rt, int t0, const KSeg& ctx, const KSeg& lat, float scale, void* Opv, int tid,
                                               bool fin = false, float lam = 0.f, float gsc = 0.f, const float* ag = nullptr, bf16* Mx = nullptr) {
  using namespace att;
  constexpr int NF = DQK / 16, RS = DQK * 2 + 16, SHM_K = 64 * RS;
  const int wid = tid >> 6, lane = tid & 63, r32 = lane & 31, hi = lane >> 5;
  LAS unsigned char* V_lds = lds; LAS unsigned char* K_lds = lds + 2 * SHM_V;
  LAS float* wsf = (LAS float*)(lds + 2 * SHM_V + 2 * SHM_K) + wid * 64; LAS float* li_l = wsf; LAS float* al_l = wsf + 32;
  (void)scale;
  const float thr = 8.f * 1.4426950408889634f;
  float m_reg = 0.f, l_reg = 0; f32x16 negm = {}; f32x16 o[4] = {}; bf16x8 qr[NF];
  const bf16* Qw = Qp + (size_t)(wid * 32 + r32) * ldq + hi * 8;
#pragma unroll
  for (int d0 = 0; d0 < NF; ++d0) qr[d0] = *reinterpret_cast<const bf16x8*>(Qw + d0 * 16);
  const int sr = tid >> 4, sc = (tid & 15) * 8, vst0 = v_st_n(sr, sc), vst1 = v_st_n(32 + sr, sc);
  const int krow = tid >> 3, kch = tid & 7, xrow = tid >> 2, xch = tid & 3; const bool xld = (DQK == 96) && tid < 256;
  const int vb0 = (int)(unsigned)(uintptr_t)V_lds + v_rd_base_n(lane);
  const int nct = ctx.n >> 6, NT = nct + (lat.n >> 6);
  constexpr int SE = 0, SO = SD - 1;
  struct { bf16x8 vs0, vs1, kn, kx; } st[SD];
#define ATT_SLOAD(i, j) do { const int j_ = (j); const bool c_ = j_ < nct; const KSeg& S_ = c_ ? ctx : lat; const int k0_ = (c_ ? j_ : j_ - nct) * 64; \
    st[i].vs0 = *reinterpret_cast<const bf16x8*>(S_.v + (size_t)(k0_ + sr) * S_.ldv + sc); st[i].vs1 = *reinterpret_cast<const bf16x8*>(S_.v + (size_t)(k0_ + 32 + sr) * S_.ldv + sc); \
    st[i].kn = *reinterpret_cast<const bf16x8*>(S_.kn + (size_t)(k0_ + krow) * S_.ldn + kch * 8); \
    if (xld) st[i].kx = *reinterpret_cast<const bf16x8*>(S_.kr + (size_t)(k0_ + xrow) * S_.ldr + xch * 8); } while (0)
#define ATT_SWRITE(b, i) do { *(LAS bf16x8*)(V_lds + (b) * SHM_V + vst0) = st[i].vs0; *(LAS bf16x8*)(V_lds + (b) * SHM_V + vst1) = st[i].vs1; \
    *(LAS bf16x8*)(K_lds + (b) * SHM_K + krow * RS + kch * 16) = st[i].kn; \
    if (xld) *(LAS bf16x8*)(K_lds + (b) * SHM_K + xrow * RS + 128 + xch * 16) = st[i].kx; } while (0)
#define ATT_SWAIT() do { if constexpr (SD == 2) asm volatile("s_waitcnt vmcnt(3)" ::: "memory"); else asm volatile("s_waitcnt vmcnt(0)" ::: "memory"); } while (0)
#define ATT_RESC(a) do { if (__any((a) < 1.f)) { if (hi == 0) al_l[r32] = (a); asm volatile("s_waitcnt lgkmcnt(0)" ::: "memory"); \
    _Pragma("unroll") for (int d = 0; d < 4; ++d) _Pragma("unroll") for (int r = 0; r < 16; ++r) o[d][r] *= al_l[crow(r, hi)]; } } while (0)
#define ATT_ROTQ() do { const int t_ = t0 + wid * 32 + r32; \
    if constexpr (DQK == 64) { const float* tb = rt + (size_t)t_ * 64 + hi * 8; u32x4 w0, w1, w2, w3; \
        float y0[8], y1[8], y2[8], y3[8]; \
        _Pragma("unroll") for (int e = 0; e < 8; ++e) { const float cr = tb[e], sn = tb[16 + e], cc = tb[32 + e], sc2 = tb[48 + e]; \
            const float x0 = bfe(qr[0], e), x1 = bfe(qr[1], e), x2 = bfe(qr[2], e), x3 = bfe(qr[3], e); \
            y0[e] = x0 * cr - x1 * sn; y1[e] = x1 * cr + x0 * sn; y2[e] = x2 * cc - x3 * sc2; y3[e] = x3 * cc + x2 * sc2; } \
        w0 = (u32x4){cvtpk(y0[0], y0[1]), cvtpk(y0[2], y0[3]), cvtpk(y0[4], y0[5]), cvtpk(y0[6], y0[7])}; w1 = (u32x4){cvtpk(y1[0], y1[1]), cvtpk(y1[2], y1[3]), cvtpk(y1[4], y1[5]), cvtpk(y1[6], y1[7])}; \
        w2 = (u32x4){cvtpk(y2[0], y2[1]), cvtpk(y2[2], y2[3]), cvtpk(y2[4], y2[5]), cvtpk(y2[6], y2[7])}; w3 = (u32x4){cvtpk(y3[0], y3[1]), cvtpk(y3[2], y3[3]), cvtpk(y3[4], y3[5]), cvtpk(y3[6], y3[7])}; \
        qr[0] = __builtin_bit_cast(bf16x8, w0); qr[1] = __builtin_bit_cast(bf16x8, w1); qr[2] = __builtin_bit_cast(bf16x8, w2); qr[3] = __builtin_bit_cast(bf16x8, w3); \
    } else { const float* tb = rt + (size_t)t_ * 32; const float sg = hi ? 1.f : -1.f; \
        const u32x4 a4 = __builtin_bit_cast(u32x4, qr[NF - 2]), a5 = __builtin_bit_cast(u32x4, qr[NF - 1]); u32x4 p4, p5; \
        _Pragma("unroll") for (int i = 0; i < 4; ++i) { p4[i] = (unsigned)__shfl_xor((int)a4[i], 32); p5[i] = (unsigned)__shfl_xor((int)a5[i], 32); } \
        const bf16x8 q4 = __builtin_bit_cast(bf16x8, p4), q5 = __builtin_bit_cast(bf16x8, p5); float y4[8], y5[8]; \
        _Pragma("unroll") for (int e = 0; e < 8; ++e) { const float cr = tb[e], sn = tb[8 + e], cc = tb[16 + e], sc2 = tb[24 + e]; \
            y4[e] = bfe(qr[NF - 2], e) * cr + sg * bfe(q4, e) * sn; y5[e] = bfe(qr[NF - 1], e) * cc + sg * bfe(q5, e) * sc2; } \
        const u32x4 w4 = {cvtpk(y4[0], y4[1]), cvtpk(y4[2], y4[3]), cvtpk(y4[4], y4[5]), cvtpk(y4[6], y4[7])}, w5 = {cvtpk(y5[0], y5[1]), cvtpk(y5[2], y5[3]), cvtpk(y5[4], y5[5]), cvtpk(y5[6], y5[7])}; \
        qr[NF - 2] = __builtin_bit_cast(bf16x8, w4); qr[NF - 1] = __builtin_bit_cast(bf16x8, w5); } } while (0)
  f32x16 pA0, pA1, pB0, pB1; float alA, alB; bf16x8 pa0, pa1, pa2, pa3;
  ATT_SLOAD(SE, 0); asm volatile("s_waitcnt vmcnt(0)" ::: "memory"); ATT_SWRITE(0, SE); ATT_LBAR();
  qkt<DQK, true>(pA0, pA1, K_lds, qr, r32, hi, negm);
  { float pm0 = max3f(pA0[0], pA0[1], pA0[2]);
#pragma unroll
    for (int r = 3; r < 15; r += 2) pm0 = max3f(pm0, pA0[r], pA0[r + 1]);
    pm0 = max2f(pm0, pA0[15]);
#pragma unroll
    for (int r = 0; r < 16; r += 2) pm0 = max3f(pm0, pA1[r], pA1[r + 1]);
    partialSM<true>(pA0, pA1, m_reg, negm, alA, thr, true, pm0); }
  ATT_SLOAD(SO, 1); if constexpr (SD == 2) { if (2 < NT) ATT_SLOAD(SE, 2); }
  ATT_SWAIT(); ATT_SWRITE(1, SO); ATT_LBAR();
  for (int j = 1; j + 1 < NT; j += 2) {
    ATT_SBAR(); qkt<DQK, true>(pB0, pB1, K_lds + SHM_K, qr, r32, hi, negm);
    finishSM(pA0, pA1, alA, l_reg, pa0, pa1, pa2, pa3); ATT_SBAR();
    ATT_SLOAD(SO, j + SD); ATT_SBAR();
    { const float pmx = pv_d0(o, vb0, pa0, pa1, pa2, pa3, pB0, pB1); partialSM<true>(pB0, pB1, m_reg, negm, alB, thr, false, pmx); }
    ATT_LBAR(); ATT_SWAIT(); ATT_SWRITE(0, SE);
    ATT_RESC(alB); ATT_LBAR();
    if (rot && j + 1 == nct) ATT_ROTQ();
    ATT_SBAR(); qkt<DQK, true>(pA0, pA1, K_lds, qr, r32, hi, negm);
    finishSM(pB0, pB1, alB, l_reg, pa0, pa1, pa2, pa3); ATT_SBAR();
    if (SD == 1 || j + 3 < NT) ATT_SLOAD(SE, j + 1 + SD); ATT_SBAR();
    { const float pmx = pv_d0(o, vb0 + SHM_V, pa0, pa1, pa2, pa3, pA0, pA1); partialSM<true>(pA0, pA1, m_reg, negm, alA, thr, false, pmx); }
    ATT_LBAR(); ATT_SWAIT(); ATT_SWRITE(1, SO);
    ATT_RESC(alA); ATT_LBAR();
  }
  ATT_SBAR(); qkt<DQK, true>(pB0, pB1, K_lds + SHM_K, qr, r32, hi, negm);
  finishSM(pA0, pA1, alA, l_reg, pa0, pa1, pa2, pa3); ATT_SBAR();
  { const float pmx = pv_d0(o, vb0, pa0, pa1, pa2, pa3, pB0, pB1); partialSM<true>(pB0, pB1, m_reg, negm, alB, thr, false, pmx); }
  ATT_LBAR(); ATT_RESC(alB);
  finishSM(pB0, pB1, alB, l_reg, pa0, pa1, pa2, pa3); ATT_SBAR();
  pv_last(o, vb0 + SHM_V, pa0, pa1, pa2, pa3);
  if (hi == 0) li_l[r32] = l_reg; asm volatile("s_waitcnt lgkmcnt(0)" ::: "memory");
  float rli[16];
#pragma unroll
  for (int r = 0; r < 16; ++r) rli[r] = __builtin_amdgcn_rcpf(li_l[crow(r, hi)]);
  if constexpr (OUTBF) { bf16* Ow = (bf16*)Opv + (size_t)(wid * 32) * DM;
#pragma unroll
    for (int r = 0; r < 16; ++r) { const int orow = crow(r, hi);
#pragma unroll
      for (int d0 = 0; d0 < 4; ++d0) Ow[(size_t)orow * DM + d0 * 32 + r32] = (bf16)f2bf(o[d0][r] * rli[r]); }
  } else { float* Ow = (float*)Opv + (size_t)(wid * 32) * NOATT;
    if (!fin) {
#pragma unroll
      for (int r = 0; r < 16; ++r) { const int orow = crow(r, hi);
#pragma unroll
        for (int d0 = 0; d0 < 4; ++d0) Ow[(size_t)orow * NOATT + d0 * 32 + r32] = o[d0][r] * rli[r]; }
    } else {
      bf16* Mw = Mx + (size_t)(wid * 32) * DM; float gv[4];
#pragma unroll
      for (int d0 = 0; d0 < 4; ++d0) gv[d0] = ag[d0 * 32 + r32] * gsc;
#pragma unroll
      for (int r = 0; r < 16; ++r) { const int orow = crow(r, hi); float v[4]; float ss = 0.f;
#pragma unroll
        for (int d0 = 0; d0 < 4; ++d0) { v[d0] = Ow[(size_t)orow * NOATT + d0 * 32 + r32] - lam * (o[d0][r] * rli[r]); ss += v[d0] * v[d0]; }
        ss += __shfl_xor(ss, 1); ss += __shfl_xor(ss, 2); ss += __shfl_xor(ss, 4); ss += __shfl_xor(ss, 8); ss += __shfl_xor(ss, 16);
        const float rs = 1.0f / sqrtf(ss * (1.f / 128.f) + EPS);
#pragma unroll
        for (int d0 = 0; d0 < 4; ++d0) Mw[(size_t)orow * DM + d0 * 32 + r32] = (bf16)f2bf(v[d0] * rs * gv[d0]); } } }
  __syncthreads();
#undef ATT_SLOAD
#undef ATT_SWRITE
#undef ATT_SWAIT
#undef ATT_RESC
#undef ATT_ROTQ
}

__device__ __forceinline__ void norm0_phase(const float* xp, const float* xs_off, const float* gm, bf16* H, float* ssq, int gw, int NGW, int lane) {
    for (int m = gw; m < M; m += NGW) {
        const float* xr = (m < MP ? xp : xs_off) + (size_t)m * DM;
        const int mi = m < MP ? 0 : 1 + (m - MP) / DSEQ; const float* g = gm + (size_t)mi * DM;
        f32x4 v[8]; float s = 0.f;
#pragma unroll
        for (int j = 0; j < 8; ++j) { v[j] = ((const f32x4*)xr)[lane + 64 * j]; s += (v[j].x * v[j].x + v[j].y * v[j].y) + (v[j].z * v[j].z + v[j].w * v[j].w); }
        s = wave_sum(s); if (lane < 32) ssq[(size_t)m * 32 + lane] = lane == 0 ? s : 0.f;
#pragma unroll
        for (int j = 0; j < 8; ++j) { const int c = (lane + 64 * j) * 4; const f32x4 y = v[j] * *(const f32x4*)(g + c); v2u o; o.x = pk2(y.x, y.y); o.y = pk2(y.z, y.w); *(v2u*)(H + (size_t)m * DM + c) = o; }
    }
}
__device__ __forceinline__ void pro2_phase(const Args& a, LAS unsigned char* lds, int tid, int bid, int G, int gt, int NGT) {
    using att::bf16x8; using att::f32x16; using att::crow;
    unsigned char* ws = a.ws; const float* MOD = (const float*)(ws + WS_MOD); float* GM = (float*)(ws + WS_GM);
    for (int i = gt; i < DEPTH * 2 * 5 * DM; i += NGT) { const int c = i % DM, mi = (i / DM) % 5, w = (i / (5 * DM)) & 1, l = i / (2 * 5 * DM);
        const float g = a.in[w ? I_N2G : I_N1G][l * DM + c]; GM[i] = g * (1.f + MOD[((size_t)(l * 5 + mi) * 6 + (w ? 4 : 1)) * DM + c]); }
    const int wave = tid >> 6, lane = tid & 63, r32 = lane & 31, hi = lane >> 5;
    LAS bf16* T = (LAS bf16*)lds;
#pragma unroll 1
    for (int kind = 0; kind < 2; ++kind) {
        __syncthreads();
        for (int e = tid; e < DEPTH * 5 * DM; e += NTH) { const int l = e / (5 * DM), mi = (e / DM) % 5, k = e % DM; T[e] = (bf16)f2bf(MOD[((size_t)(l * 5 + mi) * 6 + (kind ? 3 : 0)) * DM + k]); }
        __syncthreads();
        const int ld = kind ? 2 * DFF : NINP, items_l = ld / 32;
        for (int it = bid * NWV + wave; it < DEPTH * items_l; it += G * NWV) { const int l = it / items_l, rb = it % items_l;
            const bf16* Wr = (kind ? (const bf16*)(ws + WS_WUP + l * SZ_WUP) : (const bf16*)(ws + WS_WIN + l * SZ_WIN)) + (size_t)(rb * 32 + r32) * DM + hi * 8;
            const LAS bf16* Tb = T + (size_t)(l * 5 + (r32 < 5 ? r32 : 4)) * DM + hi * 8;
            f32x16 acc = {};
#pragma unroll 1
            for (int ks = 0; ks < DM / 16; ks += 8) { bf16x8 af[8];
#pragma unroll
                for (int j = 0; j < 8; ++j) af[j] = *reinterpret_cast<const bf16x8*>(Wr + (ks + j) * 16);
#pragma unroll
                for (int j = 0; j < 8; ++j) { bf16x8 bfv = *(const LAS bf16x8*)(Tb + (ks + j) * 16); if (r32 >= 5) bfv = (bf16x8){0, 0, 0, 0, 0, 0, 0, 0};
                    acc = __builtin_amdgcn_mfma_f32_32x32x16_bf16(af[j], bfv, acc, 0, 0, 0); } }
            if (r32 < 5) { float* dst = (kind ? (float*)(ws + WS_SHWU) + (size_t)l * 5 * 2 * DFF : (float*)(ws + WS_SHWI) + (size_t)l * 5 * NINP) + (size_t)r32 * ld + rb * 32;
#pragma unroll
                for (int r = 0; r < 16; ++r) dst[crow(r, hi)] = acc[r]; }
        }
    }
    __syncthreads();
}
__device__ __forceinline__ void final_norm_phase(const float* X, const float* g, float* out, int gw, int NGW, int lane) {
    for (int m = gw; m < M; m += NGW) {
        const float* xr = X + (size_t)m * DM; f32x4 v[8]; float s = 0.f;
#pragma unroll
        for (int j = 0; j < 8; ++j) { v[j] = ((const f32x4*)xr)[lane + 64 * j]; s += (v[j].x * v[j].x + v[j].y * v[j].y) + (v[j].z * v[j].z + v[j].w * v[j].w); }
        const float rstd = 1.0f / sqrtf(wave_sum(s) * (1.f / DM) + EPS);
#pragma unroll
        for (int j = 0; j < 8; ++j) { const int c = (lane + 64 * j) * 4; *(f32x4*)(out + (size_t)m * DM + c) = v[j] * rstd * *(const f32x4*)(g + c); }
    }
}

__device__ __forceinline__ void post_phase(const Args& a, int l, int gw, int NGW, int lane) {
    using att::bf16x8; using att::bfe; using att::cvtpk; using att::u32x4;
    unsigned char* ws = a.ws;
    const bf16* P = (const bf16*)(ws + WS_P); bf16* KRA = (bf16*)(ws + WS_KRA); bf16* KRC = (bf16*)(ws + WS_KRC); bf16* CQN = (bf16*)(ws + WS_CQN); bf16* CKVN = (bf16*)(ws + WS_CKVN);
    const float* RTA = (const float*)(ws + WS_RTA); const float* RTC = (const float*)(ws + WS_RTC);
    const float* gq = a.in[I_CQG] + l * 384; const float* gkv = a.in[I_CKVG] + l * 256;
    for (int m = gw; m < M; m += NGW) {
        const bf16* pr = P + (size_t)m * NINP;
        float xq[8], xk[8]; float sq = 0.f, sk = 0.f;
        if (lane < 48) { const bf16x8 v = *reinterpret_cast<const bf16x8*>(pr + C_CQ + lane * 8);
#pragma unroll
            for (int i = 0; i < 8; ++i) { xq[i] = bfe(v, i); sq += xq[i] * xq[i]; } }
        if (lane < 32) { const bf16x8 v = *reinterpret_cast<const bf16x8*>(pr + C_CKV + lane * 8);
#pragma unroll
            for (int i = 0; i < 8; ++i) { xk[i] = bfe(v, i); sk += xk[i] * xk[i]; } }
        const float rq = 1.0f / sqrtf(wave_sum(sq) * (1.f / 384.f) + EPS), rk = 1.0f / sqrtf(wave_sum(sk) * (1.f / 256.f) + EPS);
        if (lane < 48) { const f32x4 g0 = *(const f32x4*)(gq + lane * 8), g1 = *(const f32x4*)(gq + lane * 8 + 4);
            *(u32x4*)(CQN + (size_t)m * 384 + lane * 8) = (u32x4){cvtpk(xq[0] * rq * g0.x, xq[1] * rq * g0.y), cvtpk(xq[2] * rq * g0.z, xq[3] * rq * g0.w), cvtpk(xq[4] * rq * g1.x, xq[5] * rq * g1.y), cvtpk(xq[6] * rq * g1.z, xq[7] * rq * g1.w)}; }
        if (lane < 32) { const f32x4 g0 = *(const f32x4*)(gkv + lane * 8), g1 = *(const f32x4*)(gkv + lane * 8 + 4);
            const f32x4 y0 = {xk[0] * rk * g0.x, xk[1] * rk * g0.y, xk[2] * rk * g0.z, xk[3] * rk * g0.w}, y1 = {xk[4] * rk * g1.x, xk[5] * rk * g1.y, xk[6] * rk * g1.z, xk[7] * rk * g1.w};
            *(u32x4*)(CKVN + (size_t)m * 256 + lane * 8) = (u32x4){cvtpk(y0.x, y0.y), cvtpk(y0.z, y0.w), cvtpk(y1.x, y1.y), cvtpk(y1.z, y1.w)};
            if (m < MP) { float* o = a.out + O_CKV + (((size_t)(m / SEQ) * DEPTH + l) * SEQ + (m % SEQ)) * 256 + lane * 8; *(f32x4*)o = y0; *(f32x4*)(o + 4) = y1; } }
        if (m >= MP) { const int ms = m - MP, t = ms % DSEQ;
            if (lane < 34) { const bool isa = lane < 32; const int hh = isa ? (lane >> 1) & 1 : lane - 32;
                const int base = isa ? (lane >> 2) * 64 + hh * 32 + (lane & 1) * 8 : hh * 16, dist = isa ? 16 : 8;
                const bf16* src = pr + (isa ? C_AK : C_CKR) + base; const float* tb = isa ? RTA + (size_t)t * 64 + hh * 32 + (lane & 1) * 8 : RTC + (size_t)t * 32 + hh * 16;
                const bf16x8 v0 = *reinterpret_cast<const bf16x8*>(src), v1 = *reinterpret_cast<const bf16x8*>(src + dist);
                const f32x4 c0 = *(const f32x4*)(tb), c1 = *(const f32x4*)(tb + 4), s0 = *(const f32x4*)(tb + dist), s1 = *(const f32x4*)(tb + dist + 4);
                float y0[8], y1[8];
#pragma unroll
                for (int i = 0; i < 8; ++i) { const float cs = i < 4 ? c0[i & 3] : c1[i & 3], sn = i < 4 ? s0[i & 3] : s1[i & 3]; const float x0 = bfe(v0, i), x1 = bfe(v1, i); y0[i] = x0 * cs - x1 * sn; y1[i] = x1 * cs + x0 * sn; }
                bf16* dst = isa ? KRA + (size_t)ms * 512 + base : KRC + (size_t)ms * 32 + base;
                *(u32x4*)dst = (u32x4){cvtpk(y0[0], y0[1]), cvtpk(y0[2], y0[3]), cvtpk(y0[4], y0[5]), cvtpk(y0[6], y0[7])};
                *(u32x4*)(dst + dist) = (u32x4){cvtpk(y1[0], y1[1]), cvtpk(y1[2], y1[3]), cvtpk(y1[4], y1[5]), cvtpk(y1[6], y1[7])}; }
        } else { const size_t ro = ((size_t)(m / SEQ) * DEPTH + l) * SEQ + (m % SEQ);
            { const bf16x8 v = *reinterpret_cast<const bf16x8*>(pr + C_AK + lane * 8); float* o = a.out + O_AK + ro * 512 + lane * 8;
              *(f32x4*)o = (f32x4){bfe(v, 0), bfe(v, 1), bfe(v, 2), bfe(v, 3)}; *(f32x4*)(o + 4) = (f32x4){bfe(v, 4), bfe(v, 5), bfe(v, 6), bfe(v, 7)}; }
            { const bf16x8 v = *reinterpret_cast<const bf16x8*>(pr + C_AV + lane * 8); float* o = a.out + O_AV + ro * 512 + lane * 8;
              *(f32x4*)o = (f32x4){bfe(v, 0), bfe(v, 1), bfe(v, 2), bfe(v, 3)}; *(f32x4*)(o + 4) = (f32x4){bfe(v, 4), bfe(v, 5), bfe(v, 6), bfe(v, 7)}; }
            if (lane < 4) { const bf16x8 v = *reinterpret_cast<const bf16x8*>(pr + C_CKR + lane * 8); float* o = a.out + O_CKR + ro * 32 + lane * 8;
              *(f32x4*)o = (f32x4){bfe(v, 0), bfe(v, 1), bfe(v, 2), bfe(v, 3)}; *(f32x4*)(o + 4) = (f32x4){bfe(v, 4), bfe(v, 5), bfe(v, 6), bfe(v, 7)}; } }
    }
}


constexpr int NCHUNK = M / 64, GLA_UNITS = NCHUNK * 6;
constexpr int TS = 144;

__device__ __forceinline__ void gla_g1_unit(const Args& a, int l, int unit, LAS unsigned char* lds, int tid) {
    using namespace att;
    unsigned char* ws = a.ws; const bf16* P = (const bf16*)(ws + WS_P); bf16* QK4 = (bf16*)(ws + WS_QK4); float* U = (float*)(ws + WS_U); float* DD = (float*)(ws + WS_DD);
    const int gc = unit / 6, h = unit % 6, m0 = gc * 64;
    const int wave = tid >> 6, lane = tid & 63, r32 = lane & 31, hi = lane >> 5;
    LAS float* glr = (LAS float*)lds;
    LAS float* gw = (LAS float*)(lds + 8192);
    LAS float* gbs = (LAS float*)(lds + 16384);
    LAS float* segtot = (LAS float*)(lds + 16896);
    LAS unsigned char* KfT = lds + 20992;
    LAS unsigned char* KbT = lds + 30208;
    LAS unsigned char* Vt = lds + 39424;
    LAS float* Dl = (LAS float*)(lds + 55808);
    const float* gwt = a.in[I_BGW] + (size_t)l * 2 * 16 * 384; const float* gb = a.in[I_BGB] + l * 2 * 384;
    const int k = tid & 63, tq = tid >> 6;
    if (tid < 256) { const int t = tid >> 2, part = tid & 3; const bf16x8 v = *reinterpret_cast<const bf16x8*>(P + (size_t)(m0 + t) * NINP + C_BG + part * 8);
#pragma unroll
        for (int i = 0; i < 8; ++i) glr[t * 32 + part * 8 + i] = bfe(v, i); }
#pragma unroll
    for (int i = 0; i < 4; ++i) { const int idx = tid + NTH * i, dr = idx >> 6, kk = idx & 63; gw[idx] = gwt[(size_t)dr * 384 + h * 64 + kk]; }
    if (tid < 128) gbs[tid] = gb[(tid >> 6) * 384 + h * 64 + (tid & 63)];
    { const int sr = tid >> 4, sc = (tid & 15) * 8;
      const bf16x8 v0 = *reinterpret_cast<const bf16x8*>(P + (size_t)(m0 + sr) * NINP + C_BV + h * 128 + sc), v1 = *reinterpret_cast<const bf16x8*>(P + (size_t)(m0 + 32 + sr) * NINP + C_BV + h * 128 + sc);
      *(LAS bf16x8*)(Vt + v_st(sr, sc)) = v0; *(LAS bf16x8*)(Vt + v_st(32 + sr, sc)) = v1; }
    bf16 qv[8], kv[8];
#pragma unroll
    for (int j = 0; j < 8; ++j) { const bf16* pr = P + (size_t)(m0 + 8 * tq + j) * NINP + h * 64 + k; qv[j] = pr[C_BQ]; kv[j] = pr[C_BK]; }
    __syncthreads();
    float bf_[8], bb_[8];
#pragma unroll
    for (int dir = 0; dir < 2; ++dir) { float wr_[16];
#pragma unroll
        for (int r = 0; r < 16; ++r) wr_[r] = gw[(dir * 16 + r) * 64 + k];
        const float bias = gbs[dir * 64 + k];
#pragma unroll
        for (int j = 0; j < 8; ++j) { const LAS float* gp = glr + (8 * tq + j) * 32 + dir * 16; float pre = bias;
#pragma unroll
            for (int r4 = 0; r4 < 4; ++r4) { const f32x4 x = *(const LAS f32x4*)(gp + 4 * r4); pre += (x.x * wr_[4 * r4] + x.y * wr_[4 * r4 + 1]) + (x.z * wr_[4 * r4 + 2] + x.w * wr_[4 * r4 + 3]); }
            const float gl = (fminf(pre, 0.f) - __logf(1.f + __expf(-fabsf(pre)))) * (1.f / 16.f);
            if (dir == 0) bf_[j] = gl; else bb_[j] = gl; } }
#pragma unroll
    for (int j = 1; j < 8; ++j) bf_[j] += bf_[j - 1];
#pragma unroll
    for (int j = 6; j >= 0; --j) bb_[j] += bb_[j + 1];
    segtot[tq * 64 + k] = bf_[7]; segtot[(8 + tq) * 64 + k] = bb_[0];
    __syncthreads();
    { float of = 0.f, ob = 0.f;
#pragma unroll
      for (int q2 = 0; q2 < 8; ++q2) { const float sf = segtot[q2 * 64 + k], sb = segtot[(8 + q2) * 64 + k]; of += q2 < tq ? sf : 0.f; ob += q2 > tq ? sb : 0.f; }
      float kf[8], kb[8];
      bf16* dst = QK4 + (size_t)(m0 + 8 * tq) * 1536 + h * 64 + k;
#pragma unroll
      for (int j = 0; j < 8; ++j) { const float bfv = bf_[j] + of, bbv = bb_[j] + ob; const float ef = __expf(bfv), eb = __expf(bbv); const float q = bf2f(qv[j]) * 0.125f, kk = bf2f(kv[j]);
          kf[j] = kk * __expf(-bfv); kb[j] = kk * __expf(-bbv);
          dst[(size_t)j * 1536] = (bf16)f2bf(q * ef); dst[(size_t)j * 1536 + 384] = (bf16)f2bf(kf[j]); dst[(size_t)j * 1536 + 768] = (bf16)f2bf(q * eb); dst[(size_t)j * 1536 + 1152] = (bf16)f2bf(kb[j]);
          if (j == 7 && tq == 7) Dl[k] = ef;
          if (j == 0 && tq == 0) Dl[64 + k] = eb; }
      *(LAS u32x4*)(KfT + k * TS + tq * 16) = (u32x4){cvtpk(kf[0], kf[1]), cvtpk(kf[2], kf[3]), cvtpk(kf[4], kf[5]), cvtpk(kf[6], kf[7])};
      *(LAS u32x4*)(KbT + k * TS + tq * 16) = (u32x4){cvtpk(kb[0], kb[1]), cvtpk(kb[2], kb[3]), cvtpk(kb[4], kb[5]), cvtpk(kb[6], kb[7])}; }
    __syncthreads();
    { const int dir = wave >> 2, vb = wave & 3; const LAS unsigned char* KT = dir ? KbT : KfT;
      const int vbase = (int)(unsigned)(uintptr_t)Vt + v_rd_base(lane) + vb * 512;
      const s16x4 l0 = tr_read<v_rd_off(0, 0, 0)>(vbase), h0 = tr_read<v_rd_off(0, 0, 1)>(vbase), l1 = tr_read<v_rd_off(0, 1, 0)>(vbase), h1 = tr_read<v_rd_off(0, 1, 1)>(vbase);
      const s16x4 l2 = tr_read<v_rd_off(0, 2, 0)>(vbase), h2 = tr_read<v_rd_off(0, 2, 1)>(vbase), l3 = tr_read<v_rd_off(0, 3, 0)>(vbase), h3 = tr_read<v_rd_off(0, 3, 1)>(vbase);
      asm volatile("s_waitcnt lgkmcnt(0)" ::: "memory");
#define GLA_PK(L, H) (bf16x8){L[0], L[1], L[2], L[3], H[0], H[1], H[2], H[3]}
      const bf16x8 vf0 = GLA_PK(l0, h0), vf1 = GLA_PK(l1, h1), vf2 = GLA_PK(l2, h2), vf3 = GLA_PK(l3, h3);
      float* Ub = U + ((size_t)unit * 2 + dir) * 8192;
#pragma unroll
      for (int rb = 0; rb < 2; ++rb) { f32x16 acc = {};
          const LAS unsigned char* ar = KT + (rb * 32 + r32) * TS + hi * 16;
          acc = __builtin_amdgcn_mfma_f32_32x32x16_bf16(vf0, *(const LAS bf16x8*)(ar), acc, 0, 0, 0);
          acc = __builtin_amdgcn_mfma_f32_32x32x16_bf16(vf1, *(const LAS bf16x8*)(ar + 32), acc, 0, 0, 0);
          acc = __builtin_amdgcn_mfma_f32_32x32x16_bf16(vf2, *(const LAS bf16x8*)(ar + 64), acc, 0, 0, 0);
          acc = __builtin_amdgcn_mfma_f32_32x32x16_bf16(vf3, *(const LAS bf16x8*)(ar + 96), acc, 0, 0, 0);
          const int kr = rb * 32 + r32; const float dk = Dl[dir * 64 + kr];
#pragma unroll
          for (int g4 = 0; g4 < 4; ++g4) *(f32x4*)(Ub + kr * 128 + vb * 32 + 8 * g4 + 4 * hi) = (f32x4){acc[4 * g4] * dk, acc[4 * g4 + 1] * dk, acc[4 * g4 + 2] * dk, acc[4 * g4 + 3] * dk}; }
      if (tid < 128) DD[(size_t)unit * 128 + tid] = Dl[tid]; }
    __syncthreads();
}

constexpr int GLA_G2_ITEMS = (NPB + NDB) * 6 * 2 * 2;
__device__ __forceinline__ void gla_g2_item(const Args& a, int l, int item, int tid) {
    unsigned char* ws = a.ws; const float* U = (const float*)(ws + WS_U); const float* DD = (const float*)(ws + WS_DD); bf16* ST = (bf16*)(ws + WS_ST);
    const int half = item & 1, dir = (item >> 1) & 1, hs = item >> 2, h = hs % 6, sq = hs / 6;
    const bool smp = sq < NDB; const int b = smp ? sq : sq - NDB, nc = smp ? DSEQ / 64 : SEQ / 64, gc0 = smp ? (MP / 64) + b * (DSEQ / 64) : b * (SEQ / 64);
    const int v = tid & 127, k0 = ((tid >> 7) + 4 * half) * 8;
    float s[8];
#pragma unroll
    for (int i = 0; i < 8; ++i) s[i] = smp ? a.in[I_STB][((((size_t)b * DEPTH + l) * 2 + dir) * 6 + h) * 8192 + (k0 + i) * 128 + v] : 0.f;
    for (int ci = 0; ci < nc; ci += 4) {
        float u[4][8], d[4][8]; size_t ub[4];
#pragma unroll
        for (int j = 0; j < 4; ++j) { const int c = dir ? nc - 1 - (ci + j) : ci + j; ub[j] = ((size_t)(gc0 + c) * 6 + h) * 2 + dir;
#pragma unroll
            for (int i = 0; i < 8; ++i) { u[j][i] = U[ub[j] * 8192 + (k0 + i) * 128 + v]; d[j][i] = DD[ub[j] * 64 + k0 + i]; } }
#pragma unroll
        for (int j = 0; j < 4; ++j) {
            v4u w; w.x = pk2(s[0], s[1]); w.y = pk2(s[2], s[3]); w.z = pk2(s[4], s[5]); w.w = pk2(s[6], s[7]);
            *(v4u*)(ST + ub[j] * 8192 + v * 64 + k0) = w;
#pragma unroll
            for (int i = 0; i < 8; ++i) s[i] = d[j][i] * s[i] + u[j][i]; }
    }
    if (!smp) {
#pragma unroll
        for (int i = 0; i < 8; ++i) a.out[O_SB + ((((size_t)b * DEPTH + l) * 2 + dir) * 6 + h) * 8192 + (k0 + i) * 128 + v] = s[i];
    }
}

__device__ __forceinline__ void gla_g3_unit(const Args& a, int l, int unit, LAS unsigned char* lds, int tid) {
    using namespace att;
    unsigned char* ws = a.ws; const bf16* P = (const bf16*)(ws + WS_P); const bf16* QK4 = (const bf16*)(ws + WS_QK4); const bf16* ST = (const bf16*)(ws + WS_ST); bf16* MIX = (bf16*)(ws + WS_MIX);
    const int gc = unit / 6, h = unit % 6, m0 = gc * 64;
    const int wave = tid >> 6, lane = tid & 63, r32 = lane & 31, hi = lane >> 5;
    LAS unsigned char* T4 = lds;
    LAS unsigned char* Vt = lds + 36864;
    LAS unsigned char* AT = lds + 53248;
    LAS float* OT = (LAS float*)(lds + 71680);
    { const int row = tid >> 3, ch = tid & 7; const bf16* src = QK4 + (size_t)(m0 + row) * 1536 + h * 64 + ch * 8;
#pragma unroll
      for (int var = 0; var < 4; ++var) *(LAS bf16x8*)(T4 + var * 9216 + row * TS + ch * 16) = *reinterpret_cast<const bf16x8*>(src + var * 384);
      const int sr = tid >> 4, sc = (tid & 15) * 8;
      const bf16x8 v0 = *reinterpret_cast<const bf16x8*>(P + (size_t)(m0 + sr) * NINP + C_BV + h * 128 + sc), v1 = *reinterpret_cast<const bf16x8*>(P + (size_t)(m0 + 32 + sr) * NINP + C_BV + h * 128 + sc);
      *(LAS bf16x8*)(Vt + v_st(sr, sc)) = v0; *(LAS bf16x8*)(Vt + v_st(32 + sr, sc)) = v1; }
    __syncthreads();
    { const int dir = wave >> 2, tb = (wave >> 1) & 1, sb = wave & 1;
      const LAS unsigned char* Qt = T4 + (dir * 2) * 9216 + (tb * 32 + r32) * TS + hi * 16; const LAS unsigned char* Kt = T4 + (dir * 2 + 1) * 9216 + (sb * 32 + r32) * TS + hi * 16;
      f32x16 acc = {};
#pragma unroll
      for (int ks = 0; ks < 4; ++ks) acc = __builtin_amdgcn_mfma_f32_32x32x16_bf16(*(const LAS bf16x8*)(Kt + ks * 32), *(const LAS bf16x8*)(Qt + ks * 32), acc, 0, 0, 0);
      const int t = tb * 32 + r32;
#pragma unroll
      for (int r = 0; r < 16; ++r) { const int s = sb * 32 + crow(r, hi); const bool keep = dir ? (s >= t) : (s <= t); acc[r] = keep ? acc[r] : 0.f; }
#pragma unroll
      for (int g = 0; g < 4; ++g) { v2u w; w.x = cvtpk(acc[4 * g], acc[4 * g + 1]); w.y = cvtpk(acc[4 * g + 2], acc[4 * g + 3]);
          *(LAS v2u*)(AT + dir * 9216 + t * TS + (sb * 32 + 8 * g + 4 * hi) * 2) = w; } }
    __syncthreads();
    { const int tb = wave >> 2, vb = wave & 3; f32x16 o = {};
      const int vbase = (int)(unsigned)(uintptr_t)Vt + v_rd_base(lane) + vb * 512;
      const s16x4 l0 = tr_read<v_rd_off(0, 0, 0)>(vbase), h0 = tr_read<v_rd_off(0, 0, 1)>(vbase), l1 = tr_read<v_rd_off(0, 1, 0)>(vbase), h1 = tr_read<v_rd_off(0, 1, 1)>(vbase);
      const s16x4 l2 = tr_read<v_rd_off(0, 2, 0)>(vbase), h2 = tr_read<v_rd_off(0, 2, 1)>(vbase), l3 = tr_read<v_rd_off(0, 3, 0)>(vbase), h3 = tr_read<v_rd_off(0, 3, 1)>(vbase);
      asm volatile("s_waitcnt lgkmcnt(0)" ::: "memory");
      const bf16x8 vf0 = GLA_PK(l0, h0), vf1 = GLA_PK(l1, h1), vf2 = GLA_PK(l2, h2), vf3 = GLA_PK(l3, h3);
#pragma unroll
      for (int dir = 0; dir < 2; ++dir) {
          const bf16* Sd = ST + (((size_t)unit) * 2 + dir) * 8192 + (size_t)(vb * 32 + r32) * 64 + hi * 8;
          const bf16x8 s0 = *reinterpret_cast<const bf16x8*>(Sd), s1 = *reinterpret_cast<const bf16x8*>(Sd + 16), s2 = *reinterpret_cast<const bf16x8*>(Sd + 32), s3 = *reinterpret_cast<const bf16x8*>(Sd + 48);
          const LAS unsigned char* Qt = T4 + (dir * 2) * 9216 + (tb * 32 + r32) * TS + hi * 16; const LAS unsigned char* At = AT + dir * 9216 + (tb * 32 + r32) * TS + hi * 16;
          o = __builtin_amdgcn_mfma_f32_32x32x16_bf16(*(const LAS bf16x8*)(Qt), s0, o, 0, 0, 0);
          o = __builtin_amdgcn_mfma_f32_32x32x16_bf16(*(const LAS bf16x8*)(Qt + 32), s1, o, 0, 0, 0);
          o = __builtin_amdgcn_mfma_f32_32x32x16_bf16(*(const LAS bf16x8*)(Qt + 64), s2, o, 0, 0, 0);
          o = __builtin_amdgcn_mfma_f32_32x32x16_bf16(*(const LAS bf16x8*)(Qt + 96), s3, o, 0, 0, 0);
          o = __builtin_amdgcn_mfma_f32_32x32x16_bf16(*(const LAS bf16x8*)(At), vf0, o, 0, 0, 0);
          o = __builtin_amdgcn_mfma_f32_32x32x16_bf16(*(const LAS bf16x8*)(At + 32), vf1, o, 0, 0, 0);
          o = __builtin_amdgcn_mfma_f32_32x32x16_bf16(*(const LAS bf16x8*)(At + 64), vf2, o, 0, 0, 0);
          o = __builtin_amdgcn_mfma_f32_32x32x16_bf16(*(const LAS bf16x8*)(At + 96), vf3, o, 0, 0, 0); }
#pragma unroll
      for (int r = 0; r < 16; ++r) OT[(tb * 32 + crow(r, hi)) * 132 + vb * 32 + r32] = o[r]; }
    __syncthreads();
    { const int t = tid >> 3, c0 = (tid & 7) * 16; const float* bg = a.in[I_BNG] + l * 128 + c0;
      f32x4 x[4]; float ss = 0.f;
#pragma unroll
      for (int i = 0; i < 4; ++i) { x[i] = *(const LAS f32x4*)(OT + t * 132 + c0 + 4 * i); ss += (x[i].x * x[i].x + x[i].y * x[i].y) + (x[i].z * x[i].z + x[i].w * x[i].w); }
      ss += __shfl_xor(ss, 1); ss += __shfl_xor(ss, 2); ss += __shfl_xor(ss, 4);
      const float rs = 1.0f / sqrtf(ss * (1.f / 128.f) + EPS);
      const bf16* rg = P + (size_t)(m0 + t) * NINP + C_BR + h * 128 + c0; const bf16x8 r0 = *reinterpret_cast<const bf16x8*>(rg), r1 = *reinterpret_cast<const bf16x8*>(rg + 8);
      float y[16];
#pragma unroll
      for (int i = 0; i < 4; ++i) { const f32x4 gv = *(const f32x4*)(bg + 4 * i); y[4 * i] = x[i].x * rs * gv.x; y[4 * i + 1] = x[i].y * rs * gv.y; y[4 * i + 2] = x[i].z * rs * gv.z; y[4 * i + 3] = x[i].w * rs * gv.w; }
#pragma unroll
      for (int i = 0; i < 8; ++i) { y[i] *= siluf(bfe(r0, i)); y[8 + i] *= siluf(bfe(r1, i)); }
      bf16* dst = MIX + (size_t)(m0 + t) * DM + 512 + h * 128 + c0;
      *(u32x4*)(dst) = (u32x4){cvtpk(y[0], y[1]), cvtpk(y[2], y[3]), cvtpk(y[4], y[5]), cvtpk(y[6], y[7])};
      *(u32x4*)(dst + 8) = (u32x4){cvtpk(y[8], y[9]), cvtpk(y[10], y[11]), cvtpk(y[12], y[13]), cvtpk(y[14], y[15])}; }
    __syncthreads();
#undef GLA_PK
}

__device__ __forceinline__ void mixer_phase(const Args& a, int l, LAS unsigned char* lds, int tid_in, int bid, int G) {
    unsigned char* ws = a.ws;
    const bf16* P = (const bf16*)(ws + WS_P); const bf16* QC = (const bf16*)(ws + WS_QC); const bf16* KVC = (const bf16*)(ws + WS_KVC); const bf16* KRA = (const bf16*)(ws + WS_KRA); const bf16* KRC = (const bf16*)(ws + WS_KRC);
    const bf16* CAK = (const bf16*)(ws + WS_CAK); const bf16* CAV = (const bf16*)(ws + WS_CAV); const bf16* CKRX = (const bf16*)(ws + WS_CKRX); const bf16* KVCTX = (const bf16*)(ws + WS_KVCTX);
    const float* RTA = (const float*)(ws + WS_RTA); const float* RTC = (const float*)(ws + WS_RTC); float* OATT = (float*)(ws + WS_OATT); bf16* MIXB = (bf16*)(ws + WS_MIX);
    const float lam = ((const float*)(ws + WS_LAM))[l], li = ((const float*)(ws + WS_LAM))[4 + l]; const float* ag = a.in[I_ANG] + l * 128;
    constexpr int NAS = 256, NCS = 384, NAP = 64, NCP = 96, NFILL = NAP + NCP + GLA_UNITS;
    const bool tuned = G == 256;
    const int per = G / 8, vb = (bid % 8) * per + bid / 8, wx = vb % per, hx = per / 2;
    const bool heavy = wx < hx; const int hidx = (vb / per) * hx + wx, lidx = (vb / per) * hx + (wx - hx);
    const int nl = G / 2;
    const int nslots = tuned ? 3 + (!heavy ? (NFILL + nl - 1) / nl : 0) : (NAS + NCS + NFILL + G - 1) / G;
    for (int sl = 0; sl < nslots; ++sl) {
        int tid = tid_in; asm volatile("" : "+v"(tid));
        int kind, u, f = -1;
        if (!tuned) { const int g = bid + sl * G; if (g >= NAS + NCS + NFILL) continue; if (g < NAS) { kind = 0; u = g; } else if (g < NAS + NCS) { kind = 1; u = g - NAS; } else { kind = 5; u = 0; f = g - NAS - NCS; } }
        else if (sl == 0) { kind = 0; u = vb; }
        else if (sl == 1) { kind = 1; u = vb; }
        else if (sl == 2) { if (heavy) { kind = 1; u = G + hidx; } else continue; }
        else { kind = 5; u = 0; f = lidx + (sl - 3) * nl; if (f >= NFILL) continue; }
        if (kind == 5) { if (f < NAP) { kind = 2; u = f; } else if (f < NAP + NCP) { kind = 3; u = f - NAP; } else { kind = 4; u = f - NAP - NCP; } }
        if (kind == 0 && u >= NAS) continue;
        if (kind == 1 && u >= NCS) continue;
        if (kind == 4) { gla_g3_unit(a, l, u, lds, tid); continue; }
        if (kind == 0 || kind == 2) {
            int b, head, qb; size_t r0;
            if (kind == 0) { b = u >> 6; head = (u >> 4) & 3; qb = u & 15; r0 = (size_t)MP + (size_t)b * DSEQ; } else { b = u >> 2; head = u & 3; qb = 0; r0 = (size_t)b * SEQ; }
#pragma unroll 1
            for (int ps = 0; ps < 2; ++ps) { const int combo = head * 2 + ps; int tid2 = tid; asm volatile("" : "+v"(tid2));
                KSeg ctx{nullptr, 0, nullptr, 0, nullptr, 0, 0}, lat;
                if (kind == 0) { ctx = KSeg{CAK + ((size_t)(b * DEPTH + l) * PAST) * 512 + combo * 64, 512, nullptr, 0, CAV + ((size_t)(b * DEPTH + l) * PAST) * 512 + head * 128, 512, PAST};
                                 lat = KSeg{KRA + ((size_t)b * DSEQ) * 512 + combo * 64, 512, nullptr, 0, P + r0 * NINP + C_AV + head * 128, NINP, DSEQ}; }
                else lat = KSeg{P + r0 * NINP + C_AK + combo * 64, NINP, nullptr, 0, P + r0 * NINP + C_AV + head * 128, NINP, SEQ};
                attn_mfma_unit<64, 1, false>(lds, P + (r0 + qb * 256) * NINP + C_AQ + combo * 64, NINP, kind == 0, RTA, qb * 256, ctx, lat, 0.125f, OATT + (r0 + qb * 256) * NOATT + head * 128, tid2,
                                             ps == 1, lam, 1.f - li, ag, MIXB + (r0 + qb * 256) * DM + head * 128); }
        } else {
            KSeg ctx{nullptr, 0, nullptr, 0, nullptr, 0, 0}, lat; const bf16* Qp; int t0 = 0; bf16* Op;
            if (kind == 1) { const int b = u / 96, h = (u >> 4) % 6, qb = u & 15; const size_t r0 = (size_t)MP + (size_t)b * DSEQ; const size_t c0 = (size_t)(l * NDB + b) * PAST;
                ctx = KSeg{KVCTX + c0 * NKVP + h * 192, NKVP, CKRX + ((size_t)(b * DEPTH + l) * PAST) * 32, 32, KVCTX + c0 * NKVP + h * 192 + 64, NKVP, PAST};
                lat = KSeg{KVC + r0 * NKVP + h * 192, NKVP, KRC + ((size_t)b * DSEQ) * 32, 32, KVC + r0 * NKVP + h * 192 + 64, NKVP, DSEQ};
                Qp = QC + (r0 + qb * 256) * NQCP + h * 96; t0 = qb * 256; Op = MIXB + (r0 + qb * 256) * DM + 1280 + h * 128; }
            else { const int b = u / 6, h = u % 6; const size_t r0 = (size_t)b * SEQ;
                lat = KSeg{KVC + r0 * NKVP + h * 192, NKVP, P + r0 * NINP + C_CKR, NINP, KVC + r0 * NKVP + h * 192 + 64, NKVP, SEQ};
                Qp = QC + r0 * NQCP + h * 96; Op = MIXB + r0 * DM + 1280 + h * 128; }
            attn_mfma_unit<96, 1, true>(lds, Qp, NQCP, kind == 1, RTC, t0, ctx, lat, 0.10206207261596575f, Op, tid);
        }
    }
}

__device__ __forceinline__ void combine_phase(const Args& a, int l, int gw, int NGW, int lane) {
    using att::cvtpk; using att::u32x4;
    unsigned char* ws = a.ws; const float* OATT = (const float*)(ws + WS_OATT); bf16* MIX = (bf16*)(ws + WS_MIX);
    const float lam = ((const float*)(ws + WS_LAM))[l], li = ((const float*)(ws + WS_LAM))[4 + l];
    const int h = lane >> 4, c8 = (lane & 15) * 8; const float* ag = a.in[I_ANG] + l * 128 + c8;
    const f32x4 g0 = *(const f32x4*)ag * (1.f - li), g1 = *(const f32x4*)(ag + 4) * (1.f - li);
    for (int m = gw; m < M; m += NGW) {
        const float* oa = OATT + (size_t)m * NOATT + (2 * h) * 128 + c8;
        const f32x4 a0 = *(const f32x4*)oa, a1 = *(const f32x4*)(oa + 4), b0 = *(const f32x4*)(oa + 128), b1 = *(const f32x4*)(oa + 132);
        const f32x4 o0 = a0 - b0 * lam, o1 = a1 - b1 * lam;
        float ss = (o0.x * o0.x + o0.y * o0.y) + (o0.z * o0.z + o0.w * o0.w) + (o1.x * o1.x + o1.y * o1.y) + (o1.z * o1.z + o1.w * o1.w);
        ss += __shfl_xor(ss, 1); ss += __shfl_xor(ss, 2); ss += __shfl_xor(ss, 4); ss += __shfl_xor(ss, 8);
        const float r = 1.0f / sqrtf(ss * (1.f / 128.f) + EPS);
        const f32x4 y0 = o0 * r * g0, y1 = o1 * r * g1;
        *(u32x4*)(MIX + (size_t)m * DM + h * 128 + c8) = (u32x4){cvtpk(y0.x, y0.y), cvtpk(y0.z, y0.w), cvtpk(y1.x, y1.y), cvtpk(y1.z, y1.w)};
    }
}

__device__ __forceinline__ void convact_phase(const Args& a, int l, int gw, int NGW, int lane) {
    const bf16* GU = (const bf16*)(a.ws + WS_GU); bf16* ACT = (bf16*)(a.ws + WS_ACT);
    const float* cw = a.in[I_CONVW] + (size_t)l * 3 * DFF; const float* cb = a.in[I_CONVB] + (size_t)l * DFF;
    for (int m = gw; m < M; m += NGW) {
        int t, n; if (m < MP) { t = m % SEQ; n = SEQ; } else { t = (m - MP) % DSEQ; n = DSEQ; }
        const bool hp = t > 0, hn = t < n - 1;
        const bf16* g1 = GU + (size_t)m * (2 * DFF);
        for (int c = lane; c < DFF; c += 64) {
            const float gm = bf2f(g1[c]), gp = hp ? bf2f(g1[c - 2 * DFF]) : 0.f, gn = hn ? bf2f(g1[c + 2 * DFF]) : 0.f, uu = bf2f(g1[DFF + c]);
            const float gc = gp * cw[c] + gm * cw[DFF + c] + gn * cw[2 * DFF + c] + cb[c];
            ACT[(size_t)m * DFF + c] = (bf16)f2bf(siluf(gc) * uu);
        }
    }
}

__device__ __forceinline__ void ffn_fix_phase(const Args& a, int l, int gt, int NGT) {
    const float* side = (const float*)(a.ws + WS_SIDE); bf16* ACT = (bf16*)(a.ws + WS_ACT);
    const float* cw = a.in[I_CONVW] + (size_t)l * 3 * DFF;
    for (int i = gt; i < (MS / 256) * 2 * DFF; i += NGT) { const int j = i % DFF, w = (i / DFF) & 1, pm = 16 + i / (2 * DFF), q = (pm - 16) & 15;
        if (w == 0 ? q == 0 : q == 15) continue;
        const float* sp = side + ((size_t)(pm * 2 + w) * 3) * DFF + j;
        const float gnb = w == 0 ? side[((size_t)((pm - 1) * 2 + 1) * 3 + 2) * DFF + j] : side[((size_t)((pm + 1) * 2 + 0) * 3 + 2) * DFF + j];
        const float gc = sp[0] + cw[(w == 0 ? 0 : 2) * DFF + j] * gnb;
        ACT[(size_t)(pm * 256 + (w == 0 ? 0 : 255)) * DFF + j] = (bf16)f2bf(siluf(gc) * sp[DFF]); }
}

constexpr int PH_PER_LAYER = 11, PH_L0 = 3, PH_FIN = PH_L0 + DEPTH * PH_PER_LAYER, N_PHASES = PH_FIN + 1;
__global__ void __launch_bounds__(NTH, 2) mk_fwd(Args a) {
    extern __shared__ __attribute__((aligned(16))) unsigned char lds_raw[];
    LAS unsigned char* lds = (LAS unsigned char*)lds_raw;
    const int bid = blockIdx.x, G = gridDim.x, wave0 = __builtin_amdgcn_readfirstlane((int)threadIdx.x >> 6);
#define PH_BEGIN int tid = TID_NOW; asm volatile("" : "+v"(tid)); unsigned char* ws = a.ws; asm volatile("" : "+s"(ws)); \
    const int lane = tid & 63, wave = __builtin_amdgcn_readfirstlane(tid >> 6), gw = bid * NWV + wave, NGW = G * NWV, gt = bid * NTH + tid, NGT = G * NTH; (void)lane; (void)gw; (void)NGW; (void)gt; (void)NGT; (void)ws
    {
        volatile LAS unsigned* Z = (volatile LAS unsigned*)(lds + RING_BYTES);
        for (int u = threadIdx.x; u < (LDS_BYTES - RING_BYTES) / 4; u += NTH) Z[u] = 0u;
        __syncthreads();
    }
    if (a.use_bar) (void)xcd_barrier_post((unsigned*)(a.ws + WS_CTL) + 4096, (volatile LAS unsigned*)(lds + MISC_OFF) + 8);
#define bar (XcdBarrier{(unsigned*)(a.ws + WS_CTL) + 4096, xb_xcc_id(), (volatile LAS unsigned*)(lds + MISC_OFF) + 8})
    const int lo = a.ph_lo, hi = a.ph_hi;
#define IN(k) (lo <= (k) && (k) < hi)
#define TID_NOW (wave0 * 64 + (int)__builtin_amdgcn_mbcnt_hi(~0u, __builtin_amdgcn_mbcnt_lo(~0u, 0u)))
#define SEAM(k) do { if (IN(k) && IN((k) + 1)) xcd_barrier(bar, TID_NOW); } while (0)
#ifndef MK_DUP
#define MK_DUP 0
#endif
#define DUP(bit) _Pragma("unroll 1") for (int rep_ = 0; rep_ < (((MK_DUP) & (bit)) ? 2 : 1); ++rep_)

    if (IN(0)) DUP(512) { PH_BEGIN; pro0_phase(a, lds, tid, lane, wave, bid, G); SEAM(0); }
    if (IN(1)) { PH_BEGIN;
        modfin_phase(a, gt, NGT);
        pg8::Gemm g{(const bf16*)(ws + WS_CKVA), (const bf16*)(ws + WS_WKV), DEPTH * NDB * PAST, NKVP, 256, 256, 256, 4, (size_t)NKVP * 256}; pg8::StaticOrder S; S.init(DEPTH * NDB * PAST, NKVP, G, bid);
        pg8::EpiBf16<0> E{(bf16*)(ws + WS_KVCTX), NKVP, nullptr, 0, 0, 1.f};
        pg8::gemm_phase<pg8::EpiBf16<0>, pg8::StaticOrder, true, true>(lds, g, S, E, tid);
        SEAM(1);
    }
    if (IN(2)) DUP(8192) { PH_BEGIN; pro2_phase(a, lds, tid, bid, G, gt, NGT); SEAM(2); }
    for (int l = 0; l < DEPTH; ++l) {
        const int pb = PH_L0 + PH_PER_LAYER * l;
        if (pb + PH_PER_LAYER <= lo || pb >= hi) continue;
#define LAYER_PTRS const float* modl = (const float*)(ws + WS_MOD) + (size_t)l * 5 * 6 * DM; const float* xin0 = l == 0 ? a.in[I_XP] : (const float*)(ws + WS_X); \
        const float* xin1 = l == 0 ? a.in[I_XS] - (size_t)MP * DM : (const float*)(ws + WS_X); float* X = (float*)(ws + WS_X); (void)modl; (void)xin0; (void)xin1; (void)X
        if (IN(pb + 0) && l == 0) { PH_BEGIN; norm0_phase(a.in[I_XP], a.in[I_XS] - (size_t)MP * DM, (const float*)(ws + WS_GM), (bf16*)(ws + WS_H), (float*)(ws + WS_SSQP), gw, NGW, lane); SEAM(pb + 0); }
        if (IN(pb + 1)) DUP(2) { PH_BEGIN;
            pg8::Gemm g{(const bf16*)(ws + WS_H), (const bf16*)(ws + WS_WIN + l * SZ_WIN), M, NINP, DM, DM, DM, 1 << 20, 0}; pg8::StaticOrder S; S.init(M, NINP, G, bid);
            pg8::EpiBf16Norm E{(bf16*)(ws + WS_P), NINP, (const float*)(ws + WS_SSQP) + (size_t)(2 * l) * M * 32, (const float*)(ws + WS_SHWI) + (size_t)l * 5 * NINP, NINP, (LAS float*)(lds + RING_BYTES + 8192)};
            pg8::gemm_phase<pg8::EpiBf16Norm, pg8::StaticOrder, true, true>(lds, g, S, E, tid);
            SEAM(pb + 1);
        }
        if (IN(pb + 2)) DUP(4) { PH_BEGIN; post_phase(a, l, gw, NGW, lane);
#if 1
            __syncthreads();
            for (int u = bid; u < GLA_UNITS; u += G) { int t2 = tid; asm volatile("" : "+v"(t2)); gla_g1_unit(a, l, u, lds, t2); }
#endif
            SEAM(pb + 2); }
        if (IN(pb + 3)) DUP(8) {
            { PH_BEGIN; pg8::Gemm g{(const bf16*)(ws + WS_CQN), (const bf16*)(ws + WS_WQ + l * SZ_WQ), M, NQCP, 384, 384, 384, 1 << 20, 0}; pg8::StaticOrder S; S.init(M, NQCP, G, bid);
              pg8::EpiBf16<0> E{(bf16*)(ws + WS_QC), NQCP, nullptr, NQCP, 0, 0.10206207261596575f * 1.4426950408889634f};
              pg8::gemm_phase<pg8::EpiBf16<0>, pg8::StaticOrder, true, true>(lds, g, S, E, tid); }
            __syncthreads();
            { PH_BEGIN; pg8::Gemm g{(const bf16*)(ws + WS_CKVN), (const bf16*)(ws + WS_WKV + l * SZ_WKV), M, NKVP, 256, 256, 256, 1 << 20, 0}; pg8::StaticOrder S; S.init(M, NKVP, G, bid);
              pg8::EpiBf16<0> E{(bf16*)(ws + WS_KVC), NKVP, nullptr, 0, 0, 1.f};
              pg8::gemm_phase<pg8::EpiBf16<0>, pg8::StaticOrder, true, true>(lds, g, S, E, tid); }
#if MK_MFMA_GLA
            { PH_BEGIN; for (int it = bid; it < GLA_G2_ITEMS; it += G) gla_g2_item(a, l, it, tid); }
#endif
            SEAM(pb + 3);
        }
        if (IN(pb + 4)) DUP(16) { PH_BEGIN; mixer_phase(a, l, lds, tid, bid, G); if (IN(pb + 6)) xcd_barrier(bar, TID_NOW); }
        if (IN(pb + 6)) { PH_BEGIN; LAYER_PTRS;
            constexpr int NFULL = 512;
            { pg8::Gemm g{(const bf16*)(ws + WS_MIX), (const bf16*)(ws + WS_WOUT + l * SZ_WOUT), M, DM, DM, DM, DM, 1 << 20, 0}; pg8::StaticOrder S; S.init(M, DM, G, bid); S.lim = (MK_SPLITK && G == 256) ? NFULL : S.nwg;
              pg8::EpiResid E{MK_SPLITK ? X : xin0, MK_SPLITK ? X : xin1, X, modl + 2 * DM, (bf16*)(ws + WS_H), (const float*)(ws + WS_GM) + (size_t)(l * 2 + 1) * 5 * DM, (float*)(ws + WS_SSQP) + (size_t)(2 * l + 1) * M * 32};
              pg8::gemm_phase<pg8::EpiResid, pg8::StaticOrder, true, true>(lds, g, S, E, tid); }
            if (MK_SPLITK && G == 256) { __syncthreads(); int t3 = tid; asm volatile("" : "+v"(t3)); (void)t3;
              pg8::Gemm g{(const bf16*)(ws + WS_MIX), (const bf16*)(ws + WS_WOUT + l * SZ_WOUT), M, DM, DM / 2, DM, DM, 1 << 20, 0}; pg8::TailOrder S; S.init(M, DM, G, bid); S.base = NFULL; S.nth = DM / 128;
              pg8::EpiResidTail E{X, modl + 2 * DM, (float*)(ws + WS_SPLITK), (unsigned*)(ws + WS_CTL) + CW_TICKET + (l * 2 + 0) * 128 * 64, (LAS unsigned*)(lds + RING_BYTES + 2048)};
              pg8::gemm_phase<pg8::EpiResidTail, pg8::TailOrder, true, true>(lds, g, S, E, tid); }
            SEAM(pb + 6);
        }
        if (IN(pb + 8)) DUP(128) { PH_BEGIN;
            pg8::Gemm g{(const bf16*)(ws + WS_H), (const bf16*)(ws + WS_WUP + l * SZ_WUP), M, 2 * DFF, DM, DM, DM, 1 << 20, 0}; pg8::StaticOrder S; S.init(M, 2 * DFF, G, bid);
            pg8::EpiConvAct E{(bf16*)(ws + WS_ACT), a.in[I_CONVW] + (size_t)l * 3 * DFF, a.in[I_CONVB] + (size_t)l * DFF, (float*)(ws + WS_SIDE), (LAS float*)(lds + RING_BYTES + 4096),
                               (const float*)(ws + WS_SSQP) + (size_t)(2 * l + 1) * M * 32, (const float*)(ws + WS_SHWU) + (size_t)l * 5 * 2 * DFF, (LAS float*)(lds + RING_BYTES + 8192)};
            pg8::gemm_phase<pg8::EpiConvAct, pg8::StaticOrder, true, true>(lds, g, S, E, tid);
            SEAM(pb + 8);
        }
        if (IN(pb + 9)) DUP(256) { PH_BEGIN; ffn_fix_phase(a, l, gt, NGT); SEAM(pb + 9); }
        if (IN(pb + 10)) { PH_BEGIN; LAYER_PTRS;
            constexpr int NFULL = 512;
            { pg8::Gemm g{(const bf16*)(ws + WS_ACT), (const bf16*)(ws + WS_WDN + l * SZ_WDN), M, DM, DFF, DFF, DFF, 1 << 20, 0}; pg8::StaticOrder S; S.init(M, DM, G, bid); S.lim = (MK_SPLITK && G == 256) ? NFULL : S.nwg;
              pg8::EpiResid E{X, X, X, modl + 5 * DM, l + 1 < DEPTH ? (bf16*)(ws + WS_H) : nullptr, (const float*)(ws + WS_GM) + (size_t)((l + 1 < DEPTH ? l + 1 : l) * 2) * 5 * DM, (float*)(ws + WS_SSQP) + (size_t)(2 * (l + 1 < DEPTH ? l + 1 : l)) * M * 32};
              pg8::gemm_phase<pg8::EpiResid, pg8::StaticOrder, true, true>(lds, g, S, E, tid); }
            if (MK_SPLITK && G == 256) { __syncthreads(); int t3 = tid; asm volatile("" : "+v"(t3)); (void)t3;
              pg8::Gemm g{(const bf16*)(ws + WS_ACT), (const bf16*)(ws + WS_WDN + l * SZ_WDN), M, DM, DFF / 2, DFF, DFF, 1 << 20, 0}; pg8::TailOrder S; S.init(M, DM, G, bid); S.base = NFULL; S.nth = DFF / 128;
              pg8::EpiResidTail E{X, modl + 5 * DM, (float*)(ws + WS_SPLITK), (unsigned*)(ws + WS_CTL) + CW_TICKET + (l * 2 + 1) * 128 * 64, (LAS unsigned*)(lds + RING_BYTES + 2048)};
              pg8::gemm_phase<pg8::EpiResidTail, pg8::TailOrder, true, true>(lds, g, S, E, tid); }
            SEAM(pb + 10);
        }
    }
    if (IN(PH_FIN)) { PH_BEGIN; final_norm_phase((const float*)(ws + WS_X), a.in[I_FING], a.out, gw, NGW, lane); }
#undef IN
#undef SEAM
#undef bar
}

#ifndef MK_ONE_LAUNCH
#define MK_ONE_LAUNCH 1
#endif
extern "C" void kernel_launch(void* const* d_in, const int* in_sizes, int n_in, void* d_out, int out_size, void* d_ws, size_t ws_size, hipStream_t stream) {
    static int grid = 0;
    if (grid == 0) {
        if (n_in != N_INPUTS || (size_t)out_size != O_END || ws_size < WS_END) { fprintf(stderr, "kernel_launch: shape mismatch: n_in %d out %d ws %zu (need %zu)\n", n_in, out_size, ws_size, (size_t)WS_END); grid = -1; return; }
        int dev = 0, cus = 0, per_cu = 0;
        if (hipGetDevice(&dev) != hipSuccess || hipDeviceGetAttribute(&cus, hipDeviceAttributeMultiprocessorCount, dev) != hipSuccess) { grid = -1; return; }
        if (hipFuncSetAttribute((const void*)mk_fwd, hipFuncAttributeMaxDynamicSharedMemorySize, LDS_BYTES) != hipSuccess) { fprintf(stderr, "kernel_launch: hipFuncSetAttribute failed\n"); grid = -1; return; }
        if (hipOccupancyMaxActiveBlocksPerMultiprocessor(&per_cu, (const void*)mk_fwd, NTH, LDS_BYTES) != hipSuccess || per_cu < 1) fprintf(stderr, "kernel_launch: occupancy query reports %d\n", per_cu);
        (void)hipGetLastError();
        grid = cus;
    }
    if (grid < 0) return;
    if (hipMemsetAsync((char*)d_ws + WS_CTL, 0, CTL_ZERO_BYTES, stream) != hipSuccess) return;
    Args a{};
    for (int i = 0; i < N_INPUTS; ++i) a.in[i] = (const float*)d_in[i];
    a.out = (float*)d_out; a.ws = (unsigned char*)d_ws; a.pad = 0;
#if MK_ONE_LAUNCH
    a.ph_lo = 0; a.ph_hi = N_PHASES; a.use_bar = 1;
    hipLaunchKernelGGL(mk_fwd, dim3(grid), dim3(NTH), LDS_BYTES, stream, a);
#else
    for (int p = 0; p < N_PHASES; ++p) { a.ph_lo = p; a.ph_hi = p + 1; a.use_bar = 0; hipLaunchKernelGGL(mk_fwd, dim3(grid), dim3(NTH), LDS_BYTES, stream, a); }
#endif
    const hipError_t le = hipPeekAtLastError();
    if (le != hipSuccess) fprintf(stderr, "kernel_launch: launch failed: %s\n", hipGetErrorName(le));
}
```

```cpp
#include <hip/hip_runtime.h>
#include <cstdio>
#include <cstdint>
#include <cmath>

namespace pg8 {
#define PG8_LAS __attribute__((address_space(3)))
typedef unsigned short bf16_t;
typedef short bf16x8 __attribute__((ext_vector_type(8)));
typedef float f32x4 __attribute__((ext_vector_type(4)));
typedef unsigned u32x4 __attribute__((ext_vector_type(4)));
constexpr int BM = 256, BK = 64, HALF = 128, HTB = HALF * BK * 2  , STAGE_BYTES = 8 * HTB, NXCD = 8, WGM = 8;

__host__ __device__ __forceinline__ int lds_byte(int r, int c) { const int st = (r >> 4) * 2 + (c >> 5), rr = r & 15, cc = c & 31, ob = rr * 64 + cc * 2; return st * 1024 + (ob ^ (((ob >> 9) & 1) << 5)); }
__host__ __device__ __forceinline__ void stage_rc(int b, int& R, int& C) { const int st = b / 1024, sb = b % 1024, swz = sb ^ (((sb >> 9) & 1) << 5); R = (st >> 1) * 16 + swz / 64; C = (st & 1) * 32 + (swz % 64) / 2; }
__host__ __device__ __forceinline__ int perm32(int rho) { const int n = rho >> 4, i = rho & 15; return 8 * (i >> 2) + 4 * n + (i & 3); }

struct Unit { int pm, pn, kt0; };
struct Gemm { const bf16_t* A; const bf16_t* Bt; int M, N, K, lda, ldb, bgrp; size_t bgrp_stride; };

struct StaticOrder {
    int nM, nN, nwg, G, c;
    __host__ __device__ void init(int M, int N, int G_, int c_) { nM = M / BM; nN = N / BM; nwg = nM * nN; G = G_; c = c_; lim = nwg; }
    int lim;
    __host__ __device__ void map(int wgid, Unit& u) const {
        { const int q = nwg / NXCD, r = nwg % NXCD, xcd = wgid % NXCD, off = wgid / NXCD; wgid = (xcd < r ? xcd * (q + 1) : r * (q + 1) + (xcd - r) * q) + off; }
        const int nig = WGM * nN, gid = wgid / nig, fm = gid * WGM, gsz = (nM - fm) < WGM ? (nM - fm) : WGM;
        u.pm = fm + ((wgid % nig) % gsz); u.pn = (wgid % nig) / gsz; u.kt0 = 0;
    }
    __host__ __device__ bool next(int i, Unit& u) const {
        const long L = (long)i * G + c; if (L >= lim) return false;
        map((int)L, u); return true;
    }
    __device__ __forceinline__ void a_ready(const Unit&) const {}
    __device__ __forceinline__ void done(const Unit&) const {}
};

struct TailOrder : StaticOrder {
    int base, nth;
    __host__ __device__ bool next(int i, Unit& u) const { if (i > 0) return false; const int L = base + (c >> 1); if (L >= nwg) return false; map(L, u); u.kt0 = (c & 1) * nth; return true; }
};

__device__ __forceinline__ unsigned cvt_pk_bf16(float lo, float hi) { unsigned r; asm volatile("v_cvt_pk_bf16_f32 %0, %1, %2" : "=v"(r) : "v"(lo), "v"(hi)); return r; }
typedef float f32x2 __attribute__((ext_vector_type(2)));
__device__ __forceinline__ f32x2 gelu_pk(f32x2 v) {
    const f32x2 av = __builtin_elementwise_abs(v), d = av * 0.2316418882f + 1.0f;
    f32x2 t; t.x = __builtin_amdgcn_rcpf(d.x); t.y = __builtin_amdgcn_rcpf(d.y);
    f32x2 q = t * 0.5307027145f + (-0.7265760135f); q = q * t + 0.7107068705f; q = q * t + (-0.142248368f); q = q * t + 0.127414796f; q = q * t;
    const f32x2 s = (v * v) * (-0.72134752044f);
    f32x2 e; e.x = __builtin_amdgcn_exp2f(s.x); e.y = __builtin_amdgcn_exp2f(s.y);
    const f32x2 m = v * (q * e), r = v - m;
    f32x2 o; o.x = v.x < 0.f ? m.x : r.x; o.y = v.y < 0.f ? m.y : r.y; return o;
}

template <int ACT  > struct EpiBf16 {
    static constexpr bool PERM = true, AFTER_DRAIN = false; static_assert(ACT == 0 || ACT == 1, "EpiBf16: ACT is 0 (none) or 1 (gelu_pk)");
    bf16_t* O; int ldc; const float* bias; int split_cols; size_t split_stride; float scale0;
    __device__ __forceinline__ void operator()(const f32x4 (&acc)[2][2][4][2], const Unit& u, int wr, int wc, int fr, int fq) const {
        const int row0 = u.pm * BM + wr * 64 + fr; int colt = u.pn * BM; bf16_t* base = O;
        float sc = 1.f; if (split_cols) { const int t = colt / split_cols; base += (size_t)t * split_stride; colt -= t * split_cols; if (t == 0) sc = scale0; }
        const int col0 = colt + wc * 32 + 8 * fq, bcol0 = u.pn * BM + wc * 32 + 8 * fq;
        f32x4 bv[2][2];
#pragma unroll
        for (int bj = 0; bj < 2; ++bj)
#pragma unroll
            for (int n = 0; n < 2; ++n) bv[bj][n] = bias ? *(const f32x4*)(bias + bcol0 + bj * HALF + 4 * n) : (f32x4){0.f, 0.f, 0.f, 0.f};
#pragma unroll
        for (int ai = 0; ai < 2; ++ai)
#pragma unroll
            for (int m = 0; m < 4; ++m) { bf16_t* rowp = base + (size_t)(row0 + ai * HALF + m * 16) * ldc + col0;
#pragma unroll
                for (int bj = 0; bj < 2; ++bj) { f32x4 v0 = acc[ai][bj][m][0] + bv[bj][0], v1 = acc[ai][bj][m][1] + bv[bj][1];
                    if (ACT == 1) { f32x2 a = gelu_pk((f32x2){v0[0], v0[1]}), b = gelu_pk((f32x2){v0[2], v0[3]}), c = gelu_pk((f32x2){v1[0], v1[1]}), d = gelu_pk((f32x2){v1[2], v1[3]});
                        v0 = (f32x4){a.x, a.y, b.x, b.y}; v1 = (f32x4){c.x, c.y, d.x, d.y}; }
                    v0 = v0 * sc; v1 = v1 * sc; u32x4 w; w.x = cvt_pk_bf16(v0[0], v0[1]); w.y = cvt_pk_bf16(v0[2], v0[3]); w.z = cvt_pk_bf16(v1[0], v1[1]); w.w = cvt_pk_bf16(v1[2], v1[3]);
                    *(u32x4*)(rowp + bj * HALF) = w; } }
    }
};

template <class Epi, class Sched, bool ALIGN_EPI = false, bool SP2 = false>
__device__ __forceinline__ void gemm_phase(PG8_LAS unsigned char* lds, const Gemm g, const Sched& S, const Epi& E, int tid_in) {
    int tid_ = tid_in; asm volatile("" : "+v"(tid_));
    const int tid = tid_, wid = __builtin_amdgcn_readfirstlane(tid >> 6), lane = tid & 63, wr = wid >> 2, wc = wid & 3, fr = lane & 15, fq = lane >> 4;
    const int K = g.K, nt = K / BK;
    unsigned voffA[2], voffB[2];
#pragma unroll
    for (int i = 0; i < 2; ++i) { int R, C; stage_rc(tid * 16 + i * 8192, R, C); const int Rb = Epi::PERM ? ((R & ~31) + perm32(R & 31)) : R;
        voffA[i] = (unsigned)(R * g.lda + C) * 2u; voffB[i] = (unsigned)(Rb * g.ldb + C) * 2u; }
    const size_t kstep = (size_t)(BK * 2);
    const size_t hstepA = (size_t)HALF * g.lda * 2, hstepB = (size_t)HALF * g.ldb * 2;
    const size_t tstepA = 2 * hstepA, tstepB = 2 * hstepB;
    const unsigned ldsw = (unsigned)wid * 1024u;
    const int aoff = lds_byte(wr * 64 + fr, fq * 8), boff = lds_byte(wc * 32 + fr, fq * 8);
#define PG8_SA(b, h) (((b) * 2 + (h)) * HTB)
#define PG8_SB(b, h) ((4 + (b) * 2 + (h)) * HTB)
#define PG8_STAGE(bufoff, gbase, voff) do { _Pragma("unroll") for (int _i = 0; _i < 2; ++_i) \
        __builtin_amdgcn_global_load_lds((const unsigned*)((const char*)(gbase) + (voff)[_i]), (PG8_LAS unsigned*)(lds + (bufoff) + ldsw + _i * 8192), 16, 0, 0); } while (0)
#define PG8_LDA(dst, b, h) do { _Pragma("unroll") for (int m = 0; m < 4; ++m) _Pragma("unroll") for (int k = 0; k < 2; ++k) dst[m][k] = *(const PG8_LAS bf16x8*)(lds + PG8_SA(b, h) + aoff + m * 2048 + k * 1024); } while (0)
#define PG8_LDB(dst, b, h) do { _Pragma("unroll") for (int n = 0; n < 2; ++n) _Pragma("unroll") for (int k = 0; k < 2; ++k) dst[n][k] = *(const PG8_LAS bf16x8*)(lds + PG8_SB(b, h) + boff + n * 2048 + k * 1024); } while (0)
#define PG8_MMA(ai, bj, At, Bt) do { __builtin_amdgcn_s_setprio(1); _Pragma("unroll") for (int m = 0; m < 4; ++m) _Pragma("unroll") for (int n = 0; n < 2; ++n) _Pragma("unroll") for (int k = 0; k < 2; ++k) \
        acc[ai][bj][m][n] = __builtin_amdgcn_mfma_f32_16x16x32_bf16(Bt[n][k], At[m][k], acc[ai][bj][m][n], 0, 0, 0); __builtin_amdgcn_s_setprio(0); } while (0)
#define PG8_WAIT_V(n) asm volatile("s_waitcnt vmcnt(" #n ")" ::: "memory")
#define PG8_WAIT_L(n) asm volatile("s_waitcnt lgkmcnt(" #n ")" ::: "memory")
#define PG8_BAR __builtin_amdgcn_s_barrier()
#define PG8_SCHED __builtin_amdgcn_sched_barrier(0)
    Unit cur, nxt; int ui = 0;
    if (!S.next(0, cur)) return;
    f32x4 acc[2][2][4][2];
#pragma unroll
    for (int a = 0; a < 2; ++a)
#pragma unroll
        for (int b = 0; b < 2; ++b)
#pragma unroll
            for (int m = 0; m < 4; ++m)
#pragma unroll
                for (int n = 0; n < 2; ++n) acc[a][b][m][n] = (f32x4){0.f, 0.f, 0.f, 0.f};
    bf16x8 At[4][2], B0[2][2], B1[2][2];
    const char* cA = (const char*)g.A + (size_t)cur.pm * tstepA + (size_t)cur.kt0 * kstep; const char* cB = (const char*)g.Bt + (size_t)(cur.pm / g.bgrp) * g.bgrp_stride * 2 + (size_t)cur.pn * tstepB + (size_t)cur.kt0 * kstep;
    S.a_ready(cur);
    if constexpr (SP2) {
        PG8_STAGE(PG8_SB(0, 0), cB, voffB); PG8_STAGE(PG8_SB(0, 1), cB + hstepB, voffB); PG8_STAGE(PG8_SA(0, 0), cA, voffA); PG8_STAGE(PG8_SA(0, 1), cA + hstepA, voffA);
        if (wr == 1) PG8_BAR;
        PG8_WAIT_V(2); PG8_BAR;
        PG8_STAGE(PG8_SB(1, 0), cB + kstep, voffB); PG8_STAGE(PG8_SA(1, 0), cA + kstep, voffA); PG8_STAGE(PG8_SB(1, 1), cB + hstepB + kstep, voffB);
        PG8_WAIT_V(6); PG8_BAR;
    } else {
        PG8_STAGE(PG8_SB(0, 0), cB, voffB); PG8_STAGE(PG8_SA(0, 0), cA, voffA); PG8_STAGE(PG8_SB(0, 1), cB + hstepB, voffB); PG8_STAGE(PG8_SA(0, 1), cA + hstepA, voffA);
        if (wr == 1) PG8_BAR;
        PG8_WAIT_V(4); PG8_BAR;
        PG8_STAGE(PG8_SB(1, 0), cB + kstep, voffB); PG8_STAGE(PG8_SA(1, 0), cA + kstep, voffA); PG8_STAGE(PG8_SB(1, 1), cB + hstepB + kstep, voffB);
        PG8_WAIT_V(6); PG8_BAR;
    }
    for (;;) {
        const bool has_next = S.next(ui + 1, nxt);
        const char* nA = has_next ? (const char*)g.A + (size_t)nxt.pm * tstepA + (size_t)nxt.kt0 * kstep : cA; const char* nB = has_next ? (const char*)g.Bt + (size_t)(nxt.pm / g.bgrp) * g.bgrp_stride * 2 + (size_t)nxt.pn * tstepB + (size_t)nxt.kt0 * kstep : cB;
        for (int t = 0; t < nt; t += 2) {
            const bool last = (t == nt - 2);
            const char* a1 = cA + (size_t)(t + 1) * kstep;
            const char* a2 = last ? nA : cA + (size_t)(t + 2) * kstep; const char* b2 = last ? nB : cB + (size_t)(t + 2) * kstep;
            const char* a3 = a2 + kstep; const char* b3 = b2 + kstep;
            if (last && has_next) S.a_ready(nxt);
            if constexpr (SP2) {
            PG8_LDB(B0, 0, 0); PG8_LDB(B1, 0, 1); PG8_SCHED; PG8_LDA(At, 0, 0); PG8_STAGE(PG8_SA(1, 1), a1 + hstepA, voffA);
            PG8_WAIT_V(8); PG8_WAIT_L(0); PG8_BAR; PG8_MMA(0, 0, At, B0); PG8_MMA(0, 1, At, B1); PG8_BAR; PG8_SCHED;
            PG8_LDA(At, 0, 1); PG8_STAGE(PG8_SB(0, 0), b2, voffB); PG8_STAGE(PG8_SB(0, 1), b2 + hstepB, voffB); PG8_STAGE(PG8_SA(0, 0), a2, voffA);
            PG8_WAIT_V(8); PG8_WAIT_L(0); PG8_BAR; PG8_MMA(1, 0, At, B0); PG8_MMA(1, 1, At, B1); PG8_BAR; PG8_SCHED;
            PG8_LDB(B0, 1, 0); PG8_LDB(B1, 1, 1); PG8_SCHED; PG8_LDA(At, 1, 0); PG8_STAGE(PG8_SA(0, 1), a2 + hstepA, voffA);
            PG8_WAIT_V(8); PG8_WAIT_L(0); PG8_BAR; PG8_MMA(0, 0, At, B0); PG8_MMA(0, 1, At, B1); PG8_BAR; PG8_SCHED;
            PG8_LDA(At, 1, 1); PG8_STAGE(PG8_SB(1, 0), b3, voffB); PG8_STAGE(PG8_SB(1, 1), b3 + hstepB, voffB); PG8_STAGE(PG8_SA(1, 0), a3, voffA);
            PG8_WAIT_V(8); PG8_WAIT_L(0); PG8_BAR; PG8_MMA(1, 0, At, B0); PG8_MMA(1, 1, At, B1); PG8_BAR; PG8_SCHED;
            } else {
            PG8_LDB(B0, 0, 0); PG8_SCHED; PG8_LDA(At, 0, 0); PG8_STAGE(PG8_SA(1, 1), a1 + hstepA, voffA);
            PG8_WAIT_L(8); PG8_BAR; PG8_WAIT_L(0); PG8_MMA(0, 0, At, B0); PG8_BAR; PG8_SCHED;
            PG8_LDB(B1, 0, 1); PG8_STAGE(PG8_SB(0, 0), b2, voffB);
            PG8_BAR; PG8_WAIT_L(0); PG8_MMA(0, 1, At, B1); PG8_BAR;
            PG8_LDA(At, 0, 1); PG8_STAGE(PG8_SA(0, 0), a2, voffA);
            PG8_BAR; PG8_WAIT_L(0); PG8_MMA(1, 0, At, B0); PG8_BAR; PG8_SCHED;
            PG8_STAGE(PG8_SB(0, 1), b2 + hstepB, voffB);
            PG8_WAIT_V(6); PG8_BAR; PG8_MMA(1, 1, At, B1); PG8_BAR;
            PG8_LDB(B0, 1, 0); PG8_SCHED; PG8_LDA(At, 1, 0); PG8_STAGE(PG8_SA(0, 1), a2 + hstepA, voffA);
            PG8_WAIT_L(8); PG8_BAR; PG8_WAIT_L(0); PG8_MMA(0, 0, At, B0); PG8_BAR; PG8_SCHED;
            PG8_LDB(B1, 1, 1); PG8_STAGE(PG8_SB(1, 0), b3, voffB);
            PG8_BAR; PG8_WAIT_L(0); PG8_MMA(0, 1, At, B1); PG8_BAR;
            PG8_LDA(At, 1, 1); PG8_STAGE(PG8_SA(1, 0), a3, voffA);
            PG8_BAR; PG8_WAIT_L(0); PG8_MMA(1, 0, At, B0); PG8_BAR; PG8_SCHED;
            PG8_STAGE(PG8_SB(1, 1), b3 + hstepB, voffB);
            PG8_WAIT_V(6); PG8_BAR; PG8_MMA(1, 1, At, B1); PG8_BAR;
            }
        }
        if constexpr (ALIGN_EPI) { if (wr == 0) PG8_BAR; }
        if constexpr (!Epi::AFTER_DRAIN) { E(acc, cur, wr, wc, fr, fq); S.done(cur); }
        if (!has_next) break;
#pragma unroll
        for (int a = 0; a < 2; ++a)
#pragma unroll
            for (int b = 0; b < 2; ++b)
#pragma unroll
                for (int m = 0; m < 4; ++m)
#pragma unroll
                    for (int n = 0; n < 2; ++n) acc[a][b][m][n] = (f32x4){0.f, 0.f, 0.f, 0.f};
        cur = nxt; cA = nA; cB = nB; ++ui;
        if constexpr (ALIGN_EPI) { if (wr == 1) PG8_BAR; }
    }
    PG8_WAIT_V(0);
    if constexpr (!ALIGN_EPI) { if (wr == 0) PG8_BAR; }
    PG8_BAR;
    if constexpr (Epi::AFTER_DRAIN) { E.fused(acc, cur, wr, wc, fr, fq, lds, wid, lane); S.done(cur); }
#undef PG8_SA
#undef PG8_SB
#undef PG8_STAGE
#undef PG8_LDA
#undef PG8_LDB
#undef PG8_MMA
#undef PG8_WAIT_V
#undef PG8_WAIT_L
#undef PG8_BAR
#undef PG8_SCHED
}
}

constexpr int DM = 2048, NPB = 16, SEQ = 256, DEPTH = 4, NDB = 4, DSEQ = 4096, PAST = 256;
constexpr int MP = NPB * SEQ, MS = NDB * DSEQ, M = MP + MS;
constexpr int NIN = 4544, NINP = 4608;
constexpr int C_AQ = 0, C_AK = 512, C_AV = 1024, C_BQ = 1536, C_BK = 1920, C_BV = 2304, C_BR = 3072, C_BG = 3840, C_CQ = 3872, C_CKV = 4256, C_CKR = 4512;
constexpr int DFF = 5632, NQC = 576, NQCP = 768, NKV = 1152, NKVP = 1280;
constexpr float EPS = 1e-6f;
constexpr int NOATT = 14 * 128, NOGLA = 2 * 768;
enum { I_XP = 0, I_XS, I_CAK, I_CAV, I_STB, I_CCKV, I_CCKR, I_C, I_CCTX, I_N1G, I_ADAW, I_ADAB, I_WIN, I_LQ1, I_LK1, I_LQ2, I_LK2, I_ANG, I_BGW, I_BGB, I_BNG, I_CQG, I_CQUP, I_CKVG, I_CKVUP, I_WOUT, I_N2G, I_WUP, I_CONVW, I_CONVB, I_WDOWN, I_FING, N_INPUTS };
constexpr size_t O_YP = 0, O_YS = O_YP + (size_t)MP * DM, O_AK = O_YS + (size_t)MS * DM, O_AV = O_AK + (size_t)NPB * DEPTH * SEQ * 512, O_SB = O_AV + (size_t)NPB * DEPTH * SEQ * 512,
                 O_CKV = O_SB + (size_t)NPB * DEPTH * 2 * 6 * 64 * 128, O_CKR = O_CKV + (size_t)NPB * DEPTH * SEQ * 256, O_END = O_CKR + (size_t)NPB * DEPTH * SEQ * 32;
static_assert(O_END == 69730304, "output size");

constexpr size_t al256(size_t x) { return (x + 255) & ~(size_t)255; }
constexpr size_t WS_CTL = 0, CTL_ZERO_BYTES = 2u << 20;
constexpr size_t WS_SSQ = 1u << 20;
constexpr size_t SZ_WIN = (size_t)NINP * DM * 2, SZ_WOUT = (size_t)DM * DM * 2, SZ_WUP = (size_t)2 * DFF * DM * 2, SZ_WDN = (size_t)DM * DFF * 2, SZ_WQ = (size_t)NQCP * 384 * 2, SZ_WKV = (size_t)NKVP * 256 * 2;
constexpr size_t WS_WIN = WS_CTL + CTL_ZERO_BYTES, WS_WOUT = WS_WIN + 4 * SZ_WIN, WS_WUP = WS_WOUT + 4 * SZ_WOUT, WS_WDN = WS_WUP + 4 * SZ_WUP, WS_WQ = WS_WDN + 4 * SZ_WDN, WS_WKV = WS_WQ + 4 * SZ_WQ;
constexpr size_t SZ_MOD = (size_t)DEPTH * 5 * 6 * DM * 4;
constexpr size_t WS_MOD = WS_WKV + 4 * SZ_WKV, WS_MODP = WS_MOD + SZ_MOD, WS_RTA = WS_MODP + 8 * SZ_MOD, WS_RTC = WS_RTA + (size_t)DSEQ * 64 * 4, WS_LAM = WS_RTC + (size_t)DSEQ * 32 * 4;
constexpr size_t WS_CAK = WS_LAM + 256, WS_CAV = WS_CAK + (size_t)NDB * DEPTH * PAST * 512 * 2, WS_CKRX = WS_CAV + (size_t)NDB * DEPTH * PAST * 512 * 2, WS_CKVA = WS_CKRX + (size_t)NDB * DEPTH * PAST * 32 * 2,
                 WS_KVCTX = WS_CKVA + (size_t)DEPTH * NDB * PAST * 256 * 2, WS_SIDE = WS_KVCTX + (size_t)DEPTH * NDB * PAST * NKVP * 2, WS_GM = WS_SIDE + (size_t)(M / 256) * 2 * 3 * DFF * 4, WS_SHWI = WS_GM + (size_t)DEPTH * 2 * 5 * DM * 4,
                 WS_SHWU = WS_SHWI + (size_t)DEPTH * 5 * NINP * 4, WS_SSQP = WS_SHWU + (size_t)DEPTH * 5 * 2 * DFF * 4, WS_X = WS_SSQP + (size_t)8 * M * 32 * 4;
constexpr size_t WS_H = WS_X + (size_t)M * DM * 4, WS_T0 = WS_H + (size_t)M * DM * 2;
constexpr size_t WS_P = WS_T0, WS_MIX = WS_P + (size_t)M * NINP * 2, WS_QC = WS_MIX + (size_t)M * DM * 2, WS_KVC = WS_QC + (size_t)M * NQCP * 2, WS_CQN = WS_KVC + (size_t)M * NKVP * 2, WS_CKVN = WS_CQN + (size_t)M * 384 * 2,
                 WS_KRA = WS_CKVN + (size_t)M * 256 * 2, WS_KRC = WS_KRA + (size_t)MS * 512 * 2, WS_OATT = WS_KRC + (size_t)MS * 32 * 2, WS_OGLA = WS_OATT + (size_t)M * NOATT * 4, WS_GATE = WS_OGLA + (size_t)M * NOGLA * 4,
                 WS_ST = WS_GATE + (size_t)M * 768 * 4, WS_DD = WS_ST + (size_t)(M / 64) * 12 * 8192 * 2, WS_END1 = WS_DD + (size_t)(M / 64) * 12 * 64 * 4;
constexpr size_t WS_U = WS_OGLA, WS_QK4 = WS_GATE;
constexpr size_t WS_GU = WS_T0, WS_ACT = WS_GU + (size_t)M * 2 * DFF * 2, WS_END2 = WS_ACT + (size_t)M * DFF * 2;


static_assert(WS_WIN % 256 == 0 && WS_X % 256 == 0 && WS_H % 256 == 0 && WS_T0 % 256 == 0 && WS_QC % 256 == 0 && WS_KVC % 256 == 0 && WS_CQN % 256 == 0 && WS_CKVN % 256 == 0 && WS_OATT % 256 == 0 && WS_ACT % 256 == 0, "alignment");

constexpr size_t WS_SPLITK = WS_END1 > WS_END2 ? WS_END1 : WS_END2, WS_END3 = WS_SPLITK + (size_t)128 * 2 * 65536 * 4;
constexpr size_t WS_END = WS_END3;
static_assert(WS_END <= (size_t)1536 << 20, "workspace map must fit 4 x the largest tensor");
constexpr int CW_TICKET = 65536;

constexpr int RING_BYTES = 131072, MISC_OFF = RING_BYTES + 320, LDS_BYTES = 147456;

#define GAS __attribute__((address_space(1)))
#define LAS __attribute__((address_space(3)))
typedef unsigned short bf16;
typedef unsigned v4u __attribute__((ext_vector_type(4)));
typedef unsigned v2u __attribute__((ext_vector_type(2)));
typedef float f32x4 __attribute__((ext_vector_type(4)));
#define LDS_WAIT() asm volatile("s_waitcnt lgkmcnt(0)" ::: "memory")
__device__ __forceinline__ unsigned f2bf(float f) { unsigned u = __builtin_bit_cast(unsigned, f); return (u + 0x7fffu + ((u >> 16) & 1u)) >> 16; }
__device__ __forceinline__ unsigned pk2(float lo, float hi) { return f2bf(lo) | (f2bf(hi) << 16); }
__device__ __forceinline__ float bf2f(bf16 b) { return __builtin_bit_cast(float, (unsigned)b << 16); }
__device__ __forceinline__ float wave_sum(float v) {
#pragma unroll
    for (int o = 1; o < 64; o <<= 1) v += __shfl_xor(v, o);
    return v;
}
__device__ __forceinline__ float siluf(float x) { return x / (1.f + __expf(-x)); }

namespace pg8 {
__device__ __forceinline__ void rstd_table(const float* ssq, int pm, PG8_LAS float* rtab, int tid) {
    const int row = tid >> 1, half = tid & 1; const float* p = ssq + ((size_t)(pm * BM + row) * 32 + half * 16);
    const f32x4 a = *(const f32x4*)p, b = *(const f32x4*)(p + 4), c = *(const f32x4*)(p + 8), d = *(const f32x4*)(p + 12);
    float s = (((a[0] + a[1]) + (a[2] + a[3])) + ((b[0] + b[1]) + (b[2] + b[3]))) + (((c[0] + c[1]) + (c[2] + c[3])) + ((d[0] + d[1]) + (d[2] + d[3])));
    s += __shfl_xor(s, 1);
    if (half == 0) rtab[row] = 1.0f / sqrtf(s * (1.f / 2048.f) + 1e-6f);
    asm volatile("s_waitcnt lgkmcnt(0)" ::: "memory"); __builtin_amdgcn_s_barrier(); asm volatile("" ::: "memory");
}
struct EpiResid {
    static constexpr bool PERM = true, AFTER_DRAIN = false;
    const float* xin0; const float* xin1;
    float* out; const float* gate;
    bf16_t* H; const float* gm; float* ssq;
    __device__ __forceinline__ void operator()(const f32x4 (&acc)[2][2][4][2], const Unit& u, int wr, int wc, int fr, int fq) const {
        const int mi = u.pm < 16 ? 0 : 1 + ((u.pm - 16) >> 4);
        const float* gp = gate + (size_t)mi * 6 * 2048; const float* xin = u.pm < 16 ? xin0 : xin1;
        const int col0 = u.pn * BM + wc * 32 + 8 * fq;
        f32x4 gv[2][2], gm4[2][2];
#pragma unroll
        for (int bj = 0; bj < 2; ++bj)
#pragma unroll
            for (int n = 0; n < 2; ++n) { gv[bj][n] = *(const f32x4*)(gp + col0 + bj * HALF + 4 * n); gm4[bj][n] = H ? *(const f32x4*)(gm + (size_t)mi * 2048 + col0 + bj * HALF + 4 * n) : (f32x4){0.f, 0.f, 0.f, 0.f}; }
#pragma unroll
        for (int ai = 0; ai < 2; ++ai)
#pragma unroll
            for (int m = 0; m < 4; ++m) { const int row = u.pm * BM + ai * HALF + wr * 64 + m * 16 + fr; const size_t off = (size_t)row * 2048 + col0; float ss = 0.f;
#pragma unroll
                for (int bj = 0; bj < 2; ++bj) { const f32x4 x0 = *(const f32x4*)(xin + off + bj * HALF), x1 = *(const f32x4*)(xin + off + bj * HALF + 4);
                    const f32x4 y0 = x0 + gv[bj][0] * acc[ai][bj][m][0], y1 = x1 + gv[bj][1] * acc[ai][bj][m][1];
                    *(f32x4*)(out + off + bj * HALF) = y0; *(f32x4*)(out + off + bj * HALF + 4) = y1;
                    ss += ((y0[0] * y0[0] + y0[1] * y0[1]) + (y0[2] * y0[2] + y0[3] * y0[3])) + ((y1[0] * y1[0] + y1[1] * y1[1]) + (y1[2] * y1[2] + y1[3] * y1[3]));
                    if (H) { const f32x4 h0 = y0 * gm4[bj][0], h1 = y1 * gm4[bj][1]; u32x4 w; w.x = cvt_pk_bf16(h0[0], h0[1]); w.y = cvt_pk_bf16(h0[2], h0[3]); w.z = cvt_pk_bf16(h1[0], h1[1]); w.w = cvt_pk_bf16(h1[2], h1[3]);
                        *(u32x4*)(H + off + bj * HALF) = w; } }
                if (H) { ss += __shfl_xor(ss, 16); ss += __shfl_xor(ss, 32); if (fq == 0) ssq[(size_t)row * 32 + u.pn * 4 + wc] = ss; } }
    }
};
struct EpiBf16Norm {
    static constexpr bool PERM = true, AFTER_DRAIN = false;
    bf16_t* O; int ldc; const float* ssq; const float* shw; int shw_ld; PG8_LAS float* rtab;
    static constexpr int qtiles = 2; static constexpr float qscale = 0.125f * 1.4426950408889634f;
    __device__ __forceinline__ void operator()(const f32x4 (&acc)[2][2][4][2], const Unit& u, int wr, int wc, int fr, int fq) const {
        const int mi = u.pm < 16 ? 0 : 1 + ((u.pm - 16) >> 4);
        rstd_table(ssq, u.pm, rtab, (wr * 4 + wc) * 64 + fq * 16 + fr);
        const int row0 = u.pm * BM + wr * 64 + fr, col0 = u.pn * BM + wc * 32 + 8 * fq; const float* sp = shw + (size_t)mi * shw_ld + col0;
        const float qs = u.pn < qtiles ? qscale : 1.f;
        f32x4 sv[2][2];
#pragma unroll
        for (int bj = 0; bj < 2; ++bj)
#pragma unroll
            for (int n = 0; n < 2; ++n) sv[bj][n] = *(const f32x4*)(sp + bj * HALF + 4 * n);
#pragma unroll
        for (int ai = 0; ai < 2; ++ai)
#pragma unroll
            for (int m = 0; m < 4; ++m) { const int row = row0 + ai * HALF + m * 16; const float rs = rtab[row - u.pm * BM];
                bf16_t* rowp = O + (size_t)row * ldc + col0;
#pragma unroll
                for (int bj = 0; bj < 2; ++bj) { const f32x4 v0 = (acc[ai][bj][m][0] * rs + sv[bj][0]) * qs, v1 = (acc[ai][bj][m][1] * rs + sv[bj][1]) * qs;
                    u32x4 w; w.x = cvt_pk_bf16(v0[0], v0[1]); w.y = cvt_pk_bf16(v0[2], v0[3]); w.z = cvt_pk_bf16(v1[0], v1[1]); w.w = cvt_pk_bf16(v1[2], v1[3]);
                    *(u32x4*)(rowp + bj * HALF) = w; } }
    }
};

struct EpiResidTail {
    static constexpr bool PERM = false, AFTER_DRAIN = false;
    float* X; const float* gate; float* scratch; unsigned* ticket; PG8_LAS unsigned* lw;
    __device__ __forceinline__ void operator()(const f32x4 (&acc)[2][2][4][2], const Unit& u, int wr, int wc, int fr, int fq) const {
        const int t = blockIdx.x >> 1, half = blockIdx.x & 1, tid = threadIdx.x;
        { const __amdgpu_buffer_rsrc_t rs = __builtin_amdgcn_make_buffer_rsrc(scratch + ((size_t)t * 2 + half) * 65536, 0, 65536 * 4, 0x00020000);
#pragma unroll
          for (int ai = 0; ai < 2; ++ai)
#pragma unroll
            for (int bj = 0; bj < 2; ++bj)
#pragma unroll
                for (int m = 0; m < 4; ++m)
#pragma unroll
                    for (int n = 0; n < 2; ++n) { const int j = ((ai * 2 + bj) * 4 + m) * 2 + n; __builtin_amdgcn_raw_buffer_store_b128(__builtin_bit_cast(u32x4, acc[ai][bj][m][n]), rs, (j * 512 + tid) * 16, 0, 16); } }
        asm volatile("s_waitcnt vmcnt(0)" ::: "memory"); __builtin_amdgcn_s_barrier(); asm volatile("" ::: "memory");
        if (tid == 0) { const unsigned old = __hip_atomic_fetch_add(ticket + 64 * t, 1u, __ATOMIC_RELAXED, __HIP_MEMORY_SCOPE_AGENT); *lw = old; }
        asm volatile("s_waitcnt vmcnt(0) lgkmcnt(0)" ::: "memory"); __builtin_amdgcn_s_barrier(); asm volatile("" ::: "memory");
        const unsigned old = *lw;
        if (old == 0u) return;
        __builtin_amdgcn_fence(__ATOMIC_ACQUIRE, "agent"); asm volatile("s_waitcnt vmcnt(0)" ::: "memory");
        const float* oth = scratch + ((size_t)t * 2 + (half ^ 1)) * 65536; const float* own = scratch + ((size_t)t * 2 + half) * 65536;
        const int mi = u.pm < 16 ? 0 : 1 + ((u.pm - 16) >> 4);
        const float* gp = gate + (size_t)mi * 6 * 2048;
        const int col0 = u.pn * BM + wc * 32 + 4 * fq;
#pragma unroll
        for (int ai = 0; ai < 2; ++ai)
#pragma unroll
            for (int m = 0; m < 4; ++m) { const size_t off = (size_t)(u.pm * BM + ai * HALF + wr * 64 + m * 16 + fr) * 2048 + col0;
#pragma unroll
                for (int bj = 0; bj < 2; ++bj)
#pragma unroll
                    for (int n = 0; n < 2; ++n) { const int j = ((ai * 2 + bj) * 4 + m) * 2 + n; const f32x4 pv = *(const f32x4*)(oth + (size_t)(j * 512 + tid) * 4) + *(const f32x4*)(own + (size_t)(j * 512 + tid) * 4);
                        const f32x4 gv = *(const f32x4*)(gp + col0 + bj * HALF + n * 16), xv = *(const f32x4*)(X + off + bj * HALF + n * 16);
                        *(f32x4*)(X + off + bj * HALF + n * 16) = xv + gv * pv; }
                asm volatile("" ::: "memory"); }
    }
};

__device__ __forceinline__ float dpp_ror1(float x) { return __builtin_bit_cast(float, __builtin_amdgcn_update_dpp(__builtin_bit_cast(int, x), __builtin_bit_cast(int, x), 0x121, 0xf, 0xf, false)); }
__device__ __forceinline__ float dpp_rol1(float x) { return __builtin_bit_cast(float, __builtin_amdgcn_update_dpp(__builtin_bit_cast(int, x), __builtin_bit_cast(int, x), 0x12F, 0xf, 0xf, false)); }
struct EpiConvAct {
    static constexpr bool PERM = true, AFTER_DRAIN = false;
    bf16_t* ACT; const float* cw; const float* cb; float* side; PG8_LAS float* ex;
    const float* ssq; const float* shw; PG8_LAS float* rtab;
    __device__ __forceinline__ void operator()(const f32x4 (&acc_)[2][2][4][2], const Unit& u, int wr, int wc, int fr, int fq) const {
        constexpr int FF = 5632;
        const int colw = wc * 32 + 8 * fq, j0 = u.pn * HALF + colw;
        f32x4 (&acc)[2][2][4][2] = const_cast<f32x4 (&)[2][2][4][2]>(acc_);
        rstd_table(ssq, u.pm, rtab, (wr * 4 + wc) * 64 + fq * 16 + fr);
        { const int mi = u.pm < 16 ? 0 : 1 + ((u.pm - 16) >> 4); const float* sp = shw + (size_t)mi * (2 * FF) + u.pn * BM + colw;
          f32x4 sv[2][2];
#pragma unroll
          for (int bj = 0; bj < 2; ++bj)
#pragma unroll
              for (int n = 0; n < 2; ++n) sv[bj][n] = *(const f32x4*)(sp + bj * HALF + 4 * n);
#pragma unroll
          for (int ai = 0; ai < 2; ++ai)
#pragma unroll
              for (int m = 0; m < 4; ++m) { const int row = u.pm * BM + ai * HALF + wr * 64 + m * 16 + fr; const float rs = rtab[row - u.pm * BM];
#pragma unroll
                  for (int bj = 0; bj < 2; ++bj)
#pragma unroll
                      for (int n = 0; n < 2; ++n) acc[ai][bj][m][n] = acc[ai][bj][m][n] * rs + sv[bj][n]; } }
        float w0[8], w1[8], w2[8], bb[8];
#pragma unroll
        for (int q = 0; q < 2; ++q) { const f32x4 a0 = *(const f32x4*)(cw + j0 + 4 * q), a1 = *(const f32x4*)(cw + FF + j0 + 4 * q), a2 = *(const f32x4*)(cw + 2 * FF + j0 + 4 * q), a3 = *(const f32x4*)(cb + j0 + 4 * q);
#pragma unroll
            for (int i = 0; i < 4; ++i) { w0[4 * q + i] = a0[i]; w1[4 * q + i] = a1[i]; w2[4 * q + i] = a2[i]; bb[4 * q + i] = a3[i]; } }
#pragma unroll
        for (int ai = 0; ai < 2; ++ai) { const int blk = 2 * ai + wr;
            if (fr == 0) {
#pragma unroll
                for (int n = 0; n < 2; ++n) *(PG8_LAS f32x4*)(ex + (blk * 2 + 0) * HALF + colw + 4 * n) = acc[ai][0][0][n]; }
            if (fr == 15) {
#pragma unroll
                for (int n = 0; n < 2; ++n) *(PG8_LAS f32x4*)(ex + (blk * 2 + 1) * HALF + colw + 4 * n) = acc[ai][0][3][n]; } }
        asm volatile("s_waitcnt lgkmcnt(0)" ::: "memory"); __builtin_amdgcn_s_barrier(); asm volatile("" ::: "memory");
#pragma unroll
        for (int ai = 0; ai < 2; ++ai) { const int blk = 2 * ai + wr;
#pragma unroll
            for (int m = 0; m < 4; ++m) { float ov[8]; float gcv[8]; float pe[8], ne[8];
                if (m == 0) {
#pragma unroll
                    for (int n = 0; n < 2; ++n) { const f32x4 p4 = blk > 0 ? *(const PG8_LAS f32x4*)(ex + ((blk - 1) * 2 + 1) * HALF + colw + 4 * n) : (f32x4){0.f, 0.f, 0.f, 0.f};
#pragma unroll
                        for (int i = 0; i < 4; ++i) pe[4 * n + i] = p4[i]; } }
                if (m == 3) {
#pragma unroll
                    for (int n = 0; n < 2; ++n) { const f32x4 n4 = blk < 3 ? *(const PG8_LAS f32x4*)(ex + ((blk + 1) * 2 + 0) * HALF + colw + 4 * n) : (f32x4){0.f, 0.f, 0.f, 0.f};
#pragma unroll
                        for (int i = 0; i < 4; ++i) ne[4 * n + i] = n4[i]; } }
#pragma unroll
                for (int k = 0; k < 8; ++k) { const int n = k >> 2, i = k & 3; const float g = acc[ai][0][m][n][i];
                    const float rs = dpp_ror1(g), ls = dpp_rol1(g);
                    const float rp = m > 0 ? dpp_ror1(acc[ai][0][m > 0 ? m - 1 : 0][n][i]) : pe[k];
                    const float ln = m < 3 ? dpp_rol1(acc[ai][0][m < 3 ? m + 1 : 3][n][i]) : ne[k];
                    const float gp = fr > 0 ? rs : rp, gn = fr < 15 ? ls : ln;
                    const float gc = w0[k] * gp + w1[k] * g + w2[k] * gn + bb[k];
                    gcv[k] = gc; ov[k] = gc * __builtin_amdgcn_rcpf(1.f + __expf(-gc)) * acc[ai][1][m][n][i]; }
                const int row = u.pm * BM + ai * HALF + wr * 64 + m * 16 + fr;
                u32x4 w; w.x = cvt_pk_bf16(ov[0], ov[1]); w.y = cvt_pk_bf16(ov[2], ov[3]); w.z = cvt_pk_bf16(ov[4], ov[5]); w.w = cvt_pk_bf16(ov[6], ov[7]);
                *(u32x4*)(ACT + (size_t)row * FF + j0) = w;
                const bool first = (ai == 0 && m == 0) && wr == 0 && fr == 0, last = (ai == 1 && m == 3) && wr == 1 && fr == 15;
                if ((ai == 0 && m == 0) || (ai == 1 && m == 3)) { if (first || last) { float* sp = side + ((size_t)(u.pm * 2 + (last ? 1 : 0)) * 3) * FF + j0;
#pragma unroll
                    for (int n = 0; n < 2; ++n) { *(f32x4*)(sp + 4 * n) = (f32x4){gcv[4 * n], gcv[4 * n + 1], gcv[4 * n + 2], gcv[4 * n + 3]}; *(f32x4*)(sp + FF + 4 * n) = acc[ai][1][m][n]; *(f32x4*)(sp + 2 * FF + 4 * n) = acc[ai][0][m][n]; } } }
            } }
    }
};
}

#define XB_TMO      128
#define XB_XCNT(j)  (256  + 64 * (j))
#define XB_XSUB(j)  (1280 + 64 * (j))
#define XB_XGEN(j)  (2304 + 64 * (j))
#define XB_TOP      3328
#define XB_TOPGEN   3392
#define XCD_BAR_WORDS 3456
#define XB_SPIN_CAP (1u << 18)
__device__ __forceinline__ unsigned xb_ld(unsigned* p)              { return __hip_atomic_load(p, __ATOMIC_RELAXED, __HIP_MEMORY_SCOPE_AGENT); }
__device__ __forceinline__ unsigned xb_add(unsigned* p, unsigned v) { return __hip_atomic_fetch_add(p, v, __ATOMIC_RELAXED, __HIP_MEMORY_SCOPE_AGENT); }
__device__ __forceinline__ unsigned xb_xcc_id() { return (unsigned)__builtin_amdgcn_s_getreg((3 << 11) | 20) & 0xFu; }
#define XB_SPIN(cond, bar) do { unsigned _sp = 0; while (cond) { __builtin_amdgcn_s_sleep(1); \
    if ((++_sp & 255u) == 0u) { if (xb_ld(&(bar)[XB_TMO])) break; if (_sp > XB_SPIN_CAP) { atomicAdd(&(bar)[XB_TMO], 1u); break; } } } } while (0)
struct XcdBarrier { unsigned* bar; unsigned x; volatile LAS unsigned* st; };
__device__ __forceinline__ XcdBarrier xcd_barrier_post(unsigned* bar, volatile LAS unsigned* st) {
    XcdBarrier b; b.bar = bar; b.x = xb_xcc_id(); b.st = st;
    if (threadIdx.x == 0) (void)xb_add(&bar[XB_XCNT(b.x)], 1u);
    return b;
}
__device__ __forceinline__ void xcd_barrier_complete(unsigned* bar, unsigned x, unsigned& nloc, unsigned& nx) {
    const unsigned G = gridDim.x * gridDim.y * gridDim.z;
    unsigned sum, cnt, mine, sp = 0u;
    for (;;) {
        sum = 0u; cnt = 0u; mine = 0u;
#pragma unroll
        for (unsigned j = 0; j < 16; ++j) { const unsigned c = xb_ld(&bar[XB_XCNT(j)]); sum += c; cnt += (c > 0u) ? 1u : 0u; mine = (j == x) ? c : mine; }
        if (sum == G) break;
        __builtin_amdgcn_s_sleep(1);
        if ((++sp & 255u) == 0u) { if (xb_ld(&bar[XB_TMO])) break; if (sp > XB_SPIN_CAP) { atomicAdd(&bar[XB_TMO], 1u); break; } }
    }
    nloc = mine > 0u ? mine : 1u; nx = cnt > 0u ? cnt : 1u;
}
__device__ __forceinline__ void xcd_barrier(const XcdBarrier& b, int tid) {
    asm volatile("s_waitcnt vmcnt(0)" ::: "memory");
    __syncthreads();
    if (tid == 0) {
        unsigned* bar = b.bar;
        __builtin_amdgcn_s_waitcnt(0);
        unsigned nloc = b.st[0], nx = b.st[1];
        if (nloc == 0u) { xcd_barrier_complete(bar, b.x, nloc, nx); b.st[0] = nloc; b.st[1] = nx; }
        const unsigned old = xb_add(&bar[XB_XSUB(b.x)], 1u);
        const unsigned gen = old / nloc;
        if (old + 1u == (gen + 1u) * nloc) {
            __builtin_amdgcn_fence(__ATOMIC_RELEASE, "agent");
            asm volatile("s_waitcnt vmcnt(0)" ::: "memory");
            const unsigned og = xb_add(&bar[XB_TOP], 1u);
            const unsigned tg = og / nx;
            if (og + 1u == (tg + 1u) * nx) xb_add(&bar[XB_TOPGEN], 1u);
            else XB_SPIN(xb_ld(&bar[XB_TOPGEN]) == tg, bar);
            __builtin_amdgcn_fence(__ATOMIC_ACQUIRE, "agent");
            xb_add(&bar[XB_XGEN(b.x)], 1u);
            asm volatile("s_waitcnt vmcnt(0)" ::: "memory");
        } else {
            XB_SPIN(xb_ld(&bar[XB_XGEN(b.x)]) == gen, bar);
            __builtin_amdgcn_fence(__ATOMIC_ACQUIRE, "agent");
            asm volatile("s_waitcnt vmcnt(0)" ::: "memory");
        }
    }
    __syncthreads();
}

#ifndef MK_MFMA_ATT
#define MK_MFMA_ATT 1
#endif
#ifndef MK_MFMA_GLA
#define MK_MFMA_GLA 1
#endif
#ifndef MK_SPLITK
#define MK_SPLITK 0
#endif
constexpr int NWV = 8, NTH = 512;

template <bool UPMAP = false>
__device__ __forceinline__ void transpose_item(const float* W, int K, int N, bf16* WT, LAS float* scr, int item, int lane) {
    const int nblk = N / 32, kb = item / nblk, nb = item % nblk, k0 = 64 * kb, n0 = 32 * nb;
    const int nd0 = UPMAP ? (n0 < DFF ? 256 * (n0 >> 7) + (n0 & 127) : 256 * ((n0 - DFF) >> 7) + 128 + ((n0 - DFF) & 127)) : n0;
    float wv[32];
#pragma unroll
    for (int i = 0; i < 32; ++i) wv[i] = __builtin_nontemporal_load(W + (size_t)(k0 + 2 * i + (lane >> 5)) * N + n0 + (lane & 31));
#pragma unroll
    for (int i = 0; i < 32; ++i) scr[(2 * i + (lane >> 5)) * 33 + (lane & 31)] = wv[i];
    LDS_WAIT(); asm volatile("" ::: "memory");
    const int c = lane & 7;
#pragma unroll
    for (int j = 0; j < 4; ++j) { const int n = (lane >> 3) + 8 * j; const LAS float* s = scr + (8 * c) * 33 + n;
        v4u o; o.x = pk2(s[0 * 33], s[1 * 33]); o.y = pk2(s[2 * 33], s[3 * 33]); o.z = pk2(s[4 * 33], s[5 * 33]); o.w = pk2(s[6 * 33], s[7 * 33]);
        *(v4u*)(WT + (size_t)(nd0 + n) * K + k0 + 8 * c) = o; }
    LDS_WAIT(); asm volatile("" ::: "memory");
}

struct Args { const float* in[N_INPUTS]; float* out; unsigned char* ws; int ph_lo, ph_hi, use_bar, pad; };

__device__ __forceinline__ void pro0_phase(const Args& a, LAS unsigned char* lds, int tid, int lane, int wave, int bid, int G) {
    unsigned char* ws = a.ws;
    const int gw = bid * NWV + wave, NGW = G * NWV;
    LAS float* scr = (LAS float*)(lds + wave * 16384);
    constexpr int IT_IN = (DM / 64) * (NIN / 32), IT_OUT = (DM / 64) * (DM / 32), IT_UP = (DM / 64) * (2 * DFF / 32), IT_DN = (DFF / 64) * (DM / 32), IT_Q = (384 / 64) * (NQC / 32), IT_KV = (256 / 64) * (NKV / 32);
    constexpr int IT_L = IT_IN + IT_OUT + IT_UP + IT_DN + IT_Q + IT_KV;
    for (int it = gw; it < DEPTH * IT_L; it += NGW) {
        const int l = it / IT_L; int r = it % IT_L;
        if (r < IT_IN) { transpose_item(a.in[I_WIN] + (size_t)l * DM * NIN, DM, NIN, (bf16*)(ws + WS_WIN + l * SZ_WIN), scr, r, lane); continue; } r -= IT_IN;
        if (r < IT_OUT) { transpose_item(a.in[I_WOUT] + (size_t)l * DM * DM, DM, DM, (bf16*)(ws + WS_WOUT + l * SZ_WOUT), scr, r, lane); continue; } r -= IT_OUT;
        if (r < IT_UP) { transpose_item<true>(a.in[I_WUP] + (size_t)l * DM * 2 * DFF, DM, 2 * DFF, (bf16*)(ws + WS_WUP + l * SZ_WUP), scr, r, lane); continue; } r -= IT_UP;
        if (r < IT_DN) { transpose_item(a.in[I_WDOWN] + (size_t)l * DFF * DM, DFF, DM, (bf16*)(ws + WS_WDN + l * SZ_WDN), scr, r, lane); continue; } r -= IT_DN;
        if (r < IT_Q) { transpose_item(a.in[I_CQUP] + (size_t)l * 384 * NQC, 384, NQC, (bf16*)(ws + WS_WQ + l * SZ_WQ), scr, r, lane); continue; } r -= IT_Q;
        transpose_item(a.in[I_CKVUP] + (size_t)l * 256 * NKV, 256, NKV, (bf16*)(ws + WS_WKV + l * SZ_WKV), scr, r, lane);
    }
    const int gt = bid * NTH + tid, NGT = G * NTH;
    for (int i = gt; i < DEPTH * (NINP - NIN) * DM / 8; i += NGT) { const int l = i / ((NINP - NIN) * DM / 8), r = i % ((NINP - NIN) * DM / 8); *(v4u*)(ws + WS_WIN + l * SZ_WIN + (size_t)NIN * DM * 2 + (size_t)r * 16) = (v4u){0u, 0u, 0u, 0u}; }
    for (int i = gt; i < DEPTH * (NQCP - NQC) * 384 / 8; i += NGT) { const int l = i / ((NQCP - NQC) * 384 / 8), r = i % ((NQCP - NQC) * 384 / 8); *(v4u*)(ws + WS_WQ + l * SZ_WQ + (size_t)NQC * 384 * 2 + (size_t)r * 16) = (v4u){0u, 0u, 0u, 0u}; }
    for (int i = gt; i < DEPTH * (NKVP - NKV) * 256 / 8; i += NGT) { const int l = i / ((NKVP - NKV) * 256 / 8), r = i % ((NKVP - NKV) * 256 / 8); *(v4u*)(ws + WS_WKV + l * SZ_WKV + (size_t)NKV * 256 * 2 + (size_t)r * 16) = (v4u){0u, 0u, 0u, 0u}; }
    {
        LAS float* sc = (LAS float*)lds;
        __syncthreads();
        for (int it = bid; it < DEPTH * 24 * 8; it += G) {
            const int l = it / 192, cb = (it / 8) % 24, ks = it % 8;
            __syncthreads();
            for (int e = tid; e < 5 * 256; e += NTH) { const int mi = e >> 8, k = ks * 256 + (e & 255); const float cv = mi == 0 ? a.in[I_CCTX][k] : a.in[I_C][(mi - 1) * DM + k]; sc[e] = cv / (1.f + expf(-cv)); }
            __syncthreads();
            const float* wp = a.in[I_ADAW] + ((size_t)l * DM + ks * 256) * (6 * DM) + cb * 512 + tid;
            float s0 = 0.f, s1 = 0.f, s2 = 0.f, s3 = 0.f, s4 = 0.f;
#pragma unroll 8
            for (int k = 0; k < 256; ++k) { const float w = __builtin_nontemporal_load(wp + (size_t)k * (6 * DM)); s0 += sc[k] * w; s1 += sc[256 + k] * w; s2 += sc[512 + k] * w; s3 += sc[768 + k] * w; s4 += sc[1024 + k] * w; }
            float* mp = (float*)(ws + WS_MODP) + ((size_t)ks * DEPTH + l) * 5 * 6 * DM + cb * 512 + tid;
            mp[0] = s0; mp[6 * DM] = s1; mp[2 * 6 * DM] = s2; mp[3 * 6 * DM] = s3; mp[4 * 6 * DM] = s4;
        }
        __syncthreads();
    }
    { const float* s = a.in[I_CAK]; bf16* d = (bf16*)(ws + WS_CAK); for (int i = gt; i < NDB * DEPTH * PAST * 512; i += NGT) d[i] = (bf16)f2bf(s[i]); }
    { const float* s = a.in[I_CAV]; bf16* d = (bf16*)(ws + WS_CAV); for (int i = gt; i < NDB * DEPTH * PAST * 512; i += NGT) d[i] = (bf16)f2bf(s[i]); }
    { const float* s = a.in[I_CCKR]; bf16* d = (bf16*)(ws + WS_CKRX); for (int i = gt; i < NDB * DEPTH * PAST * 32; i += NGT) d[i] = (bf16)f2bf(s[i]); }
    { const float* s = a.in[I_CCKV]; bf16* d = (bf16*)(ws + WS_CKVA);
      for (int i = gt; i < NDB * DEPTH * PAST * 256; i += NGT) { const int c = i & 255, j = (i >> 8) & 255, bl = i >> 16, b = bl >> 2, l = bl & 3; d[(((size_t)l * NDB + b) * PAST + j) * 256 + c] = (bf16)f2bf(s[i]); } }
    { float* ra = (float*)(ws + WS_RTA); float* rc = (float*)(ws + WS_RTC);
      for (int i = gt; i < DSEQ * 16; i += NGT) { const int t = i >> 4, j = i & 15; const float inv = powf(10000.f, -(float)j / 16.f); const float ar = (float)(t >> 6) * inv, ac = (float)(t & 63) * inv;
          ra[t * 64 + j] = cosf(ar); ra[t * 64 + 16 + j] = sinf(ar); ra[t * 64 + 32 + j] = cosf(ac); ra[t * 64 + 48 + j] = sinf(ac); }
      for (int i = gt; i < DSEQ * 8; i += NGT) { const int t = i >> 3, j = i & 7; const float inv = powf(10000.f, -(float)j / 8.f); const float ar = (float)(t >> 6) * inv, ac = (float)(t & 63) * inv;
          rc[t * 32 + j] = cosf(ar); rc[t * 32 + 8 + j] = sinf(ar); rc[t * 32 + 16 + j] = cosf(ac); rc[t * 32 + 24 + j] = sinf(ac); } }
    if (gt < DEPTH) { const int l = gt; float d1 = 0.f, d2 = 0.f;
        for (int i = 0; i < 64; ++i) { d1 += a.in[I_LQ1][l * 64 + i] * a.in[I_LK1][l * 64 + i]; d2 += a.in[I_LQ2][l * 64 + i] * a.in[I_LK2][l * 64 + i]; }
        const float li = 0.8f - 0.6f * expf(-0.3f * (float)l);
        float* lam = (float*)(ws + WS_LAM); lam[l] = expf(d1) - expf(d2) + li; lam[4 + l] = li; }
}

__device__ __forceinline__ void modfin_phase(const Args& a, int gt, int NGT) {
    const float* mp = (const float*)(a.ws + WS_MODP); float* mo = (float*)(a.ws + WS_MOD);
    for (int i = gt; i < DEPTH * 5 * 6 * DM; i += NGT) { const int l = i / (5 * 6 * DM), n = i % (6 * DM); float s = a.in[I_ADAB][l * 6 * DM + n];
#pragma unroll
        for (int ks = 0; ks < 8; ++ks) s += mp[(size_t)ks * DEPTH * 5 * 6 * DM + i];
        mo[i] = s; }
}


namespace att {
using bf16x8 = __attribute__((ext_vector_type(8))) short;
using s16x4  = __attribute__((ext_vector_type(4))) short;
using f32x16 = __attribute__((ext_vector_type(16))) float;
using u32x4  = __attribute__((ext_vector_type(4))) unsigned;
constexpr int SHM_V = 64 * 128 * 2;
#define ATT_SBAR() __builtin_amdgcn_sched_barrier(0)
#define ATT_LBAR() asm volatile("s_waitcnt lgkmcnt(0)\n\ts_barrier" ::: "memory")
__device__ __forceinline__ int crow(int r, int hi) { return (r & 3) + 8 * (r >> 2) + 4 * hi; }
__device__ __forceinline__ float max3f(float a, float b, float c) { return fmaxf(fmaxf(a, b), c); }
__device__ __forceinline__ float max2f(float a, float b) { return fmaxf(a, b); }
__device__ __forceinline__ unsigned cvtpk(float lo, float hi) { unsigned r; asm volatile("v_cvt_pk_bf16_f32 %0, %1, %2" : "=v"(r) : "v"(lo), "v"(hi)); return r; }
template <bool TUP> __device__ __forceinline__ void partialSM(f32x16& p0, f32x16& p1, float& m_reg, f32x16& negm, float& alpha, float thr, bool first, float pmax) {
  if constexpr (!TUP) {
    typedef float f32x2 __attribute__((ext_vector_type(2))); const f32x2 M2 = {-m_reg, -m_reg};
#pragma unroll
    for (int r = 0; r < 16; r += 2) { f32x2 v = {p0[r], p0[r + 1]}; v += M2; p0[r] = v.x; p0[r + 1] = v.y; f32x2 w = {p1[r], p1[r + 1]}; w += M2; p1[r] = w.x; p1[r + 1] = w.y; }
    pmax -= m_reg; }
  { auto rr = __builtin_amdgcn_permlane32_swap(__float_as_uint(pmax), __float_as_uint(pmax), false, false);
    pmax = max2f(__uint_as_float(rr[0]), __uint_as_float(rr[1])); }
  if (__builtin_expect(!first && __all(pmax <= thr), 1)) { alpha = 1.f; }
  else { const float delta = first ? pmax : max2f(pmax, 0.f); alpha = __builtin_amdgcn_exp2f(-delta); m_reg += delta;
#pragma unroll
    for (int r = 0; r < 16; ++r) { p0[r] -= delta; p1[r] -= delta; }
    if constexpr (TUP) { const float nm = -m_reg;
#pragma unroll
      for (int r = 0; r < 16; ++r) negm[r] = nm;
      asm volatile("" : "+v"(negm)); } }
}
__device__ __forceinline__ void finishSM(f32x16& p0, f32x16& p1, float alpha, float& l_reg, bf16x8& pa0, bf16x8& pa1, bf16x8& pa2, bf16x8& pa3) {
  float ps;
  { typedef float f32x2 __attribute__((ext_vector_type(2))); f32x2 s2 = {p0[0], p0[1]};
#pragma unroll
    for (int r = 2; r < 16; r += 2) s2 += (f32x2){p0[r], p0[r + 1]};
#pragma unroll
    for (int r = 0; r < 16; r += 2) s2 += (f32x2){p1[r], p1[r + 1]};
    ps = s2.x + s2.y; }
  { auto rr = __builtin_amdgcn_permlane32_swap(__float_as_uint(ps), __float_as_uint(ps), false, false);
    ps = __uint_as_float(rr[0]) + __uint_as_float(rr[1]); }
  l_reg = l_reg * alpha + ps;
#define ATT_PKD(P, BASE) __builtin_bit_cast(bf16x8, (u32x4){cvtpk(P[BASE + 0], P[BASE + 1]), cvtpk(P[BASE + 2], P[BASE + 3]), cvtpk(P[BASE + 4], P[BASE + 5]), cvtpk(P[BASE + 6], P[BASE + 7])})
  pa0 = ATT_PKD(p0, 0); pa1 = ATT_PKD(p0, 8); pa2 = ATT_PKD(p1, 0); pa3 = ATT_PKD(p1, 8);
#undef ATT_PKD
}
template <int DQK, bool TUP>
__device__ __forceinline__ void qkt(f32x16& p0, f32x16& p1, const LAS unsigned char* Ks, const bf16x8* qr, int r32, int hi, const f32x16& negm) {
  constexpr int RS = DQK * 2 + 16;
  if constexpr (TUP) { p0 = negm; p1 = negm; } else { p0 = f32x16{}; p1 = f32x16{}; }
#pragma unroll
  for (int d0 = 0; d0 < DQK / 16; ++d0) { const int cb = d0 * 32 + hi * 16;
    const bf16x8 b0 = *(const LAS bf16x8*)(Ks + r32 * RS + cb);
    const bf16x8 b1 = *(const LAS bf16x8*)(Ks + (32 + r32) * RS + cb);
    p0 = __builtin_amdgcn_mfma_f32_32x32x16_bf16(b0, qr[d0], p0, 0, 0, 0);
    p1 = __builtin_amdgcn_mfma_f32_32x32x16_bf16(b1, qr[d0], p1, 0, 0, 0); }
}
__device__ __forceinline__ int v_st(int k, int c) { const int kk = (k & ~0xC) | ((k & 4) << 1) | ((k & 8) >> 1); return ((kk >> 3) * 4 + (c >> 5)) * 512 + ((kk & 7) * 32 + (c & 31)) * 2; }
__device__ __forceinline__ int v_rd_base(int lane) { return ((lane & 3) << 3) | (((lane >> 2) & 3) << 6) | (((lane >> 4) & 1) << 5) | (((lane >> 5) & 1) << 8); }
constexpr int v_rd_off(int d0, int ks, int half) { return d0 * 512 + ks * 4096 + half * 2048; }
__device__ __forceinline__ int v_st_n(int k, int c) { return (c >> 5) * 4096 + k * 64 + (c & 31) * 2; }
__device__ __forceinline__ int v_rd_base_n(int lane) { return ((lane >> 4) & 1) * 32 + (lane & 3) * 8 + (4 * (lane >> 5) + ((lane & 15) >> 2)) * 64; }
constexpr int v_rd_off_n(int d0, int ks, int half) { return d0 * 4096 + ks * 1024 + half * 512; }
template <int OFF> __device__ __forceinline__ s16x4 tr_read(int vb) {
  s16x4 r; asm volatile("ds_read_b64_tr_b16 %0, %1 offset:%2" : "=&v"(r) : "v"(vb), "i"(OFF) : "memory"); return r;
}
template <int D0, bool EX> __device__ __forceinline__ void pv_one(f32x16& od, int vb, bf16x8 pa0, bf16x8 pa1, bf16x8 pa2, bf16x8 pa3, f32x16& s) {
  const s16x4 l0 = tr_read<v_rd_off_n(D0, 0, 0)>(vb), h0 = tr_read<v_rd_off_n(D0, 0, 1)>(vb), l1 = tr_read<v_rd_off_n(D0, 1, 0)>(vb), h1 = tr_read<v_rd_off_n(D0, 1, 1)>(vb);
  const s16x4 l2 = tr_read<v_rd_off_n(D0, 2, 0)>(vb), h2 = tr_read<v_rd_off_n(D0, 2, 1)>(vb), l3 = tr_read<v_rd_off_n(D0, 3, 0)>(vb), h3 = tr_read<v_rd_off_n(D0, 3, 1)>(vb);
  asm volatile("s_waitcnt lgkmcnt(0)" ::: "memory"); ATT_SBAR();
#define ATT_PK(L, H) (bf16x8){L[0], L[1], L[2], L[3], H[0], H[1], H[2], H[3]}
  constexpr int B = (D0 & 1) * 8;
  od = __builtin_amdgcn_mfma_f32_32x32x16_bf16(pa0, ATT_PK(l0, h0), od, 0, 0, 0);
  if constexpr (EX) { s[B] = __builtin_amdgcn_exp2f(s[B]); s[B + 1] = __builtin_amdgcn_exp2f(s[B + 1]); }
  od = __builtin_amdgcn_mfma_f32_32x32x16_bf16(pa1, ATT_PK(l1, h1), od, 0, 0, 0);
  if constexpr (EX) { s[B + 2] = __builtin_amdgcn_exp2f(s[B + 2]); s[B + 3] = __builtin_amdgcn_exp2f(s[B + 3]); }
  od = __builtin_amdgcn_mfma_f32_32x32x16_bf16(pa2, ATT_PK(l2, h2), od, 0, 0, 0);
  if constexpr (EX) { s[B + 4] = __builtin_amdgcn_exp2f(s[B + 4]); s[B + 5] = __builtin_amdgcn_exp2f(s[B + 5]); }
  od = __builtin_amdgcn_mfma_f32_32x32x16_bf16(pa3, ATT_PK(l3, h3), od, 0, 0, 0);
  if constexpr (EX) { s[B + 6] = __builtin_amdgcn_exp2f(s[B + 6]); s[B + 7] = __builtin_amdgcn_exp2f(s[B + 7]); asm volatile("" : "+v"(s)); }
#undef ATT_PK
}
__device__ __forceinline__ void pv_ex(f32x16* o, int vb, bf16x8 pa0, bf16x8 pa1, bf16x8 pa2, bf16x8 pa3, f32x16& s0, f32x16& s1) {
  pv_one<0, true>(o[0], vb, pa0, pa1, pa2, pa3, s0); pv_one<1, true>(o[1], vb, pa0, pa1, pa2, pa3, s0); pv_one<2, true>(o[2], vb, pa0, pa1, pa2, pa3, s1); pv_one<3, true>(o[3], vb, pa0, pa1, pa2, pa3, s1);
}
__device__ __forceinline__ void pv_last(f32x16* o, int vb, bf16x8 pa0, bf16x8 pa1, bf16x8 pa2, bf16x8 pa3) { f32x16 z = {};
  pv_one<0, false>(o[0], vb, pa0, pa1, pa2, pa3, z); pv_one<1, false>(o[1], vb, pa0, pa1, pa2, pa3, z); pv_one<2, false>(o[2], vb, pa0, pa1, pa2, pa3, z); pv_one<3, false>(o[3], vb, pa0, pa1, pa2, pa3, z); }
__device__ __forceinline__ float rowmax32(const f32x16& p0, const f32x16& p1) {
  float a = max3f(p0[0], p0[1], p1[0]), b = max3f(p0[2], p0[3], p1[1]); a = max3f(a, p1[2], p1[3]);
#pragma unroll
  for (int r = 4; r < 16; r += 4) { a = max3f(a, p0[r], p0[r + 1]); b = max3f(b, p0[r + 2], p0[r + 3]); a = max3f(a, p1[r], p1[r + 1]); b = max3f(b, p1[r + 2], p1[r + 3]); }
  return max2f(a, b);
}
__device__ __forceinline__ float bfe(bf16x8 v, int e) { return __builtin_bit_cast(float, (unsigned)(unsigned short)v[e] << 16); }
}

struct KSeg { const bf16* kn; int ldn; const bf16* kr; int ldr; const bf16* v; int ldv; int n; };

template <int DQK, int SD, bool OUTBF>
__device__ __forceinline__ void attn_mfma_unit(LAS unsigned char* lds, const bf16* Qp, int ldq, bool rot, const float* rt, int t0, const KSeg& ctx, const KSeg& lat, float scale, void* Opv, int tid,
                                               bool fin = false, float lam = 0.f, float gsc = 0.f, const float* ag = nullptr, bf16* Mx = nullptr) {
  using namespace att;
  constexpr int NF = DQK / 16, RS = DQK * 2 + 16, SHM_K = 64 * RS;
  const int wid = tid >> 6, lane = tid & 63, r32 = lane & 31, hi = lane >> 5;
  constexpr int NSL = 3;
  LAS unsigned char* V_lds = lds; LAS unsigned char* K_lds = lds + NSL * SHM_V;
  LAS float* wsf = (LAS float*)(lds + NSL * SHM_V + NSL * SHM_K) + wid * 64; LAS float* li_l = wsf; LAS float* al_l = wsf + 32;
  (void)scale;
  const float thr = 8.f * 1.4426950408889634f;
  float m_reg = 0.f, l_reg = 0; f32x16 negm = {}; f32x16 o[4] = {}; bf16x8 qr[NF];
  const bf16* Qw = Qp + (size_t)(wid * 32 + r32) * ldq + hi * 8;
#pragma unroll
  for (int d0 = 0; d0 < NF; ++d0) qr[d0] = *reinterpret_cast<const bf16x8*>(Qw + d0 * 16);
  const int sr = tid >> 4, sc = (tid & 15) * 8, vst0 = v_st_n(sr, sc), vst1 = v_st_n(32 + sr, sc);
  const int krow = tid >> 3, kch = tid & 7, xrow = tid >> 2, xch = tid & 3; const bool xld = (DQK == 96) && tid < 256;
  const int vb0 = (int)(unsigned)(uintptr_t)V_lds + v_rd_base_n(lane);
  const int nct = ctx.n >> 6, NT = nct + (lat.n >> 6);
  struct { bf16x8 vs0, vs1, kn, kx; } st;
#define ATT_SLOAD(j) do { const int j_ = (j); const bool c_ = j_ < nct; const KSeg& S_ = c_ ? ctx : lat; const int k0_ = (c_ ? j_ : j_ - nct) * 64; \
    st.vs0 = *reinterpret_cast<const bf16x8*>(S_.v + (size_t)(k0_ + sr) * S_.ldv + sc); st.vs1 = *reinterpret_cast<const bf16x8*>(S_.v + (size_t)(k0_ + 32 + sr) * S_.ldv + sc); \
    st.kn = *reinterpret_cast<const bf16x8*>(S_.kn + (size_t)(k0_ + krow) * S_.ldn + kch * 8); \
    if (xld) st.kx = *reinterpret_cast<const bf16x8*>(S_.kr + (size_t)(k0_ + xrow) * S_.ldr + xch * 8); } while (0)
#define ATT_SWRITE(b) do { *(LAS bf16x8*)(V_lds + (b) * SHM_V + vst0) = st.vs0; *(LAS bf16x8*)(V_lds + (b) * SHM_V + vst1) = st.vs1; \
    *(LAS bf16x8*)(K_lds + (b) * SHM_K + krow * RS + kch * 16) = st.kn; \
    if (xld) *(LAS bf16x8*)(K_lds + (b) * SHM_K + xrow * RS + 128 + xch * 16) = st.kx; } while (0)
#define ATT_SWAIT() asm volatile("s_waitcnt vmcnt(0)" ::: "memory")
#define ATT_RESC(a) do { if (__any((a) < 1.f)) { if (hi == 0) al_l[r32] = (a); asm volatile("s_waitcnt lgkmcnt(0)" ::: "memory"); \
    _Pragma("unroll") for (int d = 0; d < 4; ++d) _Pragma("unroll") for (int r = 0; r < 16; ++r) o[d][r] *= al_l[crow(r, hi)]; } } while (0)
#define ATT_ROTQ() do { const int t_ = t0 + wid * 32 + r32; \
    if constexpr (DQK == 64) { const float* tb = rt + (size_t)t_ * 64 + hi * 8; u32x4 w0, w1, w2, w3; \
        float y0[8], y1[8], y2[8], y3[8]; \
        _Pragma("unroll") for (int e = 0; e < 8; ++e) { const float cr = tb[e], sn = tb[16 + e], cc = tb[32 + e], sc2 = tb[48 + e]; \
            const float x0 = bfe(qr[0], e), x1 = bfe(qr[1], e), x2 = bfe(qr[2], e), x3 = bfe(qr[3], e); \
            y0[e] = x0 * cr - x1 * sn; y1[e] = x1 * cr + x0 * sn; y2[e] = x2 * cc - x3 * sc2; y3[e] = x3 * cc + x2 * sc2; } \
        w0 = (u32x4){cvtpk(y0[0], y0[1]), cvtpk(y0[2], y0[3]), cvtpk(y0[4], y0[5]), cvtpk(y0[6], y0[7])}; w1 = (u32x4){cvtpk(y1[0], y1[1]), cvtpk(y1[2], y1[3]), cvtpk(y1[4], y1[5]), cvtpk(y1[6], y1[7])}; \
        w2 = (u32x4){cvtpk(y2[0], y2[1]), cvtpk(y2[2], y2[3]), cvtpk(y2[4], y2[5]), cvtpk(y2[6], y2[7])}; w3 = (u32x4){cvtpk(y3[0], y3[1]), cvtpk(y3[2], y3[3]), cvtpk(y3[4], y3[5]), cvtpk(y3[6], y3[7])}; \
        qr[0] = __builtin_bit_cast(bf16x8, w0); qr[1] = __builtin_bit_cast(bf16x8, w1); qr[2] = __builtin_bit_cast(bf16x8, w2); qr[3] = __builtin_bit_cast(bf16x8, w3); \
    } else { const float* tb = rt + (size_t)t_ * 32; const float sg = hi ? 1.f : -1.f; \
        const u32x4 a4 = __builtin_bit_cast(u32x4, qr[NF - 2]), a5 = __builtin_bit_cast(u32x4, qr[NF - 1]); u32x4 p4, p5; \
        _Pragma("unroll") for (int i = 0; i < 4; ++i) { p4[i] = (unsigned)__shfl_xor((int)a4[i], 32); p5[i] = (unsigned)__shfl_xor((int)a5[i], 32); } \
        const bf16x8 q4 = __builtin_bit_cast(bf16x8, p4), q5 = __builtin_bit_cast(bf16x8, p5); float y4[8], y5[8]; \
        _Pragma("unroll") for (int e = 0; e < 8; ++e) { const float cr = tb[e], sn = tb[8 + e], cc = tb[16 + e], sc2 = tb[24 + e]; \
            y4[e] = bfe(qr[NF - 2], e) * cr + sg * bfe(q4, e) * sn; y5[e] = bfe(qr[NF - 1], e) * cc + sg * bfe(q5, e) * sc2; } \
        const u32x4 w4 = {cvtpk(y4[0], y4[1]), cvtpk(y4[2], y4[3]), cvtpk(y4[4], y4[5]), cvtpk(y4[6], y4[7])}, w5 = {cvtpk(y5[0], y5[1]), cvtpk(y5[2], y5[3]), cvtpk(y5[4], y5[5]), cvtpk(y5[6], y5[7])}; \
        qr[NF - 2] = __builtin_bit_cast(bf16x8, w4); qr[NF - 1] = __builtin_bit_cast(bf16x8, w5); } } while (0)
  f32x16 pA0, pA1, pB0, pB1; float alA, alB; bf16x8 pa0, pa1, pa2, pa3;
  ATT_SLOAD(0); ATT_SWAIT(); ATT_SWRITE(0);
  ATT_SLOAD(1); ATT_SWAIT(); ATT_SWRITE(1); ATT_LBAR();
  qkt<DQK, true>(pA0, pA1, K_lds, qr, r32, hi, negm);
  partialSM<true>(pA0, pA1, m_reg, negm, alA, thr, true, rowmax32(pA0, pA1));
#pragma unroll
  for (int r = 0; r < 16; ++r) { pA0[r] = __builtin_amdgcn_exp2f(pA0[r]); pA1[r] = __builtin_amdgcn_exp2f(pA1[r]); }
  int s_cur = 0, s_nxt = 1, s_nn = 2;
#define ATT_STEP(t, X0, X1, alX, Y0, Y1, alY, HAS1, HAS2) do { \
    if (HAS1) { if (rot && (t) + 1 == nct) ATT_ROTQ(); } \
    ATT_SBAR(); if (HAS1) qkt<DQK, true>(Y0, Y1, K_lds + s_nxt * SHM_K, qr, r32, hi, negm); \
    finishSM(X0, X1, alX, l_reg, pa0, pa1, pa2, pa3); ATT_SBAR(); \
    if (HAS2) ATT_SLOAD((t) + 2); ATT_SBAR(); \
    if (HAS1) { partialSM<true>(Y0, Y1, m_reg, negm, alY, thr, false, rowmax32(Y0, Y1)); ATT_SBAR(); pv_ex(o, vb0 + s_cur * SHM_V, pa0, pa1, pa2, pa3, Y0, Y1); } \
    else pv_last(o, vb0 + s_cur * SHM_V, pa0, pa1, pa2, pa3); \
    if (HAS2) { ATT_SWAIT(); ATT_SWRITE(s_nn); } \
    if (HAS1) ATT_RESC(alY); \
    ATT_LBAR(); { const int tmp_ = s_cur; s_cur = s_nxt; s_nxt = s_nn; s_nn = tmp_; } } while (0)
  for (int t = 0; t + 2 < NT; t += 2) {
    ATT_STEP(t, pA0, pA1, alA, pB0, pB1, alB, true, true);
    ATT_STEP(t + 1, pB0, pB1, alB, pA0, pA1, alA, true, true);
  }
  ATT_STEP(NT - 2, pA0, pA1, alA, pB0, pB1, alB, true, false);
  ATT_STEP(NT - 1, pB0, pB1, alB, pA0, pA1, alA, false, false);
#undef ATT_STEP
  if (hi == 0) li_l[r32] = l_reg; asm volatile("s_waitcnt lgkmcnt(0)" ::: "memory");
  float rli[16];
#pragma unroll
  for (int r = 0; r < 16; ++r) rli[r] = __builtin_amdgcn_rcpf(li_l[crow(r, hi)]);
  if constexpr (OUTBF) { bf16* Ow = (bf16*)Opv + (size_t)(wid * 32) * DM;
#pragma unroll
    for (int r = 0; r < 16; ++r) { const int orow = crow(r, hi);
#pragma unroll
      for (int d0 = 0; d0 < 4; ++d0) Ow[(size_t)orow * DM + d0 * 32 + r32] = (bf16)f2bf(o[d0][r] * rli[r]); }
  } else { float* Ow = (float*)Opv + (size_t)(wid * 32) * NOATT;
    if (!fin) {
#pragma unroll
      for (int r = 0; r < 16; ++r) { const int orow = crow(r, hi);
#pragma unroll
        for (int d0 = 0; d0 < 4; ++d0) Ow[(size_t)orow * NOATT + d0 * 32 + r32] = o[d0][r] * rli[r]; }
    } else {
      bf16* Mw = Mx + (size_t)(wid * 32) * DM; float gv[4];
#pragma unroll
      for (int d0 = 0; d0 < 4; ++d0) gv[d0] = ag[d0 * 32 + r32] * gsc;
#pragma unroll
      for (int r = 0; r < 16; ++r) { const int orow = crow(r, hi); float v[4]; float ss = 0.f;
#pragma unroll
        for (int d0 = 0; d0 < 4; ++d0) { v[d0] = Ow[(size_t)orow * NOATT + d0 * 32 + r32] - lam * (o[d0][r] * rli[r]); ss += v[d0] * v[d0]; }
        ss += __shfl_xor(ss, 1); ss += __shfl_xor(ss, 2); ss += __shfl_xor(ss, 4); ss += __shfl_xor(ss, 8); ss += __shfl_xor(ss, 16);
        const float rs = 1.0f / sqrtf(ss * (1.f / 128.f) + EPS);
#pragma unroll
        for (int d0 = 0; d0 < 4; ++d0) Mw[(size_t)orow * DM + d0 * 32 + r32] = (bf16)f2bf(v[d0] * rs * gv[d0]); } } }
  __syncthreads();
#undef ATT_SLOAD
#undef ATT_SWRITE
#undef ATT_SWAIT
#undef ATT_RESC
#undef ATT_ROTQ
}

__device__ __forceinline__ void norm0_phase(const float* xp, const float* xs_off, const float* gm, bf16* H, float* ssq, int gw, int NGW, int lane) {
    for (int m = gw; m < M; m += NGW) {
        const float* xr = (m < MP ? xp : xs_off) + (size_t)m * DM;
        const int mi = m < MP ? 0 : 1 + (m - MP) / DSEQ; const float* g = gm + (size_t)mi * DM;
        f32x4 v[8]; float s = 0.f;
#pragma unroll
        for (int j = 0; j < 8; ++j) { v[j] = ((const f32x4*)xr)[lane + 64 * j]; s += (v[j].x * v[j].x + v[j].y * v[j].y) + (v[j].z * v[j].z + v[j].w * v[j].w); }
        s = wave_sum(s); if (lane < 32) ssq[(size_t)m * 32 + lane] = lane == 0 ? s : 0.f;
#pragma unroll
        for (int j = 0; j < 8; ++j) { const int c = (lane + 64 * j) * 4; const f32x4 y = v[j] * *(const f32x4*)(g + c); v2u o; o.x = pk2(y.x, y.y); o.y = pk2(y.z, y.w); *(v2u*)(H + (size_t)m * DM + c) = o; }
    }
}
__device__ __forceinline__ void pro2_phase(const Args& a, LAS unsigned char* lds, int tid, int bid, int G, int gt, int NGT) {
    using att::bf16x8; using att::f32x16; using att::crow;
    unsigned char* ws = a.ws; const float* MOD = (const float*)(ws + WS_MOD); float* GM = (float*)(ws + WS_GM);
    for (int i = gt; i < DEPTH * 2 * 5 * DM; i += NGT) { const int c = i % DM, mi = (i / DM) % 5, w = (i / (5 * DM)) & 1, l = i / (2 * 5 * DM);
        const float g = a.in[w ? I_N2G : I_N1G][l * DM + c]; GM[i] = g * (1.f + MOD[((size_t)(l * 5 + mi) * 6 + (w ? 4 : 1)) * DM + c]); }
    const int wave = tid >> 6, lane = tid & 63, r32 = lane & 31, hi = lane >> 5;
    LAS bf16* T = (LAS bf16*)lds;
#pragma unroll 1
    for (int kind = 0; kind < 2; ++kind) {
        __syncthreads();
        for (int e = tid; e < DEPTH * 5 * DM; e += NTH) { const int l = e / (5 * DM), mi = (e / DM) % 5, k = e % DM; T[e] = (bf16)f2bf(MOD[((size_t)(l * 5 + mi) * 6 + (kind ? 3 : 0)) * DM + k]); }
        __syncthreads();
        const int ld = kind ? 2 * DFF : NINP, items_l = ld / 32;
        for (int it = bid * NWV + wave; it < DEPTH * items_l; it += G * NWV) { const int l = it / items_l, rb = it % items_l;
            const bf16* Wr = (kind ? (const bf16*)(ws + WS_WUP + l * SZ_WUP) : (const bf16*)(ws + WS_WIN + l * SZ_WIN)) + (size_t)(rb * 32 + r32) * DM + hi * 8;
            const LAS bf16* Tb = T + (size_t)(l * 5 + (r32 < 5 ? r32 : 4)) * DM + hi * 8;
            f32x16 acc = {};
#pragma unroll 1
            for (int ks = 0; ks < DM / 16; ks += 8) { bf16x8 af[8];
#pragma unroll
                for (int j = 0; j < 8; ++j) af[j] = *reinterpret_cast<const bf16x8*>(Wr + (ks + j) * 16);
#pragma unroll
                for (int j = 0; j < 8; ++j) { bf16x8 bfv = *(const LAS bf16x8*)(Tb + (ks + j) * 16); if (r32 >= 5) bfv = (bf16x8){0, 0, 0, 0, 0, 0, 0, 0};
                    acc = __builtin_amdgcn_mfma_f32_32x32x16_bf16(af[j], bfv, acc, 0, 0, 0); } }
            if (r32 < 5) { float* dst = (kind ? (float*)(ws + WS_SHWU) + (size_t)l * 5 * 2 * DFF : (float*)(ws + WS_SHWI) + (size_t)l * 5 * NINP) + (size_t)r32 * ld + rb * 32;
#pragma unroll
                for (int r = 0; r < 16; ++r) dst[crow(r, hi)] = acc[r]; }
        }
    }
    __syncthreads();
}
__device__ __forceinline__ void final_norm_phase(const float* X, const float* g, float* out, int gw, int NGW, int lane) {
    for (int m = gw; m < M; m += NGW) {
        const float* xr = X + (size_t)m * DM; f32x4 v[8]; float s = 0.f;
#pragma unroll
        for (int j = 0; j < 8; ++j) { v[j] = ((const f32x4*)xr)[lane + 64 * j]; s += (v[j].x * v[j].x + v[j].y * v[j].y) + (v[j].z * v[j].z + v[j].w * v[j].w); }
        const float rstd = 1.0f / sqrtf(wave_sum(s) * (1.f / DM) + EPS);
#pragma unroll
        for (int j = 0; j < 8; ++j) { const int c = (lane + 64 * j) * 4; *(f32x4*)(out + (size_t)m * DM + c) = v[j] * rstd * *(const f32x4*)(g + c); }
    }
}

__device__ __forceinline__ void post_phase(const Args& a, int l, int gw, int NGW, int lane) {
    using att::bf16x8; using att::bfe; using att::cvtpk; using att::u32x4;
    unsigned char* ws = a.ws;
    const bf16* P = (const bf16*)(ws + WS_P); bf16* KRA = (bf16*)(ws + WS_KRA); bf16* KRC = (bf16*)(ws + WS_KRC); bf16* CQN = (bf16*)(ws + WS_CQN); bf16* CKVN = (bf16*)(ws + WS_CKVN);
    const float* RTA = (const float*)(ws + WS_RTA); const float* RTC = (const float*)(ws + WS_RTC);
    const float* gq = a.in[I_CQG] + l * 384; const float* gkv = a.in[I_CKVG] + l * 256;
    for (int m = gw; m < M; m += NGW) {
        const bf16* pr = P + (size_t)m * NINP;
        float xq[8], xk[8]; float sq = 0.f, sk = 0.f;
        if (lane < 48) { const bf16x8 v = *reinterpret_cast<const bf16x8*>(pr + C_CQ + lane * 8);
#pragma unroll
            for (int i = 0; i < 8; ++i) { xq[i] = bfe(v, i); sq += xq[i] * xq[i]; } }
        if (lane < 32) { const bf16x8 v = *reinterpret_cast<const bf16x8*>(pr + C_CKV + lane * 8);
#pragma unroll
            for (int i = 0; i < 8; ++i) { xk[i] = bfe(v, i); sk += xk[i] * xk[i]; } }
        const float rq = 1.0f / sqrtf(wave_sum(sq) * (1.f / 384.f) + EPS), rk = 1.0f / sqrtf(wave_sum(sk) * (1.f / 256.f) + EPS);
        if (lane < 48) { const f32x4 g0 = *(const f32x4*)(gq + lane * 8), g1 = *(const f32x4*)(gq + lane * 8 + 4);
            *(u32x4*)(CQN + (size_t)m * 384 + lane * 8) = (u32x4){cvtpk(xq[0] * rq * g0.x, xq[1] * rq * g0.y), cvtpk(xq[2] * rq * g0.z, xq[3] * rq * g0.w), cvtpk(xq[4] * rq * g1.x, xq[5] * rq * g1.y), cvtpk(xq[6] * rq * g1.z, xq[7] * rq * g1.w)}; }
        if (lane < 32) { const f32x4 g0 = *(const f32x4*)(gkv + lane * 8), g1 = *(const f32x4*)(gkv + lane * 8 + 4);
            const f32x4 y0 = {xk[0] * rk * g0.x, xk[1] * rk * g0.y, xk[2] * rk * g0.z, xk[3] * rk * g0.w}, y1 = {xk[4] * rk * g1.x, xk[5] * rk * g1.y, xk[6] * rk * g1.z, xk[7] * rk * g1.w};
            *(u32x4*)(CKVN + (size_t)m * 256 + lane * 8) = (u32x4){cvtpk(y0.x, y0.y), cvtpk(y0.z, y0.w), cvtpk(y1.x, y1.y), cvtpk(y1.z, y1.w)};
            if (m < MP) { float* o = a.out + O_CKV + (((size_t)(m / SEQ) * DEPTH + l) * SEQ + (m % SEQ)) * 256 + lane * 8; *(f32x4*)o = y0; *(f32x4*)(o + 4) = y1; } }
        if (m >= MP) { const int ms = m - MP, t = ms % DSEQ;
            if (lane < 34) { const bool isa = lane < 32; const int hh = isa ? (lane >> 1) & 1 : lane - 32;
                const int base = isa ? (lane >> 2) * 64 + hh * 32 + (lane & 1) * 8 : hh * 16, dist = isa ? 16 : 8;
                const bf16* src = pr + (isa ? C_AK : C_CKR) + base; const float* tb = isa ? RTA + (size_t)t * 64 + hh * 32 + (lane & 1) * 8 : RTC + (size_t)t * 32 + hh * 16;
                const bf16x8 v0 = *reinterpret_cast<const bf16x8*>(src), v1 = *reinterpret_cast<const bf16x8*>(src + dist);
                const f32x4 c0 = *(const f32x4*)(tb), c1 = *(const f32x4*)(tb + 4), s0 = *(const f32x4*)(tb + dist), s1 = *(const f32x4*)(tb + dist + 4);
                float y0[8], y1[8];
#pragma unroll
                for (int i = 0; i < 8; ++i) { const float cs = i < 4 ? c0[i & 3] : c1[i & 3], sn = i < 4 ? s0[i & 3] : s1[i & 3]; const float x0 = bfe(v0, i), x1 = bfe(v1, i); y0[i] = x0 * cs - x1 * sn; y1[i] = x1 * cs + x0 * sn; }
                bf16* dst = isa ? KRA + (size_t)ms * 512 + base : KRC + (size_t)ms * 32 + base;
                *(u32x4*)dst = (u32x4){cvtpk(y0[0], y0[1]), cvtpk(y0[2], y0[3]), cvtpk(y0[4], y0[5]), cvtpk(y0[6], y0[7])};
                *(u32x4*)(dst + dist) = (u32x4){cvtpk(y1[0], y1[1]), cvtpk(y1[2], y1[3]), cvtpk(y1[4], y1[5]), cvtpk(y1[6], y1[7])}; }
        } else { const size_t ro = ((size_t)(m / SEQ) * DEPTH + l) * SEQ + (m % SEQ);
            { const bf16x8 v = *reinterpret_cast<const bf16x8*>(pr + C_AK + lane * 8); float* o = a.out + O_AK + ro * 512 + lane * 8;
              *(f32x4*)o = (f32x4){bfe(v, 0), bfe(v, 1), bfe(v, 2), bfe(v, 3)}; *(f32x4*)(o + 4) = (f32x4){bfe(v, 4), bfe(v, 5), bfe(v, 6), bfe(v, 7)}; }
            { const bf16x8 v = *reinterpret_cast<const bf16x8*>(pr + C_AV + lane * 8); float* o = a.out + O_AV + ro * 512 + lane * 8;
              *(f32x4*)o = (f32x4){bfe(v, 0), bfe(v, 1), bfe(v, 2), bfe(v, 3)}; *(f32x4*)(o + 4) = (f32x4){bfe(v, 4), bfe(v, 5), bfe(v, 6), bfe(v, 7)}; }
            if (lane < 4) { const bf16x8 v = *reinterpret_cast<const bf16x8*>(pr + C_CKR + lane * 8); float* o = a.out + O_CKR + ro * 32 + lane * 8;
              *(f32x4*)o = (f32x4){bfe(v, 0), bfe(v, 1), bfe(v, 2), bfe(v, 3)}; *(f32x4*)(o + 4) = (f32x4){bfe(v, 4), bfe(v, 5), bfe(v, 6), bfe(v, 7)}; } }
    }
}


constexpr int NCHUNK = M / 64, GLA_UNITS = NCHUNK * 6;
constexpr int TS = 144;

__device__ __forceinline__ void gla_g1_unit(const Args& a, int l, int unit, LAS unsigned char* lds, int tid) {
    using namespace att;
    unsigned char* ws = a.ws; const bf16* P = (const bf16*)(ws + WS_P); bf16* QK4 = (bf16*)(ws + WS_QK4); float* U = (float*)(ws + WS_U); float* DD = (float*)(ws + WS_DD);
    const int gc = unit / 6, h = unit % 6, m0 = gc * 64;
    const int wave = tid >> 6, lane = tid & 63, r32 = lane & 31, hi = lane >> 5;
    LAS float* glr = (LAS float*)lds;
    LAS float* gw = (LAS float*)(lds + 8192);
    LAS float* gbs = (LAS float*)(lds + 16384);
    LAS float* segtot = (LAS float*)(lds + 16896);
    LAS unsigned char* KfT = lds + 20992;
    LAS unsigned char* KbT = lds + 30208;
    LAS unsigned char* Vt = lds + 39424;
    LAS float* Dl = (LAS float*)(lds + 55808);
    const float* gwt = a.in[I_BGW] + (size_t)l * 2 * 16 * 384; const float* gb = a.in[I_BGB] + l * 2 * 384;
    const int k = tid & 63, tq = tid >> 6;
    if (tid < 256) { const int t = tid >> 2, part = tid & 3; const bf16x8 v = *reinterpret_cast<const bf16x8*>(P + (size_t)(m0 + t) * NINP + C_BG + part * 8);
#pragma unroll
        for (int i = 0; i < 8; ++i) glr[t * 32 + part * 8 + i] = bfe(v, i); }
#pragma unroll
    for (int i = 0; i < 4; ++i) { const int idx = tid + NTH * i, dr = idx >> 6, kk = idx & 63; gw[idx] = gwt[(size_t)dr * 384 + h * 64 + kk]; }
    if (tid < 128) gbs[tid] = gb[(tid >> 6) * 384 + h * 64 + (tid & 63)];
    { const int sr = tid >> 4, sc = (tid & 15) * 8;
      const bf16x8 v0 = *reinterpret_cast<const bf16x8*>(P + (size_t)(m0 + sr) * NINP + C_BV + h * 128 + sc), v1 = *reinterpret_cast<const bf16x8*>(P + (size_t)(m0 + 32 + sr) * NINP + C_BV + h * 128 + sc);
      *(LAS bf16x8*)(Vt + v_st(sr, sc)) = v0; *(LAS bf16x8*)(Vt + v_st(32 + sr, sc)) = v1; }
    bf16 qv[8], kv[8];
#pragma unroll
    for (int j = 0; j < 8; ++j) { const bf16* pr = P + (size_t)(m0 + 8 * tq + j) * NINP + h * 64 + k; qv[j] = pr[C_BQ]; kv[j] = pr[C_BK]; }
    __syncthreads();
    float bf_[8], bb_[8];
#pragma unroll
    for (int dir = 0; dir < 2; ++dir) { float wr_[16];
#pragma unroll
        for (int r = 0; r < 16; ++r) wr_[r] = gw[(dir * 16 + r) * 64 + k];
        const float bias = gbs[dir * 64 + k];
#pragma unroll
        for (int j = 0; j < 8; ++j) { const LAS float* gp = glr + (8 * tq + j) * 32 + dir * 16; float pre = bias;
#pragma unroll
            for (int r4 = 0; r4 < 4; ++r4) { const f32x4 x = *(const LAS f32x4*)(gp + 4 * r4); pre += (x.x * wr_[4 * r4] + x.y * wr_[4 * r4 + 1]) + (x.z * wr_[4 * r4 + 2] + x.w * wr_[4 * r4 + 3]); }
            const float gl = (fminf(pre, 0.f) - __logf(1.f + __expf(-fabsf(pre)))) * (1.f / 16.f);
            if (dir == 0) bf_[j] = gl; else bb_[j] = gl; } }
#pragma unroll
    for (int j = 1; j < 8; ++j) bf_[j] += bf_[j - 1];
#pragma unroll
    for (int j = 6; j >= 0; --j) bb_[j] += bb_[j + 1];
    segtot[tq * 64 + k] = bf_[7]; segtot[(8 + tq) * 64 + k] = bb_[0];
    __syncthreads();
    { float of = 0.f, ob = 0.f;
#pragma unroll
      for (int q2 = 0; q2 < 8; ++q2) { const float sf = segtot[q2 * 64 + k], sb = segtot[(8 + q2) * 64 + k]; of += q2 < tq ? sf : 0.f; ob += q2 > tq ? sb : 0.f; }
      float kf[8], kb[8];
      bf16* dst = QK4 + (size_t)(m0 + 8 * tq) * 1536 + h * 64 + k;
#pragma unroll
      for (int j = 0; j < 8; ++j) { const float bfv = bf_[j] + of, bbv = bb_[j] + ob; const float ef = __expf(bfv), eb = __expf(bbv); const float q = bf2f(qv[j]) * 0.125f, kk = bf2f(kv[j]);
          kf[j] = kk * __expf(-bfv); kb[j] = kk * __expf(-bbv);
          dst[(size_t)j * 1536] = (bf16)f2bf(q * ef); dst[(size_t)j * 1536 + 384] = (bf16)f2bf(kf[j]); dst[(size_t)j * 1536 + 768] = (bf16)f2bf(q * eb); dst[(size_t)j * 1536 + 1152] = (bf16)f2bf(kb[j]);
          if (j == 7 && tq == 7) Dl[k] = ef;
          if (j == 0 && tq == 0) Dl[64 + k] = eb; }
      *(LAS u32x4*)(KfT + k * TS + tq * 16) = (u32x4){cvtpk(kf[0], kf[1]), cvtpk(kf[2], kf[3]), cvtpk(kf[4], kf[5]), cvtpk(kf[6], kf[7])};
      *(LAS u32x4*)(KbT + k * TS + tq * 16) = (u32x4){cvtpk(kb[0], kb[1]), cvtpk(kb[2], kb[3]), cvtpk(kb[4], kb[5]), cvtpk(kb[6], kb[7])}; }
    __syncthreads();
    { const int dir = wave >> 2, vb = wave & 3; const LAS unsigned char* KT = dir ? KbT : KfT;
      const int vbase = (int)(unsigned)(uintptr_t)Vt + v_rd_base(lane) + vb * 512;
      const s16x4 l0 = tr_read<v_rd_off(0, 0, 0)>(vbase), h0 = tr_read<v_rd_off(0, 0, 1)>(vbase), l1 = tr_read<v_rd_off(0, 1, 0)>(vbase), h1 = tr_read<v_rd_off(0, 1, 1)>(vbase);
      const s16x4 l2 = tr_read<v_rd_off(0, 2, 0)>(vbase), h2 = tr_read<v_rd_off(0, 2, 1)>(vbase), l3 = tr_read<v_rd_off(0, 3, 0)>(vbase), h3 = tr_read<v_rd_off(0, 3, 1)>(vbase);
      asm volatile("s_waitcnt lgkmcnt(0)" ::: "memory");
#define GLA_PK(L, H) (bf16x8){L[0], L[1], L[2], L[3], H[0], H[1], H[2], H[3]}
      const bf16x8 vf0 = GLA_PK(l0, h0), vf1 = GLA_PK(l1, h1), vf2 = GLA_PK(l2, h2), vf3 = GLA_PK(l3, h3);
      float* Ub = U + ((size_t)unit * 2 + dir) * 8192;
#pragma unroll
      for (int rb = 0; rb < 2; ++rb) { f32x16 acc = {};
          const LAS unsigned char* ar = KT + (rb * 32 + r32) * TS + hi * 16;
          acc = __builtin_amdgcn_mfma_f32_32x32x16_bf16(vf0, *(const LAS bf16x8*)(ar), acc, 0, 0, 0);
          acc = __builtin_amdgcn_mfma_f32_32x32x16_bf16(vf1, *(const LAS bf16x8*)(ar + 32), acc, 0, 0, 0);
          acc = __builtin_amdgcn_mfma_f32_32x32x16_bf16(vf2, *(const LAS bf16x8*)(ar + 64), acc, 0, 0, 0);
          acc = __builtin_amdgcn_mfma_f32_32x32x16_bf16(vf3, *(const LAS bf16x8*)(ar + 96), acc, 0, 0, 0);
          const int kr = rb * 32 + r32; const float dk = Dl[dir * 64 + kr];
#pragma unroll
          for (int g4 = 0; g4 < 4; ++g4) *(f32x4*)(Ub + kr * 128 + vb * 32 + 8 * g4 + 4 * hi) = (f32x4){acc[4 * g4] * dk, acc[4 * g4 + 1] * dk, acc[4 * g4 + 2] * dk, acc[4 * g4 + 3] * dk}; }
      if (tid < 128) DD[(size_t)unit * 128 + tid] = Dl[tid]; }
    __syncthreads();
}

constexpr int GLA_G2_ITEMS = (NPB + NDB) * 6 * 2 * 2;
__device__ __forceinline__ void gla_g2_item(const Args& a, int l, int item, int tid) {
    unsigned char* ws = a.ws; const float* U = (const float*)(ws + WS_U); const float* DD = (const float*)(ws + WS_DD); bf16* ST = (bf16*)(ws + WS_ST);
    const int half = item & 1, dir = (item >> 1) & 1, hs = item >> 2, h = hs % 6, sq = hs / 6;
    const bool smp = sq < NDB; const int b = smp ? sq : sq - NDB, nc = smp ? DSEQ / 64 : SEQ / 64, gc0 = smp ? (MP / 64) + b * (DSEQ / 64) : b * (SEQ / 64);
    const int v = tid & 127, k0 = ((tid >> 7) + 4 * half) * 8;
    float s[8];
#pragma unroll
    for (int i = 0; i < 8; ++i) s[i] = smp ? a.in[I_STB][((((size_t)b * DEPTH + l) * 2 + dir) * 6 + h) * 8192 + (k0 + i) * 128 + v] : 0.f;
    for (int ci = 0; ci < nc; ci += 4) {
        float u[4][8], d[4][8]; size_t ub[4];
#pragma unroll
        for (int j = 0; j < 4; ++j) { const int c = dir ? nc - 1 - (ci + j) : ci + j; ub[j] = ((size_t)(gc0 + c) * 6 + h) * 2 + dir;
#pragma unroll
            for (int i = 0; i < 8; ++i) { u[j][i] = U[ub[j] * 8192 + (k0 + i) * 128 + v]; d[j][i] = DD[ub[j] * 64 + k0 + i]; } }
#pragma unroll
        for (int j = 0; j < 4; ++j) {
            v4u w; w.x = pk2(s[0], s[1]); w.y = pk2(s[2], s[3]); w.z = pk2(s[4], s[5]); w.w = pk2(s[6], s[7]);
            *(v4u*)(ST + ub[j] * 8192 + v * 64 + k0) = w;
#pragma unroll
            for (int i = 0; i < 8; ++i) s[i] = d[j][i] * s[i] + u[j][i]; }
    }
    if (!smp) {
#pragma unroll
        for (int i = 0; i < 8; ++i) a.out[O_SB + ((((size_t)b * DEPTH + l) * 2 + dir) * 6 + h) * 8192 + (k0 + i) * 128 + v] = s[i];
    }
}

__device__ __forceinline__ void gla_g3_unit(const Args& a, int l, int unit, LAS unsigned char* lds, int tid) {
    using namespace att;
    unsigned char* ws = a.ws; const bf16* P = (const bf16*)(ws + WS_P); const bf16* QK4 = (const bf16*)(ws + WS_QK4); const bf16* ST = (const bf16*)(ws + WS_ST); bf16* MIX = (bf16*)(ws + WS_MIX);
    const int gc = unit / 6, h = unit % 6, m0 = gc * 64;
    const int wave = tid >> 6, lane = tid & 63, r32 = lane & 31, hi = lane >> 5;
    LAS unsigned char* T4 = lds;
    LAS unsigned char* Vt = lds + 36864;
    LAS unsigned char* AT = lds + 53248;
    LAS float* OT = (LAS float*)(lds + 71680);
    { const int row = tid >> 3, ch = tid & 7; const bf16* src = QK4 + (size_t)(m0 + row) * 1536 + h * 64 + ch * 8;
#pragma unroll
      for (int var = 0; var < 4; ++var) *(LAS bf16x8*)(T4 + var * 9216 + row * TS + ch * 16) = *reinterpret_cast<const bf16x8*>(src + var * 384);
      const int sr = tid >> 4, sc = (tid & 15) * 8;
      const bf16x8 v0 = *reinterpret_cast<const bf16x8*>(P + (size_t)(m0 + sr) * NINP + C_BV + h * 128 + sc), v1 = *reinterpret_cast<const bf16x8*>(P + (size_t)(m0 + 32 + sr) * NINP + C_BV + h * 128 + sc);
      *(LAS bf16x8*)(Vt + v_st(sr, sc)) = v0; *(LAS bf16x8*)(Vt + v_st(32 + sr, sc)) = v1; }
    __syncthreads();
    { const int dir = wave >> 2, tb = (wave >> 1) & 1, sb = wave & 1;
      const LAS unsigned char* Qt = T4 + (dir * 2) * 9216 + (tb * 32 + r32) * TS + hi * 16; const LAS unsigned char* Kt = T4 + (dir * 2 + 1) * 9216 + (sb * 32 + r32) * TS + hi * 16;
      f32x16 acc = {};
#pragma unroll
      for (int ks = 0; ks < 4; ++ks) acc = __builtin_amdgcn_mfma_f32_32x32x16_bf16(*(const LAS bf16x8*)(Kt + ks * 32), *(const LAS bf16x8*)(Qt + ks * 32), acc, 0, 0, 0);
      const int t = tb * 32 + r32;
#pragma unroll
      for (int r = 0; r < 16; ++r) { const int s = sb * 32 + crow(r, hi); const bool keep = dir ? (s >= t) : (s <= t); acc[r] = keep ? acc[r] : 0.f; }
#pragma unroll
      for (int g = 0; g < 4; ++g) { v2u w; w.x = cvtpk(acc[4 * g], acc[4 * g + 1]); w.y = cvtpk(acc[4 * g + 2], acc[4 * g + 3]);
          *(LAS v2u*)(AT + dir * 9216 + t * TS + (sb * 32 + 8 * g + 4 * hi) * 2) = w; } }
    __syncthreads();
    { const int tb = wave >> 2, vb = wave & 3; f32x16 o = {};
      const int vbase = (int)(unsigned)(uintptr_t)Vt + v_rd_base(lane) + vb * 512;
      const s16x4 l0 = tr_read<v_rd_off(0, 0, 0)>(vbase), h0 = tr_read<v_rd_off(0, 0, 1)>(vbase), l1 = tr_read<v_rd_off(0, 1, 0)>(vbase), h1 = tr_read<v_rd_off(0, 1, 1)>(vbase);
      const s16x4 l2 = tr_read<v_rd_off(0, 2, 0)>(vbase), h2 = tr_read<v_rd_off(0, 2, 1)>(vbase), l3 = tr_read<v_rd_off(0, 3, 0)>(vbase), h3 = tr_read<v_rd_off(0, 3, 1)>(vbase);
      asm volatile("s_waitcnt lgkmcnt(0)" ::: "memory");
      const bf16x8 vf0 = GLA_PK(l0, h0), vf1 = GLA_PK(l1, h1), vf2 = GLA_PK(l2, h2), vf3 = GLA_PK(l3, h3);
#pragma unroll
      for (int dir = 0; dir < 2; ++dir) {
          const bf16* Sd = ST + (((size_t)unit) * 2 + dir) * 8192 + (size_t)(vb * 32 + r32) * 64 + hi * 8;
          const bf16x8 s0 = *reinterpret_cast<const bf16x8*>(Sd), s1 = *reinterpret_cast<const bf16x8*>(Sd + 16), s2 = *reinterpret_cast<const bf16x8*>(Sd + 32), s3 = *reinterpret_cast<const bf16x8*>(Sd + 48);
          const LAS unsigned char* Qt = T4 + (dir * 2) * 9216 + (tb * 32 + r32) * TS + hi * 16; const LAS unsigned char* At = AT + dir * 9216 + (tb * 32 + r32) * TS + hi * 16;
          o = __builtin_amdgcn_mfma_f32_32x32x16_bf16(*(const LAS bf16x8*)(Qt), s0, o, 0, 0, 0);
          o = __builtin_amdgcn_mfma_f32_32x32x16_bf16(*(const LAS bf16x8*)(Qt + 32), s1, o, 0, 0, 0);
          o = __builtin_amdgcn_mfma_f32_32x32x16_bf16(*(const LAS bf16x8*)(Qt + 64), s2, o, 0, 0, 0);
          o = __builtin_amdgcn_mfma_f32_32x32x16_bf16(*(const LAS bf16x8*)(Qt + 96), s3, o, 0, 0, 0);
          o = __builtin_amdgcn_mfma_f32_32x32x16_bf16(*(const LAS bf16x8*)(At), vf0, o, 0, 0, 0);
          o = __builtin_amdgcn_mfma_f32_32x32x16_bf16(*(const LAS bf16x8*)(At + 32), vf1, o, 0, 0, 0);
          o = __builtin_amdgcn_mfma_f32_32x32x16_bf16(*(const LAS bf16x8*)(At + 64), vf2, o, 0, 0, 0);
          o = __builtin_amdgcn_mfma_f32_32x32x16_bf16(*(const LAS bf16x8*)(At + 96), vf3, o, 0, 0, 0); }
#pragma unroll
      for (int r = 0; r < 16; ++r) OT[(tb * 32 + crow(r, hi)) * 132 + vb * 32 + r32] = o[r]; }
    __syncthreads();
    { const int t = tid >> 3, c0 = (tid & 7) * 16; const float* bg = a.in[I_BNG] + l * 128 + c0;
      f32x4 x[4]; float ss = 0.f;
#pragma unroll
      for (int i = 0; i < 4; ++i) { x[i] = *(const LAS f32x4*)(OT + t * 132 + c0 + 4 * i); ss += (x[i].x * x[i].x + x[i].y * x[i].y) + (x[i].z * x[i].z + x[i].w * x[i].w); }
      ss += __shfl_xor(ss, 1); ss += __shfl_xor(ss, 2); ss += __shfl_xor(ss, 4);
      const float rs = 1.0f / sqrtf(ss * (1.f / 128.f) + EPS);
      const bf16* rg = P + (size_t)(m0 + t) * NINP + C_BR + h * 128 + c0; const bf16x8 r0 = *reinterpret_cast<const bf16x8*>(rg), r1 = *reinterpret_cast<const bf16x8*>(rg + 8);
      float y[16];
#pragma unroll
      for (int i = 0; i < 4; ++i) { const f32x4 gv = *(const f32x4*)(bg + 4 * i); y[4 * i] = x[i].x * rs * gv.x; y[4 * i + 1] = x[i].y * rs * gv.y; y[4 * i + 2] = x[i].z * rs * gv.z; y[4 * i + 3] = x[i].w * rs * gv.w; }
#pragma unroll
      for (int i = 0; i < 8; ++i) { y[i] *= siluf(bfe(r0, i)); y[8 + i] *= siluf(bfe(r1, i)); }
      bf16* dst = MIX + (size_t)(m0 + t) * DM + 512 + h * 128 + c0;
      *(u32x4*)(dst) = (u32x4){cvtpk(y[0], y[1]), cvtpk(y[2], y[3]), cvtpk(y[4], y[5]), cvtpk(y[6], y[7])};
      *(u32x4*)(dst + 8) = (u32x4){cvtpk(y[8], y[9]), cvtpk(y[10], y[11]), cvtpk(y[12], y[13]), cvtpk(y[14], y[15])}; }
    __syncthreads();
#undef GLA_PK
}

__device__ __forceinline__ void mixer_phase(const Args& a, int l, LAS unsigned char* lds, int tid_in, int bid, int G) {
    unsigned char* ws = a.ws;
    const bf16* P = (const bf16*)(ws + WS_P); const bf16* QC = (const bf16*)(ws + WS_QC); const bf16* KVC = (const bf16*)(ws + WS_KVC); const bf16* KRA = (const bf16*)(ws + WS_KRA); const bf16* KRC = (const bf16*)(ws + WS_KRC);
    const bf16* CAK = (const bf16*)(ws + WS_CAK); const bf16* CAV = (const bf16*)(ws + WS_CAV); const bf16* CKRX = (const bf16*)(ws + WS_CKRX); const bf16* KVCTX = (const bf16*)(ws + WS_KVCTX);
    const float* RTA = (const float*)(ws + WS_RTA); const float* RTC = (const float*)(ws + WS_RTC); float* OATT = (float*)(ws + WS_OATT); bf16* MIXB = (bf16*)(ws + WS_MIX);
    const float lam = ((const float*)(ws + WS_LAM))[l], li = ((const float*)(ws + WS_LAM))[4 + l]; const float* ag = a.in[I_ANG] + l * 128;
    constexpr int NAS = 256, NCS = 384, NAP = 64, NCP = 96, NFILL = NAP + NCP + GLA_UNITS;
    const bool tuned = G == 256;
    const int per = G / 8, vb = (bid % 8) * per + bid / 8, wx = vb % per, hx = per / 2;
    const bool heavy = wx < hx; const int hidx = (vb / per) * hx + wx, lidx = (vb / per) * hx + (wx - hx);
    const int nl = G / 2;
    const int nslots = tuned ? 3 + (!heavy ? (NFILL + nl - 1) / nl : 0) : (NAS + NCS + NFILL + G - 1) / G;
    for (int sl = 0; sl < nslots; ++sl) {
        int tid = tid_in; asm volatile("" : "+v"(tid));
        int kind, u, f = -1;
        if (!tuned) { const int g = bid + sl * G; if (g >= NAS + NCS + NFILL) continue; if (g < NAS) { kind = 0; u = g; } else if (g < NAS + NCS) { kind = 1; u = g - NAS; } else { kind = 5; u = 0; f = g - NAS - NCS; } }
        else if (sl == 0) { kind = 0; u = vb; }
        else if (sl == 1) { kind = 1; u = vb; }
        else if (sl == 2) { if (heavy) { kind = 1; u = G + hidx; } else continue; }
        else { kind = 5; u = 0; f = lidx + (sl - 3) * nl; if (f >= NFILL) continue; }
        if (kind == 5) { if (f < NAP) { kind = 2; u = f; } else if (f < NAP + NCP) { kind = 3; u = f - NAP; } else { kind = 4; u = f - NAP - NCP; } }
        if (kind == 0 && u >= NAS) continue;
        if (kind == 1 && u >= NCS) continue;
        if (kind == 4) { gla_g3_unit(a, l, u, lds, tid); continue; }
        if (kind == 0 || kind == 2) {
            int b, head, qb; size_t r0;
            if (kind == 0) { b = u >> 6; head = (u >> 4) & 3; qb = u & 15; r0 = (size_t)MP + (size_t)b * DSEQ; } else { b = u >> 2; head = u & 3; qb = 0; r0 = (size_t)b * SEQ; }
#pragma unroll 1
            for (int ps = 0; ps < 2; ++ps) { const int combo = head * 2 + ps; int tid2 = tid; asm volatile("" : "+v"(tid2));
                KSeg ctx{nullptr, 0, nullptr, 0, nullptr, 0, 0}, lat;
                if (kind == 0) { ctx = KSeg{CAK + ((size_t)(b * DEPTH + l) * PAST) * 512 + combo * 64, 512, nullptr, 0, CAV + ((size_t)(b * DEPTH + l) * PAST) * 512 + head * 128, 512, PAST};
                                 lat = KSeg{KRA + ((size_t)b * DSEQ) * 512 + combo * 64, 512, nullptr, 0, P + r0 * NINP + C_AV + head * 128, NINP, DSEQ}; }
                else lat = KSeg{P + r0 * NINP + C_AK + combo * 64, NINP, nullptr, 0, P + r0 * NINP + C_AV + head * 128, NINP, SEQ};
                attn_mfma_unit<64, 1, false>(lds, P + (r0 + qb * 256) * NINP + C_AQ + combo * 64, NINP, kind == 0, RTA, qb * 256, ctx, lat, 0.125f, OATT + (r0 + qb * 256) * NOATT + head * 128, tid2,
                                             ps == 1, lam, 1.f - li, ag, MIXB + (r0 + qb * 256) * DM + head * 128); }
        } else {
            KSeg ctx{nullptr, 0, nullptr, 0, nullptr, 0, 0}, lat; const bf16* Qp; int t0 = 0; bf16* Op;
            if (kind == 1) { const int b = u / 96, h = (u >> 4) % 6, qb = u & 15; const size_t r0 = (size_t)MP + (size_t)b * DSEQ; const size_t c0 = (size_t)(l * NDB + b) * PAST;
                ctx = KSeg{KVCTX + c0 * NKVP + h * 192, NKVP, CKRX + ((size_t)(b * DEPTH + l) * PAST) * 32, 32, KVCTX + c0 * NKVP + h * 192 + 64, NKVP, PAST};
                lat = KSeg{KVC + r0 * NKVP + h * 192, NKVP, KRC + ((size_t)b * DSEQ) * 32, 32, KVC + r0 * NKVP + h * 192 + 64, NKVP, DSEQ};
                Qp = QC + (r0 + qb * 256) * NQCP + h * 96; t0 = qb * 256; Op = MIXB + (r0 + qb * 256) * DM + 1280 + h * 128; }
            else { const int b = u / 6, h = u % 6; const size_t r0 = (size_t)b * SEQ;
                lat = KSeg{KVC + r0 * NKVP + h * 192, NKVP, P + r0 * NINP + C_CKR, NINP, KVC + r0 * NKVP + h * 192 + 64, NKVP, SEQ};
                Qp = QC + r0 * NQCP + h * 96; Op = MIXB + r0 * DM + 1280 + h * 128; }
            attn_mfma_unit<96, 1, true>(lds, Qp, NQCP, kind == 1, RTC, t0, ctx, lat, 0.10206207261596575f, Op, tid);
        }
    }
}

__device__ __forceinline__ void combine_phase(const Args& a, int l, int gw, int NGW, int lane) {
    using att::cvtpk; using att::u32x4;
    unsigned char* ws = a.ws; const float* OATT = (const float*)(ws + WS_OATT); bf16* MIX = (bf16*)(ws + WS_MIX);
    const float lam = ((const float*)(ws + WS_LAM))[l], li = ((const float*)(ws + WS_LAM))[4 + l];
    const int h = lane >> 4, c8 = (lane & 15) * 8; const float* ag = a.in[I_ANG] + l * 128 + c8;
    const f32x4 g0 = *(const f32x4*)ag * (1.f - li), g1 = *(const f32x4*)(ag + 4) * (1.f - li);
    for (int m = gw; m < M; m += NGW) {
        const float* oa = OATT + (size_t)m * NOATT + (2 * h) * 128 + c8;
        const f32x4 a0 = *(const f32x4*)oa, a1 = *(const f32x4*)(oa + 4), b0 = *(const f32x4*)(oa + 128), b1 = *(const f32x4*)(oa + 132);
        const f32x4 o0 = a0 - b0 * lam, o1 = a1 - b1 * lam;
        float ss = (o0.x * o0.x + o0.y * o0.y) + (o0.z * o0.z + o0.w * o0.w) + (o1.x * o1.x + o1.y * o1.y) + (o1.z * o1.z + o1.w * o1.w);
        ss += __shfl_xor(ss, 1); ss += __shfl_xor(ss, 2); ss += __shfl_xor(ss, 4); ss += __shfl_xor(ss, 8);
        const float r = 1.0f / sqrtf(ss * (1.f / 128.f) + EPS);
        const f32x4 y0 = o0 * r * g0, y1 = o1 * r * g1;
        *(u32x4*)(MIX + (size_t)m * DM + h * 128 + c8) = (u32x4){cvtpk(y0.x, y0.y), cvtpk(y0.z, y0.w), cvtpk(y1.x, y1.y), cvtpk(y1.z, y1.w)};
    }
}

__device__ __forceinline__ void convact_phase(const Args& a, int l, int gw, int NGW, int lane) {
    const bf16* GU = (const bf16*)(a.ws + WS_GU); bf16* ACT = (bf16*)(a.ws + WS_ACT);
    const float* cw = a.in[I_CONVW] + (size_t)l * 3 * DFF; const float* cb = a.in[I_CONVB] + (size_t)l * DFF;
    for (int m = gw; m < M; m += NGW) {
        int t, n; if (m < MP) { t = m % SEQ; n = SEQ; } else { t = (m - MP) % DSEQ; n = DSEQ; }
        const bool hp = t > 0, hn = t < n - 1;
        const bf16* g1 = GU + (size_t)m * (2 * DFF);
        for (int c = lane; c < DFF; c += 64) {
            const float gm = bf2f(g1[c]), gp = hp ? bf2f(g1[c - 2 * DFF]) : 0.f, gn = hn ? bf2f(g1[c + 2 * DFF]) : 0.f, uu = bf2f(g1[DFF + c]);
            const float gc = gp * cw[c] + gm * cw[DFF + c] + gn * cw[2 * DFF + c] + cb[c];
            ACT[(size_t)m * DFF + c] = (bf16)f2bf(siluf(gc) * uu);
        }
    }
}

__device__ __forceinline__ void ffn_fix_phase(const Args& a, int l, int gt, int NGT) {
    const float* side = (const float*)(a.ws + WS_SIDE); bf16* ACT = (bf16*)(a.ws + WS_ACT);
    const float* cw = a.in[I_CONVW] + (size_t)l * 3 * DFF;
    for (int i = gt; i < (MS / 256) * 2 * DFF; i += NGT) { const int j = i % DFF, w = (i / DFF) & 1, pm = 16 + i / (2 * DFF), q = (pm - 16) & 15;
        if (w == 0 ? q == 0 : q == 15) continue;
        const float* sp = side + ((size_t)(pm * 2 + w) * 3) * DFF + j;
        const float gnb = w == 0 ? side[((size_t)((pm - 1) * 2 + 1) * 3 + 2) * DFF + j] : side[((size_t)((pm + 1) * 2 + 0) * 3 + 2) * DFF + j];
        const float gc = sp[0] + cw[(w == 0 ? 0 : 2) * DFF + j] * gnb;
        ACT[(size_t)(pm * 256 + (w == 0 ? 0 : 255)) * DFF + j] = (bf16)f2bf(siluf(gc) * sp[DFF]); }
}

constexpr int PH_PER_LAYER = 11, PH_L0 = 3, PH_FIN = PH_L0 + DEPTH * PH_PER_LAYER, N_PHASES = PH_FIN + 1;
__global__ void __launch_bounds__(NTH, 2) mk_fwd(Args a) {
    extern __shared__ __attribute__((aligned(16))) unsigned char lds_raw[];
    LAS unsigned char* lds = (LAS unsigned char*)lds_raw;
    const int bid = blockIdx.x, G = gridDim.x, wave0 = __builtin_amdgcn_readfirstlane((int)threadIdx.x >> 6);
#define PH_BEGIN int tid = TID_NOW; asm volatile("" : "+v"(tid)); unsigned char* ws = a.ws; asm volatile("" : "+s"(ws)); \
    const int lane = tid & 63, wave = __builtin_amdgcn_readfirstlane(tid >> 6), gw = bid * NWV + wave, NGW = G * NWV, gt = bid * NTH + tid, NGT = G * NTH; (void)lane; (void)gw; (void)NGW; (void)gt; (void)NGT; (void)ws
    {
        volatile LAS unsigned* Z = (volatile LAS unsigned*)(lds + RING_BYTES);
        for (int u = threadIdx.x; u < (LDS_BYTES - RING_BYTES) / 4; u += NTH) Z[u] = 0u;
        __syncthreads();
    }
    if (a.use_bar) (void)xcd_barrier_post((unsigned*)(a.ws + WS_CTL) + 4096, (volatile LAS unsigned*)(lds + MISC_OFF) + 8);
#define bar (XcdBarrier{(unsigned*)(a.ws + WS_CTL) + 4096, xb_xcc_id(), (volatile LAS unsigned*)(lds + MISC_OFF) + 8})
    const int lo = a.ph_lo, hi = a.ph_hi;
#define IN(k) (lo <= (k) && (k) < hi)
#define TID_NOW (wave0 * 64 + (int)__builtin_amdgcn_mbcnt_hi(~0u, __builtin_amdgcn_mbcnt_lo(~0u, 0u)))
#define SEAM(k) do { if (IN(k) && IN((k) + 1)) xcd_barrier(bar, TID_NOW); } while (0)
#ifndef MK_DUP
#define MK_DUP 0
#endif
#define DUP(bit) _Pragma("unroll 1") for (int rep_ = 0; rep_ < (((MK_DUP) & (bit)) ? 2 : 1); ++rep_)

    if (IN(0)) DUP(512) { PH_BEGIN; pro0_phase(a, lds, tid, lane, wave, bid, G); SEAM(0); }
    if (IN(1)) { PH_BEGIN;
        modfin_phase(a, gt, NGT);
        pg8::Gemm g{(const bf16*)(ws + WS_CKVA), (const bf16*)(ws + WS_WKV), DEPTH * NDB * PAST, NKVP, 256, 256, 256, 4, (size_t)NKVP * 256}; pg8::StaticOrder S; S.init(DEPTH * NDB * PAST, NKVP, G, bid);
        pg8::EpiBf16<0> E{(bf16*)(ws + WS_KVCTX), NKVP, nullptr, 0, 0, 1.f};
        pg8::gemm_phase<pg8::EpiBf16<0>, pg8::StaticOrder, true, true>(lds, g, S, E, tid);
        SEAM(1);
    }
    if (IN(2)) DUP(8192) { PH_BEGIN; pro2_phase(a, lds, tid, bid, G, gt, NGT); SEAM(2); }
    for (int l = 0; l < DEPTH; ++l) {
        const int pb = PH_L0 + PH_PER_LAYER * l;
        if (pb + PH_PER_LAYER <= lo || pb >= hi) continue;
#define LAYER_PTRS const float* modl = (const float*)(ws + WS_MOD) + (size_t)l * 5 * 6 * DM; const float* xin0 = l == 0 ? a.in[I_XP] : (const float*)(ws + WS_X); \
        const float* xin1 = l == 0 ? a.in[I_XS] - (size_t)MP * DM : (const float*)(ws + WS_X); float* X = (float*)(ws + WS_X); (void)modl; (void)xin0; (void)xin1; (void)X
        if (IN(pb + 0) && l == 0) { PH_BEGIN; norm0_phase(a.in[I_XP], a.in[I_XS] - (size_t)MP * DM, (const float*)(ws + WS_GM), (bf16*)(ws + WS_H), (float*)(ws + WS_SSQP), gw, NGW, lane); SEAM(pb + 0); }
        if (IN(pb + 1)) DUP(2) { PH_BEGIN;
            pg8::Gemm g{(const bf16*)(ws + WS_H), (const bf16*)(ws + WS_WIN + l * SZ_WIN), M, NINP, DM, DM, DM, 1 << 20, 0}; pg8::StaticOrder S; S.init(M, NINP, G, bid);
            pg8::EpiBf16Norm E{(bf16*)(ws + WS_P), NINP, (const float*)(ws + WS_SSQP) + (size_t)(2 * l) * M * 32, (const float*)(ws + WS_SHWI) + (size_t)l * 5 * NINP, NINP, (LAS float*)(lds + RING_BYTES + 8192)};
            pg8::gemm_phase<pg8::EpiBf16Norm, pg8::StaticOrder, true, true>(lds, g, S, E, tid);
            SEAM(pb + 1);
        }
        if (IN(pb + 2)) DUP(4) { PH_BEGIN; post_phase(a, l, gw, NGW, lane);
#if 1
            __syncthreads();
            for (int u = bid; u < GLA_UNITS; u += G) { int t2 = tid; asm volatile("" : "+v"(t2)); gla_g1_unit(a, l, u, lds, t2); }
#endif
            SEAM(pb + 2); }
        if (IN(pb + 3)) DUP(8) {
            { PH_BEGIN; pg8::Gemm g{(const bf16*)(ws + WS_CQN), (const bf16*)(ws + WS_WQ + l * SZ_WQ), M, NQCP, 384, 384, 384, 1 << 20, 0}; pg8::StaticOrder S; S.init(M, NQCP, G, bid);
              pg8::EpiBf16<0> E{(bf16*)(ws + WS_QC), NQCP, nullptr, NQCP, 0, 0.10206207261596575f * 1.4426950408889634f};
              pg8::gemm_phase<pg8::EpiBf16<0>, pg8::StaticOrder, true, true>(lds, g, S, E, tid); }
            __syncthreads();
            { PH_BEGIN; pg8::Gemm g{(const bf16*)(ws + WS_CKVN), (const bf16*)(ws + WS_WKV + l * SZ_WKV), M, NKVP, 256, 256, 256, 1 << 20, 0}; pg8::StaticOrder S; S.init(M, NKVP, G, bid);
              pg8::EpiBf16<0> E{(bf16*)(ws + WS_KVC), NKVP, nullptr, 0, 0, 1.f};
              pg8::gemm_phase<pg8::EpiBf16<0>, pg8::StaticOrder, true, true>(lds, g, S, E, tid); }
#if MK_MFMA_GLA
            { PH_BEGIN; for (int it = bid; it < GLA_G2_ITEMS; it += G) gla_g2_item(a, l, it, tid); }
#endif
            SEAM(pb + 3);
        }
        if (IN(pb + 4)) DUP(16) { PH_BEGIN; mixer_phase(a, l, lds, tid, bid, G); if (IN(pb + 6)) xcd_barrier(bar, TID_NOW); }
        if (IN(pb + 6)) { PH_BEGIN; LAYER_PTRS;
            constexpr int NFULL = 512;
            { pg8::Gemm g{(const bf16*)(ws + WS_MIX), (const bf16*)(ws + WS_WOUT + l * SZ_WOUT), M, DM, DM, DM, DM, 1 << 20, 0}; pg8::StaticOrder S; S.init(M, DM, G, bid); S.lim = (MK_SPLITK && G == 256) ? NFULL : S.nwg;
              pg8::EpiResid E{MK_SPLITK ? X : xin0, MK_SPLITK ? X : xin1, X, modl + 2 * DM, (bf16*)(ws + WS_H), (const float*)(ws + WS_GM) + (size_t)(l * 2 + 1) * 5 * DM, (float*)(ws + WS_SSQP) + (size_t)(2 * l + 1) * M * 32};
              pg8::gemm_phase<pg8::EpiResid, pg8::StaticOrder, true, true>(lds, g, S, E, tid); }
            if (MK_SPLITK && G == 256) { __syncthreads(); int t3 = tid; asm volatile("" : "+v"(t3)); (void)t3;
              pg8::Gemm g{(const bf16*)(ws + WS_MIX), (const bf16*)(ws + WS_WOUT + l * SZ_WOUT), M, DM, DM / 2, DM, DM, 1 << 20, 0}; pg8::TailOrder S; S.init(M, DM, G, bid); S.base = NFULL; S.nth = DM / 128;
              pg8::EpiResidTail E{X, modl + 2 * DM, (float*)(ws + WS_SPLITK), (unsigned*)(ws + WS_CTL) + CW_TICKET + (l * 2 + 0) * 128 * 64, (LAS unsigned*)(lds + RING_BYTES + 2048)};
              pg8::gemm_phase<pg8::EpiResidTail, pg8::TailOrder, true, true>(lds, g, S, E, tid); }
            SEAM(pb + 6);
        }
        if (IN(pb + 8)) DUP(128) { PH_BEGIN;
            pg8::Gemm g{(const bf16*)(ws + WS_H), (const bf16*)(ws + WS_WUP + l * SZ_WUP), M, 2 * DFF, DM, DM, DM, 1 << 20, 0}; pg8::StaticOrder S; S.init(M, 2 * DFF, G, bid);
            pg8::EpiConvAct E{(bf16*)(ws + WS_ACT), a.in[I_CONVW] + (size_t)l * 3 * DFF, a.in[I_CONVB] + (size_t)l * DFF, (float*)(ws + WS_SIDE), (LAS float*)(lds + RING_BYTES + 4096),
                               (const float*)(ws + WS_SSQP) + (size_t)(2 * l + 1) * M * 32, (const float*)(ws + WS_SHWU) + (size_t)l * 5 * 2 * DFF, (LAS float*)(lds + RING_BYTES + 8192)};
            pg8::gemm_phase<pg8::EpiConvAct, pg8::StaticOrder, true, true>(lds, g, S, E, tid);
            SEAM(pb + 8);
        }
        if (IN(pb + 9)) DUP(256) { PH_BEGIN; ffn_fix_phase(a, l, gt, NGT); SEAM(pb + 9); }
        if (IN(pb + 10)) { PH_BEGIN; LAYER_PTRS;
            constexpr int NFULL = 512;
            { pg8::Gemm g{(const bf16*)(ws + WS_ACT), (const bf16*)(ws + WS_WDN + l * SZ_WDN), M, DM, DFF, DFF, DFF, 1 << 20, 0}; pg8::StaticOrder S; S.init(M, DM, G, bid); S.lim = (MK_SPLITK && G == 256) ? NFULL : S.nwg;
              pg8::EpiResid E{X, X, X, modl + 5 * DM, l + 1 < DEPTH ? (bf16*)(ws + WS_H) : nullptr, (const float*)(ws + WS_GM) + (size_t)((l + 1 < DEPTH ? l + 1 : l) * 2) * 5 * DM, (float*)(ws + WS_SSQP) + (size_t)(2 * (l + 1 < DEPTH ? l + 1 : l)) * M * 32};
              pg8::gemm_phase<pg8::EpiResid, pg8::StaticOrder, true, true>(lds, g, S, E, tid); }
            if (MK_SPLITK && G == 256) { __syncthreads(); int t3 = tid; asm volatile("" : "+v"(t3)); (void)t3;
              pg8::Gemm g{(const bf16*)(ws + WS_ACT), (const bf16*)(ws + WS_WDN + l * SZ_WDN), M, DM, DFF / 2, DFF, DFF, 1 << 20, 0}; pg8::TailOrder S; S.init(M, DM, G, bid); S.base = NFULL; S.nth = DFF / 128;
              pg8::EpiResidTail E{X, modl + 5 * DM, (float*)(ws + WS_SPLITK), (unsigned*)(ws + WS_CTL) + CW_TICKET + (l * 2 + 1) * 128 * 64, (LAS unsigned*)(lds + RING_BYTES + 2048)};
              pg8::gemm_phase<pg8::EpiResidTail, pg8::TailOrder, true, true>(lds, g, S, E, tid); }
            SEAM(pb + 10);
        }
    }
    if (IN(PH_FIN)) { PH_BEGIN; final_norm_phase((const float*)(ws + WS_X), a.in[I_FING], a.out, gw, NGW, lane); }
#undef IN
#undef SEAM
#undef bar
}

#ifndef MK_ONE_LAUNCH
#define MK_ONE_LAUNCH 1
#endif
extern "C" void kernel_launch(void* const* d_in, const int* in_sizes, int n_in, void* d_out, int out_size, void* d_ws, size_t ws_size, hipStream_t stream) {
    static int grid = 0;
    if (grid == 0) {
        if (n_in != N_INPUTS || (size_t)out_size != O_END || ws_size < WS_END) { fprintf(stderr, "kernel_launch: shape mismatch: n_in %d out %d ws %zu (need %zu)\n", n_in, out_size, ws_size, (size_t)WS_END); grid = -1; return; }
        int dev = 0, cus = 0, per_cu = 0;
        if (hipGetDevice(&dev) != hipSuccess || hipDeviceGetAttribute(&cus, hipDeviceAttributeMultiprocessorCount, dev) != hipSuccess) { grid = -1; return; }
        if (hipFuncSetAttribute((const void*)mk_fwd, hipFuncAttributeMaxDynamicSharedMemorySize, LDS_BYTES) != hipSuccess) { fprintf(stderr, "kernel_launch: hipFuncSetAttribute failed\n"); grid = -1; return; }
        if (hipOccupancyMaxActiveBlocksPerMultiprocessor(&per_cu, (const void*)mk_fwd, NTH, LDS_BYTES) != hipSuccess || per_cu < 1) fprintf(stderr, "kernel_launch: occupancy query reports %d\n", per_cu);
        (void)hipGetLastError();
        grid = cus;
    }
    if (grid < 0) return;
    if (hipMemsetAsync((char*)d_ws + WS_CTL, 0, CTL_ZERO_BYTES, stream) != hipSuccess) return;
    Args a{};
    for (int i = 0; i < N_INPUTS; ++i) a.in[i] = (const float*)d_in[i];
    a.out = (float*)d_out; a.ws = (unsigned char*)d_ws; a.pad = 0;
#if MK_ONE_LAUNCH
    a.ph_lo = 0; a.ph_hi = N_PHASES; a.use_bar = 1;
    hipLaunchKernelGGL(mk_fwd, dim3(grid), dim3(NTH), LDS_BYTES, stream, a);
#else
    for (int p = 0; p < N_PHASES; ++p) { a.ph_lo = p; a.ph_hi = p + 1; a.use_bar = 0; hipLaunchKernelGGL(mk_fwd, dim3(grid), dim3(NTH), LDS_BYTES, stream, a); }
#endif
    const hipError_t le = hipPeekAtLastError();
    if (le != hipSuccess) fprintf(stderr, "kernel_launch: launch failed: %s\n", hipGetErrorName(le));
}
```

```cpp
#include <hip/hip_runtime.h>
#include <cstdio>
#include <cstdint>
#include <cmath>

namespace pg8 {
#define PG8_LAS __attribute__((address_space(3)))
typedef unsigned short bf16_t;
typedef short bf16x8 __attribute__((ext_vector_type(8)));
typedef float f32x4 __attribute__((ext_vector_type(4)));
typedef unsigned u32x4 __attribute__((ext_vector_type(4)));
constexpr int BM = 256, BK = 64, HALF = 128, HTB = HALF * BK * 2  , STAGE_BYTES = 8 * HTB, NXCD = 8, WGM = 8;

__host__ __device__ __forceinline__ int lds_byte(int r, int c) { const int st = (r >> 4) * 2 + (c >> 5), rr = r & 15, cc = c & 31, ob = rr * 64 + cc * 2; return st * 1024 + (ob ^ (((ob >> 9) & 1) << 5)); }
__host__ __device__ __forceinline__ void stage_rc(int b, int& R, int& C) { const int st = b / 1024, sb = b % 1024, swz = sb ^ (((sb >> 9) & 1) << 5); R = (st >> 1) * 16 + swz / 64; C = (st & 1) * 32 + (swz % 64) / 2; }
__host__ __device__ __forceinline__ int perm32(int rho) { const int n = rho >> 4, i = rho & 15; return 8 * (i >> 2) + 4 * n + (i & 3); }

struct Unit { int pm, pn, kt0; };
struct Gemm { const bf16_t* A; const bf16_t* Bt; int M, N, K, lda, ldb, bgrp; size_t bgrp_stride; };

struct StaticOrder {
    int nM, nN, nwg, G, c;
    __host__ __device__ void init(int M, int N, int G_, int c_) { nM = M / BM; nN = N / BM; nwg = nM * nN; G = G_; c = c_; lim = nwg; }
    int lim;
    __host__ __device__ void map(int wgid, Unit& u) const {
        { const int q = nwg / NXCD, r = nwg % NXCD, xcd = wgid % NXCD, off = wgid / NXCD; wgid = (xcd < r ? xcd * (q + 1) : r * (q + 1) + (xcd - r) * q) + off; }
        const int nig = WGM * nN, gid = wgid / nig, fm = gid * WGM, gsz = (nM - fm) < WGM ? (nM - fm) : WGM;
        u.pm = fm + ((wgid % nig) % gsz); u.pn = (wgid % nig) / gsz; u.kt0 = 0;
    }
    __host__ __device__ bool next(int i, Unit& u) const {
        const long L = (long)i * G + c; if (L >= lim) return false;
        map((int)L, u); return true;
    }
    __device__ __forceinline__ void a_ready(const Unit&) const {}
    __device__ __forceinline__ void done(const Unit&) const {}
};

struct TailOrder : StaticOrder {
    int base, nth;
    __host__ __device__ bool next(int i, Unit& u) const { if (i > 0) return false; const int L = base + (c >> 1); if (L >= nwg) return false; map(L, u); u.kt0 = (c & 1) * nth; return true; }
};

__device__ __forceinline__ unsigned cvt_pk_bf16(float lo, float hi) { unsigned r; asm volatile("v_cvt_pk_bf16_f32 %0, %1, %2" : "=v"(r) : "v"(lo), "v"(hi)); return r; }
typedef float f32x2 __attribute__((ext_vector_type(2)));
__device__ __forceinline__ f32x2 gelu_pk(f32x2 v) {
    const f32x2 av = __builtin_elementwise_abs(v), d = av * 0.2316418882f + 1.0f;
    f32x2 t; t.x = __builtin_amdgcn_rcpf(d.x); t.y = __builtin_amdgcn_rcpf(d.y);
    f32x2 q = t * 0.5307027145f + (-0.7265760135f); q = q * t + 0.7107068705f; q = q * t + (-0.142248368f); q = q * t + 0.127414796f; q = q * t;
    const f32x2 s = (v * v) * (-0.72134752044f);
    f32x2 e; e.x = __builtin_amdgcn_exp2f(s.x); e.y = __builtin_amdgcn_exp2f(s.y);
    const f32x2 m = v * (q * e), r = v - m;
    f32x2 o; o.x = v.x < 0.f ? m.x : r.x; o.y = v.y < 0.f ? m.y : r.y; return o;
}

template <int ACT  > struct EpiBf16 {
    static constexpr bool PERM = true, AFTER_DRAIN = false; static_assert(ACT == 0 || ACT == 1, "EpiBf16: ACT is 0 (none) or 1 (gelu_pk)");
    bf16_t* O; int ldc; const float* bias; int split_cols; size_t split_stride; float scale0;
    __device__ __forceinline__ void operator()(const f32x4 (&acc)[2][2][4][2], const Unit& u, int wr, int wc, int fr, int fq) const {
        const int row0 = u.pm * BM + wr * 64 + fr; int colt = u.pn * BM; bf16_t* base = O;
        float sc = 1.f; if (split_cols) { const int t = colt / split_cols; base += (size_t)t * split_stride; colt -= t * split_cols; if (t == 0) sc = scale0; }
        const int col0 = colt + wc * 32 + 8 * fq, bcol0 = u.pn * BM + wc * 32 + 8 * fq;
        f32x4 bv[2][2];
#pragma unroll
        for (int bj = 0; bj < 2; ++bj)
#pragma unroll
            for (int n = 0; n < 2; ++n) bv[bj][n] = bias ? *(const f32x4*)(bias + bcol0 + bj * HALF + 4 * n) : (f32x4){0.f, 0.f, 0.f, 0.f};
#pragma unroll
        for (int ai = 0; ai < 2; ++ai)
#pragma unroll
            for (int m = 0; m < 4; ++m) { bf16_t* rowp = base + (size_t)(row0 + ai * HALF + m * 16) * ldc + col0;
#pragma unroll
                for (int bj = 0; bj < 2; ++bj) { f32x4 v0 = acc[ai][bj][m][0] + bv[bj][0], v1 = acc[ai][bj][m][1] + bv[bj][1];
                    if (ACT == 1) { f32x2 a = gelu_pk((f32x2){v0[0], v0[1]}), b = gelu_pk((f32x2){v0[2], v0[3]}), c = gelu_pk((f32x2){v1[0], v1[1]}), d = gelu_pk((f32x2){v1[2], v1[3]});
                        v0 = (f32x4){a.x, a.y, b.x, b.y}; v1 = (f32x4){c.x, c.y, d.x, d.y}; }
                    v0 = v0 * sc; v1 = v1 * sc; u32x4 w; w.x = cvt_pk_bf16(v0[0], v0[1]); w.y = cvt_pk_bf16(v0[2], v0[3]); w.z = cvt_pk_bf16(v1[0], v1[1]); w.w = cvt_pk_bf16(v1[2], v1[3]);
                    *(u32x4*)(rowp + bj * HALF) = w; } }
    }
};

template <class Epi, class Sched, bool ALIGN_EPI = false, bool SP2 = false>
__device__ __forceinline__ void gemm_phase(PG8_LAS unsigned char* lds, const Gemm g, const Sched& S, const Epi& E, int tid_in) {
    int tid_ = tid_in; asm volatile("" : "+v"(tid_));
    const int tid = tid_, wid = __builtin_amdgcn_readfirstlane(tid >> 6), lane = tid & 63, wr = wid >> 2, wc = wid & 3, fr = lane & 15, fq = lane >> 4;
    const int K = g.K, nt = K / BK;
    unsigned voffA[2], voffB[2];
#pragma unroll
    for (int i = 0; i < 2; ++i) { int R, C; stage_rc(tid * 16 + i * 8192, R, C); const int Rb = Epi::PERM ? ((R & ~31) + perm32(R & 31)) : R;
        voffA[i] = (unsigned)(R * g.lda + C) * 2u; voffB[i] = (unsigned)(Rb * g.ldb + C) * 2u; }
    const size_t kstep = (size_t)(BK * 2);
    const size_t hstepA = (size_t)HALF * g.lda * 2, hstepB = (size_t)HALF * g.ldb * 2;
    const size_t tstepA = 2 * hstepA, tstepB = 2 * hstepB;
    const unsigned ldsw = (unsigned)wid * 1024u;
    const int aoff = lds_byte(wr * 64 + fr, fq * 8), boff = lds_byte(wc * 32 + fr, fq * 8);
#define PG8_SA(b, h) (((b) * 2 + (h)) * HTB)
#define PG8_SB(b, h) ((4 + (b) * 2 + (h)) * HTB)
#define PG8_STAGE(bufoff, gbase, voff) do { _Pragma("unroll") for (int _i = 0; _i < 2; ++_i) \
        __builtin_amdgcn_global_load_lds((const unsigned*)((const char*)(gbase) + (voff)[_i]), (PG8_LAS unsigned*)(lds + (bufoff) + ldsw + _i * 8192), 16, 0, 0); } while (0)
#define PG8_LDA(dst, b, h) do { _Pragma("unroll") for (int m = 0; m < 4; ++m) _Pragma("unroll") for (int k = 0; k < 2; ++k) dst[m][k] = *(const PG8_LAS bf16x8*)(lds + PG8_SA(b, h) + aoff + m * 2048 + k * 1024); } while (0)
#define PG8_LDB(dst, b, h) do { _Pragma("unroll") for (int n = 0; n < 2; ++n) _Pragma("unroll") for (int k = 0; k < 2; ++k) dst[n][k] = *(const PG8_LAS bf16x8*)(lds + PG8_SB(b, h) + boff + n * 2048 + k * 1024); } while (0)
#define PG8_MMA(ai, bj, At, Bt) do { __builtin_amdgcn_s_setprio(1); _Pragma("unroll") for (int m = 0; m < 4; ++m) _Pragma("unroll") for (int n = 0; n < 2; ++n) _Pragma("unroll") for (int k = 0; k < 2; ++k) \
        acc[ai][bj][m][n] = __builtin_amdgcn_mfma_f32_16x16x32_bf16(Bt[n][k], At[m][k], acc[ai][bj][m][n], 0, 0, 0); __builtin_amdgcn_s_setprio(0); } while (0)
#define PG8_WAIT_V(n) asm volatile("s_waitcnt vmcnt(" #n ")" ::: "memory")
#define PG8_WAIT_L(n) asm volatile("s_waitcnt lgkmcnt(" #n ")" ::: "memory")
#define PG8_BAR __builtin_amdgcn_s_barrier()
#define PG8_SCHED __builtin_amdgcn_sched_barrier(0)
    Unit cur, nxt; int ui = 0;
    if (!S.next(0, cur)) return;
    f32x4 acc[2][2][4][2];
#pragma unroll
    for (int a = 0; a < 2; ++a)
#pragma unroll
        for (int b = 0; b < 2; ++b)
#pragma unroll
            for (int m = 0; m < 4; ++m)
#pragma unroll
                for (int n = 0; n < 2; ++n) acc[a][b][m][n] = (f32x4){0.f, 0.f, 0.f, 0.f};
    bf16x8 At[4][2], B0[2][2], B1[2][2];
    const char* cA = (const char*)g.A + (size_t)cur.pm * tstepA + (size_t)cur.kt0 * kstep; const char* cB = (const char*)g.Bt + (size_t)(cur.pm / g.bgrp) * g.bgrp_stride * 2 + (size_t)cur.pn * tstepB + (size_t)cur.kt0 * kstep;
    S.a_ready(cur);
    if constexpr (SP2) {
        PG8_STAGE(PG8_SB(0, 0), cB, voffB); PG8_STAGE(PG8_SB(0, 1), cB + hstepB, voffB); PG8_STAGE(PG8_SA(0, 0), cA, voffA); PG8_STAGE(PG8_SA(0, 1), cA + hstepA, voffA);
        if (wr == 1) PG8_BAR;
        PG8_WAIT_V(2); PG8_BAR;
        PG8_STAGE(PG8_SB(1, 0), cB + kstep, voffB); PG8_STAGE(PG8_SA(1, 0), cA + kstep, voffA); PG8_STAGE(PG8_SB(1, 1), cB + hstepB + kstep, voffB);
        PG8_WAIT_V(6); PG8_BAR;
    } else {
        PG8_STAGE(PG8_SB(0, 0), cB, voffB); PG8_STAGE(PG8_SA(0, 0), cA, voffA); PG8_STAGE(PG8_SB(0, 1), cB + hstepB, voffB); PG8_STAGE(PG8_SA(0, 1), cA + hstepA, voffA);
        if (wr == 1) PG8_BAR;
        PG8_WAIT_V(4); PG8_BAR;
        PG8_STAGE(PG8_SB(1, 0), cB + kstep, voffB); PG8_STAGE(PG8_SA(1, 0), cA + kstep, voffA); PG8_STAGE(PG8_SB(1, 1), cB + hstepB + kstep, voffB);
        PG8_WAIT_V(6); PG8_BAR;
    }
    for (;;) {
        const bool has_next = S.next(ui + 1, nxt);
        const char* nA = has_next ? (const char*)g.A + (size_t)nxt.pm * tstepA + (size_t)nxt.kt0 * kstep : cA; const char* nB = has_next ? (const char*)g.Bt + (size_t)(nxt.pm / g.bgrp) * g.bgrp_stride * 2 + (size_t)nxt.pn * tstepB + (size_t)nxt.kt0 * kstep : cB;
        for (int t = 0; t < nt; t += 2) {
            const bool last = (t == nt - 2);
            const char* a1 = cA + (size_t)(t + 1) * kstep;
            const char* a2 = last ? nA : cA + (size_t)(t + 2) * kstep; const char* b2 = last ? nB : cB + (size_t)(t + 2) * kstep;
            const char* a3 = a2 + kstep; const char* b3 = b2 + kstep;
            if (last && has_next) S.a_ready(nxt);
            if constexpr (SP2) {
            PG8_LDB(B0, 0, 0); PG8_LDB(B1, 0, 1); PG8_SCHED; PG8_LDA(At, 0, 0); PG8_STAGE(PG8_SA(1, 1), a1 + hstepA, voffA);
            PG8_WAIT_V(8); PG8_WAIT_L(0); PG8_BAR; PG8_MMA(0, 0, At, B0); PG8_MMA(0, 1, At, B1); PG8_BAR; PG8_SCHED;
            PG8_LDA(At, 0, 1); PG8_STAGE(PG8_SB(0, 0), b2, voffB); PG8_STAGE(PG8_SB(0, 1), b2 + hstepB, voffB); PG8_STAGE(PG8_SA(0, 0), a2, voffA);
            PG8_WAIT_V(8); PG8_WAIT_L(0); PG8_BAR; PG8_MMA(1, 0, At, B0); PG8_MMA(1, 1, At, B1); PG8_BAR; PG8_SCHED;
            PG8_LDB(B0, 1, 0); PG8_LDB(B1, 1, 1); PG8_SCHED; PG8_LDA(At, 1, 0); PG8_STAGE(PG8_SA(0, 1), a2 + hstepA, voffA);
            PG8_WAIT_V(8); PG8_WAIT_L(0); PG8_BAR; PG8_MMA(0, 0, At, B0); PG8_MMA(0, 1, At, B1); PG8_BAR; PG8_SCHED;
            PG8_LDA(At, 1, 1); PG8_STAGE(PG8_SB(1, 0), b3, voffB); PG8_STAGE(PG8_SB(1, 1), b3 + hstepB, voffB); PG8_STAGE(PG8_SA(1, 0), a3, voffA);
            PG8_WAIT_V(8); PG8_WAIT_L(0); PG8_BAR; PG8_MMA(1, 0, At, B0); PG8_MMA(1, 1, At, B1); PG8_BAR; PG8_SCHED;
            } else {
            PG8_LDB(B0, 0, 0); PG8_SCHED; PG8_LDA(At, 0, 0); PG8_STAGE(PG8_SA(1, 1), a1 + hstepA, voffA);
            PG8_WAIT_L(8); PG8_BAR; PG8_WAIT_L(0); PG8_MMA(0, 0, At, B0); PG8_BAR; PG8_SCHED;
            PG8_LDB(B1, 0, 1); PG8_STAGE(PG8_SB(0, 0), b2, voffB);
            PG8_BAR; PG8_WAIT_L(0); PG8_MMA(0, 1, At, B1); PG8_BAR;
            PG8_LDA(At, 0, 1); PG8_STAGE(PG8_SA(0, 0), a2, voffA);
            PG8_BAR; PG8_WAIT_L(0); PG8_MMA(1, 0, At, B0); PG8_BAR; PG8_SCHED;
            PG8_STAGE(PG8_SB(0, 1), b2 + hstepB, voffB);
            PG8_WAIT_V(6); PG8_BAR; PG8_MMA(1, 1, At, B1); PG8_BAR;
            PG8_LDB(B0, 1, 0); PG8_SCHED; PG8_LDA(At, 1, 0); PG8_STAGE(PG8_SA(0, 1), a2 + hstepA, voffA);
            PG8_WAIT_L(8); PG8_BAR; PG8_WAIT_L(0); PG8_MMA(0, 0, At, B0); PG8_BAR; PG8_SCHED;
            PG8_LDB(B1, 1, 1); PG8_STAGE(PG8_SB(1, 0), b3, voffB);
            PG8_BAR; PG8_WAIT_L(0); PG8_MMA(0, 1, At, B1); PG8_BAR;
            PG8_LDA(At, 1, 1); PG8_STAGE(PG8_SA(1, 0), a3, voffA);
            PG8_BAR; PG8_WAIT_L(0); PG8_MMA(1, 0, At, B0); PG8_BAR; PG8_SCHED;
            PG8_STAGE(PG8_SB(1, 1), b3 + hstepB, voffB);
            PG8_WAIT_V(6); PG8_BAR; PG8_MMA(1, 1, At, B1); PG8_BAR;
            }
        }
        if constexpr (ALIGN_EPI) { if (wr == 0) PG8_BAR; }
        if constexpr (!Epi::AFTER_DRAIN) { E(acc, cur, wr, wc, fr, fq); S.done(cur); }
        if (!has_next) break;
#pragma unroll
        for (int a = 0; a < 2; ++a)
#pragma unroll
            for (int b = 0; b < 2; ++b)
#pragma unroll
                for (int m = 0; m < 4; ++m)
#pragma unroll
                    for (int n = 0; n < 2; ++n) acc[a][b][m][n] = (f32x4){0.f, 0.f, 0.f, 0.f};
        cur = nxt; cA = nA; cB = nB; ++ui;
        if constexpr (ALIGN_EPI) { if (wr == 1) PG8_BAR; }
    }
    PG8_WAIT_V(0);
    if constexpr (!ALIGN_EPI) { if (wr == 0) PG8_BAR; }
    PG8_BAR;
    if constexpr (Epi::AFTER_DRAIN) { E.fused(acc, cur, wr, wc, fr, fq, lds, wid, lane); S.done(cur); }
#undef PG8_SA
#undef PG8_SB
#undef PG8_STAGE
#undef PG8_LDA
#undef PG8_LDB
#undef PG8_MMA
#undef PG8_WAIT_V
#undef PG8_WAIT_L
#undef PG8_BAR
#undef PG8_SCHED
}
}

constexpr int DM = 2048, NPB = 16, SEQ = 256, DEPTH = 4, NDB = 4, DSEQ = 4096, PAST = 256;
constexpr int MP = NPB * SEQ, MS = NDB * DSEQ, M = MP + MS;
constexpr int NIN = 4544, NINP = 4608;
constexpr int C_AQ = 0, C_AK = 512, C_AV = 1024, C_BQ = 1536, C_BK = 1920, C_BV = 2304, C_BR = 3072, C_BG = 3840, C_CQ = 3872, C_CKV = 4256, C_CKR = 4512;
constexpr int DFF = 5632, NQC = 576, NQCP = 768, NKV = 1152, NKVP = 1280;
constexpr float EPS = 1e-6f;
constexpr int NOATT = 14 * 128, NOGLA = 2 * 768;
enum { I_XP = 0, I_XS, I_CAK, I_CAV, I_STB, I_CCKV, I_CCKR, I_C, I_CCTX, I_N1G, I_ADAW, I_ADAB, I_WIN, I_LQ1, I_LK1, I_LQ2, I_LK2, I_ANG, I_BGW, I_BGB, I_BNG, I_CQG, I_CQUP, I_CKVG, I_CKVUP, I_WOUT, I_N2G, I_WUP, I_CONVW, I_CONVB, I_WDOWN, I_FING, N_INPUTS };
constexpr size_t O_YP = 0, O_YS = O_YP + (size_t)MP * DM, O_AK = O_YS + (size_t)MS * DM, O_AV = O_AK + (size_t)NPB * DEPTH * SEQ * 512, O_SB = O_AV + (size_t)NPB * DEPTH * SEQ * 512,
                 O_CKV = O_SB + (size_t)NPB * DEPTH * 2 * 6 * 64 * 128, O_CKR = O_CKV + (size_t)NPB * DEPTH * SEQ * 256, O_END = O_CKR + (size_t)NPB * DEPTH * SEQ * 32;
static_assert(O_END == 69730304, "output size");

constexpr size_t al256(size_t x) { return (x + 255) & ~(size_t)255; }
constexpr size_t WS_CTL = 0, CTL_ZERO_BYTES = 2u << 20;
constexpr size_t WS_SSQ = 1u << 20;
constexpr size_t SZ_WIN = (size_t)NINP * DM * 2, SZ_WOUT = (size_t)DM * DM * 2, SZ_WUP = (size_t)2 * DFF * DM * 2, SZ_WDN = (size_t)DM * DFF * 2, SZ_WQ = (size_t)NQCP * 384 * 2, SZ_WKV = (size_t)NKVP * 256 * 2;
constexpr size_t WS_WIN = WS_CTL + CTL_ZERO_BYTES, WS_WOUT = WS_WIN + 4 * SZ_WIN, WS_WUP = WS_WOUT + 4 * SZ_WOUT, WS_WDN = WS_WUP + 4 * SZ_WUP, WS_WQ = WS_WDN + 4 * SZ_WDN, WS_WKV = WS_WQ + 4 * SZ_WQ;
constexpr size_t SZ_MOD = (size_t)DEPTH * 5 * 6 * DM * 4;
constexpr size_t WS_MOD = WS_WKV + 4 * SZ_WKV, WS_MODP = WS_MOD + SZ_MOD, WS_RTA = WS_MODP + 8 * SZ_MOD, WS_RTC = WS_RTA + (size_t)DSEQ * 64 * 4, WS_LAM = WS_RTC + (size_t)DSEQ * 32 * 4;
constexpr size_t WS_CAK = WS_LAM + 256, WS_CAV = WS_CAK + (size_t)NDB * DEPTH * PAST * 512 * 2, WS_CKRX = WS_CAV + (size_t)NDB * DEPTH * PAST * 512 * 2, WS_CKVA = WS_CKRX + (size_t)NDB * DEPTH * PAST * 32 * 2,
                 WS_KVCTX = WS_CKVA + (size_t)DEPTH * NDB * PAST * 256 * 2, WS_SIDE = WS_KVCTX + (size_t)DEPTH * NDB * PAST * NKVP * 2, WS_GM = WS_SIDE + (size_t)(M / 256) * 2 * 3 * DFF * 4, WS_SHWI = WS_GM + (size_t)DEPTH * 2 * 5 * DM * 4,
                 WS_SHWU = WS_SHWI + (size_t)DEPTH * 5 * NINP * 4, WS_SSQP = WS_SHWU + (size_t)DEPTH * 5 * 2 * DFF * 4, WS_X = WS_SSQP + (size_t)8 * M * 32 * 4;
constexpr size_t WS_H = WS_X + (size_t)M * DM * 4, WS_T0 = WS_H + (size_t)M * DM * 2;
constexpr size_t WS_P = WS_T0, WS_MIX = WS_P + (size_t)M * NINP * 2, WS_QC = WS_MIX + (size_t)M * DM * 2, WS_KVC = WS_QC + (size_t)M * NQCP * 2, WS_CQN = WS_KVC + (size_t)M * NKVP * 2, WS_CKVN = WS_CQN + (size_t)M * 384 * 2,
                 WS_KRA = WS_CKVN + (size_t)M * 256 * 2, WS_KRC = WS_KRA + (size_t)MS * 512 * 2, WS_OATT = WS_KRC + (size_t)MS * 32 * 2, WS_OGLA = WS_OATT + (size_t)M * NOATT * 4, WS_GATE = WS_OGLA + (size_t)M * NOGLA * 4,
                 WS_ST = WS_GATE + (size_t)M * 768 * 4, WS_DD = WS_ST + (size_t)(M / 64) * 12 * 8192 * 2, WS_END1 = WS_DD + (size_t)(M / 64) * 12 * 64 * 4;
constexpr size_t WS_U = WS_OGLA, WS_QK4 = WS_GATE;
constexpr size_t WS_GU = WS_T0, WS_ACT = WS_GU + (size_t)M * 2 * DFF * 2, WS_END2 = WS_ACT + (size_t)M * DFF * 2;


static_assert(WS_WIN % 256 == 0 && WS_X % 256 == 0 && WS_H % 256 == 0 && WS_T0 % 256 == 0 && WS_QC % 256 == 0 && WS_KVC % 256 == 0 && WS_CQN % 256 == 0 && WS_CKVN % 256 == 0 && WS_OATT % 256 == 0 && WS_ACT % 256 == 0, "alignment");

constexpr size_t WS_SPLITK = WS_END1 > WS_END2 ? WS_END1 : WS_END2, WS_END3 = WS_SPLITK + (size_t)128 * 2 * 65536 * 4;
constexpr size_t WS_END = WS_END3;
static_assert(WS_END <= (size_t)1536 << 20, "workspace map must fit 4 x the largest tensor");
constexpr int CW_TICKET = 65536;

constexpr int RING_BYTES = 131072, MISC_OFF = RING_BYTES + 320, LDS_BYTES = 147456;

#define GAS __attribute__((address_space(1)))
#define LAS __attribute__((address_space(3)))
typedef unsigned short bf16;
typedef unsigned v4u __attribute__((ext_vector_type(4)));
typedef unsigned v2u __attribute__((ext_vector_type(2)));
typedef float f32x4 __attribute__((ext_vector_type(4)));
#define LDS_WAIT() asm volatile("s_waitcnt lgkmcnt(0)" ::: "memory")
__device__ __forceinline__ unsigned f2bf(float f) { unsigned u = __builtin_bit_cast(unsigned, f); return (u + 0x7fffu + ((u >> 16) & 1u)) >> 16; }
__device__ __forceinline__ unsigned pk2(float lo, float hi) { return f2bf(lo) | (f2bf(hi) << 16); }
__device__ __forceinline__ float bf2f(bf16 b) { return __builtin_bit_cast(float, (unsigned)b << 16); }
__device__ __forceinline__ float wave_sum(float v) {
#pragma unroll
    for (int o = 1; o < 64; o <<= 1) v += __shfl_xor(v, o);
    return v;
}
__device__ __forceinline__ float siluf(float x) { return x / (1.f + __expf(-x)); }

namespace pg8 {
__device__ __forceinline__ void rstd_table(const float* ssq, int pm, PG8_LAS float* rtab, int tid) {
    const int row = tid >> 1, half = tid & 1; const float* p = ssq + ((size_t)(pm * BM + row) * 32 + half * 16);
    const f32x4 a = *(const f32x4*)p, b = *(const f32x4*)(p + 4), c = *(const f32x4*)(p + 8), d = *(const f32x4*)(p + 12);
    float s = (((a[0] + a[1]) + (a[2] + a[3])) + ((b[0] + b[1]) + (b[2] + b[3]))) + (((c[0] + c[1]) + (c[2] + c[3])) + ((d[0] + d[1]) + (d[2] + d[3])));
    s += __shfl_xor(s, 1);
    if (half == 0) rtab[row] = 1.0f / sqrtf(s * (1.f / 2048.f) + 1e-6f);
    asm volatile("s_waitcnt lgkmcnt(0)" ::: "memory"); __builtin_amdgcn_s_barrier(); asm volatile("" ::: "memory");
}
struct EpiResid {
    static constexpr bool PERM = true, AFTER_DRAIN = false;
    const float* xin0; const float* xin1;
    float* out; const float* gate;
    bf16_t* H; const float* gm; float* ssq;
    __device__ __forceinline__ void operator()(const f32x4 (&acc)[2][2][4][2], const Unit& u, int wr, int wc, int fr, int fq) const {
        const int mi = u.pm < 16 ? 0 : 1 + ((u.pm - 16) >> 4);
        const float* gp = gate + (size_t)mi * 6 * 2048; const float* xin = u.pm < 16 ? xin0 : xin1;
        const int col0 = u.pn * BM + wc * 32 + 8 * fq;
        f32x4 gv[2][2], gm4[2][2];
#pragma unroll
        for (int bj = 0; bj < 2; ++bj)
#pragma unroll
            for (int n = 0; n < 2; ++n) { gv[bj][n] = *(const f32x4*)(gp + col0 + bj * HALF + 4 * n); gm4[bj][n] = H ? *(const f32x4*)(gm + (size_t)mi * 2048 + col0 + bj * HALF + 4 * n) : (f32x4){0.f, 0.f, 0.f, 0.f}; }
#pragma unroll
        for (int ai = 0; ai < 2; ++ai)
#pragma unroll
            for (int m = 0; m < 4; ++m) { const int row = u.pm * BM + ai * HALF + wr * 64 + m * 16 + fr; const size_t off = (size_t)row * 2048 + col0; float ss = 0.f;
#pragma unroll
                for (int bj = 0; bj < 2; ++bj) { const f32x4 x0 = *(const f32x4*)(xin + off + bj * HALF), x1 = *(const f32x4*)(xin + off + bj * HALF + 4);
                    const f32x4 y0 = x0 + gv[bj][0] * acc[ai][bj][m][0], y1 = x1 + gv[bj][1] * acc[ai][bj][m][1];
                    *(f32x4*)(out + off + bj * HALF) = y0; *(f32x4*)(out + off + bj * HALF + 4) = y1;
                    ss += ((y0[0] * y0[0] + y0[1] * y0[1]) + (y0[2] * y0[2] + y0[3] * y0[3])) + ((y1[0] * y1[0] + y1[1] * y1[1]) + (y1[2] * y1[2] + y1[3] * y1[3]));
                    if (H) { const f32x4 h0 = y0 * gm4[bj][0], h1 = y1 * gm4[bj][1]; u32x4 w; w.x = cvt_pk_bf16(h0[0], h0[1]); w.y = cvt_pk_bf16(h0[2], h0[3]); w.z = cvt_pk_bf16(h1[0], h1[1]); w.w = cvt_pk_bf16(h1[2], h1[3]);
                        *(u32x4*)(H + off + bj * HALF) = w; } }
                if (H) { ss += __shfl_xor(ss, 16); ss += __shfl_xor(ss, 32); if (fq == 0) ssq[(size_t)row * 32 + u.pn * 4 + wc] = ss; } }
    }
};
struct EpiBf16Norm {
    static constexpr bool PERM = true, AFTER_DRAIN = false;
    bf16_t* O; int ldc; const float* ssq; const float* shw; int shw_ld; PG8_LAS float* rtab;
    static constexpr int qtiles = 2; static constexpr float qscale = 0.125f * 1.4426950408889634f;
    __device__ __forceinline__ void operator()(const f32x4 (&acc)[2][2][4][2], const Unit& u, int wr, int wc, int fr, int fq) const {
        const int mi = u.pm < 16 ? 0 : 1 + ((u.pm - 16) >> 4);
        rstd_table(ssq, u.pm, rtab, (wr * 4 + wc) * 64 + fq * 16 + fr);
        const int row0 = u.pm * BM + wr * 64 + fr, col0 = u.pn * BM + wc * 32 + 8 * fq; const float* sp = shw + (size_t)mi * shw_ld + col0;
        const float qs = u.pn < qtiles ? qscale : 1.f;
        f32x4 sv[2][2];
#pragma unroll
        for (int bj = 0; bj < 2; ++bj)
#pragma unroll
            for (int n = 0; n < 2; ++n) sv[bj][n] = *(const f32x4*)(sp + bj * HALF + 4 * n);
#pragma unroll
        for (int ai = 0; ai < 2; ++ai)
#pragma unroll
            for (int m = 0; m < 4; ++m) { const int row = row0 + ai * HALF + m * 16; const float rs = rtab[row - u.pm * BM];
                bf16_t* rowp = O + (size_t)row * ldc + col0;
#pragma unroll
                for (int bj = 0; bj < 2; ++bj) { const f32x4 v0 = (acc[ai][bj][m][0] * rs + sv[bj][0]) * qs, v1 = (acc[ai][bj][m][1] * rs + sv[bj][1]) * qs;
                    u32x4 w; w.x = cvt_pk_bf16(v0[0], v0[1]); w.y = cvt_pk_bf16(v0[2], v0[3]); w.z = cvt_pk_bf16(v1[0], v1[1]); w.w = cvt_pk_bf16(v1[2], v1[3]);
                    *(u32x4*)(rowp + bj * HALF) = w; } }
    }
};

struct EpiResidTail {
    static constexpr bool PERM = false, AFTER_DRAIN = false;
    float* X; const float* gate; float* scratch; unsigned* ticket; PG8_LAS unsigned* lw;
    __device__ __forceinline__ void operator()(const f32x4 (&acc)[2][2][4][2], const Unit& u, int wr, int wc, int fr, int fq) const {
        const int t = blockIdx.x >> 1, half = blockIdx.x & 1, tid = threadIdx.x;
        { const __amdgpu_buffer_rsrc_t rs = __builtin_amdgcn_make_buffer_rsrc(scratch + ((size_t)t * 2 + half) * 65536, 0, 65536 * 4, 0x00020000);
#pragma unroll
          for (int ai = 0; ai < 2; ++ai)
#pragma unroll
            for (int bj = 0; bj < 2; ++bj)
#pragma unroll
                for (int m = 0; m < 4; ++m)
#pragma unroll
                    for (int n = 0; n < 2; ++n) { const int j = ((ai * 2 + bj) * 4 + m) * 2 + n; __builtin_amdgcn_raw_buffer_store_b128(__builtin_bit_cast(u32x4, acc[ai][bj][m][n]), rs, (j * 512 + tid) * 16, 0, 16); } }
        asm volatile("s_waitcnt vmcnt(0)" ::: "memory"); __builtin_amdgcn_s_barrier(); asm volatile("" ::: "memory");
        if (tid == 0) { const unsigned old = __hip_atomic_fetch_add(ticket + 64 * t, 1u, __ATOMIC_RELAXED, __HIP_MEMORY_SCOPE_AGENT); *lw = old; }
        asm volatile("s_waitcnt vmcnt(0) lgkmcnt(0)" ::: "memory"); __builtin_amdgcn_s_barrier(); asm volatile("" ::: "memory");
        const unsigned old = *lw;
        if (old == 0u) return;
        __builtin_amdgcn_fence(__ATOMIC_ACQUIRE, "agent"); asm volatile("s_waitcnt vmcnt(0)" ::: "memory");
        const float* oth = scratch + ((size_t)t * 2 + (half ^ 1)) * 65536; const float* own = scratch + ((size_t)t * 2 + half) * 65536;
        const int mi = u.pm < 16 ? 0 : 1 + ((u.pm - 16) >> 4);
        const float* gp = gate + (size_t)mi * 6 * 2048;
        const int col0 = u.pn * BM + wc * 32 + 4 * fq;
#pragma unroll
        for (int ai = 0; ai < 2; ++ai)
#pragma unroll
            for (int m = 0; m < 4; ++m) { const size_t off = (size_t)(u.pm * BM + ai * HALF + wr * 64 + m * 16 + fr) * 2048 + col0;
#pragma unroll
                for (int bj = 0; bj < 2; ++bj)
#pragma unroll
                    for (int n = 0; n < 2; ++n) { const int j = ((ai * 2 + bj) * 4 + m) * 2 + n; const f32x4 pv = *(const f32x4*)(oth + (size_t)(j * 512 + tid) * 4) + *(const f32x4*)(own + (size_t)(j * 512 + tid) * 4);
                        const f32x4 gv = *(const f32x4*)(gp + col0 + bj * HALF + n * 16), xv = *(const f32x4*)(X + off + bj * HALF + n * 16);
                        *(f32x4*)(X + off + bj * HALF + n * 16) = xv + gv * pv; }
                asm volatile("" ::: "memory"); }
    }
};

__device__ __forceinline__ float dpp_ror1(float x) { return __builtin_bit_cast(float, __builtin_amdgcn_update_dpp(__builtin_bit_cast(int, x), __builtin_bit_cast(int, x), 0x121, 0xf, 0xf, false)); }
__device__ __forceinline__ float dpp_rol1(float x) { return __builtin_bit_cast(float, __builtin_amdgcn_update_dpp(__builtin_bit_cast(int, x), __builtin_bit_cast(int, x), 0x12F, 0xf, 0xf, false)); }
struct EpiConvAct {
    static constexpr bool PERM = true, AFTER_DRAIN = false;
    bf16_t* ACT; const float* cw; const float* cb; float* side; PG8_LAS float* ex;
    const float* ssq; const float* shw; PG8_LAS float* rtab;
    __device__ __forceinline__ void operator()(const f32x4 (&acc_)[2][2][4][2], const Unit& u, int wr, int wc, int fr, int fq) const {
        constexpr int FF = 5632;
        const int colw = wc * 32 + 8 * fq, j0 = u.pn * HALF + colw;
        f32x4 (&acc)[2][2][4][2] = const_cast<f32x4 (&)[2][2][4][2]>(acc_);
#pragma unroll
        for (int ai = 0; ai < 2; ++ai) { const int blk = 2 * ai + wr;
            if (fr == 0) {
#pragma unroll
                for (int n = 0; n < 2; ++n) *(PG8_LAS f32x4*)(ex + (blk * 2 + 0) * HALF + colw + 4 * n) = acc[ai][0][0][n]; }
            if (fr == 15) {
#pragma unroll
                for (int n = 0; n < 2; ++n) *(PG8_LAS f32x4*)(ex + (blk * 2 + 1) * HALF + colw + 4 * n) = acc[ai][0][3][n]; } }
        rstd_table(ssq, u.pm, rtab, (wr * 4 + wc) * 64 + fq * 16 + fr);
        f32x4 sv[2][2];
        { const int mi = u.pm < 16 ? 0 : 1 + ((u.pm - 16) >> 4); const float* sp = shw + (size_t)mi * (2 * FF) + u.pn * BM + colw;
#pragma unroll
          for (int bj = 0; bj < 2; ++bj)
#pragma unroll
              for (int n = 0; n < 2; ++n) sv[bj][n] = *(const f32x4*)(sp + bj * HALF + 4 * n);
#pragma unroll
          for (int ai = 0; ai < 2; ++ai)
#pragma unroll
              for (int m = 0; m < 4; ++m) { const int row = u.pm * BM + ai * HALF + wr * 64 + m * 16 + fr; const float rs = rtab[row - u.pm * BM];
#pragma unroll
                  for (int bj = 0; bj < 2; ++bj)
#pragma unroll
                      for (int n = 0; n < 2; ++n) acc[ai][bj][m][n] = acc[ai][bj][m][n] * rs + sv[bj][n]; } }
        float w0[8], w1[8], w2[8], bb[8];
#pragma unroll
        for (int q = 0; q < 2; ++q) { const f32x4 a0 = *(const f32x4*)(cw + j0 + 4 * q), a1 = *(const f32x4*)(cw + FF + j0 + 4 * q), a2 = *(const f32x4*)(cw + 2 * FF + j0 + 4 * q), a3 = *(const f32x4*)(cb + j0 + 4 * q);
#pragma unroll
            for (int i = 0; i < 4; ++i) { w0[4 * q + i] = a0[i]; w1[4 * q + i] = a1[i]; w2[4 * q + i] = a2[i]; bb[4 * q + i] = a3[i]; } }
#pragma unroll
        for (int ai = 0; ai < 2; ++ai) { const int blk = 2 * ai + wr;
#pragma unroll
            for (int m = 0; m < 4; ++m) { float ov[8]; float gcv[8]; float pe[8], ne[8];
                if (m == 0) {
#pragma unroll
                    for (int n = 0; n < 2; ++n) { const f32x4 p4 = blk > 0 ? *(const PG8_LAS f32x4*)(ex + ((blk - 1) * 2 + 1) * HALF + colw + 4 * n) * rtab[blk > 0 ? blk * 64 - 1 : 0] + sv[0][n] : (f32x4){0.f, 0.f, 0.f, 0.f};
#pragma unroll
                        for (int i = 0; i < 4; ++i) pe[4 * n + i] = p4[i]; } }
                if (m == 3) {
#pragma unroll
                    for (int n = 0; n < 2; ++n) { const f32x4 n4 = blk < 3 ? *(const PG8_LAS f32x4*)(ex + ((blk + 1) * 2 + 0) * HALF + colw + 4 * n) * rtab[blk < 3 ? (blk + 1) * 64 : 0] + sv[0][n] : (f32x4){0.f, 0.f, 0.f, 0.f};
#pragma unroll
                        for (int i = 0; i < 4; ++i) ne[4 * n + i] = n4[i]; } }
#pragma unroll
                for (int kp = 0; kp < 4; ++kp) { const int k = 2 * kp, n = k >> 2, i = k & 3;
                    typedef float f32x2 __attribute__((ext_vector_type(2)));
                    f32x2 G, GP, GN;
#pragma unroll
                    for (int e = 0; e < 2; ++e) { const float g = acc[ai][0][m][n][i + e];
                        const float sp_ = fr == 15 ? (m > 0 ? acc[ai][0][m > 0 ? m - 1 : 0][n][i + e] : pe[k + e]) : g;
                        const float sn_ = fr == 0 ? (m < 3 ? acc[ai][0][m < 3 ? m + 1 : 3][n][i + e] : ne[k + e]) : g;
                        G[e] = g; GP[e] = dpp_ror1(sp_); GN[e] = dpp_rol1(sn_); }
                    const f32x2 W0 = {w0[k], w0[k + 1]}, W1 = {w1[k], w1[k + 1]}, W2 = {w2[k], w2[k + 1]}, BB = {bb[k], bb[k + 1]}, UU = {acc[ai][1][m][n][i], acc[ai][1][m][n][i + 1]};
                    const f32x2 GC = __builtin_elementwise_fma(W0, GP, __builtin_elementwise_fma(W1, G, __builtin_elementwise_fma(W2, GN, BB)));
                    const f32x2 T = GC * (f32x2){-1.4426950408889634f, -1.4426950408889634f};
                    f32x2 D = {__builtin_amdgcn_exp2f(T.x), __builtin_amdgcn_exp2f(T.y)}; D += (f32x2){1.f, 1.f};
                    const f32x2 R = {__builtin_amdgcn_rcpf(D.x), __builtin_amdgcn_rcpf(D.y)};
                    const f32x2 O = GC * R * UU;
                    gcv[k] = GC.x; gcv[k + 1] = GC.y; ov[k] = O.x; ov[k + 1] = O.y; }
                const int row = u.pm * BM + ai * HALF + wr * 64 + m * 16 + fr;
                u32x4 w; w.x = cvt_pk_bf16(ov[0], ov[1]); w.y = cvt_pk_bf16(ov[2], ov[3]); w.z = cvt_pk_bf16(ov[4], ov[5]); w.w = cvt_pk_bf16(ov[6], ov[7]);
                *(u32x4*)(ACT + (size_t)row * FF + j0) = w;
                const bool first = (ai == 0 && m == 0) && wr == 0 && fr == 0, last = (ai == 1 && m == 3) && wr == 1 && fr == 15;
                if ((ai == 0 && m == 0) || (ai == 1 && m == 3)) { if (first || last) { float* sp = side + ((size_t)(u.pm * 2 + (last ? 1 : 0)) * 3) * FF + j0;
#pragma unroll
                    for (int n = 0; n < 2; ++n) { *(f32x4*)(sp + 4 * n) = (f32x4){gcv[4 * n], gcv[4 * n + 1], gcv[4 * n + 2], gcv[4 * n + 3]}; *(f32x4*)(sp + FF + 4 * n) = acc[ai][1][m][n]; *(f32x4*)(sp + 2 * FF + 4 * n) = acc[ai][0][m][n]; } } }
            } }
    }
};
}

#define XB_TMO      128
#define XB_XCNT(j)  (256  + 64 * (j))
#define XB_XSUB(j)  (1280 + 64 * (j))
#define XB_XGEN(j)  (2304 + 64 * (j))
#define XB_TOP      3328
#define XB_TOPGEN   3392
#define XCD_BAR_WORDS 3456
#define XB_SPIN_CAP (1u << 18)
__device__ __forceinline__ unsigned xb_ld(unsigned* p)              { return __hip_atomic_load(p, __ATOMIC_RELAXED, __HIP_MEMORY_SCOPE_AGENT); }
__device__ __forceinline__ unsigned xb_add(unsigned* p, unsigned v) { return __hip_atomic_fetch_add(p, v, __ATOMIC_RELAXED, __HIP_MEMORY_SCOPE_AGENT); }
__device__ __forceinline__ unsigned xb_xcc_id() { return (unsigned)__builtin_amdgcn_s_getreg((3 << 11) | 20) & 0xFu; }
#define XB_SPIN(cond, bar) do { unsigned _sp = 0; while (cond) { __builtin_amdgcn_s_sleep(1); \
    if ((++_sp & 255u) == 0u) { if (xb_ld(&(bar)[XB_TMO])) break; if (_sp > XB_SPIN_CAP) { atomicAdd(&(bar)[XB_TMO], 1u); break; } } } } while (0)
struct XcdBarrier { unsigned* bar; unsigned x; volatile LAS unsigned* st; };
__device__ __forceinline__ XcdBarrier xcd_barrier_post(unsigned* bar, volatile LAS unsigned* st) {
    XcdBarrier b; b.bar = bar; b.x = xb_xcc_id(); b.st = st;
    if (threadIdx.x == 0) (void)xb_add(&bar[XB_XCNT(b.x)], 1u);
    return b;
}
__device__ __forceinline__ void xcd_barrier_complete(unsigned* bar, unsigned x, unsigned& nloc, unsigned& nx) {
    const unsigned G = gridDim.x * gridDim.y * gridDim.z;
    unsigned sum, cnt, mine, sp = 0u;
    for (;;) {
        sum = 0u; cnt = 0u; mine = 0u;
#pragma unroll
        for (unsigned j = 0; j < 16; ++j) { const unsigned c = xb_ld(&bar[XB_XCNT(j)]); sum += c; cnt += (c > 0u) ? 1u : 0u; mine = (j == x) ? c : mine; }
        if (sum == G) break;
        __builtin_amdgcn_s_sleep(1);
        if ((++sp & 255u) == 0u) { if (xb_ld(&bar[XB_TMO])) break; if (sp > XB_SPIN_CAP) { atomicAdd(&bar[XB_TMO], 1u); break; } }
    }
    nloc = mine > 0u ? mine : 1u; nx = cnt > 0u ? cnt : 1u;
}
__device__ __forceinline__ void xcd_barrier(const XcdBarrier& b, int tid) {
    asm volatile("s_waitcnt vmcnt(0)" ::: "memory");
    __syncthreads();
    if (tid == 0) {
        unsigned* bar = b.bar;
        __builtin_amdgcn_s_waitcnt(0);
        unsigned nloc = b.st[0], nx = b.st[1];
        if (nloc == 0u) { xcd_barrier_complete(bar, b.x, nloc, nx); b.st[0] = nloc; b.st[1] = nx; }
        const unsigned old = xb_add(&bar[XB_XSUB(b.x)], 1u);
        const unsigned gen = old / nloc;
        if (old + 1u == (gen + 1u) * nloc) {
            __builtin_amdgcn_fence(__ATOMIC_RELEASE, "agent");
            asm volatile("s_waitcnt vmcnt(0)" ::: "memory");
            const unsigned og = xb_add(&bar[XB_TOP], 1u);
            const unsigned tg = og / nx;
            if (og + 1u == (tg + 1u) * nx) xb_add(&bar[XB_TOPGEN], 1u);
            else XB_SPIN(xb_ld(&bar[XB_TOPGEN]) == tg, bar);
            __builtin_amdgcn_fence(__ATOMIC_ACQUIRE, "agent");
            xb_add(&bar[XB_XGEN(b.x)], 1u);
            asm volatile("s_waitcnt vmcnt(0)" ::: "memory");
        } else {
            XB_SPIN(xb_ld(&bar[XB_XGEN(b.x)]) == gen, bar);
            __builtin_amdgcn_fence(__ATOMIC_ACQUIRE, "agent");
            asm volatile("s_waitcnt vmcnt(0)" ::: "memory");
        }
    }
    __syncthreads();
}

#ifndef MK_MFMA_ATT
#define MK_MFMA_ATT 1
#endif
#ifndef MK_MFMA_GLA
#define MK_MFMA_GLA 1
#endif
#ifndef MK_SPLITK
#define MK_SPLITK 0
#endif
constexpr int NWV = 8, NTH = 512;

template <bool UPMAP = false>
__device__ __forceinline__ void transpose_item(const float* W, int K, int N, bf16* WT, LAS float* scr, int item, int lane) {
    const int nblk = N / 32, kb = item / nblk, nb = item % nblk, k0 = 64 * kb, n0 = 32 * nb;
    const int nd0 = UPMAP ? (n0 < DFF ? 256 * (n0 >> 7) + (n0 & 127) : 256 * ((n0 - DFF) >> 7) + 128 + ((n0 - DFF) & 127)) : n0;
    float wv[32];
#pragma unroll
    for (int i = 0; i < 32; ++i) wv[i] = __builtin_nontemporal_load(W + (size_t)(k0 + 2 * i + (lane >> 5)) * N + n0 + (lane & 31));
#pragma unroll
    for (int i = 0; i < 32; ++i) scr[(2 * i + (lane >> 5)) * 33 + (lane & 31)] = wv[i];
    LDS_WAIT(); asm volatile("" ::: "memory");
    const int c = lane & 7;
#pragma unroll
    for (int j = 0; j < 4; ++j) { const int n = (lane >> 3) + 8 * j; const LAS float* s = scr + (8 * c) * 33 + n;
        v4u o; o.x = pk2(s[0 * 33], s[1 * 33]); o.y = pk2(s[2 * 33], s[3 * 33]); o.z = pk2(s[4 * 33], s[5 * 33]); o.w = pk2(s[6 * 33], s[7 * 33]);
        *(v4u*)(WT + (size_t)(nd0 + n) * K + k0 + 8 * c) = o; }
    LDS_WAIT(); asm volatile("" ::: "memory");
}

struct Args { const float* in[N_INPUTS]; float* out; unsigned char* ws; int ph_lo, ph_hi, use_bar, pad; };

__device__ __forceinline__ void pro0_phase(const Args& a, LAS unsigned char* lds, int tid, int lane, int wave, int bid, int G) {
    unsigned char* ws = a.ws;
    const int gw = bid * NWV + wave, NGW = G * NWV;
    LAS float* scr = (LAS float*)(lds + wave * 16384);
    constexpr int IT_IN = (DM / 64) * (NIN / 32), IT_OUT = (DM / 64) * (DM / 32), IT_UP = (DM / 64) * (2 * DFF / 32), IT_DN = (DFF / 64) * (DM / 32), IT_Q = (384 / 64) * (NQC / 32), IT_KV = (256 / 64) * (NKV / 32);
    constexpr int IT_L = IT_IN + IT_OUT + IT_UP + IT_DN + IT_Q + IT_KV;
    for (int it = gw; it < DEPTH * IT_L; it += NGW) {
        const int l = it / IT_L; int r = it % IT_L;
        if (r < IT_IN) { transpose_item(a.in[I_WIN] + (size_t)l * DM * NIN, DM, NIN, (bf16*)(ws + WS_WIN + l * SZ_WIN), scr, r, lane); continue; } r -= IT_IN;
        if (r < IT_OUT) { transpose_item(a.in[I_WOUT] + (size_t)l * DM * DM, DM, DM, (bf16*)(ws + WS_WOUT + l * SZ_WOUT), scr, r, lane); continue; } r -= IT_OUT;
        if (r < IT_UP) { transpose_item<true>(a.in[I_WUP] + (size_t)l * DM * 2 * DFF, DM, 2 * DFF, (bf16*)(ws + WS_WUP + l * SZ_WUP), scr, r, lane); continue; } r -= IT_UP;
        if (r < IT_DN) { transpose_item(a.in[I_WDOWN] + (size_t)l * DFF * DM, DFF, DM, (bf16*)(ws + WS_WDN + l * SZ_WDN), scr, r, lane); continue; } r -= IT_DN;
        if (r < IT_Q) { transpose_item(a.in[I_CQUP] + (size_t)l * 384 * NQC, 384, NQC, (bf16*)(ws + WS_WQ + l * SZ_WQ), scr, r, lane); continue; } r -= IT_Q;
        transpose_item(a.in[I_CKVUP] + (size_t)l * 256 * NKV, 256, NKV, (bf16*)(ws + WS_WKV + l * SZ_WKV), scr, r, lane);
    }
    const int gt = bid * NTH + tid, NGT = G * NTH;
    for (int i = gt; i < DEPTH * (NINP - NIN) * DM / 8; i += NGT) { const int l = i / ((NINP - NIN) * DM / 8), r = i % ((NINP - NIN) * DM / 8); *(v4u*)(ws + WS_WIN + l * SZ_WIN + (size_t)NIN * DM * 2 + (size_t)r * 16) = (v4u){0u, 0u, 0u, 0u}; }
    for (int i = gt; i < DEPTH * (NQCP - NQC) * 384 / 8; i += NGT) { const int l = i / ((NQCP - NQC) * 384 / 8), r = i % ((NQCP - NQC) * 384 / 8); *(v4u*)(ws + WS_WQ + l * SZ_WQ + (size_t)NQC * 384 * 2 + (size_t)r * 16) = (v4u){0u, 0u, 0u, 0u}; }
    for (int i = gt; i < DEPTH * (NKVP - NKV) * 256 / 8; i += NGT) { const int l = i / ((NKVP - NKV) * 256 / 8), r = i % ((NKVP - NKV) * 256 / 8); *(v4u*)(ws + WS_WKV + l * SZ_WKV + (size_t)NKV * 256 * 2 + (size_t)r * 16) = (v4u){0u, 0u, 0u, 0u}; }
    {
        LAS float* sc = (LAS float*)lds;
        __syncthreads();
        for (int it = bid; it < DEPTH * 24 * 8; it += G) {
            const int l = it / 192, cb = (it / 8) % 24, ks = it % 8;
            __syncthreads();
            for (int e = tid; e < 5 * 256; e += NTH) { const int mi = e >> 8, k = ks * 256 + (e & 255); const float cv = mi == 0 ? a.in[I_CCTX][k] : a.in[I_C][(mi - 1) * DM + k]; sc[e] = cv / (1.f + expf(-cv)); }
            __syncthreads();
            const float* wp = a.in[I_ADAW] + ((size_t)l * DM + ks * 256) * (6 * DM) + cb * 512 + tid;
            float s0 = 0.f, s1 = 0.f, s2 = 0.f, s3 = 0.f, s4 = 0.f;
#pragma unroll 8
            for (int k = 0; k < 256; ++k) { const float w = __builtin_nontemporal_load(wp + (size_t)k * (6 * DM)); s0 += sc[k] * w; s1 += sc[256 + k] * w; s2 += sc[512 + k] * w; s3 += sc[768 + k] * w; s4 += sc[1024 + k] * w; }
            float* mp = (float*)(ws + WS_MODP) + ((size_t)ks * DEPTH + l) * 5 * 6 * DM + cb * 512 + tid;
            mp[0] = s0; mp[6 * DM] = s1; mp[2 * 6 * DM] = s2; mp[3 * 6 * DM] = s3; mp[4 * 6 * DM] = s4;
        }
        __syncthreads();
    }
    { const float* s = a.in[I_CAK]; bf16* d = (bf16*)(ws + WS_CAK); for (int i = gt; i < NDB * DEPTH * PAST * 512; i += NGT) d[i] = (bf16)f2bf(s[i]); }
    { const float* s = a.in[I_CAV]; bf16* d = (bf16*)(ws + WS_CAV); for (int i = gt; i < NDB * DEPTH * PAST * 512; i += NGT) d[i] = (bf16)f2bf(s[i]); }
    { const float* s = a.in[I_CCKR]; bf16* d = (bf16*)(ws + WS_CKRX); for (int i = gt; i < NDB * DEPTH * PAST * 32; i += NGT) d[i] = (bf16)f2bf(s[i]); }
    { const float* s = a.in[I_CCKV]; bf16* d = (bf16*)(ws + WS_CKVA);
      for (int i = gt; i < NDB * DEPTH * PAST * 256; i += NGT) { const int c = i & 255, j = (i >> 8) & 255, bl = i >> 16, b = bl >> 2, l = bl & 3; d[(((size_t)l * NDB + b) * PAST + j) * 256 + c] = (bf16)f2bf(s[i]); } }
    { float* ra = (float*)(ws + WS_RTA); float* rc = (float*)(ws + WS_RTC);
      for (int i = gt; i < DSEQ * 16; i += NGT) { const int t = i >> 4, j = i & 15; const float inv = powf(10000.f, -(float)j / 16.f); const float ar = (float)(t >> 6) * inv, ac = (float)(t & 63) * inv;
          ra[t * 64 + j] = cosf(ar); ra[t * 64 + 16 + j] = sinf(ar); ra[t * 64 + 32 + j] = cosf(ac); ra[t * 64 + 48 + j] = sinf(ac); }
      for (int i = gt; i < DSEQ * 8; i += NGT) { const int t = i >> 3, j = i & 7; const float inv = powf(10000.f, -(float)j / 8.f); const float ar = (float)(t >> 6) * inv, ac = (float)(t & 63) * inv;
          rc[t * 32 + j] = cosf(ar); rc[t * 32 + 8 + j] = sinf(ar); rc[t * 32 + 16 + j] = cosf(ac); rc[t * 32 + 24 + j] = sinf(ac); } }
    if (gt < DEPTH) { const int l = gt; float d1 = 0.f, d2 = 0.f;
        for (int i = 0; i < 64; ++i) { d1 += a.in[I_LQ1][l * 64 + i] * a.in[I_LK1][l * 64 + i]; d2 += a.in[I_LQ2][l * 64 + i] * a.in[I_LK2][l * 64 + i]; }
        const float li = 0.8f - 0.6f * expf(-0.3f * (float)l);
        float* lam = (float*)(ws + WS_LAM); lam[l] = expf(d1) - expf(d2) + li; lam[4 + l] = li; }
}

__device__ __forceinline__ void modfin_phase(const Args& a, int gt, int NGT) {
    const float* mp = (const float*)(a.ws + WS_MODP); float* mo = (float*)(a.ws + WS_MOD);
    for (int i = gt; i < DEPTH * 5 * 6 * DM; i += NGT) { const int l = i / (5 * 6 * DM), n = i % (6 * DM); float s = a.in[I_ADAB][l * 6 * DM + n];
#pragma unroll
        for (int ks = 0; ks < 8; ++ks) s += mp[(size_t)ks * DEPTH * 5 * 6 * DM + i];
        mo[i] = s; }
}


namespace att {
using bf16x8 = __attribute__((ext_vector_type(8))) short;
using s16x4  = __attribute__((ext_vector_type(4))) short;
using f32x16 = __attribute__((ext_vector_type(16))) float;
using u32x4  = __attribute__((ext_vector_type(4))) unsigned;
constexpr int SHM_V = 64 * 128 * 2;
#define ATT_SBAR() __builtin_amdgcn_sched_barrier(0)
#define ATT_LBAR() asm volatile("s_waitcnt lgkmcnt(0)\n\ts_barrier" ::: "memory")
__device__ __forceinline__ int crow(int r, int hi) { return (r & 3) + 8 * (r >> 2) + 4 * hi; }
__device__ __forceinline__ float max3f(float a, float b, float c) { return fmaxf(fmaxf(a, b), c); }
__device__ __forceinline__ float max2f(float a, float b) { return fmaxf(a, b); }
__device__ __forceinline__ unsigned cvtpk(float lo, float hi) { unsigned r; asm volatile("v_cvt_pk_bf16_f32 %0, %1, %2" : "=v"(r) : "v"(lo), "v"(hi)); return r; }
template <bool TUP> __device__ __forceinline__ void partialSM(f32x16& p0, f32x16& p1, float& m_reg, f32x16& negm, float& alpha, float thr, bool first, float pmax) {
  if constexpr (!TUP) {
    typedef float f32x2 __attribute__((ext_vector_type(2))); const f32x2 M2 = {-m_reg, -m_reg};
#pragma unroll
    for (int r = 0; r < 16; r += 2) { f32x2 v = {p0[r], p0[r + 1]}; v += M2; p0[r] = v.x; p0[r + 1] = v.y; f32x2 w = {p1[r], p1[r + 1]}; w += M2; p1[r] = w.x; p1[r + 1] = w.y; }
    pmax -= m_reg; }
  { auto rr = __builtin_amdgcn_permlane32_swap(__float_as_uint(pmax), __float_as_uint(pmax), false, false);
    pmax = max2f(__uint_as_float(rr[0]), __uint_as_float(rr[1])); }
  if (__builtin_expect(!first && __all(pmax <= thr), 1)) { alpha = 1.f; }
  else { const float delta = first ? pmax : max2f(pmax, 0.f); alpha = __builtin_amdgcn_exp2f(-delta); m_reg += delta;
#pragma unroll
    for (int r = 0; r < 16; ++r) { p0[r] -= delta; p1[r] -= delta; }
    if constexpr (TUP) { const float nm = -m_reg;
#pragma unroll
      for (int r = 0; r < 16; ++r) negm[r] = nm;
      asm volatile("" : "+v"(negm)); } }
}
__device__ __forceinline__ void finishSM(f32x16& p0, f32x16& p1, float alpha, float& l_reg, bf16x8& pa0, bf16x8& pa1, bf16x8& pa2, bf16x8& pa3) {
  float ps;
  { typedef float f32x2 __attribute__((ext_vector_type(2))); f32x2 s2 = {p0[0], p0[1]};
#pragma unroll
    for (int r = 2; r < 16; r += 2) s2 += (f32x2){p0[r], p0[r + 1]};
#pragma unroll
    for (int r = 0; r < 16; r += 2) s2 += (f32x2){p1[r], p1[r + 1]};
    ps = s2.x + s2.y; }
  { auto rr = __builtin_amdgcn_permlane32_swap(__float_as_uint(ps), __float_as_uint(ps), false, false);
    ps = __uint_as_float(rr[0]) + __uint_as_float(rr[1]); }
  l_reg = l_reg * alpha + ps;
#define ATT_PKD(P, BASE) __builtin_bit_cast(bf16x8, (u32x4){cvtpk(P[BASE + 0], P[BASE + 1]), cvtpk(P[BASE + 2], P[BASE + 3]), cvtpk(P[BASE + 4], P[BASE + 5]), cvtpk(P[BASE + 6], P[BASE + 7])})
  pa0 = ATT_PKD(p0, 0); pa1 = ATT_PKD(p0, 8); pa2 = ATT_PKD(p1, 0); pa3 = ATT_PKD(p1, 8);
#undef ATT_PKD
}
template <int DQK, bool TUP>
__device__ __forceinline__ void qkt(f32x16& p0, f32x16& p1, const LAS unsigned char* Ks, const bf16x8* qr, int r32, int hi, const f32x16& negm) {
  constexpr int RS = DQK * 2 + 16;
  if constexpr (TUP) { p0 = negm; p1 = negm; } else { p0 = f32x16{}; p1 = f32x16{}; }
#pragma unroll
  for (int d0 = 0; d0 < DQK / 16; ++d0) { const int cb = d0 * 32 + hi * 16;
    const bf16x8 b0 = *(const LAS bf16x8*)(Ks + r32 * RS + cb);
    const bf16x8 b1 = *(const LAS bf16x8*)(Ks + (32 + r32) * RS + cb);
    p0 = __builtin_amdgcn_mfma_f32_32x32x16_bf16(b0, qr[d0], p0, 0, 0, 0);
    p1 = __builtin_amdgcn_mfma_f32_32x32x16_bf16(b1, qr[d0], p1, 0, 0, 0); }
}
__device__ __forceinline__ int v_st(int k, int c) { const int kk = (k & ~0xC) | ((k & 4) << 1) | ((k & 8) >> 1); return ((kk >> 3) * 4 + (c >> 5)) * 512 + ((kk & 7) * 32 + (c & 31)) * 2; }
__device__ __forceinline__ int v_rd_base(int lane) { return ((lane & 3) << 3) | (((lane >> 2) & 3) << 6) | (((lane >> 4) & 1) << 5) | (((lane >> 5) & 1) << 8); }
constexpr int v_rd_off(int d0, int ks, int half) { return d0 * 512 + ks * 4096 + half * 2048; }
__device__ __forceinline__ int v_st_n(int k, int c) { return (c >> 5) * 4096 + k * 64 + (c & 31) * 2; }
__device__ __forceinline__ int v_rd_base_n(int lane) { return ((lane >> 4) & 1) * 32 + (lane & 3) * 8 + (4 * (lane >> 5) + ((lane & 15) >> 2)) * 64; }
constexpr int v_rd_off_n(int d0, int ks, int half) { return d0 * 4096 + ks * 1024 + half * 512; }
template <int OFF> __device__ __forceinline__ s16x4 tr_read(int vb) {
  s16x4 r; asm volatile("ds_read_b64_tr_b16 %0, %1 offset:%2" : "=&v"(r) : "v"(vb), "i"(OFF) : "memory"); return r;
}
template <int D0, bool EX> __device__ __forceinline__ void pv_one(f32x16& od, int vb, bf16x8 pa0, bf16x8 pa1, bf16x8 pa2, bf16x8 pa3, f32x16& s) {
  const s16x4 l0 = tr_read<v_rd_off_n(D0, 0, 0)>(vb), h0 = tr_read<v_rd_off_n(D0, 0, 1)>(vb), l1 = tr_read<v_rd_off_n(D0, 1, 0)>(vb), h1 = tr_read<v_rd_off_n(D0, 1, 1)>(vb);
  const s16x4 l2 = tr_read<v_rd_off_n(D0, 2, 0)>(vb), h2 = tr_read<v_rd_off_n(D0, 2, 1)>(vb), l3 = tr_read<v_rd_off_n(D0, 3, 0)>(vb), h3 = tr_read<v_rd_off_n(D0, 3, 1)>(vb);
  asm volatile("s_waitcnt lgkmcnt(0)" ::: "memory"); ATT_SBAR();
#define ATT_PK(L, H) (bf16x8){L[0], L[1], L[2], L[3], H[0], H[1], H[2], H[3]}
  constexpr int B = (D0 & 1) * 8;
  od = __builtin_amdgcn_mfma_f32_32x32x16_bf16(pa0, ATT_PK(l0, h0), od, 0, 0, 0);
  if constexpr (EX) { s[B] = __builtin_amdgcn_exp2f(s[B]); s[B + 1] = __builtin_amdgcn_exp2f(s[B + 1]); }
  od = __builtin_amdgcn_mfma_f32_32x32x16_bf16(pa1, ATT_PK(l1, h1), od, 0, 0, 0);
  if constexpr (EX) { s[B + 2] = __builtin_amdgcn_exp2f(s[B + 2]); s[B + 3] = __builtin_amdgcn_exp2f(s[B + 3]); }
  od = __builtin_amdgcn_mfma_f32_32x32x16_bf16(pa2, ATT_PK(l2, h2), od, 0, 0, 0);
  if constexpr (EX) { s[B + 4] = __builtin_amdgcn_exp2f(s[B + 4]); s[B + 5] = __builtin_amdgcn_exp2f(s[B + 5]); }
  od = __builtin_amdgcn_mfma_f32_32x32x16_bf16(pa3, ATT_PK(l3, h3), od, 0, 0, 0);
  if constexpr (EX) { s[B + 6] = __builtin_amdgcn_exp2f(s[B + 6]); s[B + 7] = __builtin_amdgcn_exp2f(s[B + 7]); asm volatile("" : "+v"(s)); }
#undef ATT_PK
}
__device__ __forceinline__ void pv_ex(f32x16* o, int vb, bf16x8 pa0, bf16x8 pa1, bf16x8 pa2, bf16x8 pa3, f32x16& s0, f32x16& s1) {
  pv_one<0, true>(o[0], vb, pa0, pa1, pa2, pa3, s0); pv_one<1, true>(o[1], vb, pa0, pa1, pa2, pa3, s0); pv_one<2, true>(o[2], vb, pa0, pa1, pa2, pa3, s1); pv_one<3, true>(o[3], vb, pa0, pa1, pa2, pa3, s1);
}
__device__ __forceinline__ void pv_last(f32x16* o, int vb, bf16x8 pa0, bf16x8 pa1, bf16x8 pa2, bf16x8 pa3) { f32x16 z = {};
  pv_one<0, false>(o[0], vb, pa0, pa1, pa2, pa3, z); pv_one<1, false>(o[1], vb, pa0, pa1, pa2, pa3, z); pv_one<2, false>(o[2], vb, pa0, pa1, pa2, pa3, z); pv_one<3, false>(o[3], vb, pa0, pa1, pa2, pa3, z); }
__device__ __forceinline__ float rowmax32(const f32x16& p0, const f32x16& p1) {
  float a = max3f(p0[0], p0[1], p1[0]), b = max3f(p0[2], p0[3], p1[1]); a = max3f(a, p1[2], p1[3]);
#pragma unroll
  for (int r = 4; r < 16; r += 4) { a = max3f(a, p0[r], p0[r + 1]); b = max3f(b, p0[r + 2], p0[r + 3]); a = max3f(a, p1[r], p1[r + 1]); b = max3f(b, p1[r + 2], p1[r + 3]); }
  return max2f(a, b);
}
__device__ __forceinline__ float bfe(bf16x8 v, int e) { return __builtin_bit_cast(float, (unsigned)(unsigned short)v[e] << 16); }
}

struct KSeg { const bf16* kn; int ldn; const bf16* kr; int ldr; const bf16* v; int ldv; int n; };

template <int DQK, int SD, bool OUTBF>
__device__ __forceinline__ void attn_mfma_unit(LAS unsigned char* lds, const bf16* Qp, int ldq, bool rot, const float* rt, int t0, const KSeg& ctx, const KSeg& lat, float scale, void* Opv, int tid,
                                               bool fin = false, float lam = 0.f, float gsc = 0.f, const float* ag = nullptr, bf16* Mx = nullptr) {
  using namespace att;
  constexpr int NF = DQK / 16, RS = DQK * 2 + 16, SHM_K = 64 * RS;
  const int wid = tid >> 6, lane = tid & 63, r32 = lane & 31, hi = lane >> 5;
  constexpr int NSL = 3;
  LAS unsigned char* V_lds = lds; LAS unsigned char* K_lds = lds + NSL * SHM_V;
  LAS float* wsf = (LAS float*)(lds + NSL * SHM_V + NSL * SHM_K) + wid * 64; LAS float* li_l = wsf; LAS float* al_l = wsf + 32;
  (void)scale;
  const float thr = 8.f * 1.4426950408889634f;
  float m_reg = 0.f, l_reg = 0; f32x16 negm = {}; f32x16 o[4] = {}; bf16x8 qr[NF];
  const bf16* Qw = Qp + (size_t)(wid * 32 + r32) * ldq + hi * 8;
#pragma unroll
  for (int d0 = 0; d0 < NF; ++d0) qr[d0] = *reinterpret_cast<const bf16x8*>(Qw + d0 * 16);
  const int sr = tid >> 4, sc = (tid & 15) * 8, vst0 = v_st_n(sr, sc), vst1 = v_st_n(32 + sr, sc);
  const int krow = tid >> 3, kch = tid & 7, xrow = tid >> 2, xch = tid & 3; const bool xld = (DQK == 96) && tid < 256;
  const int vb0 = (int)(unsigned)(uintptr_t)V_lds + v_rd_base_n(lane);
  const int nct = ctx.n >> 6, NT = nct + (lat.n >> 6);
  struct { bf16x8 vs0, vs1, kn, kx; } st;
#define ATT_SLOAD(j) do { const int j_ = (j); const bool c_ = j_ < nct; const KSeg& S_ = c_ ? ctx : lat; const int k0_ = (c_ ? j_ : j_ - nct) * 64; \
    st.vs0 = *reinterpret_cast<const bf16x8*>(S_.v + (size_t)(k0_ + sr) * S_.ldv + sc); st.vs1 = *reinterpret_cast<const bf16x8*>(S_.v + (size_t)(k0_ + 32 + sr) * S_.ldv + sc); \
    st.kn = *reinterpret_cast<const bf16x8*>(S_.kn + (size_t)(k0_ + krow) * S_.ldn + kch * 8); \
    if (xld) st.kx = *reinterpret_cast<const bf16x8*>(S_.kr + (size_t)(k0_ + xrow) * S_.ldr + xch * 8); } while (0)
#define ATT_SWRITE(b) do { *(LAS bf16x8*)(V_lds + (b) * SHM_V + vst0) = st.vs0; *(LAS bf16x8*)(V_lds + (b) * SHM_V + vst1) = st.vs1; \
    *(LAS bf16x8*)(K_lds + (b) * SHM_K + krow * RS + kch * 16) = st.kn; \
    if (xld) *(LAS bf16x8*)(K_lds + (b) * SHM_K + xrow * RS + 128 + xch * 16) = st.kx; } while (0)
#define ATT_SWAIT() asm volatile("s_waitcnt vmcnt(0)" ::: "memory")
#define ATT_RESC(a) do { if (__any((a) < 1.f)) { if (hi == 0) al_l[r32] = (a); asm volatile("s_waitcnt lgkmcnt(0)" ::: "memory"); \
    _Pragma("unroll") for (int d = 0; d < 4; ++d) _Pragma("unroll") for (int r = 0; r < 16; ++r) o[d][r] *= al_l[crow(r, hi)]; } } while (0)
#define ATT_ROTQ() do { const int t_ = t0 + wid * 32 + r32; \
    if constexpr (DQK == 64) { const float* tb = rt + (size_t)t_ * 64 + hi * 8; u32x4 w0, w1, w2, w3; \
        float y0[8], y1[8], y2[8], y3[8]; \
        _Pragma("unroll") for (int e = 0; e < 8; ++e) { const float cr = tb[e], sn = tb[16 + e], cc = tb[32 + e], sc2 = tb[48 + e]; \
            const float x0 = bfe(qr[0], e), x1 = bfe(qr[1], e), x2 = bfe(qr[2], e), x3 = bfe(qr[3], e); \
            y0[e] = x0 * cr - x1 * sn; y1[e] = x1 * cr + x0 * sn; y2[e] = x2 * cc - x3 * sc2; y3[e] = x3 * cc + x2 * sc2; } \
        w0 = (u32x4){cvtpk(y0[0], y0[1]), cvtpk(y0[2], y0[3]), cvtpk(y0[4], y0[5]), cvtpk(y0[6], y0[7])}; w1 = (u32x4){cvtpk(y1[0], y1[1]), cvtpk(y1[2], y1[3]), cvtpk(y1[4], y1[5]), cvtpk(y1[6], y1[7])}; \
        w2 = (u32x4){cvtpk(y2[0], y2[1]), cvtpk(y2[2], y2[3]), cvtpk(y2[4], y2[5]), cvtpk(y2[6], y2[7])}; w3 = (u32x4){cvtpk(y3[0], y3[1]), cvtpk(y3[2], y3[3]), cvtpk(y3[4], y3[5]), cvtpk(y3[6], y3[7])}; \
        qr[0] = __builtin_bit_cast(bf16x8, w0); qr[1] = __builtin_bit_cast(bf16x8, w1); qr[2] = __builtin_bit_cast(bf16x8, w2); qr[3] = __builtin_bit_cast(bf16x8, w3); \
    } else { const float* tb = rt + (size_t)t_ * 32; const float sg = hi ? 1.f : -1.f; \
        const u32x4 a4 = __builtin_bit_cast(u32x4, qr[NF - 2]), a5 = __builtin_bit_cast(u32x4, qr[NF - 1]); u32x4 p4, p5; \
        _Pragma("unroll") for (int i = 0; i < 4; ++i) { p4[i] = (unsigned)__shfl_xor((int)a4[i], 32); p5[i] = (unsigned)__shfl_xor((int)a5[i], 32); } \
        const bf16x8 q4 = __builtin_bit_cast(bf16x8, p4), q5 = __builtin_bit_cast(bf16x8, p5); float y4[8], y5[8]; \
        _Pragma("unroll") for (int e = 0; e < 8; ++e) { const float cr = tb[e], sn = tb[8 + e], cc = tb[16 + e], sc2 = tb[24 + e]; \
            y4[e] = bfe(qr[NF - 2], e) * cr + sg * bfe(q4, e) * sn; y5[e] = bfe(qr[NF - 1], e) * cc + sg * bfe(q5, e) * sc2; } \
        const u32x4 w4 = {cvtpk(y4[0], y4[1]), cvtpk(y4[2], y4[3]), cvtpk(y4[4], y4[5]), cvtpk(y4[6], y4[7])}, w5 = {cvtpk(y5[0], y5[1]), cvtpk(y5[2], y5[3]), cvtpk(y5[4], y5[5]), cvtpk(y5[6], y5[7])}; \
        qr[NF - 2] = __builtin_bit_cast(bf16x8, w4); qr[NF - 1] = __builtin_bit_cast(bf16x8, w5); } } while (0)
  f32x16 pA0, pA1, pB0, pB1; float alA, alB; bf16x8 pa0, pa1, pa2, pa3;
  ATT_SLOAD(0); ATT_SWAIT(); ATT_SWRITE(0);
  ATT_SLOAD(1); ATT_SWAIT(); ATT_SWRITE(1); ATT_LBAR();
  qkt<DQK, true>(pA0, pA1, K_lds, qr, r32, hi, negm);
  partialSM<true>(pA0, pA1, m_reg, negm, alA, thr, true, rowmax32(pA0, pA1));
#pragma unroll
  for (int r = 0; r < 16; ++r) { pA0[r] = __builtin_amdgcn_exp2f(pA0[r]); pA1[r] = __builtin_amdgcn_exp2f(pA1[r]); }
  int s_cur = 0, s_nxt = 1, s_nn = 2;
#define ATT_STEP(t, X0, X1, alX, Y0, Y1, alY, HAS1, HAS2) do { \
    if (HAS1) { if (rot && (t) + 1 == nct) ATT_ROTQ(); } \
    ATT_SBAR(); if (HAS1) qkt<DQK, true>(Y0, Y1, K_lds + s_nxt * SHM_K, qr, r32, hi, negm); \
    finishSM(X0, X1, alX, l_reg, pa0, pa1, pa2, pa3); ATT_SBAR(); \
    if (HAS2) ATT_SLOAD((t) + 2); ATT_SBAR(); \
    if (HAS1) { partialSM<true>(Y0, Y1, m_reg, negm, alY, thr, false, rowmax32(Y0, Y1)); ATT_SBAR(); pv_ex(o, vb0 + s_cur * SHM_V, pa0, pa1, pa2, pa3, Y0, Y1); } \
    else pv_last(o, vb0 + s_cur * SHM_V, pa0, pa1, pa2, pa3); \
    if (HAS2) { ATT_SWAIT(); ATT_SWRITE(s_nn); } \
    if (HAS1) ATT_RESC(alY); \
    ATT_LBAR(); { const int tmp_ = s_cur; s_cur = s_nxt; s_nxt = s_nn; s_nn = tmp_; } } while (0)
  for (int t = 0; t + 2 < NT; t += 2) {
    ATT_STEP(t, pA0, pA1, alA, pB0, pB1, alB, true, true);
    ATT_STEP(t + 1, pB0, pB1, alB, pA0, pA1, alA, true, true);
  }
  ATT_STEP(NT - 2, pA0, pA1, alA, pB0, pB1, alB, true, false);
  ATT_STEP(NT - 1, pB0, pB1, alB, pA0, pA1, alA, false, false);
#undef ATT_STEP
  if (hi == 0) li_l[r32] = l_reg; asm volatile("s_waitcnt lgkmcnt(0)" ::: "memory");
  float rli[16];
#pragma unroll
  for (int r = 0; r < 16; ++r) rli[r] = __builtin_amdgcn_rcpf(li_l[crow(r, hi)]);
  if constexpr (OUTBF) { bf16* Ow = (bf16*)Opv + (size_t)(wid * 32) * DM;
#pragma unroll
    for (int r = 0; r < 16; ++r) { const int orow = crow(r, hi);
#pragma unroll
      for (int d0 = 0; d0 < 4; ++d0) Ow[(size_t)orow * DM + d0 * 32 + r32] = (bf16)f2bf(o[d0][r] * rli[r]); }
  } else { float* Ow = (float*)Opv + (size_t)(wid * 32) * NOATT;
    if (!fin) {
#pragma unroll
      for (int r = 0; r < 16; ++r) { const int orow = crow(r, hi);
#pragma unroll
        for (int d0 = 0; d0 < 4; ++d0) Ow[(size_t)orow * NOATT + d0 * 32 + r32] = o[d0][r] * rli[r]; }
    } else {
      bf16* Mw = Mx + (size_t)(wid * 32) * DM; float gv[4];
#pragma unroll
      for (int d0 = 0; d0 < 4; ++d0) gv[d0] = ag[d0 * 32 + r32] * gsc;
#pragma unroll
      for (int r = 0; r < 16; ++r) { const int orow = crow(r, hi); float v[4]; float ss = 0.f;
#pragma unroll
        for (int d0 = 0; d0 < 4; ++d0) { v[d0] = Ow[(size_t)orow * NOATT + d0 * 32 + r32] - lam * (o[d0][r] * rli[r]); ss += v[d0] * v[d0]; }
        ss += __shfl_xor(ss, 1); ss += __shfl_xor(ss, 2); ss += __shfl_xor(ss, 4); ss += __shfl_xor(ss, 8); ss += __shfl_xor(ss, 16);
        const float rs = 1.0f / sqrtf(ss * (1.f / 128.f) + EPS);
#pragma unroll
        for (int d0 = 0; d0 < 4; ++d0) Mw[(size_t)orow * DM + d0 * 32 + r32] = (bf16)f2bf(v[d0] * rs * gv[d0]); } } }
  __syncthreads();
#undef ATT_SLOAD
#undef ATT_SWRITE
#undef ATT_SWAIT
#undef ATT_RESC
#undef ATT_ROTQ
}

__device__ __forceinline__ void norm0_phase(const float* xp, const float* xs_off, const float* gm, bf16* H, float* ssq, int gw, int NGW, int lane) {
    for (int m = gw; m < M; m += NGW) {
        const float* xr = (m < MP ? xp : xs_off) + (size_t)m * DM;
        const int mi = m < MP ? 0 : 1 + (m - MP) / DSEQ; const float* g = gm + (size_t)mi * DM;
        f32x4 v[8]; float s = 0.f;
#pragma unroll
        for (int j = 0; j < 8; ++j) { v[j] = ((const f32x4*)xr)[lane + 64 * j]; s += (v[j].x * v[j].x + v[j].y * v[j].y) + (v[j].z * v[j].z + v[j].w * v[j].w); }
        s = wave_sum(s); if (lane < 32) ssq[(size_t)m * 32 + lane] = lane == 0 ? s : 0.f;
#pragma unroll
        for (int j = 0; j < 8; ++j) { const int c = (lane + 64 * j) * 4; const f32x4 y = v[j] * *(const f32x4*)(g + c); v2u o; o.x = pk2(y.x, y.y); o.y = pk2(y.z, y.w); *(v2u*)(H + (size_t)m * DM + c) = o; }
    }
}
__device__ __forceinline__ void pro2_phase(const Args& a, LAS unsigned char* lds, int tid, int bid, int G, int gt, int NGT) {
    using att::bf16x8; using att::f32x16; using att::crow;
    unsigned char* ws = a.ws; const float* MOD = (const float*)(ws + WS_MOD); float* GM = (float*)(ws + WS_GM);
    for (int i = gt; i < DEPTH * 2 * 5 * DM; i += NGT) { const int c = i % DM, mi = (i / DM) % 5, w = (i / (5 * DM)) & 1, l = i / (2 * 5 * DM);
        const float g = a.in[w ? I_N2G : I_N1G][l * DM + c]; GM[i] = g * (1.f + MOD[((size_t)(l * 5 + mi) * 6 + (w ? 4 : 1)) * DM + c]); }
    const int wave = tid >> 6, lane = tid & 63, r32 = lane & 31, hi = lane >> 5;
    LAS bf16* T = (LAS bf16*)lds;
#pragma unroll 1
    for (int kind = 0; kind < 2; ++kind) {
        __syncthreads();
        for (int e = tid; e < DEPTH * 5 * DM; e += NTH) { const int l = e / (5 * DM), mi = (e / DM) % 5, k = e % DM; T[e] = (bf16)f2bf(MOD[((size_t)(l * 5 + mi) * 6 + (kind ? 3 : 0)) * DM + k]); }
        __syncthreads();
        const int ld = kind ? 2 * DFF : NINP, items_l = ld / 32;
        for (int it = bid * NWV + wave; it < DEPTH * items_l; it += G * NWV) { const int l = it / items_l, rb = it % items_l;
            const bf16* Wr = (kind ? (const bf16*)(ws + WS_WUP + l * SZ_WUP) : (const bf16*)(ws + WS_WIN + l * SZ_WIN)) + (size_t)(rb * 32 + r32) * DM + hi * 8;
            const LAS bf16* Tb = T + (size_t)(l * 5 + (r32 < 5 ? r32 : 4)) * DM + hi * 8;
            f32x16 acc = {};
#pragma unroll 1
            for (int ks = 0; ks < DM / 16; ks += 8) { bf16x8 af[8];
#pragma unroll
                for (int j = 0; j < 8; ++j) af[j] = *reinterpret_cast<const bf16x8*>(Wr + (ks + j) * 16);
#pragma unroll
                for (int j = 0; j < 8; ++j) { bf16x8 bfv = *(const LAS bf16x8*)(Tb + (ks + j) * 16); if (r32 >= 5) bfv = (bf16x8){0, 0, 0, 0, 0, 0, 0, 0};
                    acc = __builtin_amdgcn_mfma_f32_32x32x16_bf16(af[j], bfv, acc, 0, 0, 0); } }
            if (r32 < 5) { float* dst = (kind ? (float*)(ws + WS_SHWU) + (size_t)l * 5 * 2 * DFF : (float*)(ws + WS_SHWI) + (size_t)l * 5 * NINP) + (size_t)r32 * ld + rb * 32;
#pragma unroll
                for (int r = 0; r < 16; ++r) dst[crow(r, hi)] = acc[r]; }
        }
    }
    __syncthreads();
}
__device__ __forceinline__ void final_norm_phase(const float* X, const float* g, float* out, int gw, int NGW, int lane) {
    for (int m = gw; m < M; m += NGW) {
        const float* xr = X + (size_t)m * DM; f32x4 v[8]; float s = 0.f;
#pragma unroll
        for (int j = 0; j < 8; ++j) { v[j] = ((const f32x4*)xr)[lane + 64 * j]; s += (v[j].x * v[j].x + v[j].y * v[j].y) + (v[j].z * v[j].z + v[j].w * v[j].w); }
        const float rstd = 1.0f / sqrtf(wave_sum(s) * (1.f / DM) + EPS);
#pragma unroll
        for (int j = 0; j < 8; ++j) { const int c = (lane + 64 * j) * 4; *(f32x4*)(out + (size_t)m * DM + c) = v[j] * rstd * *(const f32x4*)(g + c); }
    }
}

__device__ __forceinline__ void post_phase(const Args& a, int l, int gw, int NGW, int lane) {
    using att::bf16x8; using att::bfe; using att::cvtpk; using att::u32x4;
    unsigned char* ws = a.ws;
    const bf16* P = (const bf16*)(ws + WS_P); bf16* KRA = (bf16*)(ws + WS_KRA); bf16* KRC = (bf16*)(ws + WS_KRC); bf16* CQN = (bf16*)(ws + WS_CQN); bf16* CKVN = (bf16*)(ws + WS_CKVN);
    const float* RTA = (const float*)(ws + WS_RTA); const float* RTC = (const float*)(ws + WS_RTC);
    const float* gq = a.in[I_CQG] + l * 384; const float* gkv = a.in[I_CKVG] + l * 256;
    for (int m = gw; m < M; m += NGW) {
        const bf16* pr = P + (size_t)m * NINP;
        float xq[8], xk[8]; float sq = 0.f, sk = 0.f;
        if (lane < 48) { const bf16x8 v = *reinterpret_cast<const bf16x8*>(pr + C_CQ + lane * 8);
#pragma unroll
            for (int i = 0; i < 8; ++i) { xq[i] = bfe(v, i); sq += xq[i] * xq[i]; } }
        if (lane < 32) { const bf16x8 v = *reinterpret_cast<const bf16x8*>(pr + C_CKV + lane * 8);
#pragma unroll
            for (int i = 0; i < 8; ++i) { xk[i] = bfe(v, i); sk += xk[i] * xk[i]; } }
        const float rq = 1.0f / sqrtf(wave_sum(sq) * (1.f / 384.f) + EPS), rk = 1.0f / sqrtf(wave_sum(sk) * (1.f / 256.f) + EPS);
        if (lane < 48) { const f32x4 g0 = *(const f32x4*)(gq + lane * 8), g1 = *(const f32x4*)(gq + lane * 8 + 4);
            *(u32x4*)(CQN + (size_t)m * 384 + lane * 8) = (u32x4){cvtpk(xq[0] * rq * g0.x, xq[1] * rq * g0.y), cvtpk(xq[2] * rq * g0.z, xq[3] * rq * g0.w), cvtpk(xq[4] * rq * g1.x, xq[5] * rq * g1.y), cvtpk(xq[6] * rq * g1.z, xq[7] * rq * g1.w)}; }
        if (lane < 32) { const f32x4 g0 = *(const f32x4*)(gkv + lane * 8), g1 = *(const f32x4*)(gkv + lane * 8 + 4);
            const f32x4 y0 = {xk[0] * rk * g0.x, xk[1] * rk * g0.y, xk[2] * rk * g0.z, xk[3] * rk * g0.w}, y1 = {xk[4] * rk * g1.x, xk[5] * rk * g1.y, xk[6] * rk * g1.z, xk[7] * rk * g1.w};
            *(u32x4*)(CKVN + (size_t)m * 256 + lane * 8) = (u32x4){cvtpk(y0.x, y0.y), cvtpk(y0.z, y0.w), cvtpk(y1.x, y1.y), cvtpk(y1.z, y1.w)};
            if (m < MP) { float* o = a.out + O_CKV + (((size_t)(m / SEQ) * DEPTH + l) * SEQ + (m % SEQ)) * 256 + lane * 8; *(f32x4*)o = y0; *(f32x4*)(o + 4) = y1; } }
        if (m >= MP) { const int ms = m - MP, t = ms % DSEQ;
            if (lane < 34) { const bool isa = lane < 32; const int hh = isa ? (lane >> 1) & 1 : lane - 32;
                const int base = isa ? (lane >> 2) * 64 + hh * 32 + (lane & 1) * 8 : hh * 16, dist = isa ? 16 : 8;
                const bf16* src = pr + (isa ? C_AK : C_CKR) + base; const float* tb = isa ? RTA + (size_t)t * 64 + hh * 32 + (lane & 1) * 8 : RTC + (size_t)t * 32 + hh * 16;
                const bf16x8 v0 = *reinterpret_cast<const bf16x8*>(src), v1 = *reinterpret_cast<const bf16x8*>(src + dist);
                const f32x4 c0 = *(const f32x4*)(tb), c1 = *(const f32x4*)(tb + 4), s0 = *(const f32x4*)(tb + dist), s1 = *(const f32x4*)(tb + dist + 4);
                float y0[8], y1[8];
#pragma unroll
                for (int i = 0; i < 8; ++i) { const float cs = i < 4 ? c0[i & 3] : c1[i & 3], sn = i < 4 ? s0[i & 3] : s1[i & 3]; const float x0 = bfe(v0, i), x1 = bfe(v1, i); y0[i] = x0 * cs - x1 * sn; y1[i] = x1 * cs + x0 * sn; }
                bf16* dst = isa ? KRA + (size_t)ms * 512 + base : KRC + (size_t)ms * 32 + base;
                *(u32x4*)dst = (u32x4){cvtpk(y0[0], y0[1]), cvtpk(y0[2], y0[3]), cvtpk(y0[4], y0[5]), cvtpk(y0[6], y0[7])};
                *(u32x4*)(dst + dist) = (u32x4){cvtpk(y1[0], y1[1]), cvtpk(y1[2], y1[3]), cvtpk(y1[4], y1[5]), cvtpk(y1[6], y1[7])}; }
        } else { const size_t ro = ((size_t)(m / SEQ) * DEPTH + l) * SEQ + (m % SEQ);
            { const bf16x8 v = *reinterpret_cast<const bf16x8*>(pr + C_AK + lane * 8); float* o = a.out + O_AK + ro * 512 + lane * 8;
              *(f32x4*)o = (f32x4){bfe(v, 0), bfe(v, 1), bfe(v, 2), bfe(v, 3)}; *(f32x4*)(o + 4) = (f32x4){bfe(v, 4), bfe(v, 5), bfe(v, 6), bfe(v, 7)}; }
            { const bf16x8 v = *reinterpret_cast<const bf16x8*>(pr + C_AV + lane * 8); float* o = a.out + O_AV + ro * 512 + lane * 8;
              *(f32x4*)o = (f32x4){bfe(v, 0), bfe(v, 1), bfe(v, 2), bfe(v, 3)}; *(f32x4*)(o + 4) = (f32x4){bfe(v, 4), bfe(v, 5), bfe(v, 6), bfe(v, 7)}; }
            if (lane < 4) { const bf16x8 v = *reinterpret_cast<const bf16x8*>(pr + C_CKR + lane * 8); float* o = a.out + O_CKR + ro * 32 + lane * 8;
              *(f32x4*)o = (f32x4){bfe(v, 0), bfe(v, 1), bfe(v, 2), bfe(v, 3)}; *(f32x4*)(o + 4) = (f32x4){bfe(v, 4), bfe(v, 5), bfe(v, 6), bfe(v, 7)}; } }
    }
}


constexpr int NCHUNK = M / 64, GLA_UNITS = NCHUNK * 6;
constexpr int TS = 144;

__device__ __forceinline__ void gla_g1_unit(const Args& a, int l, int unit, LAS unsigned char* lds, int tid) {
    using namespace att;
    unsigned char* ws = a.ws; const bf16* P = (const bf16*)(ws + WS_P); bf16* QK4 = (bf16*)(ws + WS_QK4); float* U = (float*)(ws + WS_U); float* DD = (float*)(ws + WS_DD);
    const int gc = unit / 6, h = unit % 6, m0 = gc * 64;
    const int wave = tid >> 6, lane = tid & 63, r32 = lane & 31, hi = lane >> 5;
    LAS float* glr = (LAS float*)lds;
    LAS float* gw = (LAS float*)(lds + 8192);
    LAS float* gbs = (LAS float*)(lds + 16384);
    LAS float* segtot = (LAS float*)(lds + 16896);
    LAS unsigned char* KfT = lds + 20992;
    LAS unsigned char* KbT = lds + 30208;
    LAS unsigned char* Vt = lds + 39424;
    LAS float* Dl = (LAS float*)(lds + 55808);
    const float* gwt = a.in[I_BGW] + (size_t)l * 2 * 16 * 384; const float* gb = a.in[I_BGB] + l * 2 * 384;
    const int k = tid & 63, tq = tid >> 6;
    if (tid < 256) { const int t = tid >> 2, part = tid & 3; const bf16x8 v = *reinterpret_cast<const bf16x8*>(P + (size_t)(m0 + t) * NINP + C_BG + part * 8);
#pragma unroll
        for (int i = 0; i < 8; ++i) glr[t * 32 + part * 8 + i] = bfe(v, i); }
#pragma unroll
    for (int i = 0; i < 4; ++i) { const int idx = tid + NTH * i, dr = idx >> 6, kk = idx & 63; gw[idx] = gwt[(size_t)dr * 384 + h * 64 + kk]; }
    if (tid < 128) gbs[tid] = gb[(tid >> 6) * 384 + h * 64 + (tid & 63)];
    { const int sr = tid >> 4, sc = (tid & 15) * 8;
      const bf16x8 v0 = *reinterpret_cast<const bf16x8*>(P + (size_t)(m0 + sr) * NINP + C_BV + h * 128 + sc), v1 = *reinterpret_cast<const bf16x8*>(P + (size_t)(m0 + 32 + sr) * NINP + C_BV + h * 128 + sc);
      *(LAS bf16x8*)(Vt + v_st(sr, sc)) = v0; *(LAS bf16x8*)(Vt + v_st(32 + sr, sc)) = v1; }
    bf16 qv[8], kv[8];
#pragma unroll
    for (int j = 0; j < 8; ++j) { const bf16* pr = P + (size_t)(m0 + 8 * tq + j) * NINP + h * 64 + k; qv[j] = pr[C_BQ]; kv[j] = pr[C_BK]; }
    __syncthreads();
    float bf_[8], bb_[8];
#pragma unroll
    for (int dir = 0; dir < 2; ++dir) { float wr_[16];
#pragma unroll
        for (int r = 0; r < 16; ++r) wr_[r] = gw[(dir * 16 + r) * 64 + k];
        const float bias = gbs[dir * 64 + k];
#pragma unroll
        for (int j = 0; j < 8; ++j) { const LAS float* gp = glr + (8 * tq + j) * 32 + dir * 16; float pre = bias;
#pragma unroll
            for (int r4 = 0; r4 < 4; ++r4) { const f32x4 x = *(const LAS f32x4*)(gp + 4 * r4); pre += (x.x * wr_[4 * r4] + x.y * wr_[4 * r4 + 1]) + (x.z * wr_[4 * r4 + 2] + x.w * wr_[4 * r4 + 3]); }
            const float gl = (fminf(pre, 0.f) - __logf(1.f + __expf(-fabsf(pre)))) * (1.f / 16.f);
            if (dir == 0) bf_[j] = gl; else bb_[j] = gl; } }
#pragma unroll
    for (int j = 1; j < 8; ++j) bf_[j] += bf_[j - 1];
#pragma unroll
    for (int j = 6; j >= 0; --j) bb_[j] += bb_[j + 1];
    segtot[tq * 64 + k] = bf_[7]; segtot[(8 + tq) * 64 + k] = bb_[0];
    __syncthreads();
    { float of = 0.f, ob = 0.f;
#pragma unroll
      for (int q2 = 0; q2 < 8; ++q2) { const float sf = segtot[q2 * 64 + k], sb = segtot[(8 + q2) * 64 + k]; of += q2 < tq ? sf : 0.f; ob += q2 > tq ? sb : 0.f; }
      float kf[8], kb[8];
      bf16* dst = QK4 + (size_t)(m0 + 8 * tq) * 1536 + h * 64 + k;
#pragma unroll
      for (int j = 0; j < 8; ++j) { const float bfv = bf_[j] + of, bbv = bb_[j] + ob; const float ef = __expf(bfv), eb = __expf(bbv); const float q = bf2f(qv[j]) * 0.125f, kk = bf2f(kv[j]);
          kf[j] = kk * __expf(-bfv); kb[j] = kk * __expf(-bbv);
          dst[(size_t)j * 1536] = (bf16)f2bf(q * ef); dst[(size_t)j * 1536 + 384] = (bf16)f2bf(kf[j]); dst[(size_t)j * 1536 + 768] = (bf16)f2bf(q * eb); dst[(size_t)j * 1536 + 1152] = (bf16)f2bf(kb[j]);
          if (j == 7 && tq == 7) Dl[k] = ef;
          if (j == 0 && tq == 0) Dl[64 + k] = eb; }
      *(LAS u32x4*)(KfT + k * TS + tq * 16) = (u32x4){cvtpk(kf[0], kf[1]), cvtpk(kf[2], kf[3]), cvtpk(kf[4], kf[5]), cvtpk(kf[6], kf[7])};
      *(LAS u32x4*)(KbT + k * TS + tq * 16) = (u32x4){cvtpk(kb[0], kb[1]), cvtpk(kb[2], kb[3]), cvtpk(kb[4], kb[5]), cvtpk(kb[6], kb[7])}; }
    __syncthreads();
    { const int dir = wave >> 2, vb = wave & 3; const LAS unsigned char* KT = dir ? KbT : KfT;
      const int vbase = (int)(unsigned)(uintptr_t)Vt + v_rd_base(lane) + vb * 512;
      const s16x4 l0 = tr_read<v_rd_off(0, 0, 0)>(vbase), h0 = tr_read<v_rd_off(0, 0, 1)>(vbase), l1 = tr_read<v_rd_off(0, 1, 0)>(vbase), h1 = tr_read<v_rd_off(0, 1, 1)>(vbase);
      const s16x4 l2 = tr_read<v_rd_off(0, 2, 0)>(vbase), h2 = tr_read<v_rd_off(0, 2, 1)>(vbase), l3 = tr_read<v_rd_off(0, 3, 0)>(vbase), h3 = tr_read<v_rd_off(0, 3, 1)>(vbase);
      asm volatile("s_waitcnt lgkmcnt(0)" ::: "memory");
#define GLA_PK(L, H) (bf16x8){L[0], L[1], L[2], L[3], H[0], H[1], H[2], H[3]}
      const bf16x8 vf0 = GLA_PK(l0, h0), vf1 = GLA_PK(l1, h1), vf2 = GLA_PK(l2, h2), vf3 = GLA_PK(l3, h3);
      float* Ub = U + ((size_t)unit * 2 + dir) * 8192;
#pragma unroll
      for (int rb = 0; rb < 2; ++rb) { f32x16 acc = {};
          const LAS unsigned char* ar = KT + (rb * 32 + r32) * TS + hi * 16;
          acc = __builtin_amdgcn_mfma_f32_32x32x16_bf16(vf0, *(const LAS bf16x8*)(ar), acc, 0, 0, 0);
          acc = __builtin_amdgcn_mfma_f32_32x32x16_bf16(vf1, *(const LAS bf16x8*)(ar + 32), acc, 0, 0, 0);
          acc = __builtin_amdgcn_mfma_f32_32x32x16_bf16(vf2, *(const LAS bf16x8*)(ar + 64), acc, 0, 0, 0);
          acc = __builtin_amdgcn_mfma_f32_32x32x16_bf16(vf3, *(const LAS bf16x8*)(ar + 96), acc, 0, 0, 0);
          const int kr = rb * 32 + r32; const float dk = Dl[dir * 64 + kr];
#pragma unroll
          for (int g4 = 0; g4 < 4; ++g4) *(f32x4*)(Ub + kr * 128 + vb * 32 + 8 * g4 + 4 * hi) = (f32x4){acc[4 * g4] * dk, acc[4 * g4 + 1] * dk, acc[4 * g4 + 2] * dk, acc[4 * g4 + 3] * dk}; }
      if (tid < 128) DD[(size_t)unit * 128 + tid] = Dl[tid]; }
    __syncthreads();
}

constexpr int GLA_G2_ITEMS = (NPB + NDB) * 6 * 2 * 2;
__device__ __forceinline__ void gla_g2_item(const Args& a, int l, int item, int tid) {
    unsigned char* ws = a.ws; const float* U = (const float*)(ws + WS_U); const float* DD = (const float*)(ws + WS_DD); bf16* ST = (bf16*)(ws + WS_ST);
    const int half = item & 1, dir = (item >> 1) & 1, hs = item >> 2, h = hs % 6, sq = hs / 6;
    const bool smp = sq < NDB; const int b = smp ? sq : sq - NDB, nc = smp ? DSEQ / 64 : SEQ / 64, gc0 = smp ? (MP / 64) + b * (DSEQ / 64) : b * (SEQ / 64);
    const int v = tid & 127, k0 = ((tid >> 7) + 4 * half) * 8;
    float s[8];
#pragma unroll
    for (int i = 0; i < 8; ++i) s[i] = smp ? a.in[I_STB][((((size_t)b * DEPTH + l) * 2 + dir) * 6 + h) * 8192 + (k0 + i) * 128 + v] : 0.f;
    for (int ci = 0; ci < nc; ci += 4) {
        float u[4][8], d[4][8]; size_t ub[4];
#pragma unroll
        for (int j = 0; j < 4; ++j) { const int c = dir ? nc - 1 - (ci + j) : ci + j; ub[j] = ((size_t)(gc0 + c) * 6 + h) * 2 + dir;
#pragma unroll
            for (int i = 0; i < 8; ++i) { u[j][i] = U[ub[j] * 8192 + (k0 + i) * 128 + v]; d[j][i] = DD[ub[j] * 64 + k0 + i]; } }
#pragma unroll
        for (int j = 0; j < 4; ++j) {
            v4u w; w.x = pk2(s[0], s[1]); w.y = pk2(s[2], s[3]); w.z = pk2(s[4], s[5]); w.w = pk2(s[6], s[7]);
            *(v4u*)(ST + ub[j] * 8192 + v * 64 + k0) = w;
#pragma unroll
            for (int i = 0; i < 8; ++i) s[i] = d[j][i] * s[i] + u[j][i]; }
    }
    if (!smp) {
#pragma unroll
        for (int i = 0; i < 8; ++i) a.out[O_SB + ((((size_t)b * DEPTH + l) * 2 + dir) * 6 + h) * 8192 + (k0 + i) * 128 + v] = s[i];
    }
}

__device__ __forceinline__ void gla_g3_unit(const Args& a, int l, int unit, LAS unsigned char* lds, int tid) {
    using namespace att;
    unsigned char* ws = a.ws; const bf16* P = (const bf16*)(ws + WS_P); const bf16* QK4 = (const bf16*)(ws + WS_QK4); const bf16* ST = (const bf16*)(ws + WS_ST); bf16* MIX = (bf16*)(ws + WS_MIX);
    const int gc = unit / 6, h = unit % 6, m0 = gc * 64;
    const int wave = tid >> 6, lane = tid & 63, r32 = lane & 31, hi = lane >> 5;
    LAS unsigned char* T4 = lds;
    LAS unsigned char* Vt = lds + 36864;
    LAS unsigned char* AT = lds + 53248;
    LAS float* OT = (LAS float*)(lds + 71680);
    { const int row = tid >> 3, ch = tid & 7; const bf16* src = QK4 + (size_t)(m0 + row) * 1536 + h * 64 + ch * 8;
#pragma unroll
      for (int var = 0; var < 4; ++var) *(LAS bf16x8*)(T4 + var * 9216 + row * TS + ch * 16) = *reinterpret_cast<const bf16x8*>(src + var * 384);
      const int sr = tid >> 4, sc = (tid & 15) * 8;
      const bf16x8 v0 = *reinterpret_cast<const bf16x8*>(P + (size_t)(m0 + sr) * NINP + C_BV + h * 128 + sc), v1 = *reinterpret_cast<const bf16x8*>(P + (size_t)(m0 + 32 + sr) * NINP + C_BV + h * 128 + sc);
      *(LAS bf16x8*)(Vt + v_st(sr, sc)) = v0; *(LAS bf16x8*)(Vt + v_st(32 + sr, sc)) = v1; }
    __syncthreads();
    { const int dir = wave >> 2, tb = (wave >> 1) & 1, sb = wave & 1;
      const LAS unsigned char* Qt = T4 + (dir * 2) * 9216 + (tb * 32 + r32) * TS + hi * 16; const LAS unsigned char* Kt = T4 + (dir * 2 + 1) * 9216 + (sb * 32 + r32) * TS + hi * 16;
      f32x16 acc = {};
#pragma unroll
      for (int ks = 0; ks < 4; ++ks) acc = __builtin_amdgcn_mfma_f32_32x32x16_bf16(*(const LAS bf16x8*)(Kt + ks * 32), *(const LAS bf16x8*)(Qt + ks * 32), acc, 0, 0, 0);
      const int t = tb * 32 + r32;
#pragma unroll
      for (int r = 0; r < 16; ++r) { const int s = sb * 32 + crow(r, hi); const bool keep = dir ? (s >= t) : (s <= t); acc[r] = keep ? acc[r] : 0.f; }
#pragma unroll
      for (int g = 0; g < 4; ++g) { v2u w; w.x = cvtpk(acc[4 * g], acc[4 * g + 1]); w.y = cvtpk(acc[4 * g + 2], acc[4 * g + 3]);
          *(LAS v2u*)(AT + dir * 9216 + t * TS + (sb * 32 + 8 * g + 4 * hi) * 2) = w; } }
    __syncthreads();
    { const int tb = wave >> 2, vb = wave & 3; f32x16 o = {};
      const int vbase = (int)(unsigned)(uintptr_t)Vt + v_rd_base(lane) + vb * 512;
      const s16x4 l0 = tr_read<v_rd_off(0, 0, 0)>(vbase), h0 = tr_read<v_rd_off(0, 0, 1)>(vbase), l1 = tr_read<v_rd_off(0, 1, 0)>(vbase), h1 = tr_read<v_rd_off(0, 1, 1)>(vbase);
      const s16x4 l2 = tr_read<v_rd_off(0, 2, 0)>(vbase), h2 = tr_read<v_rd_off(0, 2, 1)>(vbase), l3 = tr_read<v_rd_off(0, 3, 0)>(vbase), h3 = tr_read<v_rd_off(0, 3, 1)>(vbase);
      asm volatile("s_waitcnt lgkmcnt(0)" ::: "memory");
      const bf16x8 vf0 = GLA_PK(l0, h0), vf1 = GLA_PK(l1, h1), vf2 = GLA_PK(l2, h2), vf3 = GLA_PK(l3, h3);
#pragma unroll
      for (int dir = 0; dir < 2; ++dir) {
          const bf16* Sd = ST + (((size_t)unit) * 2 + dir) * 8192 + (size_t)(vb * 32 + r32) * 64 + hi * 8;
          const bf16x8 s0 = *reinterpret_cast<const bf16x8*>(Sd), s1 = *reinterpret_cast<const bf16x8*>(Sd + 16), s2 = *reinterpret_cast<const bf16x8*>(Sd + 32), s3 = *reinterpret_cast<const bf16x8*>(Sd + 48);
          const LAS unsigned char* Qt = T4 + (dir * 2) * 9216 + (tb * 32 + r32) * TS + hi * 16; const LAS unsigned char* At = AT + dir * 9216 + (tb * 32 + r32) * TS + hi * 16;
          o = __builtin_amdgcn_mfma_f32_32x32x16_bf16(*(const LAS bf16x8*)(Qt), s0, o, 0, 0, 0);
          o = __builtin_amdgcn_mfma_f32_32x32x16_bf16(*(const LAS bf16x8*)(Qt + 32), s1, o, 0, 0, 0);
          o = __builtin_amdgcn_mfma_f32_32x32x16_bf16(*(const LAS bf16x8*)(Qt + 64), s2, o, 0, 0, 0);
          o = __builtin_amdgcn_mfma_f32_32x32x16_bf16(*(const LAS bf16x8*)(Qt + 96), s3, o, 0, 0, 0);
          o = __builtin_amdgcn_mfma_f32_32x32x16_bf16(*(const LAS bf16x8*)(At), vf0, o, 0, 0, 0);
          o = __builtin_amdgcn_mfma_f32_32x32x16_bf16(*(const LAS bf16x8*)(At + 32), vf1, o, 0, 0, 0);
          o = __builtin_amdgcn_mfma_f32_32x32x16_bf16(*(const LAS bf16x8*)(At + 64), vf2, o, 0, 0, 0);
          o = __builtin_amdgcn_mfma_f32_32x32x16_bf16(*(const LAS bf16x8*)(At + 96), vf3, o, 0, 0, 0); }
#pragma unroll
      for (int r = 0; r < 16; ++r) OT[(tb * 32 + crow(r, hi)) * 132 + vb * 32 + r32] = o[r]; }
    __syncthreads();
    { const int t = tid >> 3, c0 = (tid & 7) * 16; const float* bg = a.in[I_BNG] + l * 128 + c0;
      f32x4 x[4]; float ss = 0.f;
#pragma unroll
      for (int i = 0; i < 4; ++i) { x[i] = *(const LAS f32x4*)(OT + t * 132 + c0 + 4 * i); ss += (x[i].x * x[i].x + x[i].y * x[i].y) + (x[i].z * x[i].z + x[i].w * x[i].w); }
      ss += __shfl_xor(ss, 1); ss += __shfl_xor(ss, 2); ss += __shfl_xor(ss, 4);
      const float rs = 1.0f / sqrtf(ss * (1.f / 128.f) + EPS);
      const bf16* rg = P + (size_t)(m0 + t) * NINP + C_BR + h * 128 + c0; const bf16x8 r0 = *reinterpret_cast<const bf16x8*>(rg), r1 = *reinterpret_cast<const bf16x8*>(rg + 8);
      float y[16];
#pragma unroll
      for (int i = 0; i < 4; ++i) { const f32x4 gv = *(const f32x4*)(bg + 4 * i); y[4 * i] = x[i].x * rs * gv.x; y[4 * i + 1] = x[i].y * rs * gv.y; y[4 * i + 2] = x[i].z * rs * gv.z; y[4 * i + 3] = x[i].w * rs * gv.w; }
#pragma unroll
      for (int i = 0; i < 8; ++i) { y[i] *= siluf(bfe(r0, i)); y[8 + i] *= siluf(bfe(r1, i)); }
      bf16* dst = MIX + (size_t)(m0 + t) * DM + 512 + h * 128 + c0;
      *(u32x4*)(dst) = (u32x4){cvtpk(y[0], y[1]), cvtpk(y[2], y[3]), cvtpk(y[4], y[5]), cvtpk(y[6], y[7])};
      *(u32x4*)(dst + 8) = (u32x4){cvtpk(y[8], y[9]), cvtpk(y[10], y[11]), cvtpk(y[12], y[13]), cvtpk(y[14], y[15])}; }
    __syncthreads();
#undef GLA_PK
}

__device__ __forceinline__ void mixer_phase(const Args& a, int l, LAS unsigned char* lds, int tid_in, int bid, int G) {
    unsigned char* ws = a.ws;
    const bf16* P = (const bf16*)(ws + WS_P); const bf16* QC = (const bf16*)(ws + WS_QC); const bf16* KVC = (const bf16*)(ws + WS_KVC); const bf16* KRA = (const bf16*)(ws + WS_KRA); const bf16* KRC = (const bf16*)(ws + WS_KRC);
    const bf16* CAK = (const bf16*)(ws + WS_CAK); const bf16* CAV = (const bf16*)(ws + WS_CAV); const bf16* CKRX = (const bf16*)(ws + WS_CKRX); const bf16* KVCTX = (const bf16*)(ws + WS_KVCTX);
    const float* RTA = (const float*)(ws + WS_RTA); const float* RTC = (const float*)(ws + WS_RTC); float* OATT = (float*)(ws + WS_OATT); bf16* MIXB = (bf16*)(ws + WS_MIX);
    const float lam = ((const float*)(ws + WS_LAM))[l], li = ((const float*)(ws + WS_LAM))[4 + l]; const float* ag = a.in[I_ANG] + l * 128;
    constexpr int NAS = 256, NCS = 384, NAP = 64, NCP = 96, NFILL = NAP + NCP + GLA_UNITS;
    const bool tuned = G == 256;
    const int per = G / 8, vb = (bid % 8) * per + bid / 8, wx = vb % per, hx = per / 2;
    const bool heavy = wx < hx; const int hidx = (vb / per) * hx + wx, lidx = (vb / per) * hx + (wx - hx);
    const int nl = G / 2;
    const int nslots = tuned ? 3 + (!heavy ? (NFILL + nl - 1) / nl : 0) : (NAS + NCS + NFILL + G - 1) / G;
    for (int sl = 0; sl < nslots; ++sl) {
        int tid = tid_in; asm volatile("" : "+v"(tid));
        int kind, u, f = -1;
        if (!tuned) { const int g = bid + sl * G; if (g >= NAS + NCS + NFILL) continue; if (g < NAS) { kind = 0; u = g; } else if (g < NAS + NCS) { kind = 1; u = g - NAS; } else { kind = 5; u = 0; f = g - NAS - NCS; } }
        else if (sl == 0) { kind = 0; u = vb; }
        else if (sl == 1) { kind = 1; u = vb; }
        else if (sl == 2) { if (heavy) { kind = 1; u = G + hidx; } else continue; }
        else { kind = 5; u = 0; f = lidx + (sl - 3) * nl; if (f >= NFILL) continue; }
        if (kind == 5) { if (f < NAP) { kind = 2; u = f; } else if (f < NAP + NCP) { kind = 3; u = f - NAP; } else { kind = 4; u = f - NAP - NCP; } }
        if (kind == 0 && u >= NAS) continue;
        if (kind == 1 && u >= NCS) continue;
        if (kind == 4) { gla_g3_unit(a, l, u, lds, tid); continue; }
        if (kind == 0 || kind == 2) {
            int b, head, qb; size_t r0;
            if (kind == 0) { b = u >> 6; head = (u >> 4) & 3; qb = u & 15; r0 = (size_t)MP + (size_t)b * DSEQ; } else { b = u >> 2; head = u & 3; qb = 0; r0 = (size_t)b * SEQ; }
#pragma unroll 1
            for (int ps = 0; ps < 2; ++ps) { const int combo = head * 2 + ps; int tid2 = tid; asm volatile("" : "+v"(tid2));
                KSeg ctx{nullptr, 0, nullptr, 0, nullptr, 0, 0}, lat;
                if (kind == 0) { ctx = KSeg{CAK + ((size_t)(b * DEPTH + l) * PAST) * 512 + combo * 64, 512, nullptr, 0, CAV + ((size_t)(b * DEPTH + l) * PAST) * 512 + head * 128, 512, PAST};
                                 lat = KSeg{KRA + ((size_t)b * DSEQ) * 512 + combo * 64, 512, nullptr, 0, P + r0 * NINP + C_AV + head * 128, NINP, DSEQ}; }
                else lat = KSeg{P + r0 * NINP + C_AK + combo * 64, NINP, nullptr, 0, P + r0 * NINP + C_AV + head * 128, NINP, SEQ};
                attn_mfma_unit<64, 1, false>(lds, P + (r0 + qb * 256) * NINP + C_AQ + combo * 64, NINP, kind == 0, RTA, qb * 256, ctx, lat, 0.125f, OATT + (r0 + qb * 256) * NOATT + head * 128, tid2,
                                             ps == 1, lam, 1.f - li, ag, MIXB + (r0 + qb * 256) * DM + head * 128); }
        } else {
            KSeg ctx{nullptr, 0, nullptr, 0, nullptr, 0, 0}, lat; const bf16* Qp; int t0 = 0; bf16* Op;
            if (kind == 1) { const int b = u / 96, h = (u >> 4) % 6, qb = u & 15; const size_t r0 = (size_t)MP + (size_t)b * DSEQ; const size_t c0 = (size_t)(l * NDB + b) * PAST;
                ctx = KSeg{KVCTX + c0 * NKVP + h * 192, NKVP, CKRX + ((size_t)(b * DEPTH + l) * PAST) * 32, 32, KVCTX + c0 * NKVP + h * 192 + 64, NKVP, PAST};
                lat = KSeg{KVC + r0 * NKVP + h * 192, NKVP, KRC + ((size_t)b * DSEQ) * 32, 32, KVC + r0 * NKVP + h * 192 + 64, NKVP, DSEQ};
                Qp = QC + (r0 + qb * 256) * NQCP + h * 96; t0 = qb * 256; Op = MIXB + (r0 + qb * 256) * DM + 1280 + h * 128; }
            else { const int b = u / 6, h = u % 6; const size_t r0 = (size_t)b * SEQ;
                lat = KSeg{KVC + r0 * NKVP + h * 192, NKVP, P + r0 * NINP + C_CKR, NINP, KVC + r0 * NKVP + h * 192 + 64, NKVP, SEQ};
                Qp = QC + r0 * NQCP + h * 96; Op = MIXB + r0 * DM + 1280 + h * 128; }
            attn_mfma_unit<96, 1, true>(lds, Qp, NQCP, kind == 1, RTC, t0, ctx, lat, 0.10206207261596575f, Op, tid);
        }
    }
}

__device__ __forceinline__ void combine_phase(const Args& a, int l, int gw, int NGW, int lane) {
    using att::cvtpk; using att::u32x4;
    unsigned char* ws = a.ws; const float* OATT = (const float*)(ws + WS_OATT); bf16* MIX = (bf16*)(ws + WS_MIX);
    const float lam = ((const float*)(ws + WS_LAM))[l], li = ((const float*)(ws + WS_LAM))[4 + l];
    const int h = lane >> 4, c8 = (lane & 15) * 8; const float* ag = a.in[I_ANG] + l * 128 + c8;
    const f32x4 g0 = *(const f32x4*)ag * (1.f - li), g1 = *(const f32x4*)(ag + 4) * (1.f - li);
    for (int m = gw; m < M; m += NGW) {
        const float* oa = OATT + (size_t)m * NOATT + (2 * h) * 128 + c8;
        const f32x4 a0 = *(const f32x4*)oa, a1 = *(const f32x4*)(oa + 4), b0 = *(const f32x4*)(oa + 128), b1 = *(const f32x4*)(oa + 132);
        const f32x4 o0 = a0 - b0 * lam, o1 = a1 - b1 * lam;
        float ss = (o0.x * o0.x + o0.y * o0.y) + (o0.z * o0.z + o0.w * o0.w) + (o1.x * o1.x + o1.y * o1.y) + (o1.z * o1.z + o1.w * o1.w);
        ss += __shfl_xor(ss, 1); ss += __shfl_xor(ss, 2); ss += __shfl_xor(ss, 4); ss += __shfl_xor(ss, 8);
        const float r = 1.0f / sqrtf(ss * (1.f / 128.f) + EPS);
        const f32x4 y0 = o0 * r * g0, y1 = o1 * r * g1;
        *(u32x4*)(MIX + (size_t)m * DM + h * 128 + c8) = (u32x4){cvtpk(y0.x, y0.y), cvtpk(y0.z, y0.w), cvtpk(y1.x, y1.y), cvtpk(y1.z, y1.w)};
    }
}

__device__ __forceinline__ void convact_phase(const Args& a, int l, int gw, int NGW, int lane) {
    const bf16* GU = (const bf16*)(a.ws + WS_GU); bf16* ACT = (bf16*)(a.ws + WS_ACT);
    const float* cw = a.in[I_CONVW] + (size_t)l * 3 * DFF; const float* cb = a.in[I_CONVB] + (size_t)l * DFF;
    for (int m = gw; m < M; m += NGW) {
        int t, n; if (m < MP) { t = m % SEQ; n = SEQ; } else { t = (m - MP) % DSEQ; n = DSEQ; }
        const bool hp = t > 0, hn = t < n - 1;
        const bf16* g1 = GU + (size_t)m * (2 * DFF);
        for (int c = lane; c < DFF; c += 64) {
            const float gm = bf2f(g1[c]), gp = hp ? bf2f(g1[c - 2 * DFF]) : 0.f, gn = hn ? bf2f(g1[c + 2 * DFF]) : 0.f, uu = bf2f(g1[DFF + c]);
            const float gc = gp * cw[c] + gm * cw[DFF + c] + gn * cw[2 * DFF + c] + cb[c];
            ACT[(size_t)m * DFF + c] = (bf16)f2bf(siluf(gc) * uu);
        }
    }
}

__device__ __forceinline__ void ffn_fix_phase(const Args& a, int l, int gt, int NGT) {
    const float* side = (const float*)(a.ws + WS_SIDE); bf16* ACT = (bf16*)(a.ws + WS_ACT);
    const float* cw = a.in[I_CONVW] + (size_t)l * 3 * DFF;
    for (int i = gt; i < (MS / 256) * 2 * DFF; i += NGT) { const int j = i % DFF, w = (i / DFF) & 1, pm = 16 + i / (2 * DFF), q = (pm - 16) & 15;
        if (w == 0 ? q == 0 : q == 15) continue;
        const float* sp = side + ((size_t)(pm * 2 + w) * 3) * DFF + j;
        const float gnb = w == 0 ? side[((size_t)((pm - 1) * 2 + 1) * 3 + 2) * DFF + j] : side[((size_t)((pm + 1) * 2 + 0) * 3 + 2) * DFF + j];
        const float gc = sp[0] + cw[(w == 0 ? 0 : 2) * DFF + j] * gnb;
        ACT[(size_t)(pm * 256 + (w == 0 ? 0 : 255)) * DFF + j] = (bf16)f2bf(siluf(gc) * sp[DFF]); }
}

constexpr int PH_PER_LAYER = 11, PH_L0 = 3, PH_FIN = PH_L0 + DEPTH * PH_PER_LAYER, N_PHASES = PH_FIN + 1;
__global__ void __launch_bounds__(NTH, 2) mk_fwd(Args a) {
    extern __shared__ __attribute__((aligned(16))) unsigned char lds_raw[];
    LAS unsigned char* lds = (LAS unsigned char*)lds_raw;
    const int bid = blockIdx.x, G = gridDim.x, wave0 = __builtin_amdgcn_readfirstlane((int)threadIdx.x >> 6);
#define PH_BEGIN int tid = TID_NOW; asm volatile("" : "+v"(tid)); unsigned char* ws = a.ws; asm volatile("" : "+s"(ws)); \
    const int lane = tid & 63, wave = __builtin_amdgcn_readfirstlane(tid >> 6), gw = bid * NWV + wave, NGW = G * NWV, gt = bid * NTH + tid, NGT = G * NTH; (void)lane; (void)gw; (void)NGW; (void)gt; (void)NGT; (void)ws
    {
        volatile LAS unsigned* Z = (volatile LAS unsigned*)(lds + RING_BYTES);
        for (int u = threadIdx.x; u < (LDS_BYTES - RING_BYTES) / 4; u += NTH) Z[u] = 0u;
        __syncthreads();
    }
    if (a.use_bar) (void)xcd_barrier_post((unsigned*)(a.ws + WS_CTL) + 4096, (volatile LAS unsigned*)(lds + MISC_OFF) + 8);
#define bar (XcdBarrier{(unsigned*)(a.ws + WS_CTL) + 4096, xb_xcc_id(), (volatile LAS unsigned*)(lds + MISC_OFF) + 8})
    const int lo = a.ph_lo, hi = a.ph_hi;
#define IN(k) (lo <= (k) && (k) < hi)
#define TID_NOW (wave0 * 64 + (int)__builtin_amdgcn_mbcnt_hi(~0u, __builtin_amdgcn_mbcnt_lo(~0u, 0u)))
#define SEAM(k) do { if (IN(k) && IN((k) + 1)) xcd_barrier(bar, TID_NOW); } while (0)
#ifndef MK_DUP
#define MK_DUP 0
#endif
#define DUP(bit) _Pragma("unroll 1") for (int rep_ = 0; rep_ < (((MK_DUP) & (bit)) ? 2 : 1); ++rep_)

    if (IN(0)) DUP(512) { PH_BEGIN; pro0_phase(a, lds, tid, lane, wave, bid, G); SEAM(0); }
    if (IN(1)) { PH_BEGIN;
        modfin_phase(a, gt, NGT);
        pg8::Gemm g{(const bf16*)(ws + WS_CKVA), (const bf16*)(ws + WS_WKV), DEPTH * NDB * PAST, NKVP, 256, 256, 256, 4, (size_t)NKVP * 256}; pg8::StaticOrder S; S.init(DEPTH * NDB * PAST, NKVP, G, bid);
        pg8::EpiBf16<0> E{(bf16*)(ws + WS_KVCTX), NKVP, nullptr, 0, 0, 1.f};
        pg8::gemm_phase<pg8::EpiBf16<0>, pg8::StaticOrder, true, true>(lds, g, S, E, tid);
        SEAM(1);
    }
    if (IN(2)) DUP(8192) { PH_BEGIN; pro2_phase(a, lds, tid, bid, G, gt, NGT); SEAM(2); }
    for (int l = 0; l < DEPTH; ++l) {
        const int pb = PH_L0 + PH_PER_LAYER * l;
        if (pb + PH_PER_LAYER <= lo || pb >= hi) continue;
#define LAYER_PTRS const float* modl = (const float*)(ws + WS_MOD) + (size_t)l * 5 * 6 * DM; const float* xin0 = l == 0 ? a.in[I_XP] : (const float*)(ws + WS_X); \
        const float* xin1 = l == 0 ? a.in[I_XS] - (size_t)MP * DM : (const float*)(ws + WS_X); float* X = (float*)(ws + WS_X); (void)modl; (void)xin0; (void)xin1; (void)X
        if (IN(pb + 0) && l == 0) { PH_BEGIN; norm0_phase(a.in[I_XP], a.in[I_XS] - (size_t)MP * DM, (const float*)(ws + WS_GM), (bf16*)(ws + WS_H), (float*)(ws + WS_SSQP), gw, NGW, lane); SEAM(pb + 0); }
        if (IN(pb + 1)) DUP(2) { PH_BEGIN;
            pg8::Gemm g{(const bf16*)(ws + WS_H), (const bf16*)(ws + WS_WIN + l * SZ_WIN), M, NINP, DM, DM, DM, 1 << 20, 0}; pg8::StaticOrder S; S.init(M, NINP, G, bid);
            pg8::EpiBf16Norm E{(bf16*)(ws + WS_P), NINP, (const float*)(ws + WS_SSQP) + (size_t)(2 * l) * M * 32, (const float*)(ws + WS_SHWI) + (size_t)l * 5 * NINP, NINP, (LAS float*)(lds + RING_BYTES + 8192)};
            pg8::gemm_phase<pg8::EpiBf16Norm, pg8::StaticOrder, true, true>(lds, g, S, E, tid);
            SEAM(pb + 1);
        }
        if (IN(pb + 2)) DUP(4) { PH_BEGIN; post_phase(a, l, gw, NGW, lane);
#if 1
            __syncthreads();
            for (int u = bid; u < GLA_UNITS; u += G) { int t2 = tid; asm volatile("" : "+v"(t2)); gla_g1_unit(a, l, u, lds, t2); }
#endif
            SEAM(pb + 2); }
        if (IN(pb + 3)) DUP(8) {
            { PH_BEGIN; pg8::Gemm g{(const bf16*)(ws + WS_CQN), (const bf16*)(ws + WS_WQ + l * SZ_WQ), M, NQCP, 384, 384, 384, 1 << 20, 0}; pg8::StaticOrder S; S.init(M, NQCP, G, bid);
              pg8::EpiBf16<0> E{(bf16*)(ws + WS_QC), NQCP, nullptr, NQCP, 0, 0.10206207261596575f * 1.4426950408889634f};
              pg8::gemm_phase<pg8::EpiBf16<0>, pg8::StaticOrder, true, true>(lds, g, S, E, tid); }
            __syncthreads();
            { PH_BEGIN; pg8::Gemm g{(const bf16*)(ws + WS_CKVN), (const bf16*)(ws + WS_WKV + l * SZ_WKV), M, NKVP, 256, 256, 256, 1 << 20, 0}; pg8::StaticOrder S; S.init(M, NKVP, G, bid);
              pg8::EpiBf16<0> E{(bf16*)(ws + WS_KVC), NKVP, nullptr, 0, 0, 1.f};
              pg8::gemm_phase<pg8::EpiBf16<0>, pg8::StaticOrder, true, true>(lds, g, S, E, tid); }
#if MK_MFMA_GLA
            { PH_BEGIN; for (int it = bid; it < GLA_G2_ITEMS; it += G) gla_g2_item(a, l, it, tid); }
#endif
            SEAM(pb + 3);
        }
        if (IN(pb + 4)) DUP(16) { PH_BEGIN; mixer_phase(a, l, lds, tid, bid, G); if (IN(pb + 6)) xcd_barrier(bar, TID_NOW); }
        if (IN(pb + 6)) { PH_BEGIN; LAYER_PTRS;
            constexpr int NFULL = 512;
            { pg8::Gemm g{(const bf16*)(ws + WS_MIX), (const bf16*)(ws + WS_WOUT + l * SZ_WOUT), M, DM, DM, DM, DM, 1 << 20, 0}; pg8::StaticOrder S; S.init(M, DM, G, bid); S.lim = (MK_SPLITK && G == 256) ? NFULL : S.nwg;
              pg8::EpiResid E{MK_SPLITK ? X : xin0, MK_SPLITK ? X : xin1, X, modl + 2 * DM, (bf16*)(ws + WS_H), (const float*)(ws + WS_GM) + (size_t)(l * 2 + 1) * 5 * DM, (float*)(ws + WS_SSQP) + (size_t)(2 * l + 1) * M * 32};
              pg8::gemm_phase<pg8::EpiResid, pg8::StaticOrder, true, true>(lds, g, S, E, tid); }
            if (MK_SPLITK && G == 256) { __syncthreads(); int t3 = tid; asm volatile("" : "+v"(t3)); (void)t3;
              pg8::Gemm g{(const bf16*)(ws + WS_MIX), (const bf16*)(ws + WS_WOUT + l * SZ_WOUT), M, DM, DM / 2, DM, DM, 1 << 20, 0}; pg8::TailOrder S; S.init(M, DM, G, bid); S.base = NFULL; S.nth = DM / 128;
              pg8::EpiResidTail E{X, modl + 2 * DM, (float*)(ws + WS_SPLITK), (unsigned*)(ws + WS_CTL) + CW_TICKET + (l * 2 + 0) * 128 * 64, (LAS unsigned*)(lds + RING_BYTES + 2048)};
              pg8::gemm_phase<pg8::EpiResidTail, pg8::TailOrder, true, true>(lds, g, S, E, tid); }
            SEAM(pb + 6);
        }
        if (IN(pb + 8)) DUP(128) { PH_BEGIN;
            pg8::Gemm g{(const bf16*)(ws + WS_H), (const bf16*)(ws + WS_WUP + l * SZ_WUP), M, 2 * DFF, DM, DM, DM, 1 << 20, 0}; pg8::StaticOrder S; S.init(M, 2 * DFF, G, bid);
            pg8::EpiConvAct E{(bf16*)(ws + WS_ACT), a.in[I_CONVW] + (size_t)l * 3 * DFF, a.in[I_CONVB] + (size_t)l * DFF, (float*)(ws + WS_SIDE), (LAS float*)(lds + RING_BYTES + 4096),
                               (const float*)(ws + WS_SSQP) + (size_t)(2 * l + 1) * M * 32, (const float*)(ws + WS_SHWU) + (size_t)l * 5 * 2 * DFF, (LAS float*)(lds + RING_BYTES + 8192)};
            pg8::gemm_phase<pg8::EpiConvAct, pg8::StaticOrder, true, true>(lds, g, S, E, tid);
            SEAM(pb + 8);
        }
        if (IN(pb + 9)) DUP(256) { PH_BEGIN; ffn_fix_phase(a, l, gt, NGT); SEAM(pb + 9); }
        if (IN(pb + 10)) { PH_BEGIN; LAYER_PTRS;
            constexpr int NFULL = 512;
            { pg8::Gemm g{(const bf16*)(ws + WS_ACT), (const bf16*)(ws + WS_WDN + l * SZ_WDN), M, DM, DFF, DFF, DFF, 1 << 20, 0}; pg8::StaticOrder S; S.init(M, DM, G, bid); S.lim = (MK_SPLITK && G == 256) ? NFULL : S.nwg;
              pg8::EpiResid E{X, X, X, modl + 5 * DM, l + 1 < DEPTH ? (bf16*)(ws + WS_H) : nullptr, (const float*)(ws + WS_GM) + (size_t)((l + 1 < DEPTH ? l + 1 : l) * 2) * 5 * DM, (float*)(ws + WS_SSQP) + (size_t)(2 * (l + 1 < DEPTH ? l + 1 : l)) * M * 32};
              pg8::gemm_phase<pg8::EpiResid, pg8::StaticOrder, true, true>(lds, g, S, E, tid); }
            if (MK_SPLITK && G == 256) { __syncthreads(); int t3 = tid; asm volatile("" : "+v"(t3)); (void)t3;
              pg8::Gemm g{(const bf16*)(ws + WS_ACT), (const bf16*)(ws + WS_WDN + l * SZ_WDN), M, DM, DFF / 2, DFF, DFF, 1 << 20, 0}; pg8::TailOrder S; S.init(M, DM, G, bid); S.base = NFULL; S.nth = DFF / 128;
              pg8::EpiResidTail E{X, modl + 5 * DM, (float*)(ws + WS_SPLITK), (unsigned*)(ws + WS_CTL) + CW_TICKET + (l * 2 + 1) * 128 * 64, (LAS unsigned*)(lds + RING_BYTES + 2048)};
              pg8::gemm_phase<pg8::EpiResidTail, pg8::TailOrder, true, true>(lds, g, S, E, tid); }
            SEAM(pb + 10);
        }
    }
    if (IN(PH_FIN)) { PH_BEGIN; final_norm_phase((const float*)(ws + WS_X), a.in[I_FING], a.out, gw, NGW, lane); }
#undef IN
#undef SEAM
#undef bar
}

#ifndef MK_ONE_LAUNCH
#define MK_ONE_LAUNCH 1
#endif
extern "C" void kernel_launch(void* const* d_in, const int* in_sizes, int n_in, void* d_out, int out_size, void* d_ws, size_t ws_size, hipStream_t stream) {
    static int grid = 0;
    if (grid == 0) {
        if (n_in != N_INPUTS || (size_t)out_size != O_END || ws_size < WS_END) { fprintf(stderr, "kernel_launch: shape mismatch: n_in %d out %d ws %zu (need %zu)\n", n_in, out_size, ws_size, (size_t)WS_END); grid = -1; return; }
        int dev = 0, cus = 0, per_cu = 0;
        if (hipGetDevice(&dev) != hipSuccess || hipDeviceGetAttribute(&cus, hipDeviceAttributeMultiprocessorCount, dev) != hipSuccess) { grid = -1; return; }
        if (hipFuncSetAttribute((const void*)mk_fwd, hipFuncAttributeMaxDynamicSharedMemorySize, LDS_BYTES) != hipSuccess) { fprintf(stderr, "kernel_launch: hipFuncSetAttribute failed\n"); grid = -1; return; }
        if (hipOccupancyMaxActiveBlocksPerMultiprocessor(&per_cu, (const void*)mk_fwd, NTH, LDS_BYTES) != hipSuccess || per_cu < 1) fprintf(stderr, "kernel_launch: occupancy query reports %d\n", per_cu);
        (void)hipGetLastError();
        grid = cus;
    }
    if (grid < 0) return;
    if (hipMemsetAsync((char*)d_ws + WS_CTL, 0, CTL_ZERO_BYTES, stream) != hipSuccess) return;
    Args a{};
    for (int i = 0; i < N_INPUTS; ++i) a.in[i] = (const float*)d_in[i];
    a.out = (float*)d_out; a.ws = (unsigned char*)d_ws; a.pad = 0;
#if MK_ONE_LAUNCH
    a.ph_lo = 0; a.ph_hi = N_PHASES; a.use_bar = 1;
    hipLaunchKernelGGL(mk_fwd, dim3(grid), dim3(NTH), LDS_BYTES, stream, a);
#else
    for (int p = 0; p < N_PHASES; ++p) { a.ph_lo = p; a.ph_hi = p + 1; a.use_bar = 0; hipLaunchKernelGGL(mk_fwd, dim3(grid), dim3(NTH), LDS_BYTES, stream, a); }
#endif
    const hipError_t le = hipPeekAtLastError();
    if (le != hipSuccess) fprintf(stderr, "kernel_launch: launch failed: %s\n", hipGetErrorName(le));
}
```

```cpp
#include <hip/hip_runtime.h>
#include <cstdio>
#include <cstdint>
#include <cmath>

namespace pg8 {
#define PG8_LAS __attribute__((address_space(3)))
typedef unsigned short bf16_t;
typedef short bf16x8 __attribute__((ext_vector_type(8)));
typedef float f32x4 __attribute__((ext_vector_type(4)));
typedef unsigned u32x4 __attribute__((ext_vector_type(4)));
constexpr int BM = 256, BK = 64, HALF = 128, HTB = HALF * BK * 2  , STAGE_BYTES = 8 * HTB, NXCD = 8, WGM = 8;

__host__ __device__ __forceinline__ int lds_byte(int r, int c) { const int st = (r >> 4) * 2 + (c >> 5), rr = r & 15, cc = c & 31, ob = rr * 64 + cc * 2; return st * 1024 + (ob ^ (((ob >> 9) & 1) << 5)); }
__host__ __device__ __forceinline__ void stage_rc(int b, int& R, int& C) { const int st = b / 1024, sb = b % 1024, swz = sb ^ (((sb >> 9) & 1) << 5); R = (st >> 1) * 16 + swz / 64; C = (st & 1) * 32 + (swz % 64) / 2; }
__host__ __device__ __forceinline__ int perm32(int rho) { const int n = rho >> 4, i = rho & 15; return 8 * (i >> 2) + 4 * n + (i & 3); }

struct Unit { int pm, pn, kt0; };
struct Gemm { const bf16_t* A; const bf16_t* Bt; int M, N, K, lda, ldb, bgrp; size_t bgrp_stride; };

struct StaticOrder {
    int nM, nN, nwg, G, c;
    __host__ __device__ void init(int M, int N, int G_, int c_) { nM = M / BM; nN = N / BM; nwg = nM * nN; G = G_; c = c_; lim = nwg; }
    int lim;
    __host__ __device__ void map(int wgid, Unit& u) const {
        { const int q = nwg / NXCD, r = nwg % NXCD, xcd = wgid % NXCD, off = wgid / NXCD; wgid = (xcd < r ? xcd * (q + 1) : r * (q + 1) + (xcd - r) * q) + off; }
        const int nig = WGM * nN, gid = wgid / nig, fm = gid * WGM, gsz = (nM - fm) < WGM ? (nM - fm) : WGM;
        u.pm = fm + ((wgid % nig) % gsz); u.pn = (wgid % nig) / gsz; u.kt0 = 0;
    }
    __host__ __device__ bool next(int i, Unit& u) const {
        const long L = (long)i * G + c; if (L >= lim) return false;
        map((int)L, u); return true;
    }
    __device__ __forceinline__ void a_ready(const Unit&) const {}
    __device__ __forceinline__ void done(const Unit&) const {}
};

struct TailOrder : StaticOrder {
    int base, nth;
    __host__ __device__ bool next(int i, Unit& u) const { if (i > 0) return false; const int L = base + (c >> 1); if (L >= nwg) return false; map(L, u); u.kt0 = (c & 1) * nth; return true; }
};

__device__ __forceinline__ unsigned cvt_pk_bf16(float lo, float hi) { unsigned r; asm volatile("v_cvt_pk_bf16_f32 %0, %1, %2" : "=v"(r) : "v"(lo), "v"(hi)); return r; }
typedef float f32x2 __attribute__((ext_vector_type(2)));
__device__ __forceinline__ f32x2 gelu_pk(f32x2 v) {
    const f32x2 av = __builtin_elementwise_abs(v), d = av * 0.2316418882f + 1.0f;
    f32x2 t; t.x = __builtin_amdgcn_rcpf(d.x); t.y = __builtin_amdgcn_rcpf(d.y);
    f32x2 q = t * 0.5307027145f + (-0.7265760135f); q = q * t + 0.7107068705f; q = q * t + (-0.142248368f); q = q * t + 0.127414796f; q = q * t;
    const f32x2 s = (v * v) * (-0.72134752044f);
    f32x2 e; e.x = __builtin_amdgcn_exp2f(s.x); e.y = __builtin_amdgcn_exp2f(s.y);
    const f32x2 m = v * (q * e), r = v - m;
    f32x2 o; o.x = v.x < 0.f ? m.x : r.x; o.y = v.y < 0.f ? m.y : r.y; return o;
}

template <int ACT  > struct EpiBf16 {
    static constexpr bool PERM = true, AFTER_DRAIN = false; static_assert(ACT == 0 || ACT == 1, "EpiBf16: ACT is 0 (none) or 1 (gelu_pk)");
    bf16_t* O; int ldc; const float* bias; int split_cols; size_t split_stride; float scale0;
    __device__ __forceinline__ void operator()(const f32x4 (&acc)[2][2][4][2], const Unit& u, int wr, int wc, int fr, int fq) const {
        const int row0 = u.pm * BM + wr * 64 + fr; int colt = u.pn * BM; bf16_t* base = O;
        float sc = 1.f; if (split_cols) { const int t = colt / split_cols; base += (size_t)t * split_stride; colt -= t * split_cols; if (t == 0) sc = scale0; }
        const int col0 = colt + wc * 32 + 8 * fq, bcol0 = u.pn * BM + wc * 32 + 8 * fq;
        f32x4 bv[2][2];
#pragma unroll
        for (int bj = 0; bj < 2; ++bj)
#pragma unroll
            for (int n = 0; n < 2; ++n) bv[bj][n] = bias ? *(const f32x4*)(bias + bcol0 + bj * HALF + 4 * n) : (f32x4){0.f, 0.f, 0.f, 0.f};
#pragma unroll
        for (int ai = 0; ai < 2; ++ai)
#pragma unroll
            for (int m = 0; m < 4; ++m) { bf16_t* rowp = base + (size_t)(row0 + ai * HALF + m * 16) * ldc + col0;
#pragma unroll
                for (int bj = 0; bj < 2; ++bj) { f32x4 v0 = acc[ai][bj][m][0] + bv[bj][0], v1 = acc[ai][bj][m][1] + bv[bj][1];
                    if (ACT == 1) { f32x2 a = gelu_pk((f32x2){v0[0], v0[1]}), b = gelu_pk((f32x2){v0[2], v0[3]}), c = gelu_pk((f32x2){v1[0], v1[1]}), d = gelu_pk((f32x2){v1[2], v1[3]});
                        v0 = (f32x4){a.x, a.y, b.x, b.y}; v1 = (f32x4){c.x, c.y, d.x, d.y}; }
                    v0 = v0 * sc; v1 = v1 * sc; u32x4 w; w.x = cvt_pk_bf16(v0[0], v0[1]); w.y = cvt_pk_bf16(v0[2], v0[3]); w.z = cvt_pk_bf16(v1[0], v1[1]); w.w = cvt_pk_bf16(v1[2], v1[3]);
                    *(u32x4*)(rowp + bj * HALF) = w; } }
    }
};

template <class Epi, class Sched, bool ALIGN_EPI = false, bool SP2 = false>
__device__ __forceinline__ void gemm_phase(PG8_LAS unsigned char* lds, const Gemm g, const Sched& S, const Epi& E, int tid_in) {
    int tid_ = tid_in; asm volatile("" : "+v"(tid_));
    const int tid = tid_, wid = __builtin_amdgcn_readfirstlane(tid >> 6), lane = tid & 63, wr = wid >> 2, wc = wid & 3, fr = lane & 15, fq = lane >> 4;
    const int K = g.K, nt = K / BK;
    unsigned voffA[2], voffB[2];
#pragma unroll
    for (int i = 0; i < 2; ++i) { int R, C; stage_rc(tid * 16 + i * 8192, R, C); const int Rb = Epi::PERM ? ((R & ~31) + perm32(R & 31)) : R;
        voffA[i] = (unsigned)(R * g.lda + C) * 2u; voffB[i] = (unsigned)(Rb * g.ldb + C) * 2u; }
    const size_t kstep = (size_t)(BK * 2);
    const size_t hstepA = (size_t)HALF * g.lda * 2, hstepB = (size_t)HALF * g.ldb * 2;
    const size_t tstepA = 2 * hstepA, tstepB = 2 * hstepB;
    const unsigned ldsw = (unsigned)wid * 1024u;
    const int aoff = lds_byte(wr * 64 + fr, fq * 8), boff = lds_byte(wc * 32 + fr, fq * 8);
#define PG8_SA(b, h) (((b) * 2 + (h)) * HTB)
#define PG8_SB(b, h) ((4 + (b) * 2 + (h)) * HTB)
#define PG8_STAGE(bufoff, gbase, voff) do { _Pragma("unroll") for (int _i = 0; _i < 2; ++_i) \
        __builtin_amdgcn_global_load_lds((const unsigned*)((const char*)(gbase) + (voff)[_i]), (PG8_LAS unsigned*)(lds + (bufoff) + ldsw + _i * 8192), 16, 0, 0); } while (0)
#define PG8_LDA(dst, b, h) do { _Pragma("unroll") for (int m = 0; m < 4; ++m) _Pragma("unroll") for (int k = 0; k < 2; ++k) dst[m][k] = *(const PG8_LAS bf16x8*)(lds + PG8_SA(b, h) + aoff + m * 2048 + k * 1024); } while (0)
#define PG8_LDB(dst, b, h) do { _Pragma("unroll") for (int n = 0; n < 2; ++n) _Pragma("unroll") for (int k = 0; k < 2; ++k) dst[n][k] = *(const PG8_LAS bf16x8*)(lds + PG8_SB(b, h) + boff + n * 2048 + k * 1024); } while (0)
#define PG8_MMA(ai, bj, At, Bt) do { __builtin_amdgcn_s_setprio(1); _Pragma("unroll") for (int m = 0; m < 4; ++m) _Pragma("unroll") for (int n = 0; n < 2; ++n) _Pragma("unroll") for (int k = 0; k < 2; ++k) \
        acc[ai][bj][m][n] = __builtin_amdgcn_mfma_f32_16x16x32_bf16(Bt[n][k], At[m][k], acc[ai][bj][m][n], 0, 0, 0); __builtin_amdgcn_s_setprio(0); } while (0)
#define PG8_WAIT_V(n) asm volatile("s_waitcnt vmcnt(" #n ")" ::: "memory")
#define PG8_WAIT_L(n) asm volatile("s_waitcnt lgkmcnt(" #n ")" ::: "memory")
#define PG8_BAR __builtin_amdgcn_s_barrier()
#define PG8_SCHED __builtin_amdgcn_sched_barrier(0)
    Unit cur, nxt; int ui = 0;
    if (!S.next(0, cur)) return;
    f32x4 acc[2][2][4][2];
#pragma unroll
    for (int a = 0; a < 2; ++a)
#pragma unroll
        for (int b = 0; b < 2; ++b)
#pragma unroll
            for (int m = 0; m < 4; ++m)
#pragma unroll
                for (int n = 0; n < 2; ++n) acc[a][b][m][n] = (f32x4){0.f, 0.f, 0.f, 0.f};
    bf16x8 At[4][2], B0[2][2], B1[2][2];
    const char* cA = (const char*)g.A + (size_t)cur.pm * tstepA + (size_t)cur.kt0 * kstep; const char* cB = (const char*)g.Bt + (size_t)(cur.pm / g.bgrp) * g.bgrp_stride * 2 + (size_t)cur.pn * tstepB + (size_t)cur.kt0 * kstep;
    S.a_ready(cur);
    if constexpr (SP2) {
        PG8_STAGE(PG8_SB(0, 0), cB, voffB); PG8_STAGE(PG8_SB(0, 1), cB + hstepB, voffB); PG8_STAGE(PG8_SA(0, 0), cA, voffA); PG8_STAGE(PG8_SA(0, 1), cA + hstepA, voffA);
        if (wr == 1) PG8_BAR;
        PG8_WAIT_V(2); PG8_BAR;
        PG8_STAGE(PG8_SB(1, 0), cB + kstep, voffB); PG8_STAGE(PG8_SA(1, 0), cA + kstep, voffA); PG8_STAGE(PG8_SB(1, 1), cB + hstepB + kstep, voffB);
        PG8_WAIT_V(6); PG8_BAR;
    } else {
        PG8_STAGE(PG8_SB(0, 0), cB, voffB); PG8_STAGE(PG8_SA(0, 0), cA, voffA); PG8_STAGE(PG8_SB(0, 1), cB + hstepB, voffB); PG8_STAGE(PG8_SA(0, 1), cA + hstepA, voffA);
        if (wr == 1) PG8_BAR;
        PG8_WAIT_V(4); PG8_BAR;
        PG8_STAGE(PG8_SB(1, 0), cB + kstep, voffB); PG8_STAGE(PG8_SA(1, 0), cA + kstep, voffA); PG8_STAGE(PG8_SB(1, 1), cB + hstepB + kstep, voffB);
        PG8_WAIT_V(6); PG8_BAR;
    }
    for (;;) {
        const bool has_next = S.next(ui + 1, nxt);
        const char* nA = has_next ? (const char*)g.A + (size_t)nxt.pm * tstepA + (size_t)nxt.kt0 * kstep : cA; const char* nB = has_next ? (const char*)g.Bt + (size_t)(nxt.pm / g.bgrp) * g.bgrp_stride * 2 + (size_t)nxt.pn * tstepB + (size_t)nxt.kt0 * kstep : cB;
        for (int t = 0; t < nt; t += 2) {
            const bool last = (t == nt - 2);
            const char* a1 = cA + (size_t)(t + 1) * kstep;
            const char* a2 = last ? nA : cA + (size_t)(t + 2) * kstep; const char* b2 = last ? nB : cB + (size_t)(t + 2) * kstep;
            const char* a3 = a2 + kstep; const char* b3 = b2 + kstep;
            if (last && has_next) S.a_ready(nxt);
            if constexpr (SP2) {
            PG8_LDB(B0, 0, 0); PG8_LDB(B1, 0, 1); PG8_SCHED; PG8_LDA(At, 0, 0); PG8_STAGE(PG8_SA(1, 1), a1 + hstepA, voffA);
            PG8_WAIT_V(8); PG8_WAIT_L(0); PG8_BAR; PG8_MMA(0, 0, At, B0); PG8_MMA(0, 1, At, B1); PG8_BAR; PG8_SCHED;
            PG8_LDA(At, 0, 1); PG8_STAGE(PG8_SB(0, 0), b2, voffB); PG8_STAGE(PG8_SB(0, 1), b2 + hstepB, voffB); PG8_STAGE(PG8_SA(0, 0), a2, voffA);
            PG8_WAIT_V(8); PG8_WAIT_L(0); PG8_BAR; PG8_MMA(1, 0, At, B0); PG8_MMA(1, 1, At, B1); PG8_BAR; PG8_SCHED;
            PG8_LDB(B0, 1, 0); PG8_LDB(B1, 1, 1); PG8_SCHED; PG8_LDA(At, 1, 0); PG8_STAGE(PG8_SA(0, 1), a2 + hstepA, voffA);
            PG8_WAIT_V(8); PG8_WAIT_L(0); PG8_BAR; PG8_MMA(0, 0, At, B0); PG8_MMA(0, 1, At, B1); PG8_BAR; PG8_SCHED;
            PG8_LDA(At, 1, 1); PG8_STAGE(PG8_SB(1, 0), b3, voffB); PG8_STAGE(PG8_SB(1, 1), b3 + hstepB, voffB); PG8_STAGE(PG8_SA(1, 0), a3, voffA);
            PG8_WAIT_V(8); PG8_WAIT_L(0); PG8_BAR; PG8_MMA(1, 0, At, B0); PG8_MMA(1, 1, At, B1); PG8_BAR; PG8_SCHED;
            } else {
            PG8_LDB(B0, 0, 0); PG8_SCHED; PG8_LDA(At, 0, 0); PG8_STAGE(PG8_SA(1, 1), a1 + hstepA, voffA);
            PG8_WAIT_L(8); PG8_BAR; PG8_WAIT_L(0); PG8_MMA(0, 0, At, B0); PG8_BAR; PG8_SCHED;
            PG8_LDB(B1, 0, 1); PG8_STAGE(PG8_SB(0, 0), b2, voffB);
            PG8_BAR; PG8_WAIT_L(0); PG8_MMA(0, 1, At, B1); PG8_BAR;
            PG8_LDA(At, 0, 1); PG8_STAGE(PG8_SA(0, 0), a2, voffA);
            PG8_BAR; PG8_WAIT_L(0); PG8_MMA(1, 0, At, B0); PG8_BAR; PG8_SCHED;
            PG8_STAGE(PG8_SB(0, 1), b2 + hstepB, voffB);
            PG8_WAIT_V(6); PG8_BAR; PG8_MMA(1, 1, At, B1); PG8_BAR;
            PG8_LDB(B0, 1, 0); PG8_SCHED; PG8_LDA(At, 1, 0); PG8_STAGE(PG8_SA(0, 1), a2 + hstepA, voffA);
            PG8_WAIT_L(8); PG8_BAR; PG8_WAIT_L(0); PG8_MMA(0, 0, At, B0); PG8_BAR; PG8_SCHED;
            PG8_LDB(B1, 1, 1); PG8_STAGE(PG8_SB(1, 0), b3, voffB);
            PG8_BAR; PG8_WAIT_L(0); PG8_MMA(0, 1, At, B1); PG8_BAR;
            PG8_LDA(At, 1, 1); PG8_STAGE(PG8_SA(1, 0), a3, voffA);
            PG8_BAR; PG8_WAIT_L(0); PG8_MMA(1, 0, At, B0); PG8_BAR; PG8_SCHED;
            PG8_STAGE(PG8_SB(1, 1), b3 + hstepB, voffB);
            PG8_WAIT_V(6); PG8_BAR; PG8_MMA(1, 1, At, B1); PG8_BAR;
            }
        }
        if constexpr (ALIGN_EPI) { if (wr == 0) PG8_BAR; }
        if constexpr (!Epi::AFTER_DRAIN) { E(acc, cur, wr, wc, fr, fq); S.done(cur); }
        if (!has_next) break;
#pragma unroll
        for (int a = 0; a < 2; ++a)
#pragma unroll
            for (int b = 0; b < 2; ++b)
#pragma unroll
                for (int m = 0; m < 4; ++m)
#pragma unroll
                    for (int n = 0; n < 2; ++n) acc[a][b][m][n] = (f32x4){0.f, 0.f, 0.f, 0.f};
        cur = nxt; cA = nA; cB = nB; ++ui;
        if constexpr (ALIGN_EPI) { if (wr == 1) PG8_BAR; }
    }
    PG8_WAIT_V(0);
    if constexpr (!ALIGN_EPI) { if (wr == 0) PG8_BAR; }
    PG8_BAR;
    if constexpr (Epi::AFTER_DRAIN) { E.fused(acc, cur, wr, wc, fr, fq, lds, wid, lane); S.done(cur); }
#undef PG8_SA
#undef PG8_SB
#undef PG8_STAGE
#undef PG8_LDA
#undef PG8_LDB
#undef PG8_MMA
#undef PG8_WAIT_V
#undef PG8_WAIT_L
#undef PG8_BAR
#undef PG8_SCHED
}
}

constexpr int DM = 2048, NPB = 16, SEQ = 256, DEPTH = 4, NDB = 4, DSEQ = 4096, PAST = 256;
constexpr int MP = NPB * SEQ, MS = NDB * DSEQ, M = MP + MS;
constexpr int NIN = 4544, NINP = 4608;
constexpr int C_AQ = 0, C_AK = 512, C_AV = 1024, C_BQ = 1536, C_BK = 1920, C_BV = 2304, C_BR = 3072, C_BG = 3840, C_CQ = 3872, C_CKV = 4256, C_CKR = 4512;
constexpr int DFF = 5632, NQC = 576, NQCP = 768, NKV = 1152, NKVP = 1280;
constexpr float EPS = 1e-6f;
constexpr int NOATT = 14 * 128, NOGLA = 2 * 768;
enum { I_XP = 0, I_XS, I_CAK, I_CAV, I_STB, I_CCKV, I_CCKR, I_C, I_CCTX, I_N1G, I_ADAW, I_ADAB, I_WIN, I_LQ1, I_LK1, I_LQ2, I_LK2, I_ANG, I_BGW, I_BGB, I_BNG, I_CQG, I_CQUP, I_CKVG, I_CKVUP, I_WOUT, I_N2G, I_WUP, I_CONVW, I_CONVB, I_WDOWN, I_FING, N_INPUTS };
constexpr size_t O_YP = 0, O_YS = O_YP + (size_t)MP * DM, O_AK = O_YS + (size_t)MS * DM, O_AV = O_AK + (size_t)NPB * DEPTH * SEQ * 512, O_SB = O_AV + (size_t)NPB * DEPTH * SEQ * 512,
                 O_CKV = O_SB + (size_t)NPB * DEPTH * 2 * 6 * 64 * 128, O_CKR = O_CKV + (size_t)NPB * DEPTH * SEQ * 256, O_END = O_CKR + (size_t)NPB * DEPTH * SEQ * 32;
static_assert(O_END == 69730304, "output size");

constexpr size_t al256(size_t x) { return (x + 255) & ~(size_t)255; }
constexpr size_t WS_CTL = 0, CTL_ZERO_BYTES = 2u << 20;
constexpr size_t WS_SSQ = 1u << 20;
constexpr size_t SZ_WIN = (size_t)NINP * DM * 2, SZ_WOUT = (size_t)DM * DM * 2, SZ_WUP = (size_t)2 * DFF * DM * 2, SZ_WDN = (size_t)DM * DFF * 2, SZ_WQ = (size_t)NQCP * 384 * 2, SZ_WKV = (size_t)NKVP * 256 * 2;
constexpr size_t WS_WIN = WS_CTL + CTL_ZERO_BYTES, WS_WOUT = WS_WIN + 4 * SZ_WIN, WS_WUP = WS_WOUT + 4 * SZ_WOUT, WS_WDN = WS_WUP + 4 * SZ_WUP, WS_WQ = WS_WDN + 4 * SZ_WDN, WS_WKV = WS_WQ + 4 * SZ_WQ;
constexpr size_t SZ_MOD = (size_t)DEPTH * 5 * 6 * DM * 4;
constexpr size_t WS_MOD = WS_WKV + 4 * SZ_WKV, WS_MODP = WS_MOD + SZ_MOD, WS_RTA = WS_MODP + 8 * SZ_MOD, WS_RTC = WS_RTA + (size_t)DSEQ * 64 * 4, WS_LAM = WS_RTC + (size_t)DSEQ * 32 * 4;
constexpr size_t WS_CAK = WS_LAM + 256, WS_CAV = WS_CAK + (size_t)NDB * DEPTH * PAST * 512 * 2, WS_CKRX = WS_CAV + (size_t)NDB * DEPTH * PAST * 512 * 2, WS_CKVA = WS_CKRX + (size_t)NDB * DEPTH * PAST * 32 * 2,
                 WS_KVCTX = WS_CKVA + (size_t)DEPTH * NDB * PAST * 256 * 2, WS_SIDE = WS_KVCTX + (size_t)DEPTH * NDB * PAST * NKVP * 2, WS_GM = WS_SIDE + (size_t)(M / 256) * 2 * 3 * DFF * 4, WS_SHWI = WS_GM + (size_t)DEPTH * 2 * 5 * DM * 4,
                 WS_SHWU = WS_SHWI + (size_t)DEPTH * 5 * NINP * 4, WS_SSQP = WS_SHWU + (size_t)DEPTH * 5 * 2 * DFF * 4, WS_X = WS_SSQP + (size_t)8 * M * 32 * 4;
constexpr size_t WS_H = WS_X + (size_t)M * DM * 4, WS_T0 = WS_H + (size_t)M * DM * 2;
constexpr size_t WS_P = WS_T0, WS_MIX = WS_P + (size_t)M * NINP * 2, WS_QC = WS_MIX + (size_t)M * DM * 2, WS_KVC = WS_QC + (size_t)M * NQCP * 2, WS_CQN = WS_KVC + (size_t)M * NKVP * 2, WS_CKVN = WS_CQN + (size_t)M * 384 * 2,
                 WS_KRA = WS_CKVN + (size_t)M * 256 * 2, WS_KRC = WS_KRA + (size_t)MS * 512 * 2, WS_OATT = WS_KRC + (size_t)MS * 32 * 2, WS_OGLA = WS_OATT + (size_t)M * NOATT * 4, WS_GATE = WS_OGLA + (size_t)M * NOGLA * 4,
                 WS_ST = WS_GATE + (size_t)M * 768 * 4, WS_DD = WS_ST + (size_t)(M / 64) * 12 * 8192 * 2, WS_END1 = WS_DD + (size_t)(M / 64) * 12 * 64 * 4;
constexpr size_t WS_U = WS_OGLA, WS_QK4 = WS_GATE;
constexpr size_t WS_GU = WS_T0, WS_ACT = WS_GU + (size_t)M * 2 * DFF * 2, WS_END2 = WS_ACT + (size_t)M * DFF * 2;


static_assert(WS_WIN % 256 == 0 && WS_X % 256 == 0 && WS_H % 256 == 0 && WS_T0 % 256 == 0 && WS_QC % 256 == 0 && WS_KVC % 256 == 0 && WS_CQN % 256 == 0 && WS_CKVN % 256 == 0 && WS_OATT % 256 == 0 && WS_ACT % 256 == 0, "alignment");

constexpr size_t WS_SPLITK = WS_END1 > WS_END2 ? WS_END1 : WS_END2, WS_END3 = WS_SPLITK + (size_t)128 * 2 * 65536 * 4;
constexpr size_t WS_END = WS_END3;
static_assert(WS_END <= (size_t)1536 << 20, "workspace map must fit 4 x the largest tensor");
constexpr int CW_TICKET = 65536;

constexpr int RING_BYTES = 131072, MISC_OFF = RING_BYTES + 320, LDS_BYTES = 147456;

#define GAS __attribute__((address_space(1)))
#define LAS __attribute__((address_space(3)))
typedef unsigned short bf16;
typedef unsigned v4u __attribute__((ext_vector_type(4)));
typedef unsigned v2u __attribute__((ext_vector_type(2)));
typedef float f32x4 __attribute__((ext_vector_type(4)));
#define LDS_WAIT() asm volatile("s_waitcnt lgkmcnt(0)" ::: "memory")
__device__ __forceinline__ unsigned f2bf(float f) { unsigned u = __builtin_bit_cast(unsigned, f); return (u + 0x7fffu + ((u >> 16) & 1u)) >> 16; }
__device__ __forceinline__ unsigned pk2(float lo, float hi) { return f2bf(lo) | (f2bf(hi) << 16); }
__device__ __forceinline__ float bf2f(bf16 b) { return __builtin_bit_cast(float, (unsigned)b << 16); }
__device__ __forceinline__ float wave_sum(float v) {
#pragma unroll
    for (int o = 1; o < 64; o <<= 1) v += __shfl_xor(v, o);
    return v;
}
__device__ __forceinline__ float siluf(float x) { return x / (1.f + __expf(-x)); }

namespace pg8 {
__device__ __forceinline__ void rstd_table(const float* ssq, int pm, PG8_LAS float* rtab, int tid) {
    const int row = tid >> 1, half = tid & 1; const float* p = ssq + ((size_t)(pm * BM + row) * 32 + half * 16);
    const f32x4 a = *(const f32x4*)p, b = *(const f32x4*)(p + 4), c = *(const f32x4*)(p + 8), d = *(const f32x4*)(p + 12);
    float s = (((a[0] + a[1]) + (a[2] + a[3])) + ((b[0] + b[1]) + (b[2] + b[3]))) + (((c[0] + c[1]) + (c[2] + c[3])) + ((d[0] + d[1]) + (d[2] + d[3])));
    s += __shfl_xor(s, 1);
    if (half == 0) rtab[row] = 1.0f / sqrtf(s * (1.f / 2048.f) + 1e-6f);
    asm volatile("s_waitcnt lgkmcnt(0)" ::: "memory"); __builtin_amdgcn_s_barrier(); asm volatile("" ::: "memory");
}
struct EpiResid {
    static constexpr bool PERM = true, AFTER_DRAIN = false;
    const float* xin0; const float* xin1;
    float* out; const float* gate;
    bf16_t* H; const float* gm; float* ssq;
    __device__ __forceinline__ void operator()(const f32x4 (&acc)[2][2][4][2], const Unit& u, int wr, int wc, int fr, int fq) const {
        const int mi = u.pm < 16 ? 0 : 1 + ((u.pm - 16) >> 4);
        const float* gp = gate + (size_t)mi * 6 * 2048; const float* xin = u.pm < 16 ? xin0 : xin1;
        const int col0 = u.pn * BM + wc * 32 + 8 * fq;
        f32x4 gv[2][2], gm4[2][2];
#pragma unroll
        for (int bj = 0; bj < 2; ++bj)
#pragma unroll
            for (int n = 0; n < 2; ++n) { gv[bj][n] = *(const f32x4*)(gp + col0 + bj * HALF + 4 * n); gm4[bj][n] = H ? *(const f32x4*)(gm + (size_t)mi * 2048 + col0 + bj * HALF + 4 * n) : (f32x4){0.f, 0.f, 0.f, 0.f}; }
#pragma unroll
        for (int ai = 0; ai < 2; ++ai)
#pragma unroll
            for (int m = 0; m < 4; ++m) { const int row = u.pm * BM + ai * HALF + wr * 64 + m * 16 + fr; const size_t off = (size_t)row * 2048 + col0; float ss = 0.f;
#pragma unroll
                for (int bj = 0; bj < 2; ++bj) { const f32x4 x0 = *(const f32x4*)(xin + off + bj * HALF), x1 = *(const f32x4*)(xin + off + bj * HALF + 4);
                    const f32x4 y0 = x0 + gv[bj][0] * acc[ai][bj][m][0], y1 = x1 + gv[bj][1] * acc[ai][bj][m][1];
                    *(f32x4*)(out + off + bj * HALF) = y0; *(f32x4*)(out + off + bj * HALF + 4) = y1;
                    ss += ((y0[0] * y0[0] + y0[1] * y0[1]) + (y0[2] * y0[2] + y0[3] * y0[3])) + ((y1[0] * y1[0] + y1[1] * y1[1]) + (y1[2] * y1[2] + y1[3] * y1[3]));
                    if (H) { const f32x4 h0 = y0 * gm4[bj][0], h1 = y1 * gm4[bj][1]; u32x4 w; w.x = cvt_pk_bf16(h0[0], h0[1]); w.y = cvt_pk_bf16(h0[2], h0[3]); w.z = cvt_pk_bf16(h1[0], h1[1]); w.w = cvt_pk_bf16(h1[2], h1[3]);
                        *(u32x4*)(H + off + bj * HALF) = w; } }
                if (H) { ss += __shfl_xor(ss, 16); ss += __shfl_xor(ss, 32); if (fq == 0) ssq[(size_t)row * 32 + u.pn * 4 + wc] = ss; } }
    }
};
struct EpiBf16Norm {
    static constexpr bool PERM = true, AFTER_DRAIN = false;
    bf16_t* O; int ldc; const float* ssq; const float* shw; int shw_ld; PG8_LAS float* rtab;
    static constexpr int qtiles = 2; static constexpr float qscale = 0.125f * 1.4426950408889634f;
    __device__ __forceinline__ void operator()(const f32x4 (&acc)[2][2][4][2], const Unit& u, int wr, int wc, int fr, int fq) const {
        const int mi = u.pm < 16 ? 0 : 1 + ((u.pm - 16) >> 4);
        rstd_table(ssq, u.pm, rtab, (wr * 4 + wc) * 64 + fq * 16 + fr);
        const int row0 = u.pm * BM + wr * 64 + fr, col0 = u.pn * BM + wc * 32 + 8 * fq; const float* sp = shw + (size_t)mi * shw_ld + col0;
        const float qs = u.pn < qtiles ? qscale : 1.f;
        f32x4 sv[2][2];
#pragma unroll
        for (int bj = 0; bj < 2; ++bj)
#pragma unroll
            for (int n = 0; n < 2; ++n) sv[bj][n] = *(const f32x4*)(sp + bj * HALF + 4 * n);
#pragma unroll
        for (int ai = 0; ai < 2; ++ai)
#pragma unroll
            for (int m = 0; m < 4; ++m) { const int row = row0 + ai * HALF + m * 16; const float rs = rtab[row - u.pm * BM];
                bf16_t* rowp = O + (size_t)row * ldc + col0;
#pragma unroll
                for (int bj = 0; bj < 2; ++bj) { const f32x4 v0 = (acc[ai][bj][m][0] * rs + sv[bj][0]) * qs, v1 = (acc[ai][bj][m][1] * rs + sv[bj][1]) * qs;
                    u32x4 w; w.x = cvt_pk_bf16(v0[0], v0[1]); w.y = cvt_pk_bf16(v0[2], v0[3]); w.z = cvt_pk_bf16(v1[0], v1[1]); w.w = cvt_pk_bf16(v1[2], v1[3]);
                    *(u32x4*)(rowp + bj * HALF) = w; } }
    }
};

struct EpiResidTail {
    static constexpr bool PERM = false, AFTER_DRAIN = false;
    float* X; const float* gate; float* scratch; unsigned* ticket; PG8_LAS unsigned* lw;
    __device__ __forceinline__ void operator()(const f32x4 (&acc)[2][2][4][2], const Unit& u, int wr, int wc, int fr, int fq) const {
        const int t = blockIdx.x >> 1, half = blockIdx.x & 1, tid = threadIdx.x;
        { const __amdgpu_buffer_rsrc_t rs = __builtin_amdgcn_make_buffer_rsrc(scratch + ((size_t)t * 2 + half) * 65536, 0, 65536 * 4, 0x00020000);
#pragma unroll
          for (int ai = 0; ai < 2; ++ai)
#pragma unroll
            for (int bj = 0; bj < 2; ++bj)
#pragma unroll
                for (int m = 0; m < 4; ++m)
#pragma unroll
                    for (int n = 0; n < 2; ++n) { const int j = ((ai * 2 + bj) * 4 + m) * 2 + n; __builtin_amdgcn_raw_buffer_store_b128(__builtin_bit_cast(u32x4, acc[ai][bj][m][n]), rs, (j * 512 + tid) * 16, 0, 16); } }
        asm volatile("s_waitcnt vmcnt(0)" ::: "memory"); __builtin_amdgcn_s_barrier(); asm volatile("" ::: "memory");
        if (tid == 0) { const unsigned old = __hip_atomic_fetch_add(ticket + 64 * t, 1u, __ATOMIC_RELAXED, __HIP_MEMORY_SCOPE_AGENT); *lw = old; }
        asm volatile("s_waitcnt vmcnt(0) lgkmcnt(0)" ::: "memory"); __builtin_amdgcn_s_barrier(); asm volatile("" ::: "memory");
        const unsigned old = *lw;
        if (old == 0u) return;
        __builtin_amdgcn_fence(__ATOMIC_ACQUIRE, "agent"); asm volatile("s_waitcnt vmcnt(0)" ::: "memory");
        const float* oth = scratch + ((size_t)t * 2 + (half ^ 1)) * 65536; const float* own = scratch + ((size_t)t * 2 + half) * 65536;
        const int mi = u.pm < 16 ? 0 : 1 + ((u.pm - 16) >> 4);
        const float* gp = gate + (size_t)mi * 6 * 2048;
        const int col0 = u.pn * BM + wc * 32 + 4 * fq;
#pragma unroll
        for (int ai = 0; ai < 2; ++ai)
#pragma unroll
            for (int m = 0; m < 4; ++m) { const size_t off = (size_t)(u.pm * BM + ai * HALF + wr * 64 + m * 16 + fr) * 2048 + col0;
#pragma unroll
                for (int bj = 0; bj < 2; ++bj)
#pragma unroll
                    for (int n = 0; n < 2; ++n) { const int j = ((ai * 2 + bj) * 4 + m) * 2 + n; const f32x4 pv = *(const f32x4*)(oth + (size_t)(j * 512 + tid) * 4) + *(const f32x4*)(own + (size_t)(j * 512 + tid) * 4);
                        const f32x4 gv = *(const f32x4*)(gp + col0 + bj * HALF + n * 16), xv = *(const f32x4*)(X + off + bj * HALF + n * 16);
                        *(f32x4*)(X + off + bj * HALF + n * 16) = xv + gv * pv; }
                asm volatile("" ::: "memory"); }
    }
};

__device__ __forceinline__ float dpp_ror1(float x) { return __builtin_bit_cast(float, __builtin_amdgcn_update_dpp(__builtin_bit_cast(int, x), __builtin_bit_cast(int, x), 0x121, 0xf, 0xf, false)); }
__device__ __forceinline__ float dpp_rol1(float x) { return __builtin_bit_cast(float, __builtin_amdgcn_update_dpp(__builtin_bit_cast(int, x), __builtin_bit_cast(int, x), 0x12F, 0xf, 0xf, false)); }
struct EpiConvAct {
    static constexpr bool PERM = true, AFTER_DRAIN = false;
    bf16_t* ACT; const float* cw; const float* cb; float* side; PG8_LAS float* ex;
    const float* ssq; const float* shw; PG8_LAS float* rtab;
    __device__ __forceinline__ void operator()(const f32x4 (&acc_)[2][2][4][2], const Unit& u, int wr, int wc, int fr, int fq) const {
        constexpr int FF = 5632;
        const int colw = wc * 32 + 8 * fq, j0 = u.pn * HALF + colw;
        f32x4 (&acc)[2][2][4][2] = const_cast<f32x4 (&)[2][2][4][2]>(acc_);
#pragma unroll
        for (int ai = 0; ai < 2; ++ai) { const int blk = 2 * ai + wr;
            if (fr == 0) {
#pragma unroll
                for (int n = 0; n < 2; ++n) *(PG8_LAS f32x4*)(ex + (blk * 2 + 0) * HALF + colw + 4 * n) = acc[ai][0][0][n]; }
            if (fr == 15) {
#pragma unroll
                for (int n = 0; n < 2; ++n) *(PG8_LAS f32x4*)(ex + (blk * 2 + 1) * HALF + colw + 4 * n) = acc[ai][0][3][n]; } }
        rstd_table(ssq, u.pm, rtab, (wr * 4 + wc) * 64 + fq * 16 + fr);
        f32x4 sv[2][2];
        { const int mi = u.pm < 16 ? 0 : 1 + ((u.pm - 16) >> 4); const float* sp = shw + (size_t)mi * (2 * FF) + u.pn * BM + colw;
#pragma unroll
          for (int bj = 0; bj < 2; ++bj)
#pragma unroll
              for (int n = 0; n < 2; ++n) sv[bj][n] = *(const f32x4*)(sp + bj * HALF + 4 * n);
#pragma unroll
          for (int ai = 0; ai < 2; ++ai)
#pragma unroll
              for (int m = 0; m < 4; ++m) { const int row = u.pm * BM + ai * HALF + wr * 64 + m * 16 + fr; const float rs = rtab[row - u.pm * BM];
#pragma unroll
                  for (int bj = 0; bj < 2; ++bj)
#pragma unroll
                      for (int n = 0; n < 2; ++n) acc[ai][bj][m][n] = acc[ai][bj][m][n] * rs + sv[bj][n]; } }
        float w0[8], w1[8], w2[8], bb[8];
#pragma unroll
        for (int q = 0; q < 2; ++q) { const f32x4 a0 = *(const f32x4*)(cw + j0 + 4 * q), a1 = *(const f32x4*)(cw + FF + j0 + 4 * q), a2 = *(const f32x4*)(cw + 2 * FF + j0 + 4 * q), a3 = *(const f32x4*)(cb + j0 + 4 * q);
#pragma unroll
            for (int i = 0; i < 4; ++i) { w0[4 * q + i] = a0[i]; w1[4 * q + i] = a1[i]; w2[4 * q + i] = a2[i]; bb[4 * q + i] = a3[i]; } }
#pragma unroll
        for (int ai = 0; ai < 2; ++ai) { const int blk = 2 * ai + wr;
#pragma unroll
            for (int m = 0; m < 4; ++m) { float ov[8]; float gcv[8]; float pe[8], ne[8];
                if (m == 0) {
#pragma unroll
                    for (int n = 0; n < 2; ++n) { const f32x4 p4 = blk > 0 ? *(const PG8_LAS f32x4*)(ex + ((blk - 1) * 2 + 1) * HALF + colw + 4 * n) * rtab[blk > 0 ? blk * 64 - 1 : 0] + sv[0][n] : (f32x4){0.f, 0.f, 0.f, 0.f};
#pragma unroll
                        for (int i = 0; i < 4; ++i) pe[4 * n + i] = p4[i]; } }
                if (m == 3) {
#pragma unroll
                    for (int n = 0; n < 2; ++n) { const f32x4 n4 = blk < 3 ? *(const PG8_LAS f32x4*)(ex + ((blk + 1) * 2 + 0) * HALF + colw + 4 * n) * rtab[blk < 3 ? (blk + 1) * 64 : 0] + sv[0][n] : (f32x4){0.f, 0.f, 0.f, 0.f};
#pragma unroll
                        for (int i = 0; i < 4; ++i) ne[4 * n + i] = n4[i]; } }
#pragma unroll
                for (int kp = 0; kp < 4; ++kp) { const int k = 2 * kp, n = k >> 2, i = k & 3;
                    typedef float f32x2 __attribute__((ext_vector_type(2)));
                    f32x2 G, GP, GN;
#pragma unroll
                    for (int e = 0; e < 2; ++e) { const float g = acc[ai][0][m][n][i + e];
                        const float sp_ = fr == 15 ? (m > 0 ? acc[ai][0][m > 0 ? m - 1 : 0][n][i + e] : pe[k + e]) : g;
                        const float sn_ = fr == 0 ? (m < 3 ? acc[ai][0][m < 3 ? m + 1 : 3][n][i + e] : ne[k + e]) : g;
                        G[e] = g; GP[e] = dpp_ror1(sp_); GN[e] = dpp_rol1(sn_); }
                    const f32x2 W0 = {w0[k], w0[k + 1]}, W1 = {w1[k], w1[k + 1]}, W2 = {w2[k], w2[k + 1]}, BB = {bb[k], bb[k + 1]}, UU = {acc[ai][1][m][n][i], acc[ai][1][m][n][i + 1]};
                    const f32x2 GC = __builtin_elementwise_fma(W0, GP, __builtin_elementwise_fma(W1, G, __builtin_elementwise_fma(W2, GN, BB)));
                    const f32x2 T = GC * (f32x2){-1.4426950408889634f, -1.4426950408889634f};
                    f32x2 D = {__builtin_amdgcn_exp2f(T.x), __builtin_amdgcn_exp2f(T.y)}; D += (f32x2){1.f, 1.f};
                    const f32x2 R = {__builtin_amdgcn_rcpf(D.x), __builtin_amdgcn_rcpf(D.y)};
                    const f32x2 O = GC * R * UU;
                    gcv[k] = GC.x; gcv[k + 1] = GC.y; ov[k] = O.x; ov[k + 1] = O.y; }
                const int row = u.pm * BM + ai * HALF + wr * 64 + m * 16 + fr;
                u32x4 w; w.x = cvt_pk_bf16(ov[0], ov[1]); w.y = cvt_pk_bf16(ov[2], ov[3]); w.z = cvt_pk_bf16(ov[4], ov[5]); w.w = cvt_pk_bf16(ov[6], ov[7]);
                *(u32x4*)(ACT + (size_t)row * FF + j0) = w;
                const bool first = (ai == 0 && m == 0) && wr == 0 && fr == 0, last = (ai == 1 && m == 3) && wr == 1 && fr == 15;
                if ((ai == 0 && m == 0) || (ai == 1 && m == 3)) { if (first || last) { float* sp = side + ((size_t)(u.pm * 2 + (last ? 1 : 0)) * 3) * FF + j0;
#pragma unroll
                    for (int n = 0; n < 2; ++n) { *(f32x4*)(sp + 4 * n) = (f32x4){gcv[4 * n], gcv[4 * n + 1], gcv[4 * n + 2], gcv[4 * n + 3]}; *(f32x4*)(sp + FF + 4 * n) = acc[ai][1][m][n]; *(f32x4*)(sp + 2 * FF + 4 * n) = acc[ai][0][m][n]; } } }
            } }
    }
};
}

#define XB_TMO      128
#define XB_XCNT(j)  (256  + 64 * (j))
#define XB_XSUB(j)  (1280 + 64 * (j))
#define XB_XGEN(j)  (2304 + 64 * (j))
#define XB_TOP      3328
#define XB_TOPGEN   3392
#define XCD_BAR_WORDS 3456
#define XB_SPIN_CAP (1u << 18)
__device__ __forceinline__ unsigned xb_ld(unsigned* p)              { return __hip_atomic_load(p, __ATOMIC_RELAXED, __HIP_MEMORY_SCOPE_AGENT); }
__device__ __forceinline__ unsigned xb_add(unsigned* p, unsigned v) { return __hip_atomic_fetch_add(p, v, __ATOMIC_RELAXED, __HIP_MEMORY_SCOPE_AGENT); }
__device__ __forceinline__ unsigned xb_xcc_id() { return (unsigned)__builtin_amdgcn_s_getreg((3 << 11) | 20) & 0xFu; }
#define XB_SPIN(cond, bar) do { unsigned _sp = 0; while (cond) { __builtin_amdgcn_s_sleep(1); \
    if ((++_sp & 255u) == 0u) { if (xb_ld(&(bar)[XB_TMO])) break; if (_sp > XB_SPIN_CAP) { atomicAdd(&(bar)[XB_TMO], 1u); break; } } } } while (0)
struct XcdBarrier { unsigned* bar; unsigned x; volatile LAS unsigned* st; };
__device__ __forceinline__ XcdBarrier xcd_barrier_post(unsigned* bar, volatile LAS unsigned* st) {
    XcdBarrier b; b.bar = bar; b.x = xb_xcc_id(); b.st = st;
    if (threadIdx.x == 0) (void)xb_add(&bar[XB_XCNT(b.x)], 1u);
    return b;
}
__device__ __forceinline__ void xcd_barrier_complete(unsigned* bar, unsigned x, unsigned& nloc, unsigned& nx) {
    const unsigned G = gridDim.x * gridDim.y * gridDim.z;
    unsigned sum, cnt, mine, sp = 0u;
    for (;;) {
        sum = 0u; cnt = 0u; mine = 0u;
#pragma unroll
        for (unsigned j = 0; j < 16; ++j) { const unsigned c = xb_ld(&bar[XB_XCNT(j)]); sum += c; cnt += (c > 0u) ? 1u : 0u; mine = (j == x) ? c : mine; }
        if (sum == G) break;
        __builtin_amdgcn_s_sleep(1);
        if ((++sp & 255u) == 0u) { if (xb_ld(&bar[XB_TMO])) break; if (sp > XB_SPIN_CAP) { atomicAdd(&bar[XB_TMO], 1u); break; } }
    }
    nloc = mine > 0u ? mine : 1u; nx = cnt > 0u ? cnt : 1u;
}
__device__ __forceinline__ void xcd_barrier(const XcdBarrier& b, int tid) {
    asm volatile("s_waitcnt vmcnt(0)" ::: "memory");
    __syncthreads();
    if (tid == 0) {
        unsigned* bar = b.bar;
        __builtin_amdgcn_s_waitcnt(0);
        unsigned nloc = b.st[0], nx = b.st[1];
        if (nloc == 0u) { xcd_barrier_complete(bar, b.x, nloc, nx); b.st[0] = nloc; b.st[1] = nx; }
        const unsigned old = xb_add(&bar[XB_XSUB(b.x)], 1u);
        const unsigned gen = old / nloc;
        if (old + 1u == (gen + 1u) * nloc) {
            __builtin_amdgcn_fence(__ATOMIC_RELEASE, "agent");
            asm volatile("s_waitcnt vmcnt(0)" ::: "memory");
            const unsigned og = xb_add(&bar[XB_TOP], 1u);
            const unsigned tg = og / nx;
            if (og + 1u == (tg + 1u) * nx) xb_add(&bar[XB_TOPGEN], 1u);
            else XB_SPIN(xb_ld(&bar[XB_TOPGEN]) == tg, bar);
            __builtin_amdgcn_fence(__ATOMIC_ACQUIRE, "agent");
            xb_add(&bar[XB_XGEN(b.x)], 1u);
            asm volatile("s_waitcnt vmcnt(0)" ::: "memory");
        } else {
            XB_SPIN(xb_ld(&bar[XB_XGEN(b.x)]) == gen, bar);
            __builtin_amdgcn_fence(__ATOMIC_ACQUIRE, "agent");
            asm volatile("s_waitcnt vmcnt(0)" ::: "memory");
        }
    }
    __syncthreads();
}

#ifndef MK_MFMA_ATT
#define MK_MFMA_ATT 1
#endif
#ifndef MK_MFMA_GLA
#define MK_MFMA_GLA 1
#endif
#ifndef MK_SPLITK
#define MK_SPLITK 0
#endif
constexpr int NWV = 8, NTH = 512;

template <bool UPMAP = false>
__device__ __forceinline__ void transpose_item(const float* W, int K, int N, bf16* WT, LAS float* scr, int item, int lane) {
    const int nblk = N / 32, kb = item / nblk, nb = item % nblk, k0 = 64 * kb, n0 = 32 * nb;
    const int nd0 = UPMAP ? (n0 < DFF ? 256 * (n0 >> 7) + (n0 & 127) : 256 * ((n0 - DFF) >> 7) + 128 + ((n0 - DFF) & 127)) : n0;
    float wv[32];
#pragma unroll
    for (int i = 0; i < 32; ++i) wv[i] = __builtin_nontemporal_load(W + (size_t)(k0 + 2 * i + (lane >> 5)) * N + n0 + (lane & 31));
#pragma unroll
    for (int i = 0; i < 32; ++i) scr[(2 * i + (lane >> 5)) * 33 + (lane & 31)] = wv[i];
    LDS_WAIT(); asm volatile("" ::: "memory");
    const int c = lane & 7;
#pragma unroll
    for (int j = 0; j < 4; ++j) { const int n = (lane >> 3) + 8 * j; const LAS float* s = scr + (8 * c) * 33 + n;
        v4u o; o.x = pk2(s[0 * 33], s[1 * 33]); o.y = pk2(s[2 * 33], s[3 * 33]); o.z = pk2(s[4 * 33], s[5 * 33]); o.w = pk2(s[6 * 33], s[7 * 33]);
        *(v4u*)(WT + (size_t)(nd0 + n) * K + k0 + 8 * c) = o; }
    LDS_WAIT(); asm volatile("" ::: "memory");
}

struct Args { const float* in[N_INPUTS]; float* out; unsigned char* ws; int ph_lo, ph_hi, use_bar, pad; };

__device__ __forceinline__ void pro0_phase(const Args& a, LAS unsigned char* lds, int tid, int lane, int wave, int bid, int G) {
    unsigned char* ws = a.ws;
    const int gw = bid * NWV + wave, NGW = G * NWV;
    LAS float* scr = (LAS float*)(lds + wave * 16384);
    constexpr int IT_IN = (DM / 64) * (NIN / 32), IT_OUT = (DM / 64) * (DM / 32), IT_UP = (DM / 64) * (2 * DFF / 32), IT_DN = (DFF / 64) * (DM / 32), IT_Q = (384 / 64) * (NQC / 32), IT_KV = (256 / 64) * (NKV / 32);
    constexpr int IT_L = IT_IN + IT_OUT + IT_UP + IT_DN + IT_Q + IT_KV;
    for (int it = gw; it < DEPTH * IT_L; it += NGW) {
        const int l = it / IT_L; int r = it % IT_L;
        if (r < IT_IN) { transpose_item(a.in[I_WIN] + (size_t)l * DM * NIN, DM, NIN, (bf16*)(ws + WS_WIN + l * SZ_WIN), scr, r, lane); continue; } r -= IT_IN;
        if (r < IT_OUT) { transpose_item(a.in[I_WOUT] + (size_t)l * DM * DM, DM, DM, (bf16*)(ws + WS_WOUT + l * SZ_WOUT), scr, r, lane); continue; } r -= IT_OUT;
        if (r < IT_UP) { transpose_item<true>(a.in[I_WUP] + (size_t)l * DM * 2 * DFF, DM, 2 * DFF, (bf16*)(ws + WS_WUP + l * SZ_WUP), scr, r, lane); continue; } r -= IT_UP;
        if (r < IT_DN) { transpose_item(a.in[I_WDOWN] + (size_t)l * DFF * DM, DFF, DM, (bf16*)(ws + WS_WDN + l * SZ_WDN), scr, r, lane); continue; } r -= IT_DN;
        if (r < IT_Q) { transpose_item(a.in[I_CQUP] + (size_t)l * 384 * NQC, 384, NQC, (bf16*)(ws + WS_WQ + l * SZ_WQ), scr, r, lane); continue; } r -= IT_Q;
        transpose_item(a.in[I_CKVUP] + (size_t)l * 256 * NKV, 256, NKV, (bf16*)(ws + WS_WKV + l * SZ_WKV), scr, r, lane);
    }
    const int gt = bid * NTH + tid, NGT = G * NTH;
    for (int i = gt; i < DEPTH * (NINP - NIN) * DM / 8; i += NGT) { const int l = i / ((NINP - NIN) * DM / 8), r = i % ((NINP - NIN) * DM / 8); *(v4u*)(ws + WS_WIN + l * SZ_WIN + (size_t)NIN * DM * 2 + (size_t)r * 16) = (v4u){0u, 0u, 0u, 0u}; }
    for (int i = gt; i < DEPTH * (NQCP - NQC) * 384 / 8; i += NGT) { const int l = i / ((NQCP - NQC) * 384 / 8), r = i % ((NQCP - NQC) * 384 / 8); *(v4u*)(ws + WS_WQ + l * SZ_WQ + (size_t)NQC * 384 * 2 + (size_t)r * 16) = (v4u){0u, 0u, 0u, 0u}; }
    for (int i = gt; i < DEPTH * (NKVP - NKV) * 256 / 8; i += NGT) { const int l = i / ((NKVP - NKV) * 256 / 8), r = i % ((NKVP - NKV) * 256 / 8); *(v4u*)(ws + WS_WKV + l * SZ_WKV + (size_t)NKV * 256 * 2 + (size_t)r * 16) = (v4u){0u, 0u, 0u, 0u}; }
    {
        LAS float* sc = (LAS float*)lds;
        __syncthreads();
        for (int it = bid; it < DEPTH * 24 * 8; it += G) {
            const int l = it / 192, cb = (it / 8) % 24, ks = it % 8;
            __syncthreads();
            for (int e = tid; e < 5 * 256; e += NTH) { const int mi = e >> 8, k = ks * 256 + (e & 255); const float cv = mi == 0 ? a.in[I_CCTX][k] : a.in[I_C][(mi - 1) * DM + k]; sc[e] = cv / (1.f + expf(-cv)); }
            __syncthreads();
            const float* wp = a.in[I_ADAW] + ((size_t)l * DM + ks * 256) * (6 * DM) + cb * 512 + tid;
            float s0 = 0.f, s1 = 0.f, s2 = 0.f, s3 = 0.f, s4 = 0.f;
#pragma unroll 8
            for (int k = 0; k < 256; ++k) { const float w = __builtin_nontemporal_load(wp + (size_t)k * (6 * DM)); s0 += sc[k] * w; s1 += sc[256 + k] * w; s2 += sc[512 + k] * w; s3 += sc[768 + k] * w; s4 += sc[1024 + k] * w; }
            float* mp = (float*)(ws + WS_MODP) + ((size_t)ks * DEPTH + l) * 5 * 6 * DM + cb * 512 + tid;
            mp[0] = s0; mp[6 * DM] = s1; mp[2 * 6 * DM] = s2; mp[3 * 6 * DM] = s3; mp[4 * 6 * DM] = s4;
        }
        __syncthreads();
    }
    { const float* s = a.in[I_CAK]; bf16* d = (bf16*)(ws + WS_CAK); for (int i = gt; i < NDB * DEPTH * PAST * 512; i += NGT) d[i] = (bf16)f2bf(s[i]); }
    { const float* s = a.in[I_CAV]; bf16* d = (bf16*)(ws + WS_CAV); for (int i = gt; i < NDB * DEPTH * PAST * 512; i += NGT) d[i] = (bf16)f2bf(s[i]); }
    { const float* s = a.in[I_CCKR]; bf16* d = (bf16*)(ws + WS_CKRX); for (int i = gt; i < NDB * DEPTH * PAST * 32; i += NGT) d[i] = (bf16)f2bf(s[i]); }
    { const float* s = a.in[I_CCKV]; bf16* d = (bf16*)(ws + WS_CKVA);
      for (int i = gt; i < NDB * DEPTH * PAST * 256; i += NGT) { const int c = i & 255, j = (i >> 8) & 255, bl = i >> 16, b = bl >> 2, l = bl & 3; d[(((size_t)l * NDB + b) * PAST + j) * 256 + c] = (bf16)f2bf(s[i]); } }
    { float* ra = (float*)(ws + WS_RTA); float* rc = (float*)(ws + WS_RTC);
      for (int i = gt; i < DSEQ * 16; i += NGT) { const int t = i >> 4, j = i & 15; const float inv = powf(10000.f, -(float)j / 16.f); const float ar = (float)(t >> 6) * inv, ac = (float)(t & 63) * inv;
          ra[t * 64 + j] = cosf(ar); ra[t * 64 + 16 + j] = sinf(ar); ra[t * 64 + 32 + j] = cosf(ac); ra[t * 64 + 48 + j] = sinf(ac); }
      for (int i = gt; i < DSEQ * 8; i += NGT) { const int t = i >> 3, j = i & 7; const float inv = powf(10000.f, -(float)j / 8.f); const float ar = (float)(t >> 6) * inv, ac = (float)(t & 63) * inv;
          rc[t * 32 + j] = cosf(ar); rc[t * 32 + 8 + j] = sinf(ar); rc[t * 32 + 16 + j] = cosf(ac); rc[t * 32 + 24 + j] = sinf(ac); } }
    if (gt < DEPTH) { const int l = gt; float d1 = 0.f, d2 = 0.f;
        for (int i = 0; i < 64; ++i) { d1 += a.in[I_LQ1][l * 64 + i] * a.in[I_LK1][l * 64 + i]; d2 += a.in[I_LQ2][l * 64 + i] * a.in[I_LK2][l * 64 + i]; }
        const float li = 0.8f - 0.6f * expf(-0.3f * (float)l);
        float* lam = (float*)(ws + WS_LAM); lam[l] = expf(d1) - expf(d2) + li; lam[4 + l] = li; }
}

__device__ __forceinline__ void modfin_phase(const Args& a, int gt, int NGT) {
    const float* mp = (const float*)(a.ws + WS_MODP); float* mo = (float*)(a.ws + WS_MOD);
    for (int i = gt; i < DEPTH * 5 * 6 * DM; i += NGT) { const int l = i / (5 * 6 * DM), n = i % (6 * DM); float s = a.in[I_ADAB][l * 6 * DM + n];
#pragma unroll
        for (int ks = 0; ks < 8; ++ks) s += mp[(size_t)ks * DEPTH * 5 * 6 * DM + i];
        mo[i] = s; }
}


namespace att {
using bf16x8 = __attribute__((ext_vector_type(8))) short;
using s16x4  = __attribute__((ext_vector_type(4))) short;
using f32x16 = __attribute__((ext_vector_type(16))) float;
using u32x4  = __attribute__((ext_vector_type(4))) unsigned;
constexpr int SHM_V = 64 * 128 * 2;
#define ATT_SBAR() __builtin_amdgcn_sched_barrier(0)
#define ATT_LBAR() asm volatile("s_waitcnt lgkmcnt(0)\n\ts_barrier" ::: "memory")
__device__ __forceinline__ int crow(int r, int hi) { return (r & 3) + 8 * (r >> 2) + 4 * hi; }
__device__ __forceinline__ float max3f(float a, float b, float c) { return fmaxf(fmaxf(a, b), c); }
__device__ __forceinline__ float max2f(float a, float b) { return fmaxf(a, b); }
__device__ __forceinline__ unsigned cvtpk(float lo, float hi) { unsigned r; asm volatile("v_cvt_pk_bf16_f32 %0, %1, %2" : "=v"(r) : "v"(lo), "v"(hi)); return r; }
template <bool TUP> __device__ __forceinline__ void partialSM(f32x16& p0, f32x16& p1, float& m_reg, f32x16& negm, float& alpha, float thr, bool first, float pmax) {
  if constexpr (!TUP) {
    typedef float f32x2 __attribute__((ext_vector_type(2))); const f32x2 M2 = {-m_reg, -m_reg};
#pragma unroll
    for (int r = 0; r < 16; r += 2) { f32x2 v = {p0[r], p0[r + 1]}; v += M2; p0[r] = v.x; p0[r + 1] = v.y; f32x2 w = {p1[r], p1[r + 1]}; w += M2; p1[r] = w.x; p1[r + 1] = w.y; }
    pmax -= m_reg; }
  { auto rr = __builtin_amdgcn_permlane32_swap(__float_as_uint(pmax), __float_as_uint(pmax), false, false);
    pmax = max2f(__uint_as_float(rr[0]), __uint_as_float(rr[1])); }
  if (__builtin_expect(!first && __all(pmax <= thr), 1)) { alpha = 1.f; }
  else { const float delta = first ? pmax : max2f(pmax, 0.f); alpha = __builtin_amdgcn_exp2f(-delta); m_reg += delta;
#pragma unroll
    for (int r = 0; r < 16; ++r) { p0[r] -= delta; p1[r] -= delta; }
    if constexpr (TUP) { const float nm = -m_reg;
#pragma unroll
      for (int r = 0; r < 16; ++r) negm[r] = nm;
      asm volatile("" : "+v"(negm)); } }
}
__device__ __forceinline__ void finishSM(f32x16& p0, f32x16& p1, float alpha, float& l_reg, bf16x8& pa0, bf16x8& pa1, bf16x8& pa2, bf16x8& pa3) {
  float ps;
  { typedef float f32x2 __attribute__((ext_vector_type(2))); f32x2 s2 = {p0[0], p0[1]};
#pragma unroll
    for (int r = 2; r < 16; r += 2) s2 += (f32x2){p0[r], p0[r + 1]};
#pragma unroll
    for (int r = 0; r < 16; r += 2) s2 += (f32x2){p1[r], p1[r + 1]};
    ps = s2.x + s2.y; }
  { auto rr = __builtin_amdgcn_permlane32_swap(__float_as_uint(ps), __float_as_uint(ps), false, false);
    ps = __uint_as_float(rr[0]) + __uint_as_float(rr[1]); }
  l_reg = l_reg * alpha + ps;
#define ATT_PKD(P, BASE) __builtin_bit_cast(bf16x8, (u32x4){cvtpk(P[BASE + 0], P[BASE + 1]), cvtpk(P[BASE + 2], P[BASE + 3]), cvtpk(P[BASE + 4], P[BASE + 5]), cvtpk(P[BASE + 6], P[BASE + 7])})
  pa0 = ATT_PKD(p0, 0); pa1 = ATT_PKD(p0, 8); pa2 = ATT_PKD(p1, 0); pa3 = ATT_PKD(p1, 8);
#undef ATT_PKD
}
template <int DQK, bool TUP>
__device__ __forceinline__ void qkt(f32x16& p0, f32x16& p1, const LAS unsigned char* Ks, const bf16x8* qr, int r32, int hi, const f32x16& negm) {
  constexpr int RS = DQK * 2 + 16;
  if constexpr (TUP) { p0 = negm; p1 = negm; } else { p0 = f32x16{}; p1 = f32x16{}; }
#pragma unroll
  for (int d0 = 0; d0 < DQK / 16; ++d0) { const int cb = d0 * 32 + hi * 16;
    const bf16x8 b0 = *(const LAS bf16x8*)(Ks + r32 * RS + cb);
    const bf16x8 b1 = *(const LAS bf16x8*)(Ks + (32 + r32) * RS + cb);
    p0 = __builtin_amdgcn_mfma_f32_32x32x16_bf16(b0, qr[d0], p0, 0, 0, 0);
    p1 = __builtin_amdgcn_mfma_f32_32x32x16_bf16(b1, qr[d0], p1, 0, 0, 0); }
}
__device__ __forceinline__ int v_st(int k, int c) { const int kk = (k & ~0xC) | ((k & 4) << 1) | ((k & 8) >> 1); return ((kk >> 3) * 4 + (c >> 5)) * 512 + ((kk & 7) * 32 + (c & 31)) * 2; }
__device__ __forceinline__ int v_rd_base(int lane) { return ((lane & 3) << 3) | (((lane >> 2) & 3) << 6) | (((lane >> 4) & 1) << 5) | (((lane >> 5) & 1) << 8); }
constexpr int v_rd_off(int d0, int ks, int half) { return d0 * 512 + ks * 4096 + half * 2048; }
__device__ __forceinline__ int v_st_n(int k, int c) { return (c >> 5) * 4096 + k * 64 + (c & 31) * 2; }
__device__ __forceinline__ int v_rd_base_n(int lane) { return ((lane >> 4) & 1) * 32 + (lane & 3) * 8 + (4 * (lane >> 5) + ((lane & 15) >> 2)) * 64; }
constexpr int v_rd_off_n(int d0, int ks, int half) { return d0 * 4096 + ks * 1024 + half * 512; }
template <int OFF> __device__ __forceinline__ s16x4 tr_read(int vb) {
  s16x4 r; asm volatile("ds_read_b64_tr_b16 %0, %1 offset:%2" : "=&v"(r) : "v"(vb), "i"(OFF) : "memory"); return r;
}
template <int D0, bool EX> __device__ __forceinline__ void pv_one(f32x16& od, int vb, bf16x8 pa0, bf16x8 pa1, bf16x8 pa2, bf16x8 pa3, f32x16& s) {
  const s16x4 l0 = tr_read<v_rd_off_n(D0, 0, 0)>(vb), h0 = tr_read<v_rd_off_n(D0, 0, 1)>(vb), l1 = tr_read<v_rd_off_n(D0, 1, 0)>(vb), h1 = tr_read<v_rd_off_n(D0, 1, 1)>(vb);
  const s16x4 l2 = tr_read<v_rd_off_n(D0, 2, 0)>(vb), h2 = tr_read<v_rd_off_n(D0, 2, 1)>(vb), l3 = tr_read<v_rd_off_n(D0, 3, 0)>(vb), h3 = tr_read<v_rd_off_n(D0, 3, 1)>(vb);
  asm volatile("s_waitcnt lgkmcnt(0)" ::: "memory"); ATT_SBAR();
#define ATT_PK(L, H) (bf16x8){L[0], L[1], L[2], L[3], H[0], H[1], H[2], H[3]}
  constexpr int B = (D0 & 1) * 8;
  od = __builtin_amdgcn_mfma_f32_32x32x16_bf16(pa0, ATT_PK(l0, h0), od, 0, 0, 0);
  if constexpr (EX) { s[B] = __builtin_amdgcn_exp2f(s[B]); s[B + 1] = __builtin_amdgcn_exp2f(s[B + 1]); }
  od = __builtin_amdgcn_mfma_f32_32x32x16_bf16(pa1, ATT_PK(l1, h1), od, 0, 0, 0);
  if constexpr (EX) { s[B + 2] = __builtin_amdgcn_exp2f(s[B + 2]); s[B + 3] = __builtin_amdgcn_exp2f(s[B + 3]); }
  od = __builtin_amdgcn_mfma_f32_32x32x16_bf16(pa2, ATT_PK(l2, h2), od, 0, 0, 0);
  if constexpr (EX) { s[B + 4] = __builtin_amdgcn_exp2f(s[B + 4]); s[B + 5] = __builtin_amdgcn_exp2f(s[B + 5]); }
  od = __builtin_amdgcn_mfma_f32_32x32x16_bf16(pa3, ATT_PK(l3, h3), od, 0, 0, 0);
  if constexpr (EX) { s[B + 6] = __builtin_amdgcn_exp2f(s[B + 6]); s[B + 7] = __builtin_amdgcn_exp2f(s[B + 7]); asm volatile("" : "+v"(s)); }
#undef ATT_PK
}
__device__ __forceinline__ void pv_ex(f32x16* o, int vb, bf16x8 pa0, bf16x8 pa1, bf16x8 pa2, bf16x8 pa3, f32x16& s0, f32x16& s1) {
  pv_one<0, true>(o[0], vb, pa0, pa1, pa2, pa3, s0); pv_one<1, true>(o[1], vb, pa0, pa1, pa2, pa3, s0); pv_one<2, true>(o[2], vb, pa0, pa1, pa2, pa3, s1); pv_one<3, true>(o[3], vb, pa0, pa1, pa2, pa3, s1);
}
__device__ __forceinline__ void pv_last(f32x16* o, int vb, bf16x8 pa0, bf16x8 pa1, bf16x8 pa2, bf16x8 pa3) { f32x16 z = {};
  pv_one<0, false>(o[0], vb, pa0, pa1, pa2, pa3, z); pv_one<1, false>(o[1], vb, pa0, pa1, pa2, pa3, z); pv_one<2, false>(o[2], vb, pa0, pa1, pa2, pa3, z); pv_one<3, false>(o[3], vb, pa0, pa1, pa2, pa3, z); }
__device__ __forceinline__ float rowmax32(const f32x16& p0, const f32x16& p1) {
  float a = max3f(p0[0], p0[1], p1[0]), b = max3f(p0[2], p0[3], p1[1]); a = max3f(a, p1[2], p1[3]);
#pragma unroll
  for (int r = 4; r < 16; r += 4) { a = max3f(a, p0[r], p0[r + 1]); b = max3f(b, p0[r + 2], p0[r + 3]); a = max3f(a, p1[r], p1[r + 1]); b = max3f(b, p1[r + 2], p1[r + 3]); }
  return max2f(a, b);
}
__device__ __forceinline__ float bfe(bf16x8 v, int e) { return __builtin_bit_cast(float, (unsigned)(unsigned short)v[e] << 16); }
}

struct KSeg { const bf16* kn; int ldn; const bf16* kr; int ldr; const bf16* v; int ldv; int n; };

template <int DQK, int SD, bool OUTBF>
__device__ __forceinline__ void attn_mfma_unit(LAS unsigned char* lds, const bf16* Qp, int ldq, bool rot, const float* rt, int t0, const KSeg& ctx, const KSeg& lat, float scale, void* Opv, int tid,
                                               bool fin = false, float lam = 0.f, float gsc = 0.f, const float* ag = nullptr, bf16* Mx = nullptr) {
  using namespace att;
  constexpr int NF = DQK / 16, RS = DQK * 2 + 16, SHM_K = 64 * RS;
  const int wid = tid >> 6, lane = tid & 63, r32 = lane & 31, hi = lane >> 5;
  constexpr int NSL = 3;
  LAS unsigned char* V_lds = lds; LAS unsigned char* K_lds = lds + NSL * SHM_V;
  LAS float* wsf = (LAS float*)(lds + NSL * SHM_V + NSL * SHM_K) + wid * 64; LAS float* li_l = wsf; LAS float* al_l = wsf + 32;
  (void)scale;
  const float thr = 8.f * 1.4426950408889634f;
  float m_reg = 0.f, l_reg = 0; f32x16 negm = {}; f32x16 o[4] = {}; bf16x8 qr[NF];
  const bf16* Qw = Qp + (size_t)(wid * 32 + r32) * ldq + hi * 8;
#pragma unroll
  for (int d0 = 0; d0 < NF; ++d0) qr[d0] = *reinterpret_cast<const bf16x8*>(Qw + d0 * 16);
  const int sr = tid >> 4, sc = (tid & 15) * 8, vst0 = v_st_n(sr, sc), vst1 = v_st_n(32 + sr, sc);
  const int krow = tid >> 3, kch = tid & 7, xrow = tid >> 2, xch = tid & 3; const bool xld = (DQK == 96) && tid < 256;
  const int vb0 = (int)(unsigned)(uintptr_t)V_lds + v_rd_base_n(lane);
  const int nct = ctx.n >> 6, NT = nct + (lat.n >> 6);
  struct { bf16x8 vs0, vs1, kn, kx; } st;
#define ATT_SLOAD(j) do { const int j_ = (j); const bool c_ = j_ < nct; const KSeg& S_ = c_ ? ctx : lat; const int k0_ = (c_ ? j_ : j_ - nct) * 64; \
    st.vs0 = *reinterpret_cast<const bf16x8*>(S_.v + (size_t)(k0_ + sr) * S_.ldv + sc); st.vs1 = *reinterpret_cast<const bf16x8*>(S_.v + (size_t)(k0_ + 32 + sr) * S_.ldv + sc); \
    st.kn = *reinterpret_cast<const bf16x8*>(S_.kn + (size_t)(k0_ + krow) * S_.ldn + kch * 8); \
    if (xld) st.kx = *reinterpret_cast<const bf16x8*>(S_.kr + (size_t)(k0_ + xrow) * S_.ldr + xch * 8); } while (0)
#define ATT_SWRITE(b) do { *(LAS bf16x8*)(V_lds + (b) * SHM_V + vst0) = st.vs0; *(LAS bf16x8*)(V_lds + (b) * SHM_V + vst1) = st.vs1; \
    *(LAS bf16x8*)(K_lds + (b) * SHM_K + krow * RS + kch * 16) = st.kn; \
    if (xld) *(LAS bf16x8*)(K_lds + (b) * SHM_K + xrow * RS + 128 + xch * 16) = st.kx; } while (0)
#define ATT_SWAIT() asm volatile("s_waitcnt vmcnt(0)" ::: "memory")
#define ATT_RESC(a) do { if (__any((a) < 1.f)) { if (hi == 0) al_l[r32] = (a); asm volatile("s_waitcnt lgkmcnt(0)" ::: "memory"); \
    _Pragma("unroll") for (int d = 0; d < 4; ++d) _Pragma("unroll") for (int r = 0; r < 16; ++r) o[d][r] *= al_l[crow(r, hi)]; } } while (0)
#define ATT_ROTQ() do { const int t_ = t0 + wid * 32 + r32; \
    if constexpr (DQK == 64) { const float* tb = rt + (size_t)t_ * 64 + hi * 8; u32x4 w0, w1, w2, w3; \
        float y0[8], y1[8], y2[8], y3[8]; \
        _Pragma("unroll") for (int e = 0; e < 8; ++e) { const float cr = tb[e], sn = tb[16 + e], cc = tb[32 + e], sc2 = tb[48 + e]; \
            const float x0 = bfe(qr[0], e), x1 = bfe(qr[1], e), x2 = bfe(qr[2], e), x3 = bfe(qr[3], e); \
            y0[e] = x0 * cr - x1 * sn; y1[e] = x1 * cr + x0 * sn; y2[e] = x2 * cc - x3 * sc2; y3[e] = x3 * cc + x2 * sc2; } \
        w0 = (u32x4){cvtpk(y0[0], y0[1]), cvtpk(y0[2], y0[3]), cvtpk(y0[4], y0[5]), cvtpk(y0[6], y0[7])}; w1 = (u32x4){cvtpk(y1[0], y1[1]), cvtpk(y1[2], y1[3]), cvtpk(y1[4], y1[5]), cvtpk(y1[6], y1[7])}; \
        w2 = (u32x4){cvtpk(y2[0], y2[1]), cvtpk(y2[2], y2[3]), cvtpk(y2[4], y2[5]), cvtpk(y2[6], y2[7])}; w3 = (u32x4){cvtpk(y3[0], y3[1]), cvtpk(y3[2], y3[3]), cvtpk(y3[4], y3[5]), cvtpk(y3[6], y3[7])}; \
        qr[0] = __builtin_bit_cast(bf16x8, w0); qr[1] = __builtin_bit_cast(bf16x8, w1); qr[2] = __builtin_bit_cast(bf16x8, w2); qr[3] = __builtin_bit_cast(bf16x8, w3); \
    } else { const float* tb = rt + (size_t)t_ * 32; const float sg = hi ? 1.f : -1.f; \
        const u32x4 a4 = __builtin_bit_cast(u32x4, qr[NF - 2]), a5 = __builtin_bit_cast(u32x4, qr[NF - 1]); u32x4 p4, p5; \
        _Pragma("unroll") for (int i = 0; i < 4; ++i) { p4[i] = (unsigned)__shfl_xor((int)a4[i], 32); p5[i] = (unsigned)__shfl_xor((int)a5[i], 32); } \
        const bf16x8 q4 = __builtin_bit_cast(bf16x8, p4), q5 = __builtin_bit_cast(bf16x8, p5); float y4[8], y5[8]; \
        _Pragma("unroll") for (int e = 0; e < 8; ++e) { const float cr = tb[e], sn = tb[8 + e], cc = tb[16 + e], sc2 = tb[24 + e]; \
            y4[e] = bfe(qr[NF - 2], e) * cr + sg * bfe(q4, e) * sn; y5[e] = bfe(qr[NF - 1], e) * cc + sg * bfe(q5, e) * sc2; } \
        const u32x4 w4 = {cvtpk(y4[0], y4[1]), cvtpk(y4[2], y4[3]), cvtpk(y4[4], y4[5]), cvtpk(y4[6], y4[7])}, w5 = {cvtpk(y5[0], y5[1]), cvtpk(y5[2], y5[3]), cvtpk(y5[4], y5[5]), cvtpk(y5[6], y5[7])}; \
        qr[NF - 2] = __builtin_bit_cast(bf16x8, w4); qr[NF - 1] = __builtin_bit_cast(bf16x8, w5); } } while (0)
  f32x16 pA0, pA1, pB0, pB1; float alA, alB; bf16x8 pa0, pa1, pa2, pa3;
  ATT_SLOAD(0); ATT_SWAIT(); ATT_SWRITE(0);
  ATT_SLOAD(1); ATT_SWAIT(); ATT_SWRITE(1); ATT_LBAR();
  qkt<DQK, true>(pA0, pA1, K_lds, qr, r32, hi, negm);
  partialSM<true>(pA0, pA1, m_reg, negm, alA, thr, true, rowmax32(pA0, pA1));
#pragma unroll
  for (int r = 0; r < 16; ++r) { pA0[r] = __builtin_amdgcn_exp2f(pA0[r]); pA1[r] = __builtin_amdgcn_exp2f(pA1[r]); }
  int s_cur = 0, s_nxt = 1, s_nn = 2;
#define ATT_STEP(t, X0, X1, alX, Y0, Y1, alY, HAS1, HAS2) do { \
    if (HAS1) { if (rot && (t) + 1 == nct) ATT_ROTQ(); } \
    ATT_SBAR(); if (HAS1) qkt<DQK, true>(Y0, Y1, K_lds + s_nxt * SHM_K, qr, r32, hi, negm); \
    finishSM(X0, X1, alX, l_reg, pa0, pa1, pa2, pa3); ATT_SBAR(); \
    if (HAS2) ATT_SLOAD((t) + 2); ATT_SBAR(); \
    if (HAS1) { partialSM<true>(Y0, Y1, m_reg, negm, alY, thr, false, rowmax32(Y0, Y1)); ATT_SBAR(); pv_ex(o, vb0 + s_cur * SHM_V, pa0, pa1, pa2, pa3, Y0, Y1); } \
    else pv_last(o, vb0 + s_cur * SHM_V, pa0, pa1, pa2, pa3); \
    if (HAS2) { ATT_SWAIT(); ATT_SWRITE(s_nn); } \
    if (HAS1) ATT_RESC(alY); \
    ATT_LBAR(); { const int tmp_ = s_cur; s_cur = s_nxt; s_nxt = s_nn; s_nn = tmp_; } } while (0)
  for (int t = 0; t + 2 < NT; t += 2) {
    ATT_STEP(t, pA0, pA1, alA, pB0, pB1, alB, true, true);
    ATT_STEP(t + 1, pB0, pB1, alB, pA0, pA1, alA, true, true);
  }
  ATT_STEP(NT - 2, pA0, pA1, alA, pB0, pB1, alB, true, false);
  ATT_STEP(NT - 1, pB0, pB1, alB, pA0, pA1, alA, false, false);
#undef ATT_STEP
  if (hi == 0) li_l[r32] = l_reg; asm volatile("s_waitcnt lgkmcnt(0)" ::: "memory");
  float rli[16];
#pragma unroll
  for (int r = 0; r < 16; ++r) rli[r] = __builtin_amdgcn_rcpf(li_l[crow(r, hi)]);
  if constexpr (OUTBF) { bf16* Ow = (bf16*)Opv + (size_t)(wid * 32) * DM;
#pragma unroll
    for (int r = 0; r < 16; ++r) { const int orow = crow(r, hi);
#pragma unroll
      for (int d0 = 0; d0 < 4; ++d0) Ow[(size_t)orow * DM + d0 * 32 + r32] = (bf16)f2bf(o[d0][r] * rli[r]); }
  } else { float* Ow = (float*)Opv + (size_t)(wid * 32) * NOATT;
    if (!fin) {
#pragma unroll
      for (int r = 0; r < 16; ++r) { const int orow = crow(r, hi);
#pragma unroll
        for (int d0 = 0; d0 < 4; ++d0) Ow[(size_t)orow * NOATT + d0 * 32 + r32] = o[d0][r] * rli[r]; }
    } else {
      bf16* Mw = Mx + (size_t)(wid * 32) * DM; float gv[4];
#pragma unroll
      for (int d0 = 0; d0 < 4; ++d0) gv[d0] = ag[d0 * 32 + r32] * gsc;
#pragma unroll
      for (int r = 0; r < 16; ++r) { const int orow = crow(r, hi); float v[4]; float ss = 0.f;
#pragma unroll
        for (int d0 = 0; d0 < 4; ++d0) { v[d0] = Ow[(size_t)orow * NOATT + d0 * 32 + r32] - lam * (o[d0][r] * rli[r]); ss += v[d0] * v[d0]; }
        ss += __shfl_xor(ss, 1); ss += __shfl_xor(ss, 2); ss += __shfl_xor(ss, 4); ss += __shfl_xor(ss, 8); ss += __shfl_xor(ss, 16);
        const float rs = 1.0f / sqrtf(ss * (1.f / 128.f) + EPS);
#pragma unroll
        for (int d0 = 0; d0 < 4; ++d0) Mw[(size_t)orow * DM + d0 * 32 + r32] = (bf16)f2bf(v[d0] * rs * gv[d0]); } } }
  __syncthreads();
#undef ATT_SLOAD
#undef ATT_SWRITE
#undef ATT_SWAIT
#undef ATT_RESC
#undef ATT_ROTQ
}

__device__ __forceinline__ void norm0_phase(const float* xp, const float* xs_off, const float* gm, bf16* H, float* ssq, int gw, int NGW, int lane) {
    for (int m = gw; m < M; m += NGW) {
        const float* xr = (m < MP ? xp : xs_off) + (size_t)m * DM;
        const int mi = m < MP ? 0 : 1 + (m - MP) / DSEQ; const float* g = gm + (size_t)mi * DM;
        f32x4 v[8]; float s = 0.f;
#pragma unroll
        for (int j = 0; j < 8; ++j) { v[j] = ((const f32x4*)xr)[lane + 64 * j]; s += (v[j].x * v[j].x + v[j].y * v[j].y) + (v[j].z * v[j].z + v[j].w * v[j].w); }
        s = wave_sum(s); if (lane < 32) ssq[(size_t)m * 32 + lane] = lane == 0 ? s : 0.f;
#pragma unroll
        for (int j = 0; j < 8; ++j) { const int c = (lane + 64 * j) * 4; const f32x4 y = v[j] * *(const f32x4*)(g + c); v2u o; o.x = pk2(y.x, y.y); o.y = pk2(y.z, y.w); *(v2u*)(H + (size_t)m * DM + c) = o; }
    }
}
__device__ __forceinline__ void pro2_phase(const Args& a, LAS unsigned char* lds, int tid, int bid, int G, int gt, int NGT) {
    using att::bf16x8; using att::f32x16; using att::crow;
    unsigned char* ws = a.ws; const float* MOD = (const float*)(ws + WS_MOD); float* GM = (float*)(ws + WS_GM);
    for (int i = gt; i < DEPTH * 2 * 5 * DM; i += NGT) { const int c = i % DM, mi = (i / DM) % 5, w = (i / (5 * DM)) & 1, l = i / (2 * 5 * DM);
        const float g = a.in[w ? I_N2G : I_N1G][l * DM + c]; GM[i] = g * (1.f + MOD[((size_t)(l * 5 + mi) * 6 + (w ? 4 : 1)) * DM + c]); }
    const int wave = tid >> 6, lane = tid & 63, r32 = lane & 31, hi = lane >> 5;
    LAS bf16* T = (LAS bf16*)lds;
#pragma unroll 1
    for (int kind = 0; kind < 2; ++kind) {
        __syncthreads();
        for (int e = tid; e < DEPTH * 5 * DM; e += NTH) { const int l = e / (5 * DM), mi = (e / DM) % 5, k = e % DM; T[e] = (bf16)f2bf(MOD[((size_t)(l * 5 + mi) * 6 + (kind ? 3 : 0)) * DM + k]); }
        __syncthreads();
        const int ld = kind ? 2 * DFF : NINP, items_l = ld / 32;
        for (int it = bid * NWV + wave; it < DEPTH * items_l; it += G * NWV) { const int l = it / items_l, rb = it % items_l;
            const bf16* Wr = (kind ? (const bf16*)(ws + WS_WUP + l * SZ_WUP) : (const bf16*)(ws + WS_WIN + l * SZ_WIN)) + (size_t)(rb * 32 + r32) * DM + hi * 8;
            const LAS bf16* Tb = T + (size_t)(l * 5 + (r32 < 5 ? r32 : 4)) * DM + hi * 8;
            f32x16 acc = {};
#pragma unroll 1
            for (int ks = 0; ks < DM / 16; ks += 8) { bf16x8 af[8];
#pragma unroll
                for (int j = 0; j < 8; ++j) af[j] = *reinterpret_cast<const bf16x8*>(Wr + (ks + j) * 16);
#pragma unroll
                for (int j = 0; j < 8; ++j) { bf16x8 bfv = *(const LAS bf16x8*)(Tb + (ks + j) * 16); if (r32 >= 5) bfv = (bf16x8){0, 0, 0, 0, 0, 0, 0, 0};
                    acc = __builtin_amdgcn_mfma_f32_32x32x16_bf16(af[j], bfv, acc, 0, 0, 0); } }
            if (r32 < 5) { float* dst = (kind ? (float*)(ws + WS_SHWU) + (size_t)l * 5 * 2 * DFF : (float*)(ws + WS_SHWI) + (size_t)l * 5 * NINP) + (size_t)r32 * ld + rb * 32;
#pragma unroll
                for (int r = 0; r < 16; ++r) dst[crow(r, hi)] = acc[r]; }
        }
    }
    __syncthreads();
}
__device__ __forceinline__ void final_norm_phase(const float* X, const float* g, float* out, int gw, int NGW, int lane) {
    for (int m = gw; m < M; m += NGW) {
        const float* xr = X + (size_t)m * DM; f32x4 v[8]; float s = 0.f;
#pragma unroll
        for (int j = 0; j < 8; ++j) { v[j] = ((const f32x4*)xr)[lane + 64 * j]; s += (v[j].x * v[j].x + v[j].y * v[j].y) + (v[j].z * v[j].z + v[j].w * v[j].w); }
        const float rstd = 1.0f / sqrtf(wave_sum(s) * (1.f / DM) + EPS);
#pragma unroll
        for (int j = 0; j < 8; ++j) { const int c = (lane + 64 * j) * 4; *(f32x4*)(out + (size_t)m * DM + c) = v[j] * rstd * *(const f32x4*)(g + c); }
    }
}

__device__ __forceinline__ void post_phase(const Args& a, int l, int gw, int NGW, int lane) {
    using att::bf16x8; using att::bfe; using att::cvtpk; using att::u32x4;
    unsigned char* ws = a.ws;
    const bf16* P = (const bf16*)(ws + WS_P); bf16* KRA = (bf16*)(ws + WS_KRA); bf16* KRC = (bf16*)(ws + WS_KRC); bf16* CQN = (bf16*)(ws + WS_CQN); bf16* CKVN = (bf16*)(ws + WS_CKVN);
    const float* RTA = (const float*)(ws + WS_RTA); const float* RTC = (const float*)(ws + WS_RTC);
    const float* gq = a.in[I_CQG] + l * 384; const float* gkv = a.in[I_CKVG] + l * 256;
    for (int m = gw; m < M; m += NGW) {
        const bf16* pr = P + (size_t)m * NINP;
        float xq[8], xk[8]; float sq = 0.f, sk = 0.f;
        if (lane < 48) { const bf16x8 v = *reinterpret_cast<const bf16x8*>(pr + C_CQ + lane * 8);
#pragma unroll
            for (int i = 0; i < 8; ++i) { xq[i] = bfe(v, i); sq += xq[i] * xq[i]; } }
        if (lane < 32) { const bf16x8 v = *reinterpret_cast<const bf16x8*>(pr + C_CKV + lane * 8);
#pragma unroll
            for (int i = 0; i < 8; ++i) { xk[i] = bfe(v, i); sk += xk[i] * xk[i]; } }
        const float rq = 1.0f / sqrtf(wave_sum(sq) * (1.f / 384.f) + EPS), rk = 1.0f / sqrtf(wave_sum(sk) * (1.f / 256.f) + EPS);
        if (lane < 48) { const f32x4 g0 = *(const f32x4*)(gq + lane * 8), g1 = *(const f32x4*)(gq + lane * 8 + 4);
            *(u32x4*)(CQN + (size_t)m * 384 + lane * 8) = (u32x4){cvtpk(xq[0] * rq * g0.x, xq[1] * rq * g0.y), cvtpk(xq[2] * rq * g0.z, xq[3] * rq * g0.w), cvtpk(xq[4] * rq * g1.x, xq[5] * rq * g1.y), cvtpk(xq[6] * rq * g1.z, xq[7] * rq * g1.w)}; }
        if (lane < 32) { const f32x4 g0 = *(const f32x4*)(gkv + lane * 8), g1 = *(const f32x4*)(gkv + lane * 8 + 4);
            const f32x4 y0 = {xk[0] * rk * g0.x, xk[1] * rk * g0.y, xk[2] * rk * g0.z, xk[3] * rk * g0.w}, y1 = {xk[4] * rk * g1.x, xk[5] * rk * g1.y, xk[6] * rk * g1.z, xk[7] * rk * g1.w};
            *(u32x4*)(CKVN + (size_t)m * 256 + lane * 8) = (u32x4){cvtpk(y0.x, y0.y), cvtpk(y0.z, y0.w), cvtpk(y1.x, y1.y), cvtpk(y1.z, y1.w)};
            if (m < MP) { float* o = a.out + O_CKV + (((size_t)(m / SEQ) * DEPTH + l) * SEQ + (m % SEQ)) * 256 + lane * 8; *(f32x4*)o = y0; *(f32x4*)(o + 4) = y1; } }
        if (m >= MP) { const int ms = m - MP, t = ms % DSEQ;
            if (lane < 34) { const bool isa = lane < 32; const int hh = isa ? (lane >> 1) & 1 : lane - 32;
                const int base = isa ? (lane >> 2) * 64 + hh * 32 + (lane & 1) * 8 : hh * 16, dist = isa ? 16 : 8;
                const bf16* src = pr + (isa ? C_AK : C_CKR) + base; const float* tb = isa ? RTA + (size_t)t * 64 + hh * 32 + (lane & 1) * 8 : RTC + (size_t)t * 32 + hh * 16;
                const bf16x8 v0 = *reinterpret_cast<const bf16x8*>(src), v1 = *reinterpret_cast<const bf16x8*>(src + dist);
                const f32x4 c0 = *(const f32x4*)(tb), c1 = *(const f32x4*)(tb + 4), s0 = *(const f32x4*)(tb + dist), s1 = *(const f32x4*)(tb + dist + 4);
                float y0[8], y1[8];
#pragma unroll
                for (int i = 0; i < 8; ++i) { const float cs = i < 4 ? c0[i & 3] : c1[i & 3], sn = i < 4 ? s0[i & 3] : s1[i & 3]; const float x0 = bfe(v0, i), x1 = bfe(v1, i); y0[i] = x0 * cs - x1 * sn; y1[i] = x1 * cs + x0 * sn; }
                bf16* dst = isa ? KRA + (size_t)ms * 512 + base : KRC + (size_t)ms * 32 + base;
                *(u32x4*)dst = (u32x4){cvtpk(y0[0], y0[1]), cvtpk(y0[2], y0[3]), cvtpk(y0[4], y0[5]), cvtpk(y0[6], y0[7])};
                *(u32x4*)(dst + dist) = (u32x4){cvtpk(y1[0], y1[1]), cvtpk(y1[2], y1[3]), cvtpk(y1[4], y1[5]), cvtpk(y1[6], y1[7])}; }
        } else { const size_t ro = ((size_t)(m / SEQ) * DEPTH + l) * SEQ + (m % SEQ);
            { const bf16x8 v = *reinterpret_cast<const bf16x8*>(pr + C_AK + lane * 8); float* o = a.out + O_AK + ro * 512 + lane * 8;
              *(f32x4*)o = (f32x4){bfe(v, 0), bfe(v, 1), bfe(v, 2), bfe(v, 3)}; *(f32x4*)(o + 4) = (f32x4){bfe(v, 4), bfe(v, 5), bfe(v, 6), bfe(v, 7)}; }
            { const bf16x8 v = *reinterpret_cast<const bf16x8*>(pr + C_AV + lane * 8); float* o = a.out + O_AV + ro * 512 + lane * 8;
              *(f32x4*)o = (f32x4){bfe(v, 0), bfe(v, 1), bfe(v, 2), bfe(v, 3)}; *(f32x4*)(o + 4) = (f32x4){bfe(v, 4), bfe(v, 5), bfe(v, 6), bfe(v, 7)}; }
            if (lane < 4) { const bf16x8 v = *reinterpret_cast<const bf16x8*>(pr + C_CKR + lane * 8); float* o = a.out + O_CKR + ro * 32 + lane * 8;
              *(f32x4*)o = (f32x4){bfe(v, 0), bfe(v, 1), bfe(v, 2), bfe(v, 3)}; *(f32x4*)(o + 4) = (f32x4){bfe(v, 4), bfe(v, 5), bfe(v, 6), bfe(v, 7)}; } }
    }
}


constexpr int NCHUNK = M / 64, GLA_UNITS = NCHUNK * 6;
constexpr int TS = 144;

__device__ __forceinline__ void gla_g1_unit(const Args& a, int l, int unit, LAS unsigned char* lds, int tid) {
    using namespace att;
    unsigned char* ws = a.ws; const bf16* P = (const bf16*)(ws + WS_P); bf16* QK4 = (bf16*)(ws + WS_QK4); float* U = (float*)(ws + WS_U); float* DD = (float*)(ws + WS_DD);
    const int gc = unit / 6, h = unit % 6, m0 = gc * 64;
    const int wave = tid >> 6, lane = tid & 63, r32 = lane & 31, hi = lane >> 5;
    LAS float* glr = (LAS float*)lds;
    LAS float* gw = (LAS float*)(lds + 8192);
    LAS float* gbs = (LAS float*)(lds + 16384);
    LAS float* segtot = (LAS float*)(lds + 16896);
    LAS unsigned char* KfT = lds + 20992;
    LAS unsigned char* KbT = lds + 30208;
    LAS unsigned char* Vt = lds + 39424;
    LAS float* Dl = (LAS float*)(lds + 55808);
    const float* gwt = a.in[I_BGW] + (size_t)l * 2 * 16 * 384; const float* gb = a.in[I_BGB] + l * 2 * 384;
    const int k = tid & 63, tq = tid >> 6;
    if (tid < 256) { const int t = tid >> 2, part = tid & 3; const bf16x8 v = *reinterpret_cast<const bf16x8*>(P + (size_t)(m0 + t) * NINP + C_BG + part * 8);
#pragma unroll
        for (int i = 0; i < 8; ++i) glr[t * 32 + part * 8 + i] = bfe(v, i); }
#pragma unroll
    for (int i = 0; i < 4; ++i) { const int idx = tid + NTH * i, dr = idx >> 6, kk = idx & 63; gw[idx] = gwt[(size_t)dr * 384 + h * 64 + kk]; }
    if (tid < 128) gbs[tid] = gb[(tid >> 6) * 384 + h * 64 + (tid & 63)];
    { const int sr = tid >> 4, sc = (tid & 15) * 8;
      const bf16x8 v0 = *reinterpret_cast<const bf16x8*>(P + (size_t)(m0 + sr) * NINP + C_BV + h * 128 + sc), v1 = *reinterpret_cast<const bf16x8*>(P + (size_t)(m0 + 32 + sr) * NINP + C_BV + h * 128 + sc);
      *(LAS bf16x8*)(Vt + v_st(sr, sc)) = v0; *(LAS bf16x8*)(Vt + v_st(32 + sr, sc)) = v1; }
    bf16 qv[8], kv[8];
#pragma unroll
    for (int j = 0; j < 8; ++j) { const bf16* pr = P + (size_t)(m0 + 8 * tq + j) * NINP + h * 64 + k; qv[j] = pr[C_BQ]; kv[j] = pr[C_BK]; }
    __syncthreads();
    float bf_[8], bb_[8];
#pragma unroll
    for (int dir = 0; dir < 2; ++dir) { float wr_[16];
#pragma unroll
        for (int r = 0; r < 16; ++r) wr_[r] = gw[(dir * 16 + r) * 64 + k];
        const float bias = gbs[dir * 64 + k];
#pragma unroll
        for (int j = 0; j < 8; ++j) { const LAS float* gp = glr + (8 * tq + j) * 32 + dir * 16; float pre = bias;
#pragma unroll
            for (int r4 = 0; r4 < 4; ++r4) { const f32x4 x = *(const LAS f32x4*)(gp + 4 * r4); pre += (x.x * wr_[4 * r4] + x.y * wr_[4 * r4 + 1]) + (x.z * wr_[4 * r4 + 2] + x.w * wr_[4 * r4 + 3]); }
            const float gl = (fminf(pre, 0.f) - __logf(1.f + __expf(-fabsf(pre)))) * (1.f / 16.f);
            if (dir == 0) bf_[j] = gl; else bb_[j] = gl; } }
#pragma unroll
    for (int j = 1; j < 8; ++j) bf_[j] += bf_[j - 1];
#pragma unroll
    for (int j = 6; j >= 0; --j) bb_[j] += bb_[j + 1];
    segtot[tq * 64 + k] = bf_[7]; segtot[(8 + tq) * 64 + k] = bb_[0];
    __syncthreads();
    { float of = 0.f, ob = 0.f;
#pragma unroll
      for (int q2 = 0; q2 < 8; ++q2) { const float sf = segtot[q2 * 64 + k], sb = segtot[(8 + q2) * 64 + k]; of += q2 < tq ? sf : 0.f; ob += q2 > tq ? sb : 0.f; }
      float kf[8], kb[8];
      bf16* dst = QK4 + (size_t)(m0 + 8 * tq) * 1536 + h * 64 + k;
#pragma unroll
      for (int j = 0; j < 8; ++j) { const float bfv = bf_[j] + of, bbv = bb_[j] + ob; const float ef = __expf(bfv), eb = __expf(bbv); const float q = bf2f(qv[j]) * 0.125f, kk = bf2f(kv[j]);
          kf[j] = kk * __expf(-bfv); kb[j] = kk * __expf(-bbv);
          dst[(size_t)j * 1536] = (bf16)f2bf(q * ef); dst[(size_t)j * 1536 + 384] = (bf16)f2bf(kf[j]); dst[(size_t)j * 1536 + 768] = (bf16)f2bf(q * eb); dst[(size_t)j * 1536 + 1152] = (bf16)f2bf(kb[j]);
          if (j == 7 && tq == 7) Dl[k] = ef;
          if (j == 0 && tq == 0) Dl[64 + k] = eb; }
      *(LAS u32x4*)(KfT + k * TS + tq * 16) = (u32x4){cvtpk(kf[0], kf[1]), cvtpk(kf[2], kf[3]), cvtpk(kf[4], kf[5]), cvtpk(kf[6], kf[7])};
      *(LAS u32x4*)(KbT + k * TS + tq * 16) = (u32x4){cvtpk(kb[0], kb[1]), cvtpk(kb[2], kb[3]), cvtpk(kb[4], kb[5]), cvtpk(kb[6], kb[7])}; }
    __syncthreads();
    { const int dir = wave >> 2, vb = wave & 3; const LAS unsigned char* KT = dir ? KbT : KfT;
      const int vbase = (int)(unsigned)(uintptr_t)Vt + v_rd_base(lane) + vb * 512;
      const s16x4 l0 = tr_read<v_rd_off(0, 0, 0)>(vbase), h0 = tr_read<v_rd_off(0, 0, 1)>(vbase), l1 = tr_read<v_rd_off(0, 1, 0)>(vbase), h1 = tr_read<v_rd_off(0, 1, 1)>(vbase);
      const s16x4 l2 = tr_read<v_rd_off(0, 2, 0)>(vbase), h2 = tr_read<v_rd_off(0, 2, 1)>(vbase), l3 = tr_read<v_rd_off(0, 3, 0)>(vbase), h3 = tr_read<v_rd_off(0, 3, 1)>(vbase);
      asm volatile("s_waitcnt lgkmcnt(0)" ::: "memory");
#define GLA_PK(L, H) (bf16x8){L[0], L[1], L[2], L[3], H[0], H[1], H[2], H[3]}
      const bf16x8 vf0 = GLA_PK(l0, h0), vf1 = GLA_PK(l1, h1), vf2 = GLA_PK(l2, h2), vf3 = GLA_PK(l3, h3);
      float* Ub = U + ((size_t)unit * 2 + dir) * 8192;
#pragma unroll
      for (int rb = 0; rb < 2; ++rb) { f32x16 acc = {};
          const LAS unsigned char* ar = KT + (rb * 32 + r32) * TS + hi * 16;
          acc = __builtin_amdgcn_mfma_f32_32x32x16_bf16(vf0, *(const LAS bf16x8*)(ar), acc, 0, 0, 0);
          acc = __builtin_amdgcn_mfma_f32_32x32x16_bf16(vf1, *(const LAS bf16x8*)(ar + 32), acc, 0, 0, 0);
          acc = __builtin_amdgcn_mfma_f32_32x32x16_bf16(vf2, *(const LAS bf16x8*)(ar + 64), acc, 0, 0, 0);
          acc = __builtin_amdgcn_mfma_f32_32x32x16_bf16(vf3, *(const LAS bf16x8*)(ar + 96), acc, 0, 0, 0);
          const int kr = rb * 32 + r32; const float dk = Dl[dir * 64 + kr];
#pragma unroll
          for (int g4 = 0; g4 < 4; ++g4) *(f32x4*)(Ub + kr * 128 + vb * 32 + 8 * g4 + 4 * hi) = (f32x4){acc[4 * g4] * dk, acc[4 * g4 + 1] * dk, acc[4 * g4 + 2] * dk, acc[4 * g4 + 3] * dk}; }
      if (tid < 128) DD[(size_t)unit * 128 + tid] = Dl[tid]; }
    __syncthreads();
}

constexpr int GLA_G2_ITEMS = (NPB + NDB) * 6 * 2 * 4;
__device__ __forceinline__ void gla_g2_item(const Args& a, int l, int item, int tid) {
    unsigned char* ws = a.ws; const float* U = (const float*)(ws + WS_U); const float* DD = (const float*)(ws + WS_DD); bf16* ST = (bf16*)(ws + WS_ST);
    const int kq = item & 3, dir = (item >> 2) & 1, hs = item >> 3, h = hs % 6, sq = hs / 6;
    const bool smp = sq < NDB; const int b = smp ? sq : sq - NDB, nc = smp ? DSEQ / 64 : SEQ / 64, gc0 = smp ? (MP / 64) + b * (DSEQ / 64) : b * (SEQ / 64);
    const int v = tid & 127, k0 = kq * 16 + (tid >> 7) * 4;
    f32x4 s;
#pragma unroll
    for (int i = 0; i < 4; ++i) s[i] = smp ? a.in[I_STB][((((size_t)b * DEPTH + l) * 2 + dir) * 6 + h) * 8192 + (k0 + i) * 128 + v] : 0.f;
    const int step = smp ? 8 : 4;
    for (int ci = 0; ci < nc; ci += step) {
        float u[8][4]; f32x4 d[8];
#pragma unroll
        for (int j = 0; j < 8; ++j) if (j < step) { const int c = dir ? nc - 1 - (ci + j) : ci + j; const size_t ub = ((size_t)(gc0 + c) * 6 + h) * 2 + dir; d[j] = *(const f32x4*)(DD + ub * 64 + k0);
#pragma unroll
            for (int i = 0; i < 4; ++i) u[j][i] = U[ub * 8192 + (k0 + i) * 128 + v]; }
#pragma unroll
        for (int j = 0; j < 8; ++j) if (j < step) { const int c = dir ? nc - 1 - (ci + j) : ci + j; const size_t ub = ((size_t)(gc0 + c) * 6 + h) * 2 + dir;
#pragma unroll
            for (int i = 0; i < 4; ++i) { ST[ub * 8192 + (size_t)(k0 + i) * 128 + v] = (bf16)f2bf(s[i]); s[i] = d[j][i] * s[i] + u[j][i]; } }
    }
    if (!smp) {
#pragma unroll
        for (int i = 0; i < 4; ++i) a.out[O_SB + ((((size_t)b * DEPTH + l) * 2 + dir) * 6 + h) * 8192 + (k0 + i) * 128 + v] = s[i];
    }
}

__device__ __forceinline__ void gla_g3_unit(const Args& a, int l, int unit, LAS unsigned char* lds, int tid) {
    using namespace att;
    unsigned char* ws = a.ws; const bf16* P = (const bf16*)(ws + WS_P); const bf16* QK4 = (const bf16*)(ws + WS_QK4); const bf16* ST = (const bf16*)(ws + WS_ST); bf16* MIX = (bf16*)(ws + WS_MIX);
    const int gc = unit / 6, h = unit % 6, m0 = gc * 64;
    const int wave = tid >> 6, lane = tid & 63, r32 = lane & 31, hi = lane >> 5;
    LAS unsigned char* T4 = lds;
    LAS unsigned char* Vt = lds + 36864;
    LAS unsigned char* AT = lds + 53248;
    LAS unsigned char* St = lds + 71680;
    LAS float* OT = (LAS float*)(lds + 71680);
    { const int row = tid >> 3, ch = tid & 7; const bf16* src = QK4 + (size_t)(m0 + row) * 1536 + h * 64 + ch * 8;
#pragma unroll
      for (int var = 0; var < 4; ++var) *(LAS bf16x8*)(T4 + var * 9216 + row * TS + ch * 16) = *reinterpret_cast<const bf16x8*>(src + var * 384);
      const int sr = tid >> 4, sc = (tid & 15) * 8;
      const bf16x8 v0 = *reinterpret_cast<const bf16x8*>(P + (size_t)(m0 + sr) * NINP + C_BV + h * 128 + sc), v1 = *reinterpret_cast<const bf16x8*>(P + (size_t)(m0 + 32 + sr) * NINP + C_BV + h * 128 + sc);
      *(LAS bf16x8*)(Vt + v_st(sr, sc)) = v0; *(LAS bf16x8*)(Vt + v_st(32 + sr, sc)) = v1;
#pragma unroll
      for (int dir = 0; dir < 2; ++dir) { const bf16* Sg = ST + (((size_t)unit) * 2 + dir) * 8192;
          const bf16x8 a0 = *reinterpret_cast<const bf16x8*>(Sg + (size_t)sr * 128 + sc), a1 = *reinterpret_cast<const bf16x8*>(Sg + (size_t)(32 + sr) * 128 + sc);
          *(LAS bf16x8*)(St + dir * 16384 + v_st(sr, sc)) = a0; *(LAS bf16x8*)(St + dir * 16384 + v_st(32 + sr, sc)) = a1; } }
    __syncthreads();
    { const int dir = wave >> 2, tb = (wave >> 1) & 1, sb = wave & 1;
      const LAS unsigned char* Qt = T4 + (dir * 2) * 9216 + (tb * 32 + r32) * TS + hi * 16; const LAS unsigned char* Kt = T4 + (dir * 2 + 1) * 9216 + (sb * 32 + r32) * TS + hi * 16;
      f32x16 acc = {};
#pragma unroll
      for (int ks = 0; ks < 4; ++ks) acc = __builtin_amdgcn_mfma_f32_32x32x16_bf16(*(const LAS bf16x8*)(Kt + ks * 32), *(const LAS bf16x8*)(Qt + ks * 32), acc, 0, 0, 0);
      const int t = tb * 32 + r32;
#pragma unroll
      for (int r = 0; r < 16; ++r) { const int s = sb * 32 + crow(r, hi); const bool keep = dir ? (s >= t) : (s <= t); acc[r] = keep ? acc[r] : 0.f; }
#pragma unroll
      for (int g = 0; g < 4; ++g) { v2u w; w.x = cvtpk(acc[4 * g], acc[4 * g + 1]); w.y = cvtpk(acc[4 * g + 2], acc[4 * g + 3]);
          *(LAS v2u*)(AT + dir * 9216 + t * TS + (sb * 32 + 8 * g + 4 * hi) * 2) = w; } }
    __syncthreads();
    { const int tb = wave >> 2, vb = wave & 3; f32x16 o = {};
      const int vbase = (int)(unsigned)(uintptr_t)Vt + v_rd_base(lane) + vb * 512;
      const s16x4 l0 = tr_read<v_rd_off(0, 0, 0)>(vbase), h0 = tr_read<v_rd_off(0, 0, 1)>(vbase), l1 = tr_read<v_rd_off(0, 1, 0)>(vbase), h1 = tr_read<v_rd_off(0, 1, 1)>(vbase);
      const s16x4 l2 = tr_read<v_rd_off(0, 2, 0)>(vbase), h2 = tr_read<v_rd_off(0, 2, 1)>(vbase), l3 = tr_read<v_rd_off(0, 3, 0)>(vbase), h3 = tr_read<v_rd_off(0, 3, 1)>(vbase);
      asm volatile("s_waitcnt lgkmcnt(0)" ::: "memory");
      const bf16x8 vf0 = GLA_PK(l0, h0), vf1 = GLA_PK(l1, h1), vf2 = GLA_PK(l2, h2), vf3 = GLA_PK(l3, h3);
#pragma unroll
      for (int dir = 0; dir < 2; ++dir) {
          const int sbase = (int)(unsigned)(uintptr_t)(St + dir * 16384) + v_rd_base(lane) + vb * 512;
          const s16x4 a0 = tr_read<v_rd_off(0, 0, 0)>(sbase), b0 = tr_read<v_rd_off(0, 0, 1)>(sbase), a1 = tr_read<v_rd_off(0, 1, 0)>(sbase), b1 = tr_read<v_rd_off(0, 1, 1)>(sbase);
          const s16x4 a2 = tr_read<v_rd_off(0, 2, 0)>(sbase), b2 = tr_read<v_rd_off(0, 2, 1)>(sbase), a3 = tr_read<v_rd_off(0, 3, 0)>(sbase), b3 = tr_read<v_rd_off(0, 3, 1)>(sbase);
          asm volatile("s_waitcnt lgkmcnt(0)" ::: "memory");
          const bf16x8 s0 = GLA_PK(a0, b0), s1 = GLA_PK(a1, b1), s2 = GLA_PK(a2, b2), s3 = GLA_PK(a3, b3);
          const LAS unsigned char* Qt = T4 + (dir * 2) * 9216 + (tb * 32 + r32) * TS + hi * 16; const LAS unsigned char* At = AT + dir * 9216 + (tb * 32 + r32) * TS + hi * 16;
          o = __builtin_amdgcn_mfma_f32_32x32x16_bf16(*(const LAS bf16x8*)(Qt), s0, o, 0, 0, 0);
          o = __builtin_amdgcn_mfma_f32_32x32x16_bf16(*(const LAS bf16x8*)(Qt + 32), s1, o, 0, 0, 0);
          o = __builtin_amdgcn_mfma_f32_32x32x16_bf16(*(const LAS bf16x8*)(Qt + 64), s2, o, 0, 0, 0);
          o = __builtin_amdgcn_mfma_f32_32x32x16_bf16(*(const LAS bf16x8*)(Qt + 96), s3, o, 0, 0, 0);
          o = __builtin_amdgcn_mfma_f32_32x32x16_bf16(*(const LAS bf16x8*)(At), vf0, o, 0, 0, 0);
          o = __builtin_amdgcn_mfma_f32_32x32x16_bf16(*(const LAS bf16x8*)(At + 32), vf1, o, 0, 0, 0);
          o = __builtin_amdgcn_mfma_f32_32x32x16_bf16(*(const LAS bf16x8*)(At + 64), vf2, o, 0, 0, 0);
          o = __builtin_amdgcn_mfma_f32_32x32x16_bf16(*(const LAS bf16x8*)(At + 96), vf3, o, 0, 0, 0); }
      __syncthreads();
#pragma unroll
      for (int r = 0; r < 16; ++r) OT[(tb * 32 + crow(r, hi)) * 132 + vb * 32 + r32] = o[r]; }
    __syncthreads();
    { const int t = tid >> 3, c0 = (tid & 7) * 16; const float* bg = a.in[I_BNG] + l * 128 + c0;
      f32x4 x[4]; float ss = 0.f;
#pragma unroll
      for (int i = 0; i < 4; ++i) { x[i] = *(const LAS f32x4*)(OT + t * 132 + c0 + 4 * i); ss += (x[i].x * x[i].x + x[i].y * x[i].y) + (x[i].z * x[i].z + x[i].w * x[i].w); }
      ss += __shfl_xor(ss, 1); ss += __shfl_xor(ss, 2); ss += __shfl_xor(ss, 4);
      const float rs = 1.0f / sqrtf(ss * (1.f / 128.f) + EPS);
      const bf16* rg = P + (size_t)(m0 + t) * NINP + C_BR + h * 128 + c0; const bf16x8 r0 = *reinterpret_cast<const bf16x8*>(rg), r1 = *reinterpret_cast<const bf16x8*>(rg + 8);
      float y[16];
#pragma unroll
      for (int i = 0; i < 4; ++i) { const f32x4 gv = *(const f32x4*)(bg + 4 * i); y[4 * i] = x[i].x * rs * gv.x; y[4 * i + 1] = x[i].y * rs * gv.y; y[4 * i + 2] = x[i].z * rs * gv.z; y[4 * i + 3] = x[i].w * rs * gv.w; }
#pragma unroll
      for (int i = 0; i < 8; ++i) { y[i] *= siluf(bfe(r0, i)); y[8 + i] *= siluf(bfe(r1, i)); }
      bf16* dst = MIX + (size_t)(m0 + t) * DM + 512 + h * 128 + c0;
      *(u32x4*)(dst) = (u32x4){cvtpk(y[0], y[1]), cvtpk(y[2], y[3]), cvtpk(y[4], y[5]), cvtpk(y[6], y[7])};
      *(u32x4*)(dst + 8) = (u32x4){cvtpk(y[8], y[9]), cvtpk(y[10], y[11]), cvtpk(y[12], y[13]), cvtpk(y[14], y[15])}; }
    __syncthreads();
#undef GLA_PK
}

__device__ __forceinline__ void mixer_phase(const Args& a, int l, LAS unsigned char* lds, int tid_in, int bid, int G) {
    unsigned char* ws = a.ws;
    const bf16* P = (const bf16*)(ws + WS_P); const bf16* QC = (const bf16*)(ws + WS_QC); const bf16* KVC = (const bf16*)(ws + WS_KVC); const bf16* KRA = (const bf16*)(ws + WS_KRA); const bf16* KRC = (const bf16*)(ws + WS_KRC);
    const bf16* CAK = (const bf16*)(ws + WS_CAK); const bf16* CAV = (const bf16*)(ws + WS_CAV); const bf16* CKRX = (const bf16*)(ws + WS_CKRX); const bf16* KVCTX = (const bf16*)(ws + WS_KVCTX);
    const float* RTA = (const float*)(ws + WS_RTA); const float* RTC = (const float*)(ws + WS_RTC); float* OATT = (float*)(ws + WS_OATT); bf16* MIXB = (bf16*)(ws + WS_MIX);
    const float lam = ((const float*)(ws + WS_LAM))[l], li = ((const float*)(ws + WS_LAM))[4 + l]; const float* ag = a.in[I_ANG] + l * 128;
    constexpr int NAS = 256, NCS = 384, NAP = 64, NCP = 96, NFILL = NAP + NCP + GLA_UNITS;
    const bool tuned = G == 256;
    const int per = G / 8, vb = (bid % 8) * per + bid / 8, wx = vb % per, hx = per / 2;
    const bool heavy = wx < hx; const int hidx = (vb / per) * hx + wx, lidx = (vb / per) * hx + (wx - hx);
    const int nl = G / 2;
    const int nslots = tuned ? 3 + (!heavy ? (NFILL + nl - 1) / nl : 0) : (NAS + NCS + NFILL + G - 1) / G;
    for (int sl = 0; sl < nslots; ++sl) {
        int tid = tid_in; asm volatile("" : "+v"(tid));
        int kind, u, f = -1;
        if (!tuned) { const int g = bid + sl * G; if (g >= NAS + NCS + NFILL) continue; if (g < NAS) { kind = 0; u = g; } else if (g < NAS + NCS) { kind = 1; u = g - NAS; } else { kind = 5; u = 0; f = g - NAS - NCS; } }
        else if (sl == 0) { kind = 0; u = vb; }
        else if (sl == 1) { kind = 1; u = vb; }
        else if (sl == 2) { if (heavy) { kind = 1; u = G + hidx; } else continue; }
        else { kind = 5; u = 0; f = lidx + (sl - 3) * nl; if (f >= NFILL) continue; }
        if (kind == 5) { if (f < NAP) { kind = 2; u = f; } else if (f < NAP + NCP) { kind = 3; u = f - NAP; } else { kind = 4; u = f - NAP - NCP; } }
        if (kind == 0 && u >= NAS) continue;
        if (kind == 1 && u >= NCS) continue;
        if (kind == 4) { gla_g3_unit(a, l, u, lds, tid); continue; }
        if (kind == 0 || kind == 2) {
            int b, head, qb; size_t r0;
            if (kind == 0) { b = u >> 6; head = (u >> 4) & 3; qb = u & 15; r0 = (size_t)MP + (size_t)b * DSEQ; } else { b = u >> 2; head = u & 3; qb = 0; r0 = (size_t)b * SEQ; }
#pragma unroll 1
            for (int ps = 0; ps < 2; ++ps) { const int combo = head * 2 + ps; int tid2 = tid; asm volatile("" : "+v"(tid2));
                KSeg ctx{nullptr, 0, nullptr, 0, nullptr, 0, 0}, lat;
                if (kind == 0) { ctx = KSeg{CAK + ((size_t)(b * DEPTH + l) * PAST) * 512 + combo * 64, 512, nullptr, 0, CAV + ((size_t)(b * DEPTH + l) * PAST) * 512 + head * 128, 512, PAST};
                                 lat = KSeg{KRA + ((size_t)b * DSEQ) * 512 + combo * 64, 512, nullptr, 0, P + r0 * NINP + C_AV + head * 128, NINP, DSEQ}; }
                else lat = KSeg{P + r0 * NINP + C_AK + combo * 64, NINP, nullptr, 0, P + r0 * NINP + C_AV + head * 128, NINP, SEQ};
                attn_mfma_unit<64, 1, false>(lds, P + (r0 + qb * 256) * NINP + C_AQ + combo * 64, NINP, kind == 0, RTA, qb * 256, ctx, lat, 0.125f, OATT + (r0 + qb * 256) * NOATT + head * 128, tid2,
                                             ps == 1, lam, 1.f - li, ag, MIXB + (r0 + qb * 256) * DM + head * 128); }
        } else {
            KSeg ctx{nullptr, 0, nullptr, 0, nullptr, 0, 0}, lat; const bf16* Qp; int t0 = 0; bf16* Op;
            if (kind == 1) { const int b = u / 96, h = (u >> 4) % 6, qb = u & 15; const size_t r0 = (size_t)MP + (size_t)b * DSEQ; const size_t c0 = (size_t)(l * NDB + b) * PAST;
                ctx = KSeg{KVCTX + c0 * NKVP + h * 192, NKVP, CKRX + ((size_t)(b * DEPTH + l) * PAST) * 32, 32, KVCTX + c0 * NKVP + h * 192 + 64, NKVP, PAST};
                lat = KSeg{KVC + r0 * NKVP + h * 192, NKVP, KRC + ((size_t)b * DSEQ) * 32, 32, KVC + r0 * NKVP + h * 192 + 64, NKVP, DSEQ};
                Qp = QC + (r0 + qb * 256) * NQCP + h * 96; t0 = qb * 256; Op = MIXB + (r0 + qb * 256) * DM + 1280 + h * 128; }
            else { const int b = u / 6, h = u % 6; const size_t r0 = (size_t)b * SEQ;
                lat = KSeg{KVC + r0 * NKVP + h * 192, NKVP, P + r0 * NINP + C_CKR, NINP, KVC + r0 * NKVP + h * 192 + 64, NKVP, SEQ};
                Qp = QC + r0 * NQCP + h * 96; Op = MIXB + r0 * DM + 1280 + h * 128; }
            attn_mfma_unit<96, 1, true>(lds, Qp, NQCP, kind == 1, RTC, t0, ctx, lat, 0.10206207261596575f, Op, tid);
        }
    }
}

__device__ __forceinline__ void combine_phase(const Args& a, int l, int gw, int NGW, int lane) {
    using att::cvtpk; using att::u32x4;
    unsigned char* ws = a.ws; const float* OATT = (const float*)(ws + WS_OATT); bf16* MIX = (bf16*)(ws + WS_MIX);
    const float lam = ((const float*)(ws + WS_LAM))[l], li = ((const float*)(ws + WS_LAM))[4 + l];
    const int h = lane >> 4, c8 = (lane & 15) * 8; const float* ag = a.in[I_ANG] + l * 128 + c8;
    const f32x4 g0 = *(const f32x4*)ag * (1.f - li), g1 = *(const f32x4*)(ag + 4) * (1.f - li);
    for (int m = gw; m < M; m += NGW) {
        const float* oa = OATT + (size_t)m * NOATT + (2 * h) * 128 + c8;
        const f32x4 a0 = *(const f32x4*)oa, a1 = *(const f32x4*)(oa + 4), b0 = *(const f32x4*)(oa + 128), b1 = *(const f32x4*)(oa + 132);
        const f32x4 o0 = a0 - b0 * lam, o1 = a1 - b1 * lam;
        float ss = (o0.x * o0.x + o0.y * o0.y) + (o0.z * o0.z + o0.w * o0.w) + (o1.x * o1.x + o1.y * o1.y) + (o1.z * o1.z + o1.w * o1.w);
        ss += __shfl_xor(ss, 1); ss += __shfl_xor(ss, 2); ss += __shfl_xor(ss, 4); ss += __shfl_xor(ss, 8);
        const float r = 1.0f / sqrtf(ss * (1.f / 128.f) + EPS);
        const f32x4 y0 = o0 * r * g0, y1 = o1 * r * g1;
        *(u32x4*)(MIX + (size_t)m * DM + h * 128 + c8) = (u32x4){cvtpk(y0.x, y0.y), cvtpk(y0.z, y0.w), cvtpk(y1.x, y1.y), cvtpk(y1.z, y1.w)};
    }
}

__device__ __forceinline__ void convact_phase(const Args& a, int l, int gw, int NGW, int lane) {
    const bf16* GU = (const bf16*)(a.ws + WS_GU); bf16* ACT = (bf16*)(a.ws + WS_ACT);
    const float* cw = a.in[I_CONVW] + (size_t)l * 3 * DFF; const float* cb = a.in[I_CONVB] + (size_t)l * DFF;
    for (int m = gw; m < M; m += NGW) {
        int t, n; if (m < MP) { t = m % SEQ; n = SEQ; } else { t = (m - MP) % DSEQ; n = DSEQ; }
        const bool hp = t > 0, hn = t < n - 1;
        const bf16* g1 = GU + (size_t)m * (2 * DFF);
        for (int c = lane; c < DFF; c += 64) {
            const float gm = bf2f(g1[c]), gp = hp ? bf2f(g1[c - 2 * DFF]) : 0.f, gn = hn ? bf2f(g1[c + 2 * DFF]) : 0.f, uu = bf2f(g1[DFF + c]);
            const float gc = gp * cw[c] + gm * cw[DFF + c] + gn * cw[2 * DFF + c] + cb[c];
            ACT[(size_t)m * DFF + c] = (bf16)f2bf(siluf(gc) * uu);
        }
    }
}

__device__ __forceinline__ void ffn_fix_phase(const Args& a, int l, int gt, int NGT) {
    const float* side = (const float*)(a.ws + WS_SIDE); bf16* ACT = (bf16*)(a.ws + WS_ACT);
    const float* cw = a.in[I_CONVW] + (size_t)l * 3 * DFF;
    for (int i = gt; i < (MS / 256) * 2 * DFF; i += NGT) { const int j = i % DFF, w = (i / DFF) & 1, pm = 16 + i / (2 * DFF), q = (pm - 16) & 15;
        if (w == 0 ? q == 0 : q == 15) continue;
        const float* sp = side + ((size_t)(pm * 2 + w) * 3) * DFF + j;
        const float gnb = w == 0 ? side[((size_t)((pm - 1) * 2 + 1) * 3 + 2) * DFF + j] : side[((size_t)((pm + 1) * 2 + 0) * 3 + 2) * DFF + j];
        const float gc = sp[0] + cw[(w == 0 ? 0 : 2) * DFF + j] * gnb;
        ACT[(size_t)(pm * 256 + (w == 0 ? 0 : 255)) * DFF + j] = (bf16)f2bf(siluf(gc) * sp[DFF]); }
}

constexpr int PH_PER_LAYER = 11, PH_L0 = 3, PH_FIN = PH_L0 + DEPTH * PH_PER_LAYER, N_PHASES = PH_FIN + 1;
__global__ void __launch_bounds__(NTH, 2) mk_fwd(Args a) {
    extern __shared__ __attribute__((aligned(16))) unsigned char lds_raw[];
    LAS unsigned char* lds = (LAS unsigned char*)lds_raw;
    const int bid = blockIdx.x, G = gridDim.x, wave0 = __builtin_amdgcn_readfirstlane((int)threadIdx.x >> 6);
#define PH_BEGIN int tid = TID_NOW; asm volatile("" : "+v"(tid)); unsigned char* ws = a.ws; asm volatile("" : "+s"(ws)); \
    const int lane = tid & 63, wave = __builtin_amdgcn_readfirstlane(tid >> 6), gw = bid * NWV + wave, NGW = G * NWV, gt = bid * NTH + tid, NGT = G * NTH; (void)lane; (void)gw; (void)NGW; (void)gt; (void)NGT; (void)ws
    {
        volatile LAS unsigned* Z = (volatile LAS unsigned*)(lds + RING_BYTES);
        for (int u = threadIdx.x; u < (LDS_BYTES - RING_BYTES) / 4; u += NTH) Z[u] = 0u;
        __syncthreads();
    }
    if (a.use_bar) (void)xcd_barrier_post((unsigned*)(a.ws + WS_CTL) + 4096, (volatile LAS unsigned*)(lds + MISC_OFF) + 8);
#define bar (XcdBarrier{(unsigned*)(a.ws + WS_CTL) + 4096, xb_xcc_id(), (volatile LAS unsigned*)(lds + MISC_OFF) + 8})
    const int lo = a.ph_lo, hi = a.ph_hi;
#define IN(k) (lo <= (k) && (k) < hi)
#define TID_NOW (wave0 * 64 + (int)__builtin_amdgcn_mbcnt_hi(~0u, __builtin_amdgcn_mbcnt_lo(~0u, 0u)))
#define SEAM(k) do { if (IN(k) && IN((k) + 1)) xcd_barrier(bar, TID_NOW); } while (0)
#ifndef MK_DUP
#define MK_DUP 0
#endif
#define DUP(bit) _Pragma("unroll 1") for (int rep_ = 0; rep_ < (((MK_DUP) & (bit)) ? 2 : 1); ++rep_)

    if (IN(0)) DUP(512) { PH_BEGIN; pro0_phase(a, lds, tid, lane, wave, bid, G); SEAM(0); }
    if (IN(1)) { PH_BEGIN;
        modfin_phase(a, gt, NGT);
        pg8::Gemm g{(const bf16*)(ws + WS_CKVA), (const bf16*)(ws + WS_WKV), DEPTH * NDB * PAST, NKVP, 256, 256, 256, 4, (size_t)NKVP * 256}; pg8::StaticOrder S; S.init(DEPTH * NDB * PAST, NKVP, G, bid);
        pg8::EpiBf16<0> E{(bf16*)(ws + WS_KVCTX), NKVP, nullptr, 0, 0, 1.f};
        pg8::gemm_phase<pg8::EpiBf16<0>, pg8::StaticOrder, true, true>(lds, g, S, E, tid);
        SEAM(1);
    }
    if (IN(2)) DUP(8192) { PH_BEGIN; pro2_phase(a, lds, tid, bid, G, gt, NGT); SEAM(2); }
    for (int l = 0; l < DEPTH; ++l) {
        const int pb = PH_L0 + PH_PER_LAYER * l;
        if (pb + PH_PER_LAYER <= lo || pb >= hi) continue;
#define LAYER_PTRS const float* modl = (const float*)(ws + WS_MOD) + (size_t)l * 5 * 6 * DM; const float* xin0 = l == 0 ? a.in[I_XP] : (const float*)(ws + WS_X); \
        const float* xin1 = l == 0 ? a.in[I_XS] - (size_t)MP * DM : (const float*)(ws + WS_X); float* X = (float*)(ws + WS_X); (void)modl; (void)xin0; (void)xin1; (void)X
        if (IN(pb + 0) && l == 0) { PH_BEGIN; norm0_phase(a.in[I_XP], a.in[I_XS] - (size_t)MP * DM, (const float*)(ws + WS_GM), (bf16*)(ws + WS_H), (float*)(ws + WS_SSQP), gw, NGW, lane); SEAM(pb + 0); }
        if (IN(pb + 1)) DUP(2) { PH_BEGIN;
            pg8::Gemm g{(const bf16*)(ws + WS_H), (const bf16*)(ws + WS_WIN + l * SZ_WIN), M, NINP, DM, DM, DM, 1 << 20, 0}; pg8::StaticOrder S; S.init(M, NINP, G, bid);
            pg8::EpiBf16Norm E{(bf16*)(ws + WS_P), NINP, (const float*)(ws + WS_SSQP) + (size_t)(2 * l) * M * 32, (const float*)(ws + WS_SHWI) + (size_t)l * 5 * NINP, NINP, (LAS float*)(lds + RING_BYTES + 8192)};
            pg8::gemm_phase<pg8::EpiBf16Norm, pg8::StaticOrder, true, true>(lds, g, S, E, tid);
            SEAM(pb + 1);
        }
        if (IN(pb + 2)) DUP(4) { PH_BEGIN; post_phase(a, l, gw, NGW, lane);
#if 1
            __syncthreads();
            for (int u = bid; u < GLA_UNITS; u += G) { int t2 = tid; asm volatile("" : "+v"(t2)); gla_g1_unit(a, l, u, lds, t2); }
#endif
            SEAM(pb + 2); }
        if (IN(pb + 3)) DUP(8) {
            { PH_BEGIN; pg8::Gemm g{(const bf16*)(ws + WS_CQN), (const bf16*)(ws + WS_WQ + l * SZ_WQ), M, NQCP, 384, 384, 384, 1 << 20, 0}; pg8::StaticOrder S; S.init(M, NQCP, G, bid);
              pg8::EpiBf16<0> E{(bf16*)(ws + WS_QC), NQCP, nullptr, NQCP, 0, 0.10206207261596575f * 1.4426950408889634f};
              pg8::gemm_phase<pg8::EpiBf16<0>, pg8::StaticOrder, true, true>(lds, g, S, E, tid); }
            __syncthreads();
            { PH_BEGIN; pg8::Gemm g{(const bf16*)(ws + WS_CKVN), (const bf16*)(ws + WS_WKV + l * SZ_WKV), M, NKVP, 256, 256, 256, 1 << 20, 0}; pg8::StaticOrder S; S.init(M, NKVP, G, bid);
              pg8::EpiBf16<0> E{(bf16*)(ws + WS_KVC), NKVP, nullptr, 0, 0, 1.f};
              pg8::gemm_phase<pg8::EpiBf16<0>, pg8::StaticOrder, true, true>(lds, g, S, E, tid); }
#if MK_MFMA_GLA
            { PH_BEGIN; for (int it = bid; it < GLA_G2_ITEMS; it += G) gla_g2_item(a, l, it, tid); }
#endif
            SEAM(pb + 3);
        }
        if (IN(pb + 4)) DUP(16) { PH_BEGIN; mixer_phase(a, l, lds, tid, bid, G); if (IN(pb + 6)) xcd_barrier(bar, TID_NOW); }
        if (IN(pb + 6)) { PH_BEGIN; LAYER_PTRS;
            constexpr int NFULL = 512;
            { pg8::Gemm g{(const bf16*)(ws + WS_MIX), (const bf16*)(ws + WS_WOUT + l * SZ_WOUT), M, DM, DM, DM, DM, 1 << 20, 0}; pg8::StaticOrder S; S.init(M, DM, G, bid); S.lim = (MK_SPLITK && G == 256) ? NFULL : S.nwg;
              pg8::EpiResid E{MK_SPLITK ? X : xin0, MK_SPLITK ? X : xin1, X, modl + 2 * DM, (bf16*)(ws + WS_H), (const float*)(ws + WS_GM) + (size_t)(l * 2 + 1) * 5 * DM, (float*)(ws + WS_SSQP) + (size_t)(2 * l + 1) * M * 32};
              pg8::gemm_phase<pg8::EpiResid, pg8::StaticOrder, true, true>(lds, g, S, E, tid); }
            if (MK_SPLITK && G == 256) { __syncthreads(); int t3 = tid; asm volatile("" : "+v"(t3)); (void)t3;
              pg8::Gemm g{(const bf16*)(ws + WS_MIX), (const bf16*)(ws + WS_WOUT + l * SZ_WOUT), M, DM, DM / 2, DM, DM, 1 << 20, 0}; pg8::TailOrder S; S.init(M, DM, G, bid); S.base = NFULL; S.nth = DM / 128;
              pg8::EpiResidTail E{X, modl + 2 * DM, (float*)(ws + WS_SPLITK), (unsigned*)(ws + WS_CTL) + CW_TICKET + (l * 2 + 0) * 128 * 64, (LAS unsigned*)(lds + RING_BYTES + 2048)};
              pg8::gemm_phase<pg8::EpiResidTail, pg8::TailOrder, true, true>(lds, g, S, E, tid); }
            SEAM(pb + 6);
        }
        if (IN(pb + 8)) DUP(128) { PH_BEGIN;
            pg8::Gemm g{(const bf16*)(ws + WS_H), (const bf16*)(ws + WS_WUP + l * SZ_WUP), M, 2 * DFF, DM, DM, DM, 1 << 20, 0}; pg8::StaticOrder S; S.init(M, 2 * DFF, G, bid);
            pg8::EpiConvAct E{(bf16*)(ws + WS_ACT), a.in[I_CONVW] + (size_t)l * 3 * DFF, a.in[I_CONVB] + (size_t)l * DFF, (float*)(ws + WS_SIDE), (LAS float*)(lds + RING_BYTES + 4096),
                               (const float*)(ws + WS_SSQP) + (size_t)(2 * l + 1) * M * 32, (const float*)(ws + WS_SHWU) + (size_t)l * 5 * 2 * DFF, (LAS float*)(lds + RING_BYTES + 8192)};
            pg8::gemm_phase<pg8::EpiConvAct, pg8::StaticOrder, true, true>(lds, g, S, E, tid);
            SEAM(pb + 8);
        }
        if (IN(pb + 9)) DUP(256) { PH_BEGIN; ffn_fix_phase(a, l, gt, NGT); SEAM(pb + 9); }
        if (IN(pb + 10)) { PH_BEGIN; LAYER_PTRS;
            constexpr int NFULL = 512;
            { pg8::Gemm g{(const bf16*)(ws + WS_ACT), (const bf16*)(ws + WS_WDN + l * SZ_WDN), M, DM, DFF, DFF, DFF, 1 << 20, 0}; pg8::StaticOrder S; S.init(M, DM, G, bid); S.lim = (MK_SPLITK && G == 256) ? NFULL : S.nwg;
              pg8::EpiResid E{X, X, X, modl + 5 * DM, l + 1 < DEPTH ? (bf16*)(ws + WS_H) : nullptr, (const float*)(ws + WS_GM) + (size_t)((l + 1 < DEPTH ? l + 1 : l) * 2) * 5 * DM, (float*)(ws + WS_SSQP) + (size_t)(2 * (l + 1 < DEPTH ? l + 1 : l)) * M * 32};
              pg8::gemm_phase<pg8::EpiResid, pg8::StaticOrder, true, true>(lds, g, S, E, tid); }
            if (MK_SPLITK && G == 256) { __syncthreads(); int t3 = tid; asm volatile("" : "+v"(t3)); (void)t3;
              pg8::Gemm g{(const bf16*)(ws + WS_ACT), (const bf16*)(ws + WS_WDN + l * SZ_WDN), M, DM, DFF / 2, DFF, DFF, 1 << 20, 0}; pg8::TailOrder S; S.init(M, DM, G, bid); S.base = NFULL; S.nth = DFF / 128;
              pg8::EpiResidTail E{X, modl + 5 * DM, (float*)(ws + WS_SPLITK), (unsigned*)(ws + WS_CTL) + CW_TICKET + (l * 2 + 1) * 128 * 64, (LAS unsigned*)(lds + RING_BYTES + 2048)};
              pg8::gemm_phase<pg8::EpiResidTail, pg8::TailOrder, true, true>(lds, g, S, E, tid); }
            SEAM(pb + 10);
        }
    }
    if (IN(PH_FIN)) { PH_BEGIN; final_norm_phase((const float*)(ws + WS_X), a.in[I_FING], a.out, gw, NGW, lane); }
#undef IN
#undef SEAM
#undef bar
}

#ifndef MK_ONE_LAUNCH
#define MK_ONE_LAUNCH 1
#endif
extern "C" void kernel_launch(void* const* d_in, const int* in_sizes, int n_in, void* d_out, int out_size, void* d_ws, size_t ws_size, hipStream_t stream) {
    static int grid = 0;
    if (grid == 0) {
        if (n_in != N_INPUTS || (size_t)out_size != O_END || ws_size < WS_END) { fprintf(stderr, "kernel_launch: shape mismatch: n_in %d out %d ws %zu (need %zu)\n", n_in, out_size, ws_size, (size_t)WS_END); grid = -1; return; }
        int dev = 0, cus = 0, per_cu = 0;
        if (hipGetDevice(&dev) != hipSuccess || hipDeviceGetAttribute(&cus, hipDeviceAttributeMultiprocessorCount, dev) != hipSuccess) { grid = -1; return; }
        if (hipFuncSetAttribute((const void*)mk_fwd, hipFuncAttributeMaxDynamicSharedMemorySize, LDS_BYTES) != hipSuccess) { fprintf(stderr, "kernel_launch: hipFuncSetAttribute failed\n"); grid = -1; return; }
        if (hipOccupancyMaxActiveBlocksPerMultiprocessor(&per_cu, (const void*)mk_fwd, NTH, LDS_BYTES) != hipSuccess || per_cu < 1) fprintf(stderr, "kernel_launch: occupancy query reports %d\n", per_cu);
        (void)hipGetLastError();
        grid = cus;
    }
    if (grid < 0) return;
    if (hipMemsetAsync((char*)d_ws + WS_CTL, 0, CTL_ZERO_BYTES, stream) != hipSuccess) return;
    Args a{};
    for (int i = 0; i < N_INPUTS; ++i) a.in[i] = (const float*)d_in[i];
    a.out = (float*)d_out; a.ws = (unsigned char*)d_ws; a.pad = 0;
#if MK_ONE_LAUNCH
    a.ph_lo = 0; a.ph_hi = N_PHASES; a.use_bar = 1;
    hipLaunchKernelGGL(mk_fwd, dim3(grid), dim3(NTH), LDS_BYTES, stream, a);
#else
    for (int p = 0; p < N_PHASES; ++p) { a.ph_lo = p; a.ph_hi = p + 1; a.use_bar = 0; hipLaunchKernelGGL(mk_fwd, dim3(grid), dim3(NTH), LDS_BYTES, stream, a); }
#endif
    const hipError_t le = hipPeekAtLastError();
    if (le != hipSuccess) fprintf(stderr, "kernel_launch: launch failed: %s\n", hipGetErrorName(le));
}
```

```cpp
#include <hip/hip_runtime.h>
#include <cstdio>
#include <cstdint>
#include <cmath>

namespace pg8 {
#define PG8_LAS __attribute__((address_space(3)))
typedef unsigned short bf16_t;
typedef short bf16x8 __attribute__((ext_vector_type(8)));
typedef float f32x4 __attribute__((ext_vector_type(4)));
typedef unsigned u32x4 __attribute__((ext_vector_type(4)));
constexpr int BM = 256, BK = 64, HALF = 128, HTB = HALF * BK * 2  , STAGE_BYTES = 8 * HTB, NXCD = 8, WGM = 8;

__host__ __device__ __forceinline__ int lds_byte(int r, int c) { const int st = (r >> 4) * 2 + (c >> 5), rr = r & 15, cc = c & 31, ob = rr * 64 + cc * 2; return st * 1024 + (ob ^ (((ob >> 9) & 1) << 5)); }
__host__ __device__ __forceinline__ void stage_rc(int b, int& R, int& C) { const int st = b / 1024, sb = b % 1024, swz = sb ^ (((sb >> 9) & 1) << 5); R = (st >> 1) * 16 + swz / 64; C = (st & 1) * 32 + (swz % 64) / 2; }
__host__ __device__ __forceinline__ int perm32(int rho) { const int n = rho >> 4, i = rho & 15; return 8 * (i >> 2) + 4 * n + (i & 3); }

struct Unit { int pm, pn, kt0; };
struct Gemm { const bf16_t* A; const bf16_t* Bt; int M, N, K, lda, ldb, bgrp; size_t bgrp_stride; };

struct StaticOrder {
    int nM, nN, nwg, G, c;
    __host__ __device__ void init(int M, int N, int G_, int c_) { nM = M / BM; nN = N / BM; nwg = nM * nN; G = G_; c = c_; lim = nwg; }
    int lim;
    __host__ __device__ void map(int wgid, Unit& u) const {
        { const int q = nwg / NXCD, r = nwg % NXCD, xcd = wgid % NXCD, off = wgid / NXCD; wgid = (xcd < r ? xcd * (q + 1) : r * (q + 1) + (xcd - r) * q) + off; }
        const int nig = WGM * nN, gid = wgid / nig, fm = gid * WGM, gsz = (nM - fm) < WGM ? (nM - fm) : WGM;
        u.pm = fm + ((wgid % nig) % gsz); u.pn = (wgid % nig) / gsz; u.kt0 = 0;
    }
    __host__ __device__ bool next(int i, Unit& u) const {
        const long L = (long)i * G + c; if (L >= lim) return false;
        map((int)L, u); return true;
    }
    __device__ __forceinline__ void a_ready(const Unit&) const {}
    __device__ __forceinline__ void done(const Unit&) const {}
};

struct TailOrder : StaticOrder {
    int base, nth;
    __host__ __device__ bool next(int i, Unit& u) const { if (i > 0) return false; const int L = base + (c >> 1); if (L >= nwg) return false; map(L, u); u.kt0 = (c & 1) * nth; return true; }
};

__device__ __forceinline__ unsigned cvt_pk_bf16(float lo, float hi) { unsigned r; asm volatile("v_cvt_pk_bf16_f32 %0, %1, %2" : "=v"(r) : "v"(lo), "v"(hi)); return r; }
typedef float f32x2 __attribute__((ext_vector_type(2)));
__device__ __forceinline__ f32x2 gelu_pk(f32x2 v) {
    const f32x2 av = __builtin_elementwise_abs(v), d = av * 0.2316418882f + 1.0f;
    f32x2 t; t.x = __builtin_amdgcn_rcpf(d.x); t.y = __builtin_amdgcn_rcpf(d.y);
    f32x2 q = t * 0.5307027145f + (-0.7265760135f); q = q * t + 0.7107068705f; q = q * t + (-0.142248368f); q = q * t + 0.127414796f; q = q * t;
    const f32x2 s = (v * v) * (-0.72134752044f);
    f32x2 e; e.x = __builtin_amdgcn_exp2f(s.x); e.y = __builtin_amdgcn_exp2f(s.y);
    const f32x2 m = v * (q * e), r = v - m;
    f32x2 o; o.x = v.x < 0.f ? m.x : r.x; o.y = v.y < 0.f ? m.y : r.y; return o;
}

template <int ACT  > struct EpiBf16 {
    static constexpr bool PERM = true, AFTER_DRAIN = false; static_assert(ACT == 0 || ACT == 1, "EpiBf16: ACT is 0 (none) or 1 (gelu_pk)");
    bf16_t* O; int ldc; const float* bias; int split_cols; size_t split_stride; float scale0;
    __device__ __forceinline__ void operator()(const f32x4 (&acc)[2][2][4][2], const Unit& u, int wr, int wc, int fr, int fq) const {
        const int row0 = u.pm * BM + wr * 64 + fr; int colt = u.pn * BM; bf16_t* base = O;
        float sc = 1.f; if (split_cols) { const int t = colt / split_cols; base += (size_t)t * split_stride; colt -= t * split_cols; if (t == 0) sc = scale0; }
        const int col0 = colt + wc * 32 + 8 * fq, bcol0 = u.pn * BM + wc * 32 + 8 * fq;
        f32x4 bv[2][2];
#pragma unroll
        for (int bj = 0; bj < 2; ++bj)
#pragma unroll
            for (int n = 0; n < 2; ++n) bv[bj][n] = bias ? *(const f32x4*)(bias + bcol0 + bj * HALF + 4 * n) : (f32x4){0.f, 0.f, 0.f, 0.f};
#pragma unroll
        for (int ai = 0; ai < 2; ++ai)
#pragma unroll
            for (int m = 0; m < 4; ++m) { bf16_t* rowp = base + (size_t)(row0 + ai * HALF + m * 16) * ldc + col0;
#pragma unroll
                for (int bj = 0; bj < 2; ++bj) { f32x4 v0 = acc[ai][bj][m][0] + bv[bj][0], v1 = acc[ai][bj][m][1] + bv[bj][1];
                    if (ACT == 1) { f32x2 a = gelu_pk((f32x2){v0[0], v0[1]}), b = gelu_pk((f32x2){v0[2], v0[3]}), c = gelu_pk((f32x2){v1[0], v1[1]}), d = gelu_pk((f32x2){v1[2], v1[3]});
                        v0 = (f32x4){a.x, a.y, b.x, b.y}; v1 = (f32x4){c.x, c.y, d.x, d.y}; }
                    v0 = v0 * sc; v1 = v1 * sc; u32x4 w; w.x = cvt_pk_bf16(v0[0], v0[1]); w.y = cvt_pk_bf16(v0[2], v0[3]); w.z = cvt_pk_bf16(v1[0], v1[1]); w.w = cvt_pk_bf16(v1[2], v1[3]);
                    *(u32x4*)(rowp + bj * HALF) = w; } }
    }
};

template <class Epi, class Sched, bool ALIGN_EPI = false, bool SP2 = false>
__device__ __forceinline__ void gemm_phase(PG8_LAS unsigned char* lds, const Gemm g, const Sched& S, const Epi& E, int tid_in) {
    int tid_ = tid_in; asm volatile("" : "+v"(tid_));
    const int tid = tid_, wid = __builtin_amdgcn_readfirstlane(tid >> 6), lane = tid & 63, wr = wid >> 2, wc = wid & 3, fr = lane & 15, fq = lane >> 4;
    const int K = g.K, nt = K / BK;
    unsigned voffA[2], voffB[2];
#pragma unroll
    for (int i = 0; i < 2; ++i) { int R, C; stage_rc(tid * 16 + i * 8192, R, C); const int Rb = Epi::PERM ? ((R & ~31) + perm32(R & 31)) : R;
        voffA[i] = (unsigned)(R * g.lda + C) * 2u; voffB[i] = (unsigned)(Rb * g.ldb + C) * 2u; }
    const size_t kstep = (size_t)(BK * 2);
    const size_t hstepA = (size_t)HALF * g.lda * 2, hstepB = (size_t)HALF * g.ldb * 2;
    const size_t tstepA = 2 * hstepA, tstepB = 2 * hstepB;
    const unsigned ldsw = (unsigned)wid * 1024u;
    const int aoff = lds_byte(wr * 64 + fr, fq * 8), boff = lds_byte(wc * 32 + fr, fq * 8);
#define PG8_SA(b, h) (((b) * 2 + (h)) * HTB)
#define PG8_SB(b, h) ((4 + (b) * 2 + (h)) * HTB)
#define PG8_STAGE(bufoff, gbase, voff) do { _Pragma("unroll") for (int _i = 0; _i < 2; ++_i) \
        __builtin_amdgcn_global_load_lds((const unsigned*)((const char*)(gbase) + (voff)[_i]), (PG8_LAS unsigned*)(lds + (bufoff) + ldsw + _i * 8192), 16, 0, 0); } while (0)
#define PG8_LDA(dst, b, h) do { _Pragma("unroll") for (int m = 0; m < 4; ++m) _Pragma("unroll") for (int k = 0; k < 2; ++k) dst[m][k] = *(const PG8_LAS bf16x8*)(lds + PG8_SA(b, h) + aoff + m * 2048 + k * 1024); } while (0)
#define PG8_LDB(dst, b, h) do { _Pragma("unroll") for (int n = 0; n < 2; ++n) _Pragma("unroll") for (int k = 0; k < 2; ++k) dst[n][k] = *(const PG8_LAS bf16x8*)(lds + PG8_SB(b, h) + boff + n * 2048 + k * 1024); } while (0)
#define PG8_MMA(ai, bj, At, Bt) do { __builtin_amdgcn_s_setprio(1); _Pragma("unroll") for (int m = 0; m < 4; ++m) _Pragma("unroll") for (int n = 0; n < 2; ++n) _Pragma("unroll") for (int k = 0; k < 2; ++k) \
        acc[ai][bj][m][n] = __builtin_amdgcn_mfma_f32_16x16x32_bf16(Bt[n][k], At[m][k], acc[ai][bj][m][n], 0, 0, 0); __builtin_amdgcn_s_setprio(0); } while (0)
#define PG8_WAIT_V(n) asm volatile("s_waitcnt vmcnt(" #n ")" ::: "memory")
#define PG8_WAIT_L(n) asm volatile("s_waitcnt lgkmcnt(" #n ")" ::: "memory")
#define PG8_BAR __builtin_amdgcn_s_barrier()
#define PG8_SCHED __builtin_amdgcn_sched_barrier(0)
    Unit cur, nxt; int ui = 0;
    if (!S.next(0, cur)) return;
    f32x4 acc[2][2][4][2];
#pragma unroll
    for (int a = 0; a < 2; ++a)
#pragma unroll
        for (int b = 0; b < 2; ++b)
#pragma unroll
            for (int m = 0; m < 4; ++m)
#pragma unroll
                for (int n = 0; n < 2; ++n) acc[a][b][m][n] = (f32x4){0.f, 0.f, 0.f, 0.f};
    bf16x8 At[4][2], B0[2][2], B1[2][2];
    const char* cA = (const char*)g.A + (size_t)cur.pm * tstepA + (size_t)cur.kt0 * kstep; const char* cB = (const char*)g.Bt + (size_t)(cur.pm / g.bgrp) * g.bgrp_stride * 2 + (size_t)cur.pn * tstepB + (size_t)cur.kt0 * kstep;
    S.a_ready(cur);
    if constexpr (SP2) {
        PG8_STAGE(PG8_SB(0, 0), cB, voffB); PG8_STAGE(PG8_SB(0, 1), cB + hstepB, voffB); PG8_STAGE(PG8_SA(0, 0), cA, voffA); PG8_STAGE(PG8_SA(0, 1), cA + hstepA, voffA);
        if (wr == 1) PG8_BAR;
        PG8_WAIT_V(2); PG8_BAR;
        PG8_STAGE(PG8_SB(1, 0), cB + kstep, voffB); PG8_STAGE(PG8_SA(1, 0), cA + kstep, voffA); PG8_STAGE(PG8_SB(1, 1), cB + hstepB + kstep, voffB);
        PG8_WAIT_V(6); PG8_BAR;
    } else {
        PG8_STAGE(PG8_SB(0, 0), cB, voffB); PG8_STAGE(PG8_SA(0, 0), cA, voffA); PG8_STAGE(PG8_SB(0, 1), cB + hstepB, voffB); PG8_STAGE(PG8_SA(0, 1), cA + hstepA, voffA);
        if (wr == 1) PG8_BAR;
        PG8_WAIT_V(4); PG8_BAR;
        PG8_STAGE(PG8_SB(1, 0), cB + kstep, voffB); PG8_STAGE(PG8_SA(1, 0), cA + kstep, voffA); PG8_STAGE(PG8_SB(1, 1), cB + hstepB + kstep, voffB);
        PG8_WAIT_V(6); PG8_BAR;
    }
    for (;;) {
        const bool has_next = S.next(ui + 1, nxt);
        const char* nA = has_next ? (const char*)g.A + (size_t)nxt.pm * tstepA + (size_t)nxt.kt0 * kstep : cA; const char* nB = has_next ? (const char*)g.Bt + (size_t)(nxt.pm / g.bgrp) * g.bgrp_stride * 2 + (size_t)nxt.pn * tstepB + (size_t)nxt.kt0 * kstep : cB;
        for (int t = 0; t < nt; t += 2) {
            const bool last = (t == nt - 2);
            const char* a1 = cA + (size_t)(t + 1) * kstep;
            const char* a2 = last ? nA : cA + (size_t)(t + 2) * kstep; const char* b2 = last ? nB : cB + (size_t)(t + 2) * kstep;
            const char* a3 = a2 + kstep; const char* b3 = b2 + kstep;
            if (last && has_next) S.a_ready(nxt);
            if constexpr (SP2) {
            PG8_LDB(B0, 0, 0); PG8_LDB(B1, 0, 1); PG8_SCHED; PG8_LDA(At, 0, 0); PG8_STAGE(PG8_SA(1, 1), a1 + hstepA, voffA);
            PG8_WAIT_V(8); PG8_WAIT_L(0); PG8_BAR; PG8_MMA(0, 0, At, B0); PG8_MMA(0, 1, At, B1); PG8_BAR; PG8_SCHED;
            PG8_LDA(At, 0, 1); PG8_STAGE(PG8_SB(0, 0), b2, voffB); PG8_STAGE(PG8_SB(0, 1), b2 + hstepB, voffB); PG8_STAGE(PG8_SA(0, 0), a2, voffA);
            PG8_WAIT_V(8); PG8_WAIT_L(0); PG8_BAR; PG8_MMA(1, 0, At, B0); PG8_MMA(1, 1, At, B1); PG8_BAR; PG8_SCHED;
            PG8_LDB(B0, 1, 0); PG8_LDB(B1, 1, 1); PG8_SCHED; PG8_LDA(At, 1, 0); PG8_STAGE(PG8_SA(0, 1), a2 + hstepA, voffA);
            PG8_WAIT_V(8); PG8_WAIT_L(0); PG8_BAR; PG8_MMA(0, 0, At, B0); PG8_MMA(0, 1, At, B1); PG8_BAR; PG8_SCHED;
            PG8_LDA(At, 1, 1); PG8_STAGE(PG8_SB(1, 0), b3, voffB); PG8_STAGE(PG8_SB(1, 1), b3 + hstepB, voffB); PG8_STAGE(PG8_SA(1, 0), a3, voffA);
            PG8_WAIT_V(8); PG8_WAIT_L(0); PG8_BAR; PG8_MMA(1, 0, At, B0); PG8_MMA(1, 1, At, B1); PG8_BAR; PG8_SCHED;
            } else {
            PG8_LDB(B0, 0, 0); PG8_SCHED; PG8_LDA(At, 0, 0); PG8_STAGE(PG8_SA(1, 1), a1 + hstepA, voffA);
            PG8_WAIT_L(8); PG8_BAR; PG8_WAIT_L(0); PG8_MMA(0, 0, At, B0); PG8_BAR; PG8_SCHED;
            PG8_LDB(B1, 0, 1); PG8_STAGE(PG8_SB(0, 0), b2, voffB);
            PG8_BAR; PG8_WAIT_L(0); PG8_MMA(0, 1, At, B1); PG8_BAR;
            PG8_LDA(At, 0, 1); PG8_STAGE(PG8_SA(0, 0), a2, voffA);
            PG8_BAR; PG8_WAIT_L(0); PG8_MMA(1, 0, At, B0); PG8_BAR; PG8_SCHED;
            PG8_STAGE(PG8_SB(0, 1), b2 + hstepB, voffB);
            PG8_WAIT_V(6); PG8_BAR; PG8_MMA(1, 1, At, B1); PG8_BAR;
            PG8_LDB(B0, 1, 0); PG8_SCHED; PG8_LDA(At, 1, 0); PG8_STAGE(PG8_SA(0, 1), a2 + hstepA, voffA);
            PG8_WAIT_L(8); PG8_BAR; PG8_WAIT_L(0); PG8_MMA(0, 0, At, B0); PG8_BAR; PG8_SCHED;
            PG8_LDB(B1, 1, 1); PG8_STAGE(PG8_SB(1, 0), b3, voffB);
            PG8_BAR; PG8_WAIT_L(0); PG8_MMA(0, 1, At, B1); PG8_BAR;
            PG8_LDA(At, 1, 1); PG8_STAGE(PG8_SA(1, 0), a3, voffA);
            PG8_BAR; PG8_WAIT_L(0); PG8_MMA(1, 0, At, B0); PG8_BAR; PG8_SCHED;
            PG8_STAGE(PG8_SB(1, 1), b3 + hstepB, voffB);
            PG8_WAIT_V(6); PG8_BAR; PG8_MMA(1, 1, At, B1); PG8_BAR;
            }
        }
        if constexpr (ALIGN_EPI) { if (wr == 0) PG8_BAR; }
        if constexpr (!Epi::AFTER_DRAIN) { E(acc, cur, wr, wc, fr, fq); S.done(cur); }
        if (!has_next) break;
#pragma unroll
        for (int a = 0; a < 2; ++a)
#pragma unroll
            for (int b = 0; b < 2; ++b)
#pragma unroll
                for (int m = 0; m < 4; ++m)
#pragma unroll
                    for (int n = 0; n < 2; ++n) acc[a][b][m][n] = (f32x4){0.f, 0.f, 0.f, 0.f};
        cur = nxt; cA = nA; cB = nB; ++ui;
        if constexpr (ALIGN_EPI) { if (wr == 1) PG8_BAR; }
    }
    PG8_WAIT_V(0);
    if constexpr (!ALIGN_EPI) { if (wr == 0) PG8_BAR; }
    PG8_BAR;
    if constexpr (Epi::AFTER_DRAIN) { E.fused(acc, cur, wr, wc, fr, fq, lds, wid, lane); S.done(cur); }
#undef PG8_SA
#undef PG8_SB
#undef PG8_STAGE
#undef PG8_LDA
#undef PG8_LDB
#undef PG8_MMA
#undef PG8_WAIT_V
#undef PG8_WAIT_L
#undef PG8_BAR
#undef PG8_SCHED
}
}

constexpr int DM = 2048, NPB = 16, SEQ = 256, DEPTH = 4, NDB = 4, DSEQ = 4096, PAST = 256;
constexpr int MP = NPB * SEQ, MS = NDB * DSEQ, M = MP + MS;
constexpr int NIN = 4544, NINP = 4608;
constexpr int C_AQ = 0, C_AK = 512, C_AV = 1024, C_BQ = 1536, C_BK = 1920, C_BV = 2304, C_BR = 3072, C_BG = 3840, C_CQ = 3872, C_CKV = 4256, C_CKR = 4512;
constexpr int DFF = 5632, NQC = 576, NQCP = 768, NKV = 1152, NKVP = 1280;
constexpr float EPS = 1e-6f;
constexpr int NOATT = 14 * 128, NOGLA = 2 * 768;
enum { I_XP = 0, I_XS, I_CAK, I_CAV, I_STB, I_CCKV, I_CCKR, I_C, I_CCTX, I_N1G, I_ADAW, I_ADAB, I_WIN, I_LQ1, I_LK1, I_LQ2, I_LK2, I_ANG, I_BGW, I_BGB, I_BNG, I_CQG, I_CQUP, I_CKVG, I_CKVUP, I_WOUT, I_N2G, I_WUP, I_CONVW, I_CONVB, I_WDOWN, I_FING, N_INPUTS };
constexpr size_t O_YP = 0, O_YS = O_YP + (size_t)MP * DM, O_AK = O_YS + (size_t)MS * DM, O_AV = O_AK + (size_t)NPB * DEPTH * SEQ * 512, O_SB = O_AV + (size_t)NPB * DEPTH * SEQ * 512,
                 O_CKV = O_SB + (size_t)NPB * DEPTH * 2 * 6 * 64 * 128, O_CKR = O_CKV + (size_t)NPB * DEPTH * SEQ * 256, O_END = O_CKR + (size_t)NPB * DEPTH * SEQ * 32;
static_assert(O_END == 69730304, "output size");

constexpr size_t al256(size_t x) { return (x + 255) & ~(size_t)255; }
constexpr size_t WS_CTL = 0, CTL_ZERO_BYTES = 2u << 20;
constexpr size_t WS_SSQ = 1u << 20;
constexpr size_t SZ_WIN = (size_t)NINP * DM * 2, SZ_WOUT = (size_t)DM * DM * 2, SZ_WUP = (size_t)2 * DFF * DM * 2, SZ_WDN = (size_t)DM * DFF * 2, SZ_WQ = (size_t)NQCP * 384 * 2, SZ_WKV = (size_t)NKVP * 256 * 2;
constexpr size_t WS_WIN = WS_CTL + CTL_ZERO_BYTES, WS_WOUT = WS_WIN + 4 * SZ_WIN, WS_WUP = WS_WOUT + 4 * SZ_WOUT, WS_WDN = WS_WUP + 4 * SZ_WUP, WS_WQ = WS_WDN + 4 * SZ_WDN, WS_WKV = WS_WQ + 4 * SZ_WQ;
constexpr size_t SZ_MOD = (size_t)DEPTH * 5 * 6 * DM * 4;
constexpr size_t WS_MOD = WS_WKV + 4 * SZ_WKV, WS_MODP = WS_MOD + SZ_MOD, WS_RTA = WS_MODP + 8 * SZ_MOD, WS_RTC = WS_RTA + (size_t)DSEQ * 64 * 4, WS_LAM = WS_RTC + (size_t)DSEQ * 32 * 4;
constexpr size_t WS_CAK = WS_LAM + 256, WS_CAV = WS_CAK + (size_t)NDB * DEPTH * PAST * 512 * 2, WS_CKRX = WS_CAV + (size_t)NDB * DEPTH * PAST * 512 * 2, WS_CKVA = WS_CKRX + (size_t)NDB * DEPTH * PAST * 32 * 2,
                 WS_KVCTX = WS_CKVA + (size_t)DEPTH * NDB * PAST * 256 * 2, WS_SIDE = WS_KVCTX + (size_t)DEPTH * NDB * PAST * NKVP * 2, WS_GM = WS_SIDE + (size_t)(M / 256) * 2 * 3 * DFF * 4, WS_SHWI = WS_GM + (size_t)DEPTH * 2 * 5 * DM * 4,
                 WS_SHWU = WS_SHWI + (size_t)DEPTH * 5 * NINP * 4, WS_SSQP = WS_SHWU + (size_t)DEPTH * 5 * 2 * DFF * 4, WS_X = WS_SSQP + (size_t)8 * M * 32 * 4;
constexpr size_t WS_H = WS_X + (size_t)M * DM * 4, WS_T0 = WS_H + (size_t)M * DM * 2;
constexpr size_t WS_P = WS_T0, WS_MIX = WS_P + (size_t)M * NINP * 2, WS_QC = WS_MIX + (size_t)M * DM * 2, WS_KVC = WS_QC + (size_t)M * NQCP * 2, WS_CQN = WS_KVC + (size_t)M * NKVP * 2, WS_CKVN = WS_CQN + (size_t)M * 384 * 2,
                 WS_KRA = WS_CKVN + (size_t)M * 256 * 2, WS_KRC = WS_KRA + (size_t)MS * 512 * 2, WS_OATT = WS_KRC + (size_t)MS * 32 * 2, WS_OGLA = WS_OATT + (size_t)M * NOATT * 4, WS_GATE = WS_OGLA + (size_t)M * NOGLA * 4,
                 WS_ST = WS_GATE + (size_t)M * 768 * 4, WS_DD = WS_ST + (size_t)(M / 64) * 12 * 8192 * 2, WS_END1 = WS_DD + (size_t)(M / 64) * 12 * 64 * 4;
constexpr size_t WS_U = WS_OGLA, WS_QK4 = WS_GATE;
constexpr size_t WS_GU = WS_T0, WS_ACT = WS_GU + (size_t)M * 2 * DFF * 2, WS_END2 = WS_ACT + (size_t)M * DFF * 2;


static_assert(WS_WIN % 256 == 0 && WS_X % 256 == 0 && WS_H % 256 == 0 && WS_T0 % 256 == 0 && WS_QC % 256 == 0 && WS_KVC % 256 == 0 && WS_CQN % 256 == 0 && WS_CKVN % 256 == 0 && WS_OATT % 256 == 0 && WS_ACT % 256 == 0, "alignment");

constexpr size_t WS_SPLITK = WS_END1 > WS_END2 ? WS_END1 : WS_END2, WS_END3 = WS_SPLITK + (size_t)128 * 2 * 65536 * 4;
constexpr size_t WS_END = WS_END3;
static_assert(WS_END <= (size_t)1536 << 20, "workspace map must fit 4 x the largest tensor");
constexpr int CW_TICKET = 65536;

constexpr int RING_BYTES = 131072, MISC_OFF = RING_BYTES + 320, LDS_BYTES = 147456;

#define GAS __attribute__((address_space(1)))
#define LAS __attribute__((address_space(3)))
typedef unsigned short bf16;
typedef unsigned v4u __attribute__((ext_vector_type(4)));
typedef unsigned v2u __attribute__((ext_vector_type(2)));
typedef float f32x4 __attribute__((ext_vector_type(4)));
#define LDS_WAIT() asm volatile("s_waitcnt lgkmcnt(0)" ::: "memory")
__device__ __forceinline__ unsigned f2bf(float f) { unsigned u = __builtin_bit_cast(unsigned, f); return (u + 0x7fffu + ((u >> 16) & 1u)) >> 16; }
__device__ __forceinline__ unsigned pk2(float lo, float hi) { return f2bf(lo) | (f2bf(hi) << 16); }
__device__ __forceinline__ float bf2f(bf16 b) { return __builtin_bit_cast(float, (unsigned)b << 16); }
__device__ __forceinline__ float wave_sum(float v) {
#pragma unroll
    for (int o = 1; o < 64; o <<= 1) v += __shfl_xor(v, o);
    return v;
}
__device__ __forceinline__ float siluf(float x) { return x / (1.f + __expf(-x)); }

namespace pg8 {
__device__ __forceinline__ void rstd_table(const float* ssq, int pm, PG8_LAS float* rtab, int tid) {
    const int row = tid >> 1, half = tid & 1; const float* p = ssq + ((size_t)(pm * BM + row) * 32 + half * 16);
    const f32x4 a = *(const f32x4*)p, b = *(const f32x4*)(p + 4), c = *(const f32x4*)(p + 8), d = *(const f32x4*)(p + 12);
    float s = (((a[0] + a[1]) + (a[2] + a[3])) + ((b[0] + b[1]) + (b[2] + b[3]))) + (((c[0] + c[1]) + (c[2] + c[3])) + ((d[0] + d[1]) + (d[2] + d[3])));
    s += __shfl_xor(s, 1);
    if (half == 0) rtab[row] = 1.0f / sqrtf(s * (1.f / 2048.f) + 1e-6f);
    asm volatile("s_waitcnt lgkmcnt(0)" ::: "memory"); __builtin_amdgcn_s_barrier(); asm volatile("" ::: "memory");
}
struct EpiResid {
    static constexpr bool PERM = true, AFTER_DRAIN = false;
    const float* xin0; const float* xin1;
    float* out; const float* gate;
    bf16_t* H; const float* gm; float* ssq;
    __device__ __forceinline__ void operator()(const f32x4 (&acc)[2][2][4][2], const Unit& u, int wr, int wc, int fr, int fq) const {
        const int mi = u.pm < 16 ? 0 : 1 + ((u.pm - 16) >> 4);
        const float* gp = gate + (size_t)mi * 6 * 2048; const float* xin = u.pm < 16 ? xin0 : xin1;
        const int col0 = u.pn * BM + wc * 32 + 8 * fq;
        f32x4 gv[2][2], gm4[2][2];
#pragma unroll
        for (int bj = 0; bj < 2; ++bj)
#pragma unroll
            for (int n = 0; n < 2; ++n) { gv[bj][n] = *(const f32x4*)(gp + col0 + bj * HALF + 4 * n); gm4[bj][n] = H ? *(const f32x4*)(gm + (size_t)mi * 2048 + col0 + bj * HALF + 4 * n) : (f32x4){0.f, 0.f, 0.f, 0.f}; }
#pragma unroll
        for (int ai = 0; ai < 2; ++ai)
#pragma unroll
            for (int m = 0; m < 4; ++m) { const int row = u.pm * BM + ai * HALF + wr * 64 + m * 16 + fr; const size_t off = (size_t)row * 2048 + col0; float ss = 0.f;
#pragma unroll
                for (int bj = 0; bj < 2; ++bj) { const f32x4 x0 = *(const f32x4*)(xin + off + bj * HALF), x1 = *(const f32x4*)(xin + off + bj * HALF + 4);
                    const f32x4 y0 = x0 + gv[bj][0] * acc[ai][bj][m][0], y1 = x1 + gv[bj][1] * acc[ai][bj][m][1];
                    *(f32x4*)(out + off + bj * HALF) = y0; *(f32x4*)(out + off + bj * HALF + 4) = y1;
                    ss += ((y0[0] * y0[0] + y0[1] * y0[1]) + (y0[2] * y0[2] + y0[3] * y0[3])) + ((y1[0] * y1[0] + y1[1] * y1[1]) + (y1[2] * y1[2] + y1[3] * y1[3]));
                    if (H) { const f32x4 h0 = y0 * gm4[bj][0], h1 = y1 * gm4[bj][1]; u32x4 w; w.x = cvt_pk_bf16(h0[0], h0[1]); w.y = cvt_pk_bf16(h0[2], h0[3]); w.z = cvt_pk_bf16(h1[0], h1[1]); w.w = cvt_pk_bf16(h1[2], h1[3]);
                        *(u32x4*)(H + off + bj * HALF) = w; } }
                if (H) { ss += __shfl_xor(ss, 16); ss += __shfl_xor(ss, 32); if (fq == 0) ssq[(size_t)row * 32 + u.pn * 4 + wc] = ss; } }
    }
};
struct EpiBf16Norm {
    static constexpr bool PERM = true, AFTER_DRAIN = false;
    bf16_t* O; int ldc; const float* ssq; const float* shw; int shw_ld; PG8_LAS float* rtab;
    static constexpr int qtiles = 2; static constexpr float qscale = 0.125f * 1.4426950408889634f;
    __device__ __forceinline__ void operator()(const f32x4 (&acc)[2][2][4][2], const Unit& u, int wr, int wc, int fr, int fq) const {
        const int mi = u.pm < 16 ? 0 : 1 + ((u.pm - 16) >> 4);
        rstd_table(ssq, u.pm, rtab, (wr * 4 + wc) * 64 + fq * 16 + fr);
        const int row0 = u.pm * BM + wr * 64 + fr, col0 = u.pn * BM + wc * 32 + 8 * fq; const float* sp = shw + (size_t)mi * shw_ld + col0;
        const float qs = u.pn < qtiles ? qscale : 1.f;
        f32x4 sv[2][2];
#pragma unroll
        for (int bj = 0; bj < 2; ++bj)
#pragma unroll
            for (int n = 0; n < 2; ++n) sv[bj][n] = *(const f32x4*)(sp + bj * HALF + 4 * n);
#pragma unroll
        for (int ai = 0; ai < 2; ++ai)
#pragma unroll
            for (int m = 0; m < 4; ++m) { const int row = row0 + ai * HALF + m * 16; const float rs = rtab[row - u.pm * BM];
                bf16_t* rowp = O + (size_t)row * ldc + col0;
#pragma unroll
                for (int bj = 0; bj < 2; ++bj) { const f32x4 v0 = (acc[ai][bj][m][0] * rs + sv[bj][0]) * qs, v1 = (acc[ai][bj][m][1] * rs + sv[bj][1]) * qs;
                    u32x4 w; w.x = cvt_pk_bf16(v0[0], v0[1]); w.y = cvt_pk_bf16(v0[2], v0[3]); w.z = cvt_pk_bf16(v1[0], v1[1]); w.w = cvt_pk_bf16(v1[2], v1[3]);
                    *(u32x4*)(rowp + bj * HALF) = w; } }
    }
};

struct EpiResidTail {
    static constexpr bool PERM = false, AFTER_DRAIN = false;
    float* X; const float* gate; float* scratch; unsigned* ticket; PG8_LAS unsigned* lw;
    __device__ __forceinline__ void operator()(const f32x4 (&acc)[2][2][4][2], const Unit& u, int wr, int wc, int fr, int fq) const {
        const int t = blockIdx.x >> 1, half = blockIdx.x & 1, tid = threadIdx.x;
        { const __amdgpu_buffer_rsrc_t rs = __builtin_amdgcn_make_buffer_rsrc(scratch + ((size_t)t * 2 + half) * 65536, 0, 65536 * 4, 0x00020000);
#pragma unroll
          for (int ai = 0; ai < 2; ++ai)
#pragma unroll
            for (int bj = 0; bj < 2; ++bj)
#pragma unroll
                for (int m = 0; m < 4; ++m)
#pragma unroll
                    for (int n = 0; n < 2; ++n) { const int j = ((ai * 2 + bj) * 4 + m) * 2 + n; __builtin_amdgcn_raw_buffer_store_b128(__builtin_bit_cast(u32x4, acc[ai][bj][m][n]), rs, (j * 512 + tid) * 16, 0, 16); } }
        asm volatile("s_waitcnt vmcnt(0)" ::: "memory"); __builtin_amdgcn_s_barrier(); asm volatile("" ::: "memory");
        if (tid == 0) { const unsigned old = __hip_atomic_fetch_add(ticket + 64 * t, 1u, __ATOMIC_RELAXED, __HIP_MEMORY_SCOPE_AGENT); *lw = old; }
        asm volatile("s_waitcnt vmcnt(0) lgkmcnt(0)" ::: "memory"); __builtin_amdgcn_s_barrier(); asm volatile("" ::: "memory");
        const unsigned old = *lw;
        if (old == 0u) return;
        __builtin_amdgcn_fence(__ATOMIC_ACQUIRE, "agent"); asm volatile("s_waitcnt vmcnt(0)" ::: "memory");
        const float* oth = scratch + ((size_t)t * 2 + (half ^ 1)) * 65536; const float* own = scratch + ((size_t)t * 2 + half) * 65536;
        const int mi = u.pm < 16 ? 0 : 1 + ((u.pm - 16) >> 4);
        const float* gp = gate + (size_t)mi * 6 * 2048;
        const int col0 = u.pn * BM + wc * 32 + 4 * fq;
#pragma unroll
        for (int ai = 0; ai < 2; ++ai)
#pragma unroll
            for (int m = 0; m < 4; ++m) { const size_t off = (size_t)(u.pm * BM + ai * HALF + wr * 64 + m * 16 + fr) * 2048 + col0;
#pragma unroll
                for (int bj = 0; bj < 2; ++bj)
#pragma unroll
                    for (int n = 0; n < 2; ++n) { const int j = ((ai * 2 + bj) * 4 + m) * 2 + n; const f32x4 pv = *(const f32x4*)(oth + (size_t)(j * 512 + tid) * 4) + *(const f32x4*)(own + (size_t)(j * 512 + tid) * 4);
                        const f32x4 gv = *(const f32x4*)(gp + col0 + bj * HALF + n * 16), xv = *(const f32x4*)(X + off + bj * HALF + n * 16);
                        *(f32x4*)(X + off + bj * HALF + n * 16) = xv + gv * pv; }
                asm volatile("" ::: "memory"); }
    }
};

__device__ __forceinline__ float dpp_ror1(float x) { return __builtin_bit_cast(float, __builtin_amdgcn_update_dpp(__builtin_bit_cast(int, x), __builtin_bit_cast(int, x), 0x121, 0xf, 0xf, false)); }
__device__ __forceinline__ float dpp_rol1(float x) { return __builtin_bit_cast(float, __builtin_amdgcn_update_dpp(__builtin_bit_cast(int, x), __builtin_bit_cast(int, x), 0x12F, 0xf, 0xf, false)); }
struct EpiConvAct {
    static constexpr bool PERM = true, AFTER_DRAIN = false;
    bf16_t* ACT; const float* cw; const float* cb; float* side; PG8_LAS float* ex;
    const float* ssq; const float* shw; PG8_LAS float* rtab;
    __device__ __forceinline__ void operator()(const f32x4 (&acc_)[2][2][4][2], const Unit& u, int wr, int wc, int fr, int fq) const {
        constexpr int FF = 5632;
        const int colw = wc * 32 + 8 * fq, j0 = u.pn * HALF + colw;
        f32x4 (&acc)[2][2][4][2] = const_cast<f32x4 (&)[2][2][4][2]>(acc_);
#pragma unroll
        for (int ai = 0; ai < 2; ++ai) { const int blk = 2 * ai + wr;
            if (fr == 0) {
#pragma unroll
                for (int n = 0; n < 2; ++n) *(PG8_LAS f32x4*)(ex + (blk * 2 + 0) * HALF + colw + 4 * n) = acc[ai][0][0][n]; }
            if (fr == 15) {
#pragma unroll
                for (int n = 0; n < 2; ++n) *(PG8_LAS f32x4*)(ex + (blk * 2 + 1) * HALF + colw + 4 * n) = acc[ai][0][3][n]; } }
        rstd_table(ssq, u.pm, rtab, (wr * 4 + wc) * 64 + fq * 16 + fr);
        f32x4 sv[2][2];
        { const int mi = u.pm < 16 ? 0 : 1 + ((u.pm - 16) >> 4); const float* sp = shw + (size_t)mi * (2 * FF) + u.pn * BM + colw;
#pragma unroll
          for (int bj = 0; bj < 2; ++bj)
#pragma unroll
              for (int n = 0; n < 2; ++n) sv[bj][n] = *(const f32x4*)(sp + bj * HALF + 4 * n);
#pragma unroll
          for (int ai = 0; ai < 2; ++ai)
#pragma unroll
              for (int m = 0; m < 4; ++m) { const int row = u.pm * BM + ai * HALF + wr * 64 + m * 16 + fr; const float rs = rtab[row - u.pm * BM];
#pragma unroll
                  for (int bj = 0; bj < 2; ++bj)
#pragma unroll
                      for (int n = 0; n < 2; ++n) acc[ai][bj][m][n] = acc[ai][bj][m][n] * rs + sv[bj][n]; } }
        float w0[8], w1[8], w2[8], bb[8];
#pragma unroll
        for (int q = 0; q < 2; ++q) { const f32x4 a0 = *(const f32x4*)(cw + j0 + 4 * q), a1 = *(const f32x4*)(cw + FF + j0 + 4 * q), a2 = *(const f32x4*)(cw + 2 * FF + j0 + 4 * q), a3 = *(const f32x4*)(cb + j0 + 4 * q);
#pragma unroll
            for (int i = 0; i < 4; ++i) { w0[4 * q + i] = a0[i]; w1[4 * q + i] = a1[i]; w2[4 * q + i] = a2[i]; bb[4 * q + i] = a3[i]; } }
#pragma unroll
        for (int ai = 0; ai < 2; ++ai) { const int blk = 2 * ai + wr;
#pragma unroll
            for (int m = 0; m < 4; ++m) { float ov[8]; float gcv[8]; float pe[8], ne[8];
                if (m == 0) {
#pragma unroll
                    for (int n = 0; n < 2; ++n) { const f32x4 p4 = blk > 0 ? *(const PG8_LAS f32x4*)(ex + ((blk - 1) * 2 + 1) * HALF + colw + 4 * n) * rtab[blk > 0 ? blk * 64 - 1 : 0] + sv[0][n] : (f32x4){0.f, 0.f, 0.f, 0.f};
#pragma unroll
                        for (int i = 0; i < 4; ++i) pe[4 * n + i] = p4[i]; } }
                if (m == 3) {
#pragma unroll
                    for (int n = 0; n < 2; ++n) { const f32x4 n4 = blk < 3 ? *(const PG8_LAS f32x4*)(ex + ((blk + 1) * 2 + 0) * HALF + colw + 4 * n) * rtab[blk < 3 ? (blk + 1) * 64 : 0] + sv[0][n] : (f32x4){0.f, 0.f, 0.f, 0.f};
#pragma unroll
                        for (int i = 0; i < 4; ++i) ne[4 * n + i] = n4[i]; } }
#pragma unroll
                for (int kp = 0; kp < 4; ++kp) { const int k = 2 * kp, n = k >> 2, i = k & 3;
                    typedef float f32x2 __attribute__((ext_vector_type(2)));
                    f32x2 G, GP, GN;
#pragma unroll
                    for (int e = 0; e < 2; ++e) { const float g = acc[ai][0][m][n][i + e];
                        const float sp_ = fr == 15 ? (m > 0 ? acc[ai][0][m > 0 ? m - 1 : 0][n][i + e] : pe[k + e]) : g;
                        const float sn_ = fr == 0 ? (m < 3 ? acc[ai][0][m < 3 ? m + 1 : 3][n][i + e] : ne[k + e]) : g;
                        G[e] = g; GP[e] = dpp_ror1(sp_); GN[e] = dpp_rol1(sn_); }
                    const f32x2 W0 = {w0[k], w0[k + 1]}, W1 = {w1[k], w1[k + 1]}, W2 = {w2[k], w2[k + 1]}, BB = {bb[k], bb[k + 1]}, UU = {acc[ai][1][m][n][i], acc[ai][1][m][n][i + 1]};
                    const f32x2 GC = __builtin_elementwise_fma(W0, GP, __builtin_elementwise_fma(W1, G, __builtin_elementwise_fma(W2, GN, BB)));
                    const f32x2 T = GC * (f32x2){-1.4426950408889634f, -1.4426950408889634f};
                    f32x2 D = {__builtin_amdgcn_exp2f(T.x), __builtin_amdgcn_exp2f(T.y)}; D += (f32x2){1.f, 1.f};
                    const f32x2 R = {__builtin_amdgcn_rcpf(D.x), __builtin_amdgcn_rcpf(D.y)};
                    const f32x2 O = GC * R * UU;
                    gcv[k] = GC.x; gcv[k + 1] = GC.y; ov[k] = O.x; ov[k + 1] = O.y; }
                const int row = u.pm * BM + ai * HALF + wr * 64 + m * 16 + fr;
                u32x4 w; w.x = cvt_pk_bf16(ov[0], ov[1]); w.y = cvt_pk_bf16(ov[2], ov[3]); w.z = cvt_pk_bf16(ov[4], ov[5]); w.w = cvt_pk_bf16(ov[6], ov[7]);
                *(u32x4*)(ACT + (size_t)row * FF + j0) = w;
                const bool first = (ai == 0 && m == 0) && wr == 0 && fr == 0, last = (ai == 1 && m == 3) && wr == 1 && fr == 15;
                if ((ai == 0 && m == 0) || (ai == 1 && m == 3)) { if (first || last) { float* sp = side + ((size_t)(u.pm * 2 + (last ? 1 : 0)) * 3) * FF + j0;
#pragma unroll
                    for (int n = 0; n < 2; ++n) { *(f32x4*)(sp + 4 * n) = (f32x4){gcv[4 * n], gcv[4 * n + 1], gcv[4 * n + 2], gcv[4 * n + 3]}; *(f32x4*)(sp + FF + 4 * n) = acc[ai][1][m][n]; *(f32x4*)(sp + 2 * FF + 4 * n) = acc[ai][0][m][n]; } } }
            } }
    }
};
}

#define XB_TMO      128
#define XB_XCNT(j)  (256  + 64 * (j))
#define XB_XSUB(j)  (1280 + 64 * (j))
#define XB_XGEN(j)  (2304 + 64 * (j))
#define XB_TOP      3328
#define XB_TOPGEN   3392
#define XCD_BAR_WORDS 3456
#define XB_SPIN_CAP (1u << 18)
__device__ __forceinline__ unsigned xb_ld(unsigned* p)              { return __hip_atomic_load(p, __ATOMIC_RELAXED, __HIP_MEMORY_SCOPE_AGENT); }
__device__ __forceinline__ unsigned xb_add(unsigned* p, unsigned v) { return __hip_atomic_fetch_add(p, v, __ATOMIC_RELAXED, __HIP_MEMORY_SCOPE_AGENT); }
__device__ __forceinline__ unsigned xb_xcc_id() { return (unsigned)__builtin_amdgcn_s_getreg((3 << 11) | 20) & 0xFu; }
#define XB_SPIN(cond, bar) do { unsigned _sp = 0; while (cond) { __builtin_amdgcn_s_sleep(1); \
    if ((++_sp & 255u) == 0u) { if (xb_ld(&(bar)[XB_TMO])) break; if (_sp > XB_SPIN_CAP) { atomicAdd(&(bar)[XB_TMO], 1u); break; } } } } while (0)
struct XcdBarrier { unsigned* bar; unsigned x; volatile LAS unsigned* st; };
__device__ __forceinline__ XcdBarrier xcd_barrier_post(unsigned* bar, volatile LAS unsigned* st) {
    XcdBarrier b; b.bar = bar; b.x = xb_xcc_id(); b.st = st;
    if (threadIdx.x == 0) (void)xb_add(&bar[XB_XCNT(b.x)], 1u);
    return b;
}
__device__ __forceinline__ void xcd_barrier_complete(unsigned* bar, unsigned x, unsigned& nloc, unsigned& nx) {
    const unsigned G = gridDim.x * gridDim.y * gridDim.z;
    unsigned sum, cnt, mine, sp = 0u;
    for (;;) {
        sum = 0u; cnt = 0u; mine = 0u;
#pragma unroll
        for (unsigned j = 0; j < 16; ++j) { const unsigned c = xb_ld(&bar[XB_XCNT(j)]); sum += c; cnt += (c > 0u) ? 1u : 0u; mine = (j == x) ? c : mine; }
        if (sum == G) break;
        __builtin_amdgcn_s_sleep(1);
        if ((++sp & 255u) == 0u) { if (xb_ld(&bar[XB_TMO])) break; if (sp > XB_SPIN_CAP) { atomicAdd(&bar[XB_TMO], 1u); break; } }
    }
    nloc = mine > 0u ? mine : 1u; nx = cnt > 0u ? cnt : 1u;
}
__device__ __forceinline__ void xcd_barrier(const XcdBarrier& b, int tid) {
    asm volatile("s_waitcnt vmcnt(0)" ::: "memory");
    __syncthreads();
    if (tid == 0) {
        unsigned* bar = b.bar;
        __builtin_amdgcn_s_waitcnt(0);
        unsigned nloc = b.st[0], nx = b.st[1];
        if (nloc == 0u) { xcd_barrier_complete(bar, b.x, nloc, nx); b.st[0] = nloc; b.st[1] = nx; }
        const unsigned old = xb_add(&bar[XB_XSUB(b.x)], 1u);
        const unsigned gen = old / nloc;
        if (old + 1u == (gen + 1u) * nloc) {
            __builtin_amdgcn_fence(__ATOMIC_RELEASE, "agent");
            asm volatile("s_waitcnt vmcnt(0)" ::: "memory");
            const unsigned og = xb_add(&bar[XB_TOP], 1u);
            const unsigned tg = og / nx;
            if (og + 1u == (tg + 1u) * nx) xb_add(&bar[XB_TOPGEN], 1u);
            else XB_SPIN(xb_ld(&bar[XB_TOPGEN]) == tg, bar);
            __builtin_amdgcn_fence(__ATOMIC_ACQUIRE, "agent");
            xb_add(&bar[XB_XGEN(b.x)], 1u);
            asm volatile("s_waitcnt vmcnt(0)" ::: "memory");
        } else {
            XB_SPIN(xb_ld(&bar[XB_XGEN(b.x)]) == gen, bar);
            __builtin_amdgcn_fence(__ATOMIC_ACQUIRE, "agent");
            asm volatile("s_waitcnt vmcnt(0)" ::: "memory");
        }
    }
    __syncthreads();
}

#ifndef MK_MFMA_ATT
#define MK_MFMA_ATT 1
#endif
#ifndef MK_MFMA_GLA
#define MK_MFMA_GLA 1
#endif
#ifndef MK_SPLITK
#define MK_SPLITK 0
#endif
constexpr int NWV = 8, NTH = 512;

template <bool UPMAP = false>
__device__ __forceinline__ void transpose_item(const float* W, int K, int N, bf16* WT, LAS float* scr, int item, int lane) {
    const int nblk = N / 32, kb = item / nblk, nb = item % nblk, k0 = 64 * kb, n0 = 32 * nb;
    const int nd0 = UPMAP ? (n0 < DFF ? 256 * (n0 >> 7) + (n0 & 127) : 256 * ((n0 - DFF) >> 7) + 128 + ((n0 - DFF) & 127)) : n0;
    float wv[32];
#pragma unroll
    for (int i = 0; i < 32; ++i) wv[i] = __builtin_nontemporal_load(W + (size_t)(k0 + 2 * i + (lane >> 5)) * N + n0 + (lane & 31));
#pragma unroll
    for (int i = 0; i < 32; ++i) scr[(2 * i + (lane >> 5)) * 33 + (lane & 31)] = wv[i];
    LDS_WAIT(); asm volatile("" ::: "memory");
    const int c = lane & 7;
#pragma unroll
    for (int j = 0; j < 4; ++j) { const int n = (lane >> 3) + 8 * j; const LAS float* s = scr + (8 * c) * 33 + n;
        v4u o; o.x = pk2(s[0 * 33], s[1 * 33]); o.y = pk2(s[2 * 33], s[3 * 33]); o.z = pk2(s[4 * 33], s[5 * 33]); o.w = pk2(s[6 * 33], s[7 * 33]);
        *(v4u*)(WT + (size_t)(nd0 + n) * K + k0 + 8 * c) = o; }
    LDS_WAIT(); asm volatile("" ::: "memory");
}

struct Args { const float* in[N_INPUTS]; float* out; unsigned char* ws; int ph_lo, ph_hi, use_bar, pad; };

__device__ __forceinline__ void pro0_phase(const Args& a, LAS unsigned char* lds, int tid, int lane, int wave, int bid, int G) {
    unsigned char* ws = a.ws;
    const int gw = bid * NWV + wave, NGW = G * NWV;
    LAS float* scr = (LAS float*)(lds + wave * 16384);
    constexpr int IT_IN = (DM / 64) * (NIN / 32), IT_OUT = (DM / 64) * (DM / 32), IT_UP = (DM / 64) * (2 * DFF / 32), IT_DN = (DFF / 64) * (DM / 32), IT_Q = (384 / 64) * (NQC / 32), IT_KV = (256 / 64) * (NKV / 32);
    constexpr int IT_L = IT_IN + IT_OUT + IT_UP + IT_DN + IT_Q + IT_KV;
    for (int it = gw; it < DEPTH * IT_L; it += NGW) {
        const int l = it / IT_L; int r = it % IT_L;
        if (r < IT_IN) { transpose_item(a.in[I_WIN] + (size_t)l * DM * NIN, DM, NIN, (bf16*)(ws + WS_WIN + l * SZ_WIN), scr, r, lane); continue; } r -= IT_IN;
        if (r < IT_OUT) { transpose_item(a.in[I_WOUT] + (size_t)l * DM * DM, DM, DM, (bf16*)(ws + WS_WOUT + l * SZ_WOUT), scr, r, lane); continue; } r -= IT_OUT;
        if (r < IT_UP) { transpose_item<true>(a.in[I_WUP] + (size_t)l * DM * 2 * DFF, DM, 2 * DFF, (bf16*)(ws + WS_WUP + l * SZ_WUP), scr, r, lane); continue; } r -= IT_UP;
        if (r < IT_DN) { transpose_item(a.in[I_WDOWN] + (size_t)l * DFF * DM, DFF, DM, (bf16*)(ws + WS_WDN + l * SZ_WDN), scr, r, lane); continue; } r -= IT_DN;
        if (r < IT_Q) { transpose_item(a.in[I_CQUP] + (size_t)l * 384 * NQC, 384, NQC, (bf16*)(ws + WS_WQ + l * SZ_WQ), scr, r, lane); continue; } r -= IT_Q;
        transpose_item(a.in[I_CKVUP] + (size_t)l * 256 * NKV, 256, NKV, (bf16*)(ws + WS_WKV + l * SZ_WKV), scr, r, lane);
    }
    const int gt = bid * NTH + tid, NGT = G * NTH;
    for (int i = gt; i < DEPTH * (NINP - NIN) * DM / 8; i += NGT) { const int l = i / ((NINP - NIN) * DM / 8), r = i % ((NINP - NIN) * DM / 8); *(v4u*)(ws + WS_WIN + l * SZ_WIN + (size_t)NIN * DM * 2 + (size_t)r * 16) = (v4u){0u, 0u, 0u, 0u}; }
    for (int i = gt; i < DEPTH * (NQCP - NQC) * 384 / 8; i += NGT) { const int l = i / ((NQCP - NQC) * 384 / 8), r = i % ((NQCP - NQC) * 384 / 8); *(v4u*)(ws + WS_WQ + l * SZ_WQ + (size_t)NQC * 384 * 2 + (size_t)r * 16) = (v4u){0u, 0u, 0u, 0u}; }
    for (int i = gt; i < DEPTH * (NKVP - NKV) * 256 / 8; i += NGT) { const int l = i / ((NKVP - NKV) * 256 / 8), r = i % ((NKVP - NKV) * 256 / 8); *(v4u*)(ws + WS_WKV + l * SZ_WKV + (size_t)NKV * 256 * 2 + (size_t)r * 16) = (v4u){0u, 0u, 0u, 0u}; }
    {
        LAS float* sc = (LAS float*)lds;
        __syncthreads();
        for (int it = bid; it < DEPTH * 24 * 8; it += G) {
            const int l = it / 192, cb = (it / 8) % 24, ks = it % 8;
            __syncthreads();
            for (int e = tid; e < 5 * 256; e += NTH) { const int mi = e >> 8, k = ks * 256 + (e & 255); const float cv = mi == 0 ? a.in[I_CCTX][k] : a.in[I_C][(mi - 1) * DM + k]; sc[e] = cv / (1.f + expf(-cv)); }
            __syncthreads();
            const float* wp = a.in[I_ADAW] + ((size_t)l * DM + ks * 256) * (6 * DM) + cb * 512 + tid;
            float s0 = 0.f, s1 = 0.f, s2 = 0.f, s3 = 0.f, s4 = 0.f;
#pragma unroll 8
            for (int k = 0; k < 256; ++k) { const float w = __builtin_nontemporal_load(wp + (size_t)k * (6 * DM)); s0 += sc[k] * w; s1 += sc[256 + k] * w; s2 += sc[512 + k] * w; s3 += sc[768 + k] * w; s4 += sc[1024 + k] * w; }
            float* mp = (float*)(ws + WS_MODP) + ((size_t)ks * DEPTH + l) * 5 * 6 * DM + cb * 512 + tid;
            mp[0] = s0; mp[6 * DM] = s1; mp[2 * 6 * DM] = s2; mp[3 * 6 * DM] = s3; mp[4 * 6 * DM] = s4;
        }
        __syncthreads();
    }
    { const float* s = a.in[I_CAK]; bf16* d = (bf16*)(ws + WS_CAK); for (int i = gt; i < NDB * DEPTH * PAST * 512; i += NGT) d[i] = (bf16)f2bf(s[i]); }
    { const float* s = a.in[I_CAV]; bf16* d = (bf16*)(ws + WS_CAV); for (int i = gt; i < NDB * DEPTH * PAST * 512; i += NGT) d[i] = (bf16)f2bf(s[i]); }
    { const float* s = a.in[I_CCKR]; bf16* d = (bf16*)(ws + WS_CKRX); for (int i = gt; i < NDB * DEPTH * PAST * 32; i += NGT) d[i] = (bf16)f2bf(s[i]); }
    { const float* s = a.in[I_CCKV]; bf16* d = (bf16*)(ws + WS_CKVA);
      for (int i = gt; i < NDB * DEPTH * PAST * 256; i += NGT) { const int c = i & 255, j = (i >> 8) & 255, bl = i >> 16, b = bl >> 2, l = bl & 3; d[(((size_t)l * NDB + b) * PAST + j) * 256 + c] = (bf16)f2bf(s[i]); } }
    { float* ra = (float*)(ws + WS_RTA); float* rc = (float*)(ws + WS_RTC);
      for (int i = gt; i < DSEQ * 16; i += NGT) { const int t = i >> 4, j = i & 15; const float inv = powf(10000.f, -(float)j / 16.f); const float ar = (float)(t >> 6) * inv, ac = (float)(t & 63) * inv;
          ra[t * 64 + j] = cosf(ar); ra[t * 64 + 16 + j] = sinf(ar); ra[t * 64 + 32 + j] = cosf(ac); ra[t * 64 + 48 + j] = sinf(ac); }
      for (int i = gt; i < DSEQ * 8; i += NGT) { const int t = i >> 3, j = i & 7; const float inv = powf(10000.f, -(float)j / 8.f); const float ar = (float)(t >> 6) * inv, ac = (float)(t & 63) * inv;
          rc[t * 32 + j] = cosf(ar); rc[t * 32 + 8 + j] = sinf(ar); rc[t * 32 + 16 + j] = cosf(ac); rc[t * 32 + 24 + j] = sinf(ac); } }
    if (gt < DEPTH) { const int l = gt; float d1 = 0.f, d2 = 0.f;
        for (int i = 0; i < 64; ++i) { d1 += a.in[I_LQ1][l * 64 + i] * a.in[I_LK1][l * 64 + i]; d2 += a.in[I_LQ2][l * 64 + i] * a.in[I_LK2][l * 64 + i]; }
        const float li = 0.8f - 0.6f * expf(-0.3f * (float)l);
        float* lam = (float*)(ws + WS_LAM); lam[l] = expf(d1) - expf(d2) + li; lam[4 + l] = li; }
}

__device__ __forceinline__ void modfin_phase(const Args& a, int gt, int NGT) {
    const float* mp = (const float*)(a.ws + WS_MODP); float* mo = (float*)(a.ws + WS_MOD);
    for (int i = gt; i < DEPTH * 5 * 6 * DM; i += NGT) { const int l = i / (5 * 6 * DM), n = i % (6 * DM); float s = a.in[I_ADAB][l * 6 * DM + n];
#pragma unroll
        for (int ks = 0; ks < 8; ++ks) s += mp[(size_t)ks * DEPTH * 5 * 6 * DM + i];
        mo[i] = s; }
}


namespace att {
using bf16x8 = __attribute__((ext_vector_type(8))) short;
using s16x4  = __attribute__((ext_vector_type(4))) short;
using f32x16 = __attribute__((ext_vector_type(16))) float;
using u32x4  = __attribute__((ext_vector_type(4))) unsigned;
constexpr int SHM_V = 64 * 128 * 2;
#define ATT_SBAR() __builtin_amdgcn_sched_barrier(0)
#define ATT_LBAR() asm volatile("s_waitcnt lgkmcnt(0)\n\ts_barrier" ::: "memory")
__device__ __forceinline__ int crow(int r, int hi) { return (r & 3) + 8 * (r >> 2) + 4 * hi; }
__device__ __forceinline__ float max3f(float a, float b, float c) { return fmaxf(fmaxf(a, b), c); }
__device__ __forceinline__ float max2f(float a, float b) { return fmaxf(a, b); }
__device__ __forceinline__ unsigned cvtpk(float lo, float hi) { unsigned r; asm volatile("v_cvt_pk_bf16_f32 %0, %1, %2" : "=v"(r) : "v"(lo), "v"(hi)); return r; }
template <bool TUP> __device__ __forceinline__ void partialSM(f32x16& p0, f32x16& p1, float& m_reg, f32x16& negm, float& alpha, float thr, bool first, float pmax) {
  if constexpr (!TUP) {
    typedef float f32x2 __attribute__((ext_vector_type(2))); const f32x2 M2 = {-m_reg, -m_reg};
#pragma unroll
    for (int r = 0; r < 16; r += 2) { f32x2 v = {p0[r], p0[r + 1]}; v += M2; p0[r] = v.x; p0[r + 1] = v.y; f32x2 w = {p1[r], p1[r + 1]}; w += M2; p1[r] = w.x; p1[r + 1] = w.y; }
    pmax -= m_reg; }
  { auto rr = __builtin_amdgcn_permlane32_swap(__float_as_uint(pmax), __float_as_uint(pmax), false, false);
    pmax = max2f(__uint_as_float(rr[0]), __uint_as_float(rr[1])); }
  if (__builtin_expect(!first && __all(pmax <= thr), 1)) { alpha = 1.f; }
  else { const float delta = first ? pmax : max2f(pmax, 0.f); alpha = __builtin_amdgcn_exp2f(-delta); m_reg += delta;
#pragma unroll
    for (int r = 0; r < 16; ++r) { p0[r] -= delta; p1[r] -= delta; }
    if constexpr (TUP) { const float nm = -m_reg;
#pragma unroll
      for (int r = 0; r < 16; ++r) negm[r] = nm;
      asm volatile("" : "+v"(negm)); } }
}
__device__ __forceinline__ void finishSM(f32x16& p0, f32x16& p1, float alpha, float& l_reg, bf16x8& pa0, bf16x8& pa1, bf16x8& pa2, bf16x8& pa3) {
  float ps;
  { typedef float f32x2 __attribute__((ext_vector_type(2))); f32x2 s2 = {p0[0], p0[1]};
#pragma unroll
    for (int r = 2; r < 16; r += 2) s2 += (f32x2){p0[r], p0[r + 1]};
#pragma unroll
    for (int r = 0; r < 16; r += 2) s2 += (f32x2){p1[r], p1[r + 1]};
    ps = s2.x + s2.y; }
  { auto rr = __builtin_amdgcn_permlane32_swap(__float_as_uint(ps), __float_as_uint(ps), false, false);
    ps = __uint_as_float(rr[0]) + __uint_as_float(rr[1]); }
  l_reg = l_reg * alpha + ps;
#define ATT_PKD(P, BASE) __builtin_bit_cast(bf16x8, (u32x4){cvtpk(P[BASE + 0], P[BASE + 1]), cvtpk(P[BASE + 2], P[BASE + 3]), cvtpk(P[BASE + 4], P[BASE + 5]), cvtpk(P[BASE + 6], P[BASE + 7])})
  pa0 = ATT_PKD(p0, 0); pa1 = ATT_PKD(p0, 8); pa2 = ATT_PKD(p1, 0); pa3 = ATT_PKD(p1, 8);
#undef ATT_PKD
}
template <int DQK, bool TUP>
__device__ __forceinline__ void qkt(f32x16& p0, f32x16& p1, const LAS unsigned char* Ks, const bf16x8* qr, int r32, int hi, const f32x16& negm) {
  constexpr int RS = DQK * 2 + 16;
  if constexpr (TUP) { p0 = negm; p1 = negm; } else { p0 = f32x16{}; p1 = f32x16{}; }
#pragma unroll
  for (int d0 = 0; d0 < DQK / 16; ++d0) { const int cb = d0 * 32 + hi * 16;
    const bf16x8 b0 = *(const LAS bf16x8*)(Ks + r32 * RS + cb);
    const bf16x8 b1 = *(const LAS bf16x8*)(Ks + (32 + r32) * RS + cb);
    p0 = __builtin_amdgcn_mfma_f32_32x32x16_bf16(b0, qr[d0], p0, 0, 0, 0);
    p1 = __builtin_amdgcn_mfma_f32_32x32x16_bf16(b1, qr[d0], p1, 0, 0, 0); }
}
__device__ __forceinline__ int v_st(int k, int c) { const int kk = (k & ~0xC) | ((k & 4) << 1) | ((k & 8) >> 1); return ((kk >> 3) * 4 + (c >> 5)) * 512 + ((kk & 7) * 32 + (c & 31)) * 2; }
__device__ __forceinline__ int v_rd_base(int lane) { return ((lane & 3) << 3) | (((lane >> 2) & 3) << 6) | (((lane >> 4) & 1) << 5) | (((lane >> 5) & 1) << 8); }
constexpr int v_rd_off(int d0, int ks, int half) { return d0 * 512 + ks * 4096 + half * 2048; }
__device__ __forceinline__ int v_st_n(int k, int c) { return (c >> 5) * 4096 + k * 64 + (c & 31) * 2; }
__device__ __forceinline__ int v_rd_base_n(int lane) { return ((lane >> 4) & 1) * 32 + (lane & 3) * 8 + (4 * (lane >> 5) + ((lane & 15) >> 2)) * 64; }
constexpr int v_rd_off_n(int d0, int ks, int half) { return d0 * 4096 + ks * 1024 + half * 512; }
template <int OFF> __device__ __forceinline__ s16x4 tr_read(int vb) {
  s16x4 r; asm volatile("ds_read_b64_tr_b16 %0, %1 offset:%2" : "=&v"(r) : "v"(vb), "i"(OFF) : "memory"); return r;
}
template <int D0, bool EX> __device__ __forceinline__ void pv_one(f32x16& od, int vb, bf16x8 pa0, bf16x8 pa1, bf16x8 pa2, bf16x8 pa3, f32x16& s) {
  const s16x4 l0 = tr_read<v_rd_off_n(D0, 0, 0)>(vb), h0 = tr_read<v_rd_off_n(D0, 0, 1)>(vb), l1 = tr_read<v_rd_off_n(D0, 1, 0)>(vb), h1 = tr_read<v_rd_off_n(D0, 1, 1)>(vb);
  const s16x4 l2 = tr_read<v_rd_off_n(D0, 2, 0)>(vb), h2 = tr_read<v_rd_off_n(D0, 2, 1)>(vb), l3 = tr_read<v_rd_off_n(D0, 3, 0)>(vb), h3 = tr_read<v_rd_off_n(D0, 3, 1)>(vb);
  asm volatile("s_waitcnt lgkmcnt(0)" ::: "memory"); ATT_SBAR();
#define ATT_PK(L, H) (bf16x8){L[0], L[1], L[2], L[3], H[0], H[1], H[2], H[3]}
  constexpr int B = (D0 & 1) * 8;
  od = __builtin_amdgcn_mfma_f32_32x32x16_bf16(pa0, ATT_PK(l0, h0), od, 0, 0, 0);
  if constexpr (EX) { s[B] = __builtin_amdgcn_exp2f(s[B]); s[B + 1] = __builtin_amdgcn_exp2f(s[B + 1]); }
  od = __builtin_amdgcn_mfma_f32_32x32x16_bf16(pa1, ATT_PK(l1, h1), od, 0, 0, 0);
  if constexpr (EX) { s[B + 2] = __builtin_amdgcn_exp2f(s[B + 2]); s[B + 3] = __builtin_amdgcn_exp2f(s[B + 3]); }
  od = __builtin_amdgcn_mfma_f32_32x32x16_bf16(pa2, ATT_PK(l2, h2), od, 0, 0, 0);
  if constexpr (EX) { s[B + 4] = __builtin_amdgcn_exp2f(s[B + 4]); s[B + 5] = __builtin_amdgcn_exp2f(s[B + 5]); }
  od = __builtin_amdgcn_mfma_f32_32x32x16_bf16(pa3, ATT_PK(l3, h3), od, 0, 0, 0);
  if constexpr (EX) { s[B + 6] = __builtin_amdgcn_exp2f(s[B + 6]); s[B + 7] = __builtin_amdgcn_exp2f(s[B + 7]); asm volatile("" : "+v"(s)); }
#undef ATT_PK
}
__device__ __forceinline__ void pv_ex(f32x16* o, int vb, bf16x8 pa0, bf16x8 pa1, bf16x8 pa2, bf16x8 pa3, f32x16& s0, f32x16& s1) {
  pv_one<0, true>(o[0], vb, pa0, pa1, pa2, pa3, s0); pv_one<1, true>(o[1], vb, pa0, pa1, pa2, pa3, s0); pv_one<2, true>(o[2], vb, pa0, pa1, pa2, pa3, s1); pv_one<3, true>(o[3], vb, pa0, pa1, pa2, pa3, s1);
}
__device__ __forceinline__ void pv_last(f32x16* o, int vb, bf16x8 pa0, bf16x8 pa1, bf16x8 pa2, bf16x8 pa3) { f32x16 z = {};
  pv_one<0, false>(o[0], vb, pa0, pa1, pa2, pa3, z); pv_one<1, false>(o[1], vb, pa0, pa1, pa2, pa3, z); pv_one<2, false>(o[2], vb, pa0, pa1, pa2, pa3, z); pv_one<3, false>(o[3], vb, pa0, pa1, pa2, pa3, z); }
__device__ __forceinline__ float rowmax32(const f32x16& p0, const f32x16& p1) {
  float a = max3f(p0[0], p0[1], p1[0]), b = max3f(p0[2], p0[3], p1[1]); a = max3f(a, p1[2], p1[3]);
#pragma unroll
  for (int r = 4; r < 16; r += 4) { a = max3f(a, p0[r], p0[r + 1]); b = max3f(b, p0[r + 2], p0[r + 3]); a = max3f(a, p1[r], p1[r + 1]); b = max3f(b, p1[r + 2], p1[r + 3]); }
  return max2f(a, b);
}
__device__ __forceinline__ float bfe(bf16x8 v, int e) { return __builtin_bit_cast(float, (unsigned)(unsigned short)v[e] << 16); }
}

struct KSeg { const bf16* kn; int ldn; const bf16* kr; int ldr; const bf16* v; int ldv; int n; };

template <int DQK, int SD, bool OUTBF>
__device__ __forceinline__ void attn_mfma_unit(LAS unsigned char* lds, const bf16* Qp, int ldq, bool rot, const float* rt, int t0, const KSeg& ctx, const KSeg& lat, float scale, void* Opv, int tid,
                                               bool fin = false, float lam = 0.f, float gsc = 0.f, const float* ag = nullptr, bf16* Mx = nullptr) {
  using namespace att;
  constexpr int NF = DQK / 16, RS = DQK * 2 + 16, SHM_K = 64 * RS;
  const int wid = tid >> 6, lane = tid & 63, r32 = lane & 31, hi = lane >> 5;
  constexpr int NSL = 3;
  LAS unsigned char* V_lds = lds; LAS unsigned char* K_lds = lds + NSL * SHM_V;
  LAS float* wsf = (LAS float*)(lds + NSL * SHM_V + NSL * SHM_K) + wid * 64; LAS float* li_l = wsf; LAS float* al_l = wsf + 32;
  (void)scale;
  const float thr = 8.f * 1.4426950408889634f;
  float m_reg = 0.f, l_reg = 0; f32x16 negm = {}; f32x16 o[4] = {}; bf16x8 qr[NF];
  const bf16* Qw = Qp + (size_t)(wid * 32 + r32) * ldq + hi * 8;
#pragma unroll
  for (int d0 = 0; d0 < NF; ++d0) qr[d0] = *reinterpret_cast<const bf16x8*>(Qw + d0 * 16);
  const int sr = tid >> 4, sc = (tid & 15) * 8, vst0 = v_st_n(sr, sc), vst1 = v_st_n(32 + sr, sc);
  const int krow = tid >> 3, kch = tid & 7, xrow = tid >> 2, xch = tid & 3; const bool xld = (DQK == 96) && tid < 256;
  const int vb0 = (int)(unsigned)(uintptr_t)V_lds + v_rd_base_n(lane);
  const int nct = ctx.n >> 6, NT = nct + (lat.n >> 6);
  struct { bf16x8 vs0, vs1, kn, kx; } st;
#define ATT_SLOAD(j) do { const int j_ = (j); const bool c_ = j_ < nct; const KSeg& S_ = c_ ? ctx : lat; const int k0_ = (c_ ? j_ : j_ - nct) * 64; \
    st.vs0 = *reinterpret_cast<const bf16x8*>(S_.v + (size_t)(k0_ + sr) * S_.ldv + sc); st.vs1 = *reinterpret_cast<const bf16x8*>(S_.v + (size_t)(k0_ + 32 + sr) * S_.ldv + sc); \
    st.kn = *reinterpret_cast<const bf16x8*>(S_.kn + (size_t)(k0_ + krow) * S_.ldn + kch * 8); \
    if (xld) st.kx = *reinterpret_cast<const bf16x8*>(S_.kr + (size_t)(k0_ + xrow) * S_.ldr + xch * 8); } while (0)
#define ATT_SWRITE(b) do { *(LAS bf16x8*)(V_lds + (b) * SHM_V + vst0) = st.vs0; *(LAS bf16x8*)(V_lds + (b) * SHM_V + vst1) = st.vs1; \
    *(LAS bf16x8*)(K_lds + (b) * SHM_K + krow * RS + kch * 16) = st.kn; \
    if (xld) *(LAS bf16x8*)(K_lds + (b) * SHM_K + xrow * RS + 128 + xch * 16) = st.kx; } while (0)
#define ATT_SWAIT() asm volatile("s_waitcnt vmcnt(0)" ::: "memory")
#define ATT_RESC(a) do { if (__any((a) < 1.f)) { if (hi == 0) al_l[r32] = (a); asm volatile("s_waitcnt lgkmcnt(0)" ::: "memory"); \
    _Pragma("unroll") for (int d = 0; d < 4; ++d) _Pragma("unroll") for (int r = 0; r < 16; ++r) o[d][r] *= al_l[crow(r, hi)]; } } while (0)
#define ATT_ROTQ() do { const int t_ = t0 + wid * 32 + r32; \
    if constexpr (DQK == 64) { const float* tb = rt + (size_t)t_ * 64 + hi * 8; u32x4 w0, w1, w2, w3; \
        float y0[8], y1[8], y2[8], y3[8]; \
        _Pragma("unroll") for (int e = 0; e < 8; ++e) { const float cr = tb[e], sn = tb[16 + e], cc = tb[32 + e], sc2 = tb[48 + e]; \
            const float x0 = bfe(qr[0], e), x1 = bfe(qr[1], e), x2 = bfe(qr[2], e), x3 = bfe(qr[3], e); \
            y0[e] = x0 * cr - x1 * sn; y1[e] = x1 * cr + x0 * sn; y2[e] = x2 * cc - x3 * sc2; y3[e] = x3 * cc + x2 * sc2; } \
        w0 = (u32x4){cvtpk(y0[0], y0[1]), cvtpk(y0[2], y0[3]), cvtpk(y0[4], y0[5]), cvtpk(y0[6], y0[7])}; w1 = (u32x4){cvtpk(y1[0], y1[1]), cvtpk(y1[2], y1[3]), cvtpk(y1[4], y1[5]), cvtpk(y1[6], y1[7])}; \
        w2 = (u32x4){cvtpk(y2[0], y2[1]), cvtpk(y2[2], y2[3]), cvtpk(y2[4], y2[5]), cvtpk(y2[6], y2[7])}; w3 = (u32x4){cvtpk(y3[0], y3[1]), cvtpk(y3[2], y3[3]), cvtpk(y3[4], y3[5]), cvtpk(y3[6], y3[7])}; \
        qr[0] = __builtin_bit_cast(bf16x8, w0); qr[1] = __builtin_bit_cast(bf16x8, w1); qr[2] = __builtin_bit_cast(bf16x8, w2); qr[3] = __builtin_bit_cast(bf16x8, w3); \
    } else { const float* tb = rt + (size_t)t_ * 32; const float sg = hi ? 1.f : -1.f; \
        const u32x4 a4 = __builtin_bit_cast(u32x4, qr[NF - 2]), a5 = __builtin_bit_cast(u32x4, qr[NF - 1]); u32x4 p4, p5; \
        _Pragma("unroll") for (int i = 0; i < 4; ++i) { p4[i] = (unsigned)__shfl_xor((int)a4[i], 32); p5[i] = (unsigned)__shfl_xor((int)a5[i], 32); } \
        const bf16x8 q4 = __builtin_bit_cast(bf16x8, p4), q5 = __builtin_bit_cast(bf16x8, p5); float y4[8], y5[8]; \
        _Pragma("unroll") for (int e = 0; e < 8; ++e) { const float cr = tb[e], sn = tb[8 + e], cc = tb[16 + e], sc2 = tb[24 + e]; \
            y4[e] = bfe(qr[NF - 2], e) * cr + sg * bfe(q4, e) * sn; y5[e] = bfe(qr[NF - 1], e) * cc + sg * bfe(q5, e) * sc2; } \
        const u32x4 w4 = {cvtpk(y4[0], y4[1]), cvtpk(y4[2], y4[3]), cvtpk(y4[4], y4[5]), cvtpk(y4[6], y4[7])}, w5 = {cvtpk(y5[0], y5[1]), cvtpk(y5[2], y5[3]), cvtpk(y5[4], y5[5]), cvtpk(y5[6], y5[7])}; \
        qr[NF - 2] = __builtin_bit_cast(bf16x8, w4); qr[NF - 1] = __builtin_bit_cast(bf16x8, w5); } } while (0)
  f32x16 pA0, pA1, pB0, pB1; float alA, alB; bf16x8 pa0, pa1, pa2, pa3;
  ATT_SLOAD(0); ATT_SWAIT(); ATT_SWRITE(0);
  ATT_SLOAD(1); ATT_SWAIT(); ATT_SWRITE(1); ATT_LBAR();
  qkt<DQK, true>(pA0, pA1, K_lds, qr, r32, hi, negm);
  partialSM<true>(pA0, pA1, m_reg, negm, alA, thr, true, rowmax32(pA0, pA1));
#pragma unroll
  for (int r = 0; r < 16; ++r) { pA0[r] = __builtin_amdgcn_exp2f(pA0[r]); pA1[r] = __builtin_amdgcn_exp2f(pA1[r]); }
  int s_cur = 0, s_nxt = 1, s_nn = 2;
#define ATT_STEP(t, X0, X1, alX, Y0, Y1, alY, HAS1, HAS2) do { \
    if (HAS1) { if (rot && (t) + 1 == nct) ATT_ROTQ(); } \
    ATT_SBAR(); if (HAS1) qkt<DQK, true>(Y0, Y1, K_lds + s_nxt * SHM_K, qr, r32, hi, negm); \
    finishSM(X0, X1, alX, l_reg, pa0, pa1, pa2, pa3); ATT_SBAR(); \
    if (HAS2) ATT_SLOAD((t) + 2); ATT_SBAR(); \
    if (HAS1) { partialSM<true>(Y0, Y1, m_reg, negm, alY, thr, false, rowmax32(Y0, Y1)); ATT_SBAR(); pv_ex(o, vb0 + s_cur * SHM_V, pa0, pa1, pa2, pa3, Y0, Y1); } \
    else pv_last(o, vb0 + s_cur * SHM_V, pa0, pa1, pa2, pa3); \
    if (HAS2) { ATT_SWAIT(); ATT_SWRITE(s_nn); } \
    if (HAS1) ATT_RESC(alY); \
    ATT_LBAR(); { const int tmp_ = s_cur; s_cur = s_nxt; s_nxt = s_nn; s_nn = tmp_; } } while (0)
  for (int t = 0; t + 2 < NT; t += 2) {
    ATT_STEP(t, pA0, pA1, alA, pB0, pB1, alB, true, true);
    ATT_STEP(t + 1, pB0, pB1, alB, pA0, pA1, alA, true, true);
  }
  ATT_STEP(NT - 2, pA0, pA1, alA, pB0, pB1, alB, true, false);
  ATT_STEP(NT - 1, pB0, pB1, alB, pA0, pA1, alA, false, false);
#undef ATT_STEP
  if (hi == 0) li_l[r32] = l_reg; asm volatile("s_waitcnt lgkmcnt(0)" ::: "memory");
  float rli[16];
#pragma unroll
  for (int r = 0; r < 16; ++r) rli[r] = __builtin_amdgcn_rcpf(li_l[crow(r, hi)]);
  if constexpr (OUTBF) { bf16* Ow = (bf16*)Opv + (size_t)(wid * 32) * DM;
#pragma unroll
    for (int r = 0; r < 16; ++r) { const int orow = crow(r, hi);
#pragma unroll
      for (int d0 = 0; d0 < 4; ++d0) Ow[(size_t)orow * DM + d0 * 32 + r32] = (bf16)f2bf(o[d0][r] * rli[r]); }
  } else { float* Ow = (float*)Opv + (size_t)(wid * 32) * NOATT;
    if (!fin) {
#pragma unroll
      for (int r = 0; r < 16; ++r) { const int orow = crow(r, hi);
#pragma unroll
        for (int d0 = 0; d0 < 4; ++d0) Ow[(size_t)orow * NOATT + d0 * 32 + r32] = o[d0][r] * rli[r]; }
    } else {
      bf16* Mw = Mx + (size_t)(wid * 32) * DM; float gv[4];
#pragma unroll
      for (int d0 = 0; d0 < 4; ++d0) gv[d0] = ag[d0 * 32 + r32] * gsc;
#pragma unroll
      for (int r = 0; r < 16; ++r) { const int orow = crow(r, hi); float v[4]; float ss = 0.f;
#pragma unroll
        for (int d0 = 0; d0 < 4; ++d0) { v[d0] = Ow[(size_t)orow * NOATT + d0 * 32 + r32] - lam * (o[d0][r] * rli[r]); ss += v[d0] * v[d0]; }
        ss += __shfl_xor(ss, 1); ss += __shfl_xor(ss, 2); ss += __shfl_xor(ss, 4); ss += __shfl_xor(ss, 8); ss += __shfl_xor(ss, 16);
        const float rs = 1.0f / sqrtf(ss * (1.f / 128.f) + EPS);
#pragma unroll
        for (int d0 = 0; d0 < 4; ++d0) Mw[(size_t)orow * DM + d0 * 32 + r32] = (bf16)f2bf(v[d0] * rs * gv[d0]); } } }
  __syncthreads();
#undef ATT_SLOAD
#undef ATT_SWRITE
#undef ATT_SWAIT
#undef ATT_RESC
#undef ATT_ROTQ
}

__device__ __forceinline__ void norm0_phase(const float* xp, const float* xs_off, const float* gm, bf16* H, float* ssq, int gw, int NGW, int lane) {
    for (int m = gw; m < M; m += NGW) {
        const float* xr = (m < MP ? xp : xs_off) + (size_t)m * DM;
        const int mi = m < MP ? 0 : 1 + (m - MP) / DSEQ; const float* g = gm + (size_t)mi * DM;
        f32x4 v[8]; float s = 0.f;
#pragma unroll
        for (int j = 0; j < 8; ++j) { v[j] = ((const f32x4*)xr)[lane + 64 * j]; s += (v[j].x * v[j].x + v[j].y * v[j].y) + (v[j].z * v[j].z + v[j].w * v[j].w); }
        s = wave_sum(s); if (lane < 32) ssq[(size_t)m * 32 + lane] = lane == 0 ? s : 0.f;
#pragma unroll
        for (int j = 0; j < 8; ++j) { const int c = (lane + 64 * j) * 4; const f32x4 y = v[j] * *(const f32x4*)(g + c); v2u o; o.x = pk2(y.x, y.y); o.y = pk2(y.z, y.w); *(v2u*)(H + (size_t)m * DM + c) = o; }
    }
}
__device__ __forceinline__ void pro2_phase(const Args& a, LAS unsigned char* lds, int tid, int bid, int G, int gt, int NGT) {
    using att::bf16x8; using att::f32x16; using att::crow;
    unsigned char* ws = a.ws; const float* MOD = (const float*)(ws + WS_MOD); float* GM = (float*)(ws + WS_GM);
    for (int i = gt; i < DEPTH * 2 * 5 * DM; i += NGT) { const int c = i % DM, mi = (i / DM) % 5, w = (i / (5 * DM)) & 1, l = i / (2 * 5 * DM);
        const float g = a.in[w ? I_N2G : I_N1G][l * DM + c]; GM[i] = g * (1.f + MOD[((size_t)(l * 5 + mi) * 6 + (w ? 4 : 1)) * DM + c]); }
    const int wave = tid >> 6, lane = tid & 63, r32 = lane & 31, hi = lane >> 5;
    LAS bf16* T = (LAS bf16*)lds;
#pragma unroll 1
    for (int kind = 0; kind < 2; ++kind) {
        __syncthreads();
        for (int e = tid; e < DEPTH * 5 * DM; e += NTH) { const int l = e / (5 * DM), mi = (e / DM) % 5, k = e % DM; T[e] = (bf16)f2bf(MOD[((size_t)(l * 5 + mi) * 6 + (kind ? 3 : 0)) * DM + k]); }
        __syncthreads();
        const int ld = kind ? 2 * DFF : NINP, items_l = ld / 32;
        for (int it = bid * NWV + wave; it < DEPTH * items_l; it += G * NWV) { const int l = it / items_l, rb = it % items_l;
            const bf16* Wr = (kind ? (const bf16*)(ws + WS_WUP + l * SZ_WUP) : (const bf16*)(ws + WS_WIN + l * SZ_WIN)) + (size_t)(rb * 32 + r32) * DM + hi * 8;
            const LAS bf16* Tb = T + (size_t)(l * 5 + (r32 < 5 ? r32 : 4)) * DM + hi * 8;
            f32x16 acc = {};
#pragma unroll 1
            for (int ks = 0; ks < DM / 16; ks += 8) { bf16x8 af[8];
#pragma unroll
                for (int j = 0; j < 8; ++j) af[j] = *reinterpret_cast<const bf16x8*>(Wr + (ks + j) * 16);
#pragma unroll
                for (int j = 0; j < 8; ++j) { bf16x8 bfv = *(const LAS bf16x8*)(Tb + (ks + j) * 16); if (r32 >= 5) bfv = (bf16x8){0, 0, 0, 0, 0, 0, 0, 0};
                    acc = __builtin_amdgcn_mfma_f32_32x32x16_bf16(af[j], bfv, acc, 0, 0, 0); } }
            if (r32 < 5) { float* dst = (kind ? (float*)(ws + WS_SHWU) + (size_t)l * 5 * 2 * DFF : (float*)(ws + WS_SHWI) + (size_t)l * 5 * NINP) + (size_t)r32 * ld + rb * 32;
#pragma unroll
                for (int r = 0; r < 16; ++r) dst[crow(r, hi)] = acc[r]; }
        }
    }
    __syncthreads();
}
__device__ __forceinline__ void final_norm_phase(const float* X, const float* g, float* out, int gw, int NGW, int lane) {
    for (int m = gw; m < M; m += NGW) {
        const float* xr = X + (size_t)m * DM; f32x4 v[8]; float s = 0.f;
#pragma unroll
        for (int j = 0; j < 8; ++j) { v[j] = ((const f32x4*)xr)[lane + 64 * j]; s += (v[j].x * v[j].x + v[j].y * v[j].y) + (v[j].z * v[j].z + v[j].w * v[j].w); }
        const float rstd = 1.0f / sqrtf(wave_sum(s) * (1.f / DM) + EPS);
#pragma unroll
        for (int j = 0; j < 8; ++j) { const int c = (lane + 64 * j) * 4; *(f32x4*)(out + (size_t)m * DM + c) = v[j] * rstd * *(const f32x4*)(g + c); }
    }
}

__device__ __forceinline__ void post_phase(const Args& a, int l, int gw, int NGW, int lane) {
    using att::bf16x8; using att::bfe; using att::cvtpk; using att::u32x4;
    unsigned char* ws = a.ws;
    const bf16* P = (const bf16*)(ws + WS_P); bf16* KRA = (bf16*)(ws + WS_KRA); bf16* KRC = (bf16*)(ws + WS_KRC); bf16* CQN = (bf16*)(ws + WS_CQN); bf16* CKVN = (bf16*)(ws + WS_CKVN);
    const float* RTA = (const float*)(ws + WS_RTA); const float* RTC = (const float*)(ws + WS_RTC);
    const float* gq = a.in[I_CQG] + l * 384; const float* gkv = a.in[I_CKVG] + l * 256;
    for (int m = gw; m < M; m += NGW) {
        const bf16* pr = P + (size_t)m * NINP;
        float xq[8], xk[8]; float sq = 0.f, sk = 0.f;
        if (lane < 48) { const bf16x8 v = *reinterpret_cast<const bf16x8*>(pr + C_CQ + lane * 8);
#pragma unroll
            for (int i = 0; i < 8; ++i) { xq[i] = bfe(v, i); sq += xq[i] * xq[i]; } }
        if (lane < 32) { const bf16x8 v = *reinterpret_cast<const bf16x8*>(pr + C_CKV + lane * 8);
#pragma unroll
            for (int i = 0; i < 8; ++i) { xk[i] = bfe(v, i); sk += xk[i] * xk[i]; } }
        const float rq = 1.0f / sqrtf(wave_sum(sq) * (1.f / 384.f) + EPS), rk = 1.0f / sqrtf(wave_sum(sk) * (1.f / 256.f) + EPS);
        if (lane < 48) { const f32x4 g0 = *(const f32x4*)(gq + lane * 8), g1 = *(const f32x4*)(gq + lane * 8 + 4);
            *(u32x4*)(CQN + (size_t)m * 384 + lane * 8) = (u32x4){cvtpk(xq[0] * rq * g0.x, xq[1] * rq * g0.y), cvtpk(xq[2] * rq * g0.z, xq[3] * rq * g0.w), cvtpk(xq[4] * rq * g1.x, xq[5] * rq * g1.y), cvtpk(xq[6] * rq * g1.z, xq[7] * rq * g1.w)}; }
        if (lane < 32) { const f32x4 g0 = *(const f32x4*)(gkv + lane * 8), g1 = *(const f32x4*)(gkv + lane * 8 + 4);
            const f32x4 y0 = {xk[0] * rk * g0.x, xk[1] * rk * g0.y, xk[2] * rk * g0.z, xk[3] * rk * g0.w}, y1 = {xk[4] * rk * g1.x, xk[5] * rk * g1.y, xk[6] * rk * g1.z, xk[7] * rk * g1.w};
            *(u32x4*)(CKVN + (size_t)m * 256 + lane * 8) = (u32x4){cvtpk(y0.x, y0.y), cvtpk(y0.z, y0.w), cvtpk(y1.x, y1.y), cvtpk(y1.z, y1.w)};
            if (m < MP) { float* o = a.out + O_CKV + (((size_t)(m / SEQ) * DEPTH + l) * SEQ + (m % SEQ)) * 256 + lane * 8; *(f32x4*)o = y0; *(f32x4*)(o + 4) = y1; } }
        if (m >= MP) { const int ms = m - MP, t = ms % DSEQ;
            if (lane < 34) { const bool isa = lane < 32; const int hh = isa ? (lane >> 1) & 1 : lane - 32;
                const int base = isa ? (lane >> 2) * 64 + hh * 32 + (lane & 1) * 8 : hh * 16, dist = isa ? 16 : 8;
                const bf16* src = pr + (isa ? C_AK : C_CKR) + base; const float* tb = isa ? RTA + (size_t)t * 64 + hh * 32 + (lane & 1) * 8 : RTC + (size_t)t * 32 + hh * 16;
                const bf16x8 v0 = *reinterpret_cast<const bf16x8*>(src), v1 = *reinterpret_cast<const bf16x8*>(src + dist);
                const f32x4 c0 = *(const f32x4*)(tb), c1 = *(const f32x4*)(tb + 4), s0 = *(const f32x4*)(tb + dist), s1 = *(const f32x4*)(tb + dist + 4);
                float y0[8], y1[8];
#pragma unroll
                for (int i = 0; i < 8; ++i) { const float cs = i < 4 ? c0[i & 3] : c1[i & 3], sn = i < 4 ? s0[i & 3] : s1[i & 3]; const float x0 = bfe(v0, i), x1 = bfe(v1, i); y0[i] = x0 * cs - x1 * sn; y1[i] = x1 * cs + x0 * sn; }
                bf16* dst = isa ? KRA + (size_t)ms * 512 + base : KRC + (size_t)ms * 32 + base;
                *(u32x4*)dst = (u32x4){cvtpk(y0[0], y0[1]), cvtpk(y0[2], y0[3]), cvtpk(y0[4], y0[5]), cvtpk(y0[6], y0[7])};
                *(u32x4*)(dst + dist) = (u32x4){cvtpk(y1[0], y1[1]), cvtpk(y1[2], y1[3]), cvtpk(y1[4], y1[5]), cvtpk(y1[6], y1[7])}; }
        } else { const size_t ro = ((size_t)(m / SEQ) * DEPTH + l) * SEQ + (m % SEQ);
            { const bf16x8 v = *reinterpret_cast<const bf16x8*>(pr + C_AK + lane * 8); float* o = a.out + O_AK + ro * 512 + lane * 8;
              *(f32x4*)o = (f32x4){bfe(v, 0), bfe(v, 1), bfe(v, 2), bfe(v, 3)}; *(f32x4*)(o + 4) = (f32x4){bfe(v, 4), bfe(v, 5), bfe(v, 6), bfe(v, 7)}; }
            { const bf16x8 v = *reinterpret_cast<const bf16x8*>(pr + C_AV + lane * 8); float* o = a.out + O_AV + ro * 512 + lane * 8;
              *(f32x4*)o = (f32x4){bfe(v, 0), bfe(v, 1), bfe(v, 2), bfe(v, 3)}; *(f32x4*)(o + 4) = (f32x4){bfe(v, 4), bfe(v, 5), bfe(v, 6), bfe(v, 7)}; }
            if (lane < 4) { const bf16x8 v = *reinterpret_cast<const bf16x8*>(pr + C_CKR + lane * 8); float* o = a.out + O_CKR + ro * 32 + lane * 8;
              *(f32x4*)o = (f32x4){bfe(v, 0), bfe(v, 1), bfe(v, 2), bfe(v, 3)}; *(f32x4*)(o + 4) = (f32x4){bfe(v, 4), bfe(v, 5), bfe(v, 6), bfe(v, 7)}; } }
    }
}


constexpr int NCHUNK = M / 64, GLA_UNITS = NCHUNK * 6;
constexpr int TS = 144;

__device__ __forceinline__ void gla_g1_unit(const Args& a, int l, int unit, LAS unsigned char* lds, int tid) {
    using namespace att;
    unsigned char* ws = a.ws; const bf16* P = (const bf16*)(ws + WS_P); bf16* QK4 = (bf16*)(ws + WS_QK4); float* U = (float*)(ws + WS_U); float* DD = (float*)(ws + WS_DD);
    const int gc = unit / 6, h = unit % 6, m0 = gc * 64;
    const int wave = tid >> 6, lane = tid & 63, r32 = lane & 31, hi = lane >> 5;
    LAS float* glr = (LAS float*)lds;
    LAS float* gw = (LAS float*)(lds + 8192);
    LAS float* gbs = (LAS float*)(lds + 16384);
    LAS float* segtot = (LAS float*)(lds + 16896);
    LAS unsigned char* KfT = lds + 20992;
    LAS unsigned char* KbT = lds + 30208;
    LAS unsigned char* Vt = lds + 39424;
    LAS float* Dl = (LAS float*)(lds + 55808);
    const float* gwt = a.in[I_BGW] + (size_t)l * 2 * 16 * 384; const float* gb = a.in[I_BGB] + l * 2 * 384;
    const int k = tid & 63, tq = tid >> 6;
    if (tid < 256) { const int t = tid >> 2, part = tid & 3; const bf16x8 v = *reinterpret_cast<const bf16x8*>(P + (size_t)(m0 + t) * NINP + C_BG + part * 8);
#pragma unroll
        for (int i = 0; i < 8; ++i) glr[t * 32 + part * 8 + i] = bfe(v, i); }
#pragma unroll
    for (int i = 0; i < 4; ++i) { const int idx = tid + NTH * i, dr = idx >> 6, kk = idx & 63; gw[idx] = gwt[(size_t)dr * 384 + h * 64 + kk]; }
    if (tid < 128) gbs[tid] = gb[(tid >> 6) * 384 + h * 64 + (tid & 63)];
    { const int sr = tid >> 4, sc = (tid & 15) * 8;
      const bf16x8 v0 = *reinterpret_cast<const bf16x8*>(P + (size_t)(m0 + sr) * NINP + C_BV + h * 128 + sc), v1 = *reinterpret_cast<const bf16x8*>(P + (size_t)(m0 + 32 + sr) * NINP + C_BV + h * 128 + sc);
      *(LAS bf16x8*)(Vt + v_st(sr, sc)) = v0; *(LAS bf16x8*)(Vt + v_st(32 + sr, sc)) = v1; }
    bf16 qv[8], kv[8];
#pragma unroll
    for (int j = 0; j < 8; ++j) { const bf16* pr = P + (size_t)(m0 + 8 * tq + j) * NINP + h * 64 + k; qv[j] = pr[C_BQ]; kv[j] = pr[C_BK]; }
    __syncthreads();
    float bf_[8], bb_[8];
#pragma unroll
    for (int dir = 0; dir < 2; ++dir) { float wr_[16];
#pragma unroll
        for (int r = 0; r < 16; ++r) wr_[r] = gw[(dir * 16 + r) * 64 + k];
        const float bias = gbs[dir * 64 + k];
#pragma unroll
        for (int j = 0; j < 8; ++j) { const LAS float* gp = glr + (8 * tq + j) * 32 + dir * 16; float pre = bias;
#pragma unroll
            for (int r4 = 0; r4 < 4; ++r4) { const f32x4 x = *(const LAS f32x4*)(gp + 4 * r4); pre += (x.x * wr_[4 * r4] + x.y * wr_[4 * r4 + 1]) + (x.z * wr_[4 * r4 + 2] + x.w * wr_[4 * r4 + 3]); }
            const float gl = (fminf(pre, 0.f) - __logf(1.f + __expf(-fabsf(pre)))) * (1.f / 16.f);
            if (dir == 0) bf_[j] = gl; else bb_[j] = gl; } }
#pragma unroll
    for (int j = 1; j < 8; ++j) bf_[j] += bf_[j - 1];
#pragma unroll
    for (int j = 6; j >= 0; --j) bb_[j] += bb_[j + 1];
    segtot[tq * 64 + k] = bf_[7]; segtot[(8 + tq) * 64 + k] = bb_[0];
    __syncthreads();
    { float of = 0.f, ob = 0.f;
#pragma unroll
      for (int q2 = 0; q2 < 8; ++q2) { const float sf = segtot[q2 * 64 + k], sb = segtot[(8 + q2) * 64 + k]; of += q2 < tq ? sf : 0.f; ob += q2 > tq ? sb : 0.f; }
      float kf[8], kb[8];
      bf16* dst = QK4 + (size_t)(m0 + 8 * tq) * 1536 + h * 64 + k;
#pragma unroll
      for (int j = 0; j < 8; ++j) { const float bfv = bf_[j] + of, bbv = bb_[j] + ob; const float ef = __expf(bfv), eb = __expf(bbv); const float q = bf2f(qv[j]) * 0.125f, kk = bf2f(kv[j]);
          kf[j] = kk * __expf(-bfv); kb[j] = kk * __expf(-bbv);
          dst[(size_t)j * 1536] = (bf16)f2bf(q * ef); dst[(size_t)j * 1536 + 384] = (bf16)f2bf(kf[j]); dst[(size_t)j * 1536 + 768] = (bf16)f2bf(q * eb); dst[(size_t)j * 1536 + 1152] = (bf16)f2bf(kb[j]);
          if (j == 7 && tq == 7) Dl[k] = ef;
          if (j == 0 && tq == 0) Dl[64 + k] = eb; }
      *(LAS u32x4*)(KfT + k * TS + tq * 16) = (u32x4){cvtpk(kf[0], kf[1]), cvtpk(kf[2], kf[3]), cvtpk(kf[4], kf[5]), cvtpk(kf[6], kf[7])};
      *(LAS u32x4*)(KbT + k * TS + tq * 16) = (u32x4){cvtpk(kb[0], kb[1]), cvtpk(kb[2], kb[3]), cvtpk(kb[4], kb[5]), cvtpk(kb[6], kb[7])}; }
    __syncthreads();
    { const int dir = wave >> 2, vb = wave & 3; const LAS unsigned char* KT = dir ? KbT : KfT;
      const int vbase = (int)(unsigned)(uintptr_t)Vt + v_rd_base(lane) + vb * 512;
      const s16x4 l0 = tr_read<v_rd_off(0, 0, 0)>(vbase), h0 = tr_read<v_rd_off(0, 0, 1)>(vbase), l1 = tr_read<v_rd_off(0, 1, 0)>(vbase), h1 = tr_read<v_rd_off(0, 1, 1)>(vbase);
      const s16x4 l2 = tr_read<v_rd_off(0, 2, 0)>(vbase), h2 = tr_read<v_rd_off(0, 2, 1)>(vbase), l3 = tr_read<v_rd_off(0, 3, 0)>(vbase), h3 = tr_read<v_rd_off(0, 3, 1)>(vbase);
      asm volatile("s_waitcnt lgkmcnt(0)" ::: "memory");
#define GLA_PK(L, H) (bf16x8){L[0], L[1], L[2], L[3], H[0], H[1], H[2], H[3]}
      const bf16x8 vf0 = GLA_PK(l0, h0), vf1 = GLA_PK(l1, h1), vf2 = GLA_PK(l2, h2), vf3 = GLA_PK(l3, h3);
      float* Ub = U + ((size_t)unit * 2 + dir) * 8192;
#pragma unroll
      for (int rb = 0; rb < 2; ++rb) { f32x16 acc = {};
          const LAS unsigned char* ar = KT + (rb * 32 + r32) * TS + hi * 16;
          acc = __builtin_amdgcn_mfma_f32_32x32x16_bf16(*(const LAS bf16x8*)(ar), vf0, acc, 0, 0, 0);
          acc = __builtin_amdgcn_mfma_f32_32x32x16_bf16(*(const LAS bf16x8*)(ar + 32), vf1, acc, 0, 0, 0);
          acc = __builtin_amdgcn_mfma_f32_32x32x16_bf16(*(const LAS bf16x8*)(ar + 64), vf2, acc, 0, 0, 0);
          acc = __builtin_amdgcn_mfma_f32_32x32x16_bf16(*(const LAS bf16x8*)(ar + 96), vf3, acc, 0, 0, 0);
#pragma unroll
          for (int r = 0; r < 16; ++r) { const int k = rb * 32 + crow(r, hi); Ub[k * 128 + vb * 32 + r32] = acc[r] * Dl[dir * 64 + k]; } }
      if (tid < 128) DD[(size_t)unit * 128 + tid] = Dl[tid]; }
    __syncthreads();
}

constexpr int GLA_G2_ITEMS = (NPB + NDB) * 6 * 2 * 4;
__device__ __forceinline__ void gla_g2_item(const Args& a, int l, int item, int tid) {
    unsigned char* ws = a.ws; const float* U = (const float*)(ws + WS_U); const float* DD = (const float*)(ws + WS_DD); bf16* ST = (bf16*)(ws + WS_ST);
    const int kq = item & 3, dir = (item >> 2) & 1, hs = item >> 3, h = hs % 6, sq = hs / 6;
    const bool smp = sq < NDB; const int b = smp ? sq : sq - NDB, nc = smp ? DSEQ / 64 : SEQ / 64, gc0 = smp ? (MP / 64) + b * (DSEQ / 64) : b * (SEQ / 64);
    const int v = tid & 127, k0 = kq * 16 + (tid >> 7) * 4;
    f32x4 s;
#pragma unroll
    for (int i = 0; i < 4; ++i) s[i] = smp ? a.in[I_STB][((((size_t)b * DEPTH + l) * 2 + dir) * 6 + h) * 8192 + (k0 + i) * 128 + v] : 0.f;
    const int step = smp ? 8 : 4;
    for (int ci = 0; ci < nc; ci += step) {
        float u[8][4]; f32x4 d[8];
#pragma unroll
        for (int j = 0; j < 8; ++j) if (j < step) { const int c = dir ? nc - 1 - (ci + j) : ci + j; const size_t ub = ((size_t)(gc0 + c) * 6 + h) * 2 + dir; d[j] = *(const f32x4*)(DD + ub * 64 + k0);
#pragma unroll
            for (int i = 0; i < 4; ++i) u[j][i] = U[ub * 8192 + (k0 + i) * 128 + v]; }
#pragma unroll
        for (int j = 0; j < 8; ++j) if (j < step) { const int c = dir ? nc - 1 - (ci + j) : ci + j; const size_t ub = ((size_t)(gc0 + c) * 6 + h) * 2 + dir;
#pragma unroll
            for (int i = 0; i < 4; ++i) { ST[ub * 8192 + (size_t)(k0 + i) * 128 + v] = (bf16)f2bf(s[i]); s[i] = d[j][i] * s[i] + u[j][i]; } }
    }
    if (!smp) {
#pragma unroll
        for (int i = 0; i < 4; ++i) a.out[O_SB + ((((size_t)b * DEPTH + l) * 2 + dir) * 6 + h) * 8192 + (k0 + i) * 128 + v] = s[i];
    }
}

__device__ __forceinline__ void gla_g3_unit(const Args& a, int l, int unit, LAS unsigned char* lds, int tid) {
    using namespace att;
    unsigned char* ws = a.ws; const bf16* P = (const bf16*)(ws + WS_P); const bf16* QK4 = (const bf16*)(ws + WS_QK4); const bf16* ST = (const bf16*)(ws + WS_ST); bf16* MIX = (bf16*)(ws + WS_MIX);
    const int gc = unit / 6, h = unit % 6, m0 = gc * 64;
    const int wave = tid >> 6, lane = tid & 63, r32 = lane & 31, hi = lane >> 5;
    LAS unsigned char* T4 = lds;
    LAS unsigned char* Vt = lds + 36864;
    LAS unsigned char* AT = lds + 53248;
    LAS unsigned char* St = lds + 71680;
    LAS float* OT = (LAS float*)(lds + 71680);
    { const int row = tid >> 3, ch = tid & 7; const bf16* src = QK4 + (size_t)(m0 + row) * 1536 + h * 64 + ch * 8;
#pragma unroll
      for (int var = 0; var < 4; ++var) *(LAS bf16x8*)(T4 + var * 9216 + row * TS + ch * 16) = *reinterpret_cast<const bf16x8*>(src + var * 384);
      const int sr = tid >> 4, sc = (tid & 15) * 8;
      const bf16x8 v0 = *reinterpret_cast<const bf16x8*>(P + (size_t)(m0 + sr) * NINP + C_BV + h * 128 + sc), v1 = *reinterpret_cast<const bf16x8*>(P + (size_t)(m0 + 32 + sr) * NINP + C_BV + h * 128 + sc);
      *(LAS bf16x8*)(Vt + v_st(sr, sc)) = v0; *(LAS bf16x8*)(Vt + v_st(32 + sr, sc)) = v1;
#pragma unroll
      for (int dir = 0; dir < 2; ++dir) { const bf16* Sg = ST + (((size_t)unit) * 2 + dir) * 8192;
          const bf16x8 a0 = *reinterpret_cast<const bf16x8*>(Sg + (size_t)sr * 128 + sc), a1 = *reinterpret_cast<const bf16x8*>(Sg + (size_t)(32 + sr) * 128 + sc);
          *(LAS bf16x8*)(St + dir * 16384 + v_st(sr, sc)) = a0; *(LAS bf16x8*)(St + dir * 16384 + v_st(32 + sr, sc)) = a1; } }
    __syncthreads();
    { const int dir = wave >> 2, tb = (wave >> 1) & 1, sb = wave & 1;
      const LAS unsigned char* Qt = T4 + (dir * 2) * 9216 + (tb * 32 + r32) * TS + hi * 16; const LAS unsigned char* Kt = T4 + (dir * 2 + 1) * 9216 + (sb * 32 + r32) * TS + hi * 16;
      f32x16 acc = {};
#pragma unroll
      for (int ks = 0; ks < 4; ++ks) acc = __builtin_amdgcn_mfma_f32_32x32x16_bf16(*(const LAS bf16x8*)(Kt + ks * 32), *(const LAS bf16x8*)(Qt + ks * 32), acc, 0, 0, 0);
      const int t = tb * 32 + r32;
#pragma unroll
      for (int r = 0; r < 16; ++r) { const int s = sb * 32 + crow(r, hi); const bool keep = dir ? (s >= t) : (s <= t); acc[r] = keep ? acc[r] : 0.f; }
#pragma unroll
      for (int g = 0; g < 4; ++g) { v2u w; w.x = cvtpk(acc[4 * g], acc[4 * g + 1]); w.y = cvtpk(acc[4 * g + 2], acc[4 * g + 3]);
          *(LAS v2u*)(AT + dir * 9216 + t * TS + (sb * 32 + 8 * g + 4 * hi) * 2) = w; } }
    __syncthreads();
    { const int tb = wave >> 2, vb = wave & 3; f32x16 o = {};
      const int vbase = (int)(unsigned)(uintptr_t)Vt + v_rd_base(lane) + vb * 512;
      const s16x4 l0 = tr_read<v_rd_off(0, 0, 0)>(vbase), h0 = tr_read<v_rd_off(0, 0, 1)>(vbase), l1 = tr_read<v_rd_off(0, 1, 0)>(vbase), h1 = tr_read<v_rd_off(0, 1, 1)>(vbase);
      const s16x4 l2 = tr_read<v_rd_off(0, 2, 0)>(vbase), h2 = tr_read<v_rd_off(0, 2, 1)>(vbase), l3 = tr_read<v_rd_off(0, 3, 0)>(vbase), h3 = tr_read<v_rd_off(0, 3, 1)>(vbase);
      asm volatile("s_waitcnt lgkmcnt(0)" ::: "memory");
      const bf16x8 vf0 = GLA_PK(l0, h0), vf1 = GLA_PK(l1, h1), vf2 = GLA_PK(l2, h2), vf3 = GLA_PK(l3, h3);
#pragma unroll
      for (int dir = 0; dir < 2; ++dir) {
          const int sbase = (int)(unsigned)(uintptr_t)(St + dir * 16384) + v_rd_base(lane) + vb * 512;
          const s16x4 a0 = tr_read<v_rd_off(0, 0, 0)>(sbase), b0 = tr_read<v_rd_off(0, 0, 1)>(sbase), a1 = tr_read<v_rd_off(0, 1, 0)>(sbase), b1 = tr_read<v_rd_off(0, 1, 1)>(sbase);
          const s16x4 a2 = tr_read<v_rd_off(0, 2, 0)>(sbase), b2 = tr_read<v_rd_off(0, 2, 1)>(sbase), a3 = tr_read<v_rd_off(0, 3, 0)>(sbase), b3 = tr_read<v_rd_off(0, 3, 1)>(sbase);
          asm volatile("s_waitcnt lgkmcnt(0)" ::: "memory");
          const bf16x8 s0 = GLA_PK(a0, b0), s1 = GLA_PK(a1, b1), s2 = GLA_PK(a2, b2), s3 = GLA_PK(a3, b3);
          const LAS unsigned char* Qt = T4 + (dir * 2) * 9216 + (tb * 32 + r32) * TS + hi * 16; const LAS unsigned char* At = AT + dir * 9216 + (tb * 32 + r32) * TS + hi * 16;
          o = __builtin_amdgcn_mfma_f32_32x32x16_bf16(*(const LAS bf16x8*)(Qt), s0, o, 0, 0, 0);
          o = __builtin_amdgcn_mfma_f32_32x32x16_bf16(*(const LAS bf16x8*)(Qt + 32), s1, o, 0, 0, 0);
          o = __builtin_amdgcn_mfma_f32_32x32x16_bf16(*(const LAS bf16x8*)(Qt + 64), s2, o, 0, 0, 0);
          o = __builtin_amdgcn_mfma_f32_32x32x16_bf16(*(const LAS bf16x8*)(Qt + 96), s3, o, 0, 0, 0);
          o = __builtin_amdgcn_mfma_f32_32x32x16_bf16(*(const LAS bf16x8*)(At), vf0, o, 0, 0, 0);
          o = __builtin_amdgcn_mfma_f32_32x32x16_bf16(*(const LAS bf16x8*)(At + 32), vf1, o, 0, 0, 0);
          o = __builtin_amdgcn_mfma_f32_32x32x16_bf16(*(const LAS bf16x8*)(At + 64), vf2, o, 0, 0, 0);
          o = __builtin_amdgcn_mfma_f32_32x32x16_bf16(*(const LAS bf16x8*)(At + 96), vf3, o, 0, 0, 0); }
      __syncthreads();
#pragma unroll
      for (int r = 0; r < 16; ++r) OT[(tb * 32 + crow(r, hi)) * 132 + vb * 32 + r32] = o[r]; }
    __syncthreads();
    { const int t = tid >> 3, c0 = (tid & 7) * 16; const float* bg = a.in[I_BNG] + l * 128 + c0;
      f32x4 x[4]; float ss = 0.f;
#pragma unroll
      for (int i = 0; i < 4; ++i) { x[i] = *(const LAS f32x4*)(OT + t * 132 + c0 + 4 * i); ss += (x[i].x * x[i].x + x[i].y * x[i].y) + (x[i].z * x[i].z + x[i].w * x[i].w); }
      ss += __shfl_xor(ss, 1); ss += __shfl_xor(ss, 2); ss += __shfl_xor(ss, 4);
      const float rs = 1.0f / sqrtf(ss * (1.f / 128.f) + EPS);
      const bf16* rg = P + (size_t)(m0 + t) * NINP + C_BR + h * 128 + c0; const bf16x8 r0 = *reinterpret_cast<const bf16x8*>(rg), r1 = *reinterpret_cast<const bf16x8*>(rg + 8);
      float y[16];
#pragma unroll
      for (int i = 0; i < 4; ++i) { const f32x4 gv = *(const f32x4*)(bg + 4 * i); y[4 * i] = x[i].x * rs * gv.x; y[4 * i + 1] = x[i].y * rs * gv.y; y[4 * i + 2] = x[i].z * rs * gv.z; y[4 * i + 3] = x[i].w * rs * gv.w; }
#pragma unroll
      for (int i = 0; i < 8; ++i) { y[i] *= siluf(bfe(r0, i)); y[8 + i] *= siluf(bfe(r1, i)); }
      bf16* dst = MIX + (size_t)(m0 + t) * DM + 512 + h * 128 + c0;
      *(u32x4*)(dst) = (u32x4){cvtpk(y[0], y[1]), cvtpk(y[2], y[3]), cvtpk(y[4], y[5]), cvtpk(y[6], y[7])};
      *(u32x4*)(dst + 8) = (u32x4){cvtpk(y[8], y[9]), cvtpk(y[10], y[11]), cvtpk(y[12], y[13]), cvtpk(y[14], y[15])}; }
    __syncthreads();
#undef GLA_PK
}

__device__ __forceinline__ void mixer_phase(const Args& a, int l, LAS unsigned char* lds, int tid_in, int bid, int G) {
    unsigned char* ws = a.ws;
    const bf16* P = (const bf16*)(ws + WS_P); const bf16* QC = (const bf16*)(ws + WS_QC); const bf16* KVC = (const bf16*)(ws + WS_KVC); const bf16* KRA = (const bf16*)(ws + WS_KRA); const bf16* KRC = (const bf16*)(ws + WS_KRC);
    const bf16* CAK = (const bf16*)(ws + WS_CAK); const bf16* CAV = (const bf16*)(ws + WS_CAV); const bf16* CKRX = (const bf16*)(ws + WS_CKRX); const bf16* KVCTX = (const bf16*)(ws + WS_KVCTX);
    const float* RTA = (const float*)(ws + WS_RTA); const float* RTC = (const float*)(ws + WS_RTC); float* OATT = (float*)(ws + WS_OATT); bf16* MIXB = (bf16*)(ws + WS_MIX);
    const float lam = ((const float*)(ws + WS_LAM))[l], li = ((const float*)(ws + WS_LAM))[4 + l]; const float* ag = a.in[I_ANG] + l * 128;
    constexpr int NAS = 256, NCS = 384, NAP = 64, NCP = 96, NFILL = NAP + NCP + GLA_UNITS;
    const bool tuned = G == 256;
    const int per = G / 8, vb = (bid % 8) * per + bid / 8, wx = vb % per, hx = per / 2;
    const bool heavy = wx < hx; const int hidx = (vb / per) * hx + wx, lidx = (vb / per) * hx + (wx - hx);
    const int nl = G / 2;
    const int nslots = tuned ? 3 + (!heavy ? (NFILL + nl - 1) / nl : 0) : (NAS + NCS + NFILL + G - 1) / G;
    for (int sl = 0; sl < nslots; ++sl) {
        int tid = tid_in; asm volatile("" : "+v"(tid));
        int kind, u, f = -1;
        if (!tuned) { const int g = bid + sl * G; if (g >= NAS + NCS + NFILL) continue; if (g < NAS) { kind = 0; u = g; } else if (g < NAS + NCS) { kind = 1; u = g - NAS; } else { kind = 5; u = 0; f = g - NAS - NCS; } }
        else if (sl == 0) { kind = 0; u = vb; }
        else if (sl == 1) { kind = 1; u = vb; }
        else if (sl == 2) { if (heavy) { kind = 1; u = G + hidx; } else continue; }
        else { kind = 5; u = 0; f = lidx + (sl - 3) * nl; if (f >= NFILL) continue; }
        if (kind == 5) { if (f < NAP) { kind = 2; u = f; } else if (f < NAP + NCP) { kind = 3; u = f - NAP; } else { kind = 4; u = f - NAP - NCP; } }
        if (kind == 0 && u >= NAS) continue;
        if (kind == 1 && u >= NCS) continue;
        if (kind == 4) { gla_g3_unit(a, l, u, lds, tid); continue; }
        if (kind == 0 || kind == 2) {
            int b, head, qb; size_t r0;
            if (kind == 0) { b = u >> 6; head = (u >> 4) & 3; qb = u & 15; r0 = (size_t)MP + (size_t)b * DSEQ; } else { b = u >> 2; head = u & 3; qb = 0; r0 = (size_t)b * SEQ; }
#pragma unroll 1
            for (int ps = 0; ps < 2; ++ps) { const int combo = head * 2 + ps; int tid2 = tid; asm volatile("" : "+v"(tid2));
                KSeg ctx{nullptr, 0, nullptr, 0, nullptr, 0, 0}, lat;
                if (kind == 0) { ctx = KSeg{CAK + ((size_t)(b * DEPTH + l) * PAST) * 512 + combo * 64, 512, nullptr, 0, CAV + ((size_t)(b * DEPTH + l) * PAST) * 512 + head * 128, 512, PAST};
                                 lat = KSeg{KRA + ((size_t)b * DSEQ) * 512 + combo * 64, 512, nullptr, 0, P + r0 * NINP + C_AV + head * 128, NINP, DSEQ}; }
                else lat = KSeg{P + r0 * NINP + C_AK + combo * 64, NINP, nullptr, 0, P + r0 * NINP + C_AV + head * 128, NINP, SEQ};
                attn_mfma_unit<64, 1, false>(lds, P + (r0 + qb * 256) * NINP + C_AQ + combo * 64, NINP, kind == 0, RTA, qb * 256, ctx, lat, 0.125f, OATT + (r0 + qb * 256) * NOATT + head * 128, tid2,
                                             ps == 1, lam, 1.f - li, ag, MIXB + (r0 + qb * 256) * DM + head * 128); }
        } else {
            KSeg ctx{nullptr, 0, nullptr, 0, nullptr, 0, 0}, lat; const bf16* Qp; int t0 = 0; bf16* Op;
            if (kind == 1) { const int b = u / 96, h = (u >> 4) % 6, qb = u & 15; const size_t r0 = (size_t)MP + (size_t)b * DSEQ; const size_t c0 = (size_t)(l * NDB + b) * PAST;
                ctx = KSeg{KVCTX + c0 * NKVP + h * 192, NKVP, CKRX + ((size_t)(b * DEPTH + l) * PAST) * 32, 32, KVCTX + c0 * NKVP + h * 192 + 64, NKVP, PAST};
                lat = KSeg{KVC + r0 * NKVP + h * 192, NKVP, KRC + ((size_t)b * DSEQ) * 32, 32, KVC + r0 * NKVP + h * 192 + 64, NKVP, DSEQ};
                Qp = QC + (r0 + qb * 256) * NQCP + h * 96; t0 = qb * 256; Op = MIXB + (r0 + qb * 256) * DM + 1280 + h * 128; }
            else { const int b = u / 6, h = u % 6; const size_t r0 = (size_t)b * SEQ;
                lat = KSeg{KVC + r0 * NKVP + h * 192, NKVP, P + r0 * NINP + C_CKR, NINP, KVC + r0 * NKVP + h * 192 + 64, NKVP, SEQ};
                Qp = QC + r0 * NQCP + h * 96; Op = MIXB + r0 * DM + 1280 + h * 128; }
            attn_mfma_unit<96, 1, true>(lds, Qp, NQCP, kind == 1, RTC, t0, ctx, lat, 0.10206207261596575f, Op, tid);
        }
    }
}

__device__ __forceinline__ void combine_phase(const Args& a, int l, int gw, int NGW, int lane) {
    using att::cvtpk; using att::u32x4;
    unsigned char* ws = a.ws; const float* OATT = (const float*)(ws + WS_OATT); bf16* MIX = (bf16*)(ws + WS_MIX);
    const float lam = ((const float*)(ws + WS_LAM))[l], li = ((const float*)(ws + WS_LAM))[4 + l];
    const int h = lane >> 4, c8 = (lane & 15) * 8; const float* ag = a.in[I_ANG] + l * 128 + c8;
    const f32x4 g0 = *(const f32x4*)ag * (1.f - li), g1 = *(const f32x4*)(ag + 4) * (1.f - li);
    for (int m = gw; m < M; m += NGW) {
        const float* oa = OATT + (size_t)m * NOATT + (2 * h) * 128 + c8;
        const f32x4 a0 = *(const f32x4*)oa, a1 = *(const f32x4*)(oa + 4), b0 = *(const f32x4*)(oa + 128), b1 = *(const f32x4*)(oa + 132);
        const f32x4 o0 = a0 - b0 * lam, o1 = a1 - b1 * lam;
        float ss = (o0.x * o0.x + o0.y * o0.y) + (o0.z * o0.z + o0.w * o0.w) + (o1.x * o1.x + o1.y * o1.y) + (o1.z * o1.z + o1.w * o1.w);
        ss += __shfl_xor(ss, 1); ss += __shfl_xor(ss, 2); ss += __shfl_xor(ss, 4); ss += __shfl_xor(ss, 8);
        const float r = 1.0f / sqrtf(ss * (1.f / 128.f) + EPS);
        const f32x4 y0 = o0 * r * g0, y1 = o1 * r * g1;
        *(u32x4*)(MIX + (size_t)m * DM + h * 128 + c8) = (u32x4){cvtpk(y0.x, y0.y), cvtpk(y0.z, y0.w), cvtpk(y1.x, y1.y), cvtpk(y1.z, y1.w)};
    }
}

__device__ __forceinline__ void convact_phase(const Args& a, int l, int gw, int NGW, int lane) {
    const bf16* GU = (const bf16*)(a.ws + WS_GU); bf16* ACT = (bf16*)(a.ws + WS_ACT);
    const float* cw = a.in[I_CONVW] + (size_t)l * 3 * DFF; const float* cb = a.in[I_CONVB] + (size_t)l * DFF;
    for (int m = gw; m < M; m += NGW) {
        int t, n; if (m < MP) { t = m % SEQ; n = SEQ; } else { t = (m - MP) % DSEQ; n = DSEQ; }
        const bool hp = t > 0, hn = t < n - 1;
        const bf16* g1 = GU + (size_t)m * (2 * DFF);
        for (int c = lane; c < DFF; c += 64) {
            const float gm = bf2f(g1[c]), gp = hp ? bf2f(g1[c - 2 * DFF]) : 0.f, gn = hn ? bf2f(g1[c + 2 * DFF]) : 0.f, uu = bf2f(g1[DFF + c]);
            const float gc = gp * cw[c] + gm * cw[DFF + c] + gn * cw[2 * DFF + c] + cb[c];
            ACT[(size_t)m * DFF + c] = (bf16)f2bf(siluf(gc) * uu);
        }
    }
}

__device__ __forceinline__ void ffn_fix_phase(const Args& a, int l, int gt, int NGT) {
    const float* side = (const float*)(a.ws + WS_SIDE); bf16* ACT = (bf16*)(a.ws + WS_ACT);
    const float* cw = a.in[I_CONVW] + (size_t)l * 3 * DFF;
    for (int i = gt; i < (MS / 256) * 2 * DFF; i += NGT) { const int j = i % DFF, w = (i / DFF) & 1, pm = 16 + i / (2 * DFF), q = (pm - 16) & 15;
        if (w == 0 ? q == 0 : q == 15) continue;
        const float* sp = side + ((size_t)(pm * 2 + w) * 3) * DFF + j;
        const float gnb = w == 0 ? side[((size_t)((pm - 1) * 2 + 1) * 3 + 2) * DFF + j] : side[((size_t)((pm + 1) * 2 + 0) * 3 + 2) * DFF + j];
        const float gc = sp[0] + cw[(w == 0 ? 0 : 2) * DFF + j] * gnb;
        ACT[(size_t)(pm * 256 + (w == 0 ? 0 : 255)) * DFF + j] = (bf16)f2bf(siluf(gc) * sp[DFF]); }
}

constexpr int PH_PER_LAYER = 11, PH_L0 = 3, PH_FIN = PH_L0 + DEPTH * PH_PER_LAYER, N_PHASES = PH_FIN + 1;
__global__ void __launch_bounds__(NTH, 2) mk_fwd(Args a) {
    extern __shared__ __attribute__((aligned(16))) unsigned char lds_raw[];
    LAS unsigned char* lds = (LAS unsigned char*)lds_raw;
    const int bid = blockIdx.x, G = gridDim.x, wave0 = __builtin_amdgcn_readfirstlane((int)threadIdx.x >> 6);
#define PH_BEGIN int tid = TID_NOW; asm volatile("" : "+v"(tid)); unsigned char* ws = a.ws; asm volatile("" : "+s"(ws)); \
    const int lane = tid & 63, wave = __builtin_amdgcn_readfirstlane(tid >> 6), gw = bid * NWV + wave, NGW = G * NWV, gt = bid * NTH + tid, NGT = G * NTH; (void)lane; (void)gw; (void)NGW; (void)gt; (void)NGT; (void)ws
    {
        volatile LAS unsigned* Z = (volatile LAS unsigned*)(lds + RING_BYTES);
        for (int u = threadIdx.x; u < (LDS_BYTES - RING_BYTES) / 4; u += NTH) Z[u] = 0u;
        __syncthreads();
    }
    if (a.use_bar) (void)xcd_barrier_post((unsigned*)(a.ws + WS_CTL) + 4096, (volatile LAS unsigned*)(lds + MISC_OFF) + 8);
#define bar (XcdBarrier{(unsigned*)(a.ws + WS_CTL) + 4096, xb_xcc_id(), (volatile LAS unsigned*)(lds + MISC_OFF) + 8})
    const int lo = a.ph_lo, hi = a.ph_hi;
#define IN(k) (lo <= (k) && (k) < hi)
#define TID_NOW (wave0 * 64 + (int)__builtin_amdgcn_mbcnt_hi(~0u, __builtin_amdgcn_mbcnt_lo(~0u, 0u)))
#define SEAM(k) do { if (IN(k) && IN((k) + 1)) xcd_barrier(bar, TID_NOW); } while (0)
#ifndef MK_DUP
#define MK_DUP 0
#endif
#define DUP(bit) _Pragma("unroll 1") for (int rep_ = 0; rep_ < (((MK_DUP) & (bit)) ? 2 : 1); ++rep_)

    if (IN(0)) DUP(512) { PH_BEGIN; pro0_phase(a, lds, tid, lane, wave, bid, G); SEAM(0); }
    if (IN(1)) { PH_BEGIN;
        modfin_phase(a, gt, NGT);
        pg8::Gemm g{(const bf16*)(ws + WS_CKVA), (const bf16*)(ws + WS_WKV), DEPTH * NDB * PAST, NKVP, 256, 256, 256, 4, (size_t)NKVP * 256}; pg8::StaticOrder S; S.init(DEPTH * NDB * PAST, NKVP, G, bid);
        pg8::EpiBf16<0> E{(bf16*)(ws + WS_KVCTX), NKVP, nullptr, 0, 0, 1.f};
        pg8::gemm_phase<pg8::EpiBf16<0>, pg8::StaticOrder, true, true>(lds, g, S, E, tid);
        SEAM(1);
    }
    if (IN(2)) DUP(8192) { PH_BEGIN; pro2_phase(a, lds, tid, bid, G, gt, NGT); SEAM(2); }
    for (int l = 0; l < DEPTH; ++l) {
        const int pb = PH_L0 + PH_PER_LAYER * l;
        if (pb + PH_PER_LAYER <= lo || pb >= hi) continue;
#define LAYER_PTRS const float* modl = (const float*)(ws + WS_MOD) + (size_t)l * 5 * 6 * DM; const float* xin0 = l == 0 ? a.in[I_XP] : (const float*)(ws + WS_X); \
        const float* xin1 = l == 0 ? a.in[I_XS] - (size_t)MP * DM : (const float*)(ws + WS_X); float* X = (float*)(ws + WS_X); (void)modl; (void)xin0; (void)xin1; (void)X
        if (IN(pb + 0) && l == 0) { PH_BEGIN; norm0_phase(a.in[I_XP], a.in[I_XS] - (size_t)MP * DM, (const float*)(ws + WS_GM), (bf16*)(ws + WS_H), (float*)(ws + WS_SSQP), gw, NGW, lane); SEAM(pb + 0); }
        if (IN(pb + 1)) DUP(2) { PH_BEGIN;
            pg8::Gemm g{(const bf16*)(ws + WS_H), (const bf16*)(ws + WS_WIN + l * SZ_WIN), M, NINP, DM, DM, DM, 1 << 20, 0}; pg8::StaticOrder S; S.init(M, NINP, G, bid);
            pg8::EpiBf16Norm E{(bf16*)(ws + WS_P), NINP, (const float*)(ws + WS_SSQP) + (size_t)(2 * l) * M * 32, (const float*)(ws + WS_SHWI) + (size_t)l * 5 * NINP, NINP, (LAS float*)(lds + RING_BYTES + 8192)};
            pg8::gemm_phase<pg8::EpiBf16Norm, pg8::StaticOrder, true, true>(lds, g, S, E, tid);
            SEAM(pb + 1);
        }
        if (IN(pb + 2)) DUP(4) { PH_BEGIN; post_phase(a, l, gw, NGW, lane);
#if 1
            __syncthreads();
            for (int u = bid; u < GLA_UNITS; u += G) { int t2 = tid; asm volatile("" : "+v"(t2)); gla_g1_unit(a, l, u, lds, t2); }
#endif
            SEAM(pb + 2); }
        if (IN(pb + 3)) DUP(8) {
            { PH_BEGIN; pg8::Gemm g{(const bf16*)(ws + WS_CQN), (const bf16*)(ws + WS_WQ + l * SZ_WQ), M, NQCP, 384, 384, 384, 1 << 20, 0}; pg8::StaticOrder S; S.init(M, NQCP, G, bid);
              pg8::EpiBf16<0> E{(bf16*)(ws + WS_QC), NQCP, nullptr, NQCP, 0, 0.10206207261596575f * 1.4426950408889634f};
              pg8::gemm_phase<pg8::EpiBf16<0>, pg8::StaticOrder, true, true>(lds, g, S, E, tid); }
            __syncthreads();
            { PH_BEGIN; pg8::Gemm g{(const bf16*)(ws + WS_CKVN), (const bf16*)(ws + WS_WKV + l * SZ_WKV), M, NKVP, 256, 256, 256, 1 << 20, 0}; pg8::StaticOrder S; S.init(M, NKVP, G, bid);
              pg8::EpiBf16<0> E{(bf16*)(ws + WS_KVC), NKVP, nullptr, 0, 0, 1.f};
              pg8::gemm_phase<pg8::EpiBf16<0>, pg8::StaticOrder, true, true>(lds, g, S, E, tid); }
#if MK_MFMA_GLA
            { PH_BEGIN; for (int it = bid; it < GLA_G2_ITEMS; it += G) gla_g2_item(a, l, it, tid); }
#endif
            SEAM(pb + 3);
        }
        if (IN(pb + 4)) DUP(16) { PH_BEGIN; mixer_phase(a, l, lds, tid, bid, G); if (IN(pb + 6)) xcd_barrier(bar, TID_NOW); }
        if (IN(pb + 6)) { PH_BEGIN; LAYER_PTRS;
            constexpr int NFULL = 512;
            { pg8::Gemm g{(const bf16*)(ws + WS_MIX), (const bf16*)(ws + WS_WOUT + l * SZ_WOUT), M, DM, DM, DM, DM, 1 << 20, 0}; pg8::StaticOrder S; S.init(M, DM, G, bid); S.lim = (MK_SPLITK && G == 256) ? NFULL : S.nwg;
              pg8::EpiResid E{MK_SPLITK ? X : xin0, MK_SPLITK ? X : xin1, X, modl + 2 * DM, (bf16*)(ws + WS_H), (const float*)(ws + WS_GM) + (size_t)(l * 2 + 1) * 5 * DM, (float*)(ws + WS_SSQP) + (size_t)(2 * l + 1) * M * 32};
              pg8::gemm_phase<pg8::EpiResid, pg8::StaticOrder, true, true>(lds, g, S, E, tid); }
            if (MK_SPLITK && G == 256) { __syncthreads(); int t3 = tid; asm volatile("" : "+v"(t3)); (void)t3;
              pg8::Gemm g{(const bf16*)(ws + WS_MIX), (const bf16*)(ws + WS_WOUT + l * SZ_WOUT), M, DM, DM / 2, DM, DM, 1 << 20, 0}; pg8::TailOrder S; S.init(M, DM, G, bid); S.base = NFULL; S.nth = DM / 128;
              pg8::EpiResidTail E{X, modl + 2 * DM, (float*)(ws + WS_SPLITK), (unsigned*)(ws + WS_CTL) + CW_TICKET + (l * 2 + 0) * 128 * 64, (LAS unsigned*)(lds + RING_BYTES + 2048)};
              pg8::gemm_phase<pg8::EpiResidTail, pg8::TailOrder, true, true>(lds, g, S, E, tid); }
            SEAM(pb + 6);
        }
        if (IN(pb + 8)) DUP(128) { PH_BEGIN;
            pg8::Gemm g{(const bf16*)(ws + WS_H), (const bf16*)(ws + WS_WUP + l * SZ_WUP), M, 2 * DFF, DM, DM, DM, 1 << 20, 0}; pg8::StaticOrder S; S.init(M, 2 * DFF, G, bid);
            pg8::EpiConvAct E{(bf16*)(ws + WS_ACT), a.in[I_CONVW] + (size_t)l * 3 * DFF, a.in[I_CONVB] + (size_t)l * DFF, (float*)(ws + WS_SIDE), (LAS float*)(lds + RING_BYTES + 4096),
                               (const float*)(ws + WS_SSQP) + (size_t)(2 * l + 1) * M * 32, (const float*)(ws + WS_SHWU) + (size_t)l * 5 * 2 * DFF, (LAS float*)(lds + RING_BYTES + 8192)};
            pg8::gemm_phase<pg8::EpiConvAct, pg8::StaticOrder, true, true>(lds, g, S, E, tid);
            SEAM(pb + 8);
        }
        if (IN(pb + 9)) DUP(256) { PH_BEGIN; ffn_fix_phase(a, l, gt, NGT); SEAM(pb + 9); }
        if (IN(pb + 10)) { PH_BEGIN; LAYER_PTRS;
            constexpr int NFULL = 512;
            { pg8::Gemm g{(const bf16*)(ws + WS_ACT), (const bf16*)(ws + WS_WDN + l * SZ_WDN), M, DM, DFF, DFF, DFF, 1 << 20, 0}; pg8::StaticOrder S; S.init(M, DM, G, bid); S.lim = (MK_SPLITK && G == 256) ? NFULL : S.nwg;
              pg8::EpiResid E{X, X, X, modl + 5 * DM, l + 1 < DEPTH ? (bf16*)(ws + WS_H) : nullptr, (const float*)(ws + WS_GM) + (size_t)((l + 1 < DEPTH ? l + 1 : l) * 2) * 5 * DM, (float*)(ws + WS_SSQP) + (size_t)(2 * (l + 1 < DEPTH ? l + 1 : l)) * M * 32};
              pg8::gemm_phase<pg8::EpiResid, pg8::StaticOrder, true, true>(lds, g, S, E, tid); }
            if (MK_SPLITK && G == 256) { __syncthreads(); int t3 = tid; asm volatile("" : "+v"(t3)); (void)t3;
              pg8::Gemm g{(const bf16*)(ws + WS_ACT), (const bf16*)(ws + WS_WDN + l * SZ_WDN), M, DM, DFF / 2, DFF, DFF, 1 << 20, 0}; pg8::TailOrder S; S.init(M, DM, G, bid); S.base = NFULL; S.nth = DFF / 128;
              pg8::EpiResidTail E{X, modl + 5 * DM, (float*)(ws + WS_SPLITK), (unsigned*)(ws + WS_CTL) + CW_TICKET + (l * 2 + 1) * 128 * 64, (LAS unsigned*)(lds + RING_BYTES + 2048)};
              pg8::gemm_phase<pg8::EpiResidTail, pg8::TailOrder, true, true>(lds, g, S, E, tid); }
            SEAM(pb + 10);
        }
    }
    if (IN(PH_FIN)) { PH_BEGIN; final_norm_phase((const float*)(ws + WS_X), a.in[I_FING], a.out, gw, NGW, lane); }
#undef IN
#undef SEAM
#undef bar
}

#ifndef MK_ONE_LAUNCH
#define MK_ONE_LAUNCH 1
#endif
extern "C" void kernel_launch(void* const* d_in, const int* in_sizes, int n_in, void* d_out, int out_size, void* d_ws, size_t ws_size, hipStream_t stream) {
    static int grid = 0;
    if (grid == 0) {
        if (n_in != N_INPUTS || (size_t)out_size != O_END || ws_size < WS_END) { fprintf(stderr, "kernel_launch: shape mismatch: n_in %d out %d ws %zu (need %zu)\n", n_in, out_size, ws_size, (size_t)WS_END); grid = -1; return; }
        int dev = 0, cus = 0, per_cu = 0;
        if (hipGetDevice(&dev) != hipSuccess || hipDeviceGetAttribute(&cus, hipDeviceAttributeMultiprocessorCount, dev) != hipSuccess) { grid = -1; return; }
        if (hipFuncSetAttribute((const void*)mk_fwd, hipFuncAttributeMaxDynamicSharedMemorySize, LDS_BYTES) != hipSuccess) { fprintf(stderr, "kernel_launch: hipFuncSetAttribute failed\n"); grid = -1; return; }
        if (hipOccupancyMaxActiveBlocksPerMultiprocessor(&per_cu, (const void*)mk_fwd, NTH, LDS_BYTES) != hipSuccess || per_cu < 1) fprintf(stderr, "kernel_launch: occupancy query reports %d\n", per_cu);
        (void)hipGetLastError();
        grid = cus;
    }
    if (grid < 0) return;
    if (hipMemsetAsync((char*)d_ws + WS_CTL, 0, CTL_ZERO_BYTES, stream) != hipSuccess) return;
    Args a{};
    for (int i = 0; i < N_INPUTS; ++i) a.in[i] = (const float*)d_in[i];
    a.out = (float*)d_out; a.ws = (unsigned char*)d_ws; a.pad = 0;
#if MK_ONE_LAUNCH
    a.ph_lo = 0; a.ph_hi = N_PHASES; a.use_bar = 1;
    hipLaunchKernelGGL(mk_fwd, dim3(grid), dim3(NTH), LDS_BYTES, stream, a);
#else
    for (int p = 0; p < N_PHASES; ++p) { a.ph_lo = p; a.ph_hi = p + 1; a.use_bar = 0; hipLaunchKernelGGL(mk_fwd, dim3(grid), dim3(NTH), LDS_BYTES, stream, a); }
#endif
    const hipError_t le = hipPeekAtLastError();
    if (le != hipSuccess) fprintf(stderr, "kernel_launch: launch failed: %s\n", hipGetErrorName(le));
}
```

```cpp
#include <hip/hip_runtime.h>
#include <cstdio>
#include <cstdint>
#include <cmath>

namespace pg8 {
#define PG8_LAS __attribute__((address_space(3)))
typedef unsigned short bf16_t;
typedef short bf16x8 __attribute__((ext_vector_type(8)));
typedef float f32x4 __attribute__((ext_vector_type(4)));
typedef unsigned u32x4 __attribute__((ext_vector_type(4)));
constexpr int BM = 256, BK = 64, HALF = 128, HTB = HALF * BK * 2  , STAGE_BYTES = 8 * HTB, NXCD = 8, WGM = 8;

__host__ __device__ __forceinline__ int lds_byte(int r, int c) { const int st = (r >> 4) * 2 + (c >> 5), rr = r & 15, cc = c & 31, ob = rr * 64 + cc * 2; return st * 1024 + (ob ^ (((ob >> 9) & 1) << 5)); }
__host__ __device__ __forceinline__ void stage_rc(int b, int& R, int& C) { const int st = b / 1024, sb = b % 1024, swz = sb ^ (((sb >> 9) & 1) << 5); R = (st >> 1) * 16 + swz / 64; C = (st & 1) * 32 + (swz % 64) / 2; }
__host__ __device__ __forceinline__ int perm32(int rho) { const int n = rho >> 4, i = rho & 15; return 8 * (i >> 2) + 4 * n + (i & 3); }

struct Unit { int pm, pn, kt0; };
struct Gemm { const bf16_t* A; const bf16_t* Bt; int M, N, K, lda, ldb, bgrp; size_t bgrp_stride; };

struct StaticOrder {
    int nM, nN, nwg, G, c;
    __host__ __device__ void init(int M, int N, int G_, int c_) { nM = M / BM; nN = N / BM; nwg = nM * nN; G = G_; c = c_; lim = nwg; }
    int lim;
    __host__ __device__ void map(int wgid, Unit& u) const {
        { const int q = nwg / NXCD, r = nwg % NXCD, xcd = wgid % NXCD, off = wgid / NXCD; wgid = (xcd < r ? xcd * (q + 1) : r * (q + 1) + (xcd - r) * q) + off; }
        const int nig = WGM * nN, gid = wgid / nig, fm = gid * WGM, gsz = (nM - fm) < WGM ? (nM - fm) : WGM;
        u.pm = fm + ((wgid % nig) % gsz); u.pn = (wgid % nig) / gsz; u.kt0 = 0;
    }
    __host__ __device__ bool next(int i, Unit& u) const {
        const long L = (long)i * G + c; if (L >= lim) return false;
        map((int)L, u); return true;
    }
    __device__ __forceinline__ void a_ready(const Unit&) const {}
    __device__ __forceinline__ void done(const Unit&) const {}
};

struct TailOrder : StaticOrder {
    int base, nth;
    __host__ __device__ bool next(int i, Unit& u) const { if (i > 0) return false; const int L = base + (c >> 1); if (L >= nwg) return false; map(L, u); u.kt0 = (c & 1) * nth; return true; }
};

__device__ __forceinline__ unsigned cvt_pk_bf16(float lo, float hi) { unsigned r; asm volatile("v_cvt_pk_bf16_f32 %0, %1, %2" : "=v"(r) : "v"(lo), "v"(hi)); return r; }
typedef float f32x2 __attribute__((ext_vector_type(2)));
__device__ __forceinline__ f32x2 gelu_pk(f32x2 v) {
    const f32x2 av = __builtin_elementwise_abs(v), d = av * 0.2316418882f + 1.0f;
    f32x2 t; t.x = __builtin_amdgcn_rcpf(d.x); t.y = __builtin_amdgcn_rcpf(d.y);
    f32x2 q = t * 0.5307027145f + (-0.7265760135f); q = q * t + 0.7107068705f; q = q * t + (-0.142248368f); q = q * t + 0.127414796f; q = q * t;
    const f32x2 s = (v * v) * (-0.72134752044f);
    f32x2 e; e.x = __builtin_amdgcn_exp2f(s.x); e.y = __builtin_amdgcn_exp2f(s.y);
    const f32x2 m = v * (q * e), r = v - m;
    f32x2 o; o.x = v.x < 0.f ? m.x : r.x; o.y = v.y < 0.f ? m.y : r.y; return o;
}

template <int ACT  > struct EpiBf16 {
    static constexpr bool PERM = true, AFTER_DRAIN = false; static_assert(ACT == 0 || ACT == 1, "EpiBf16: ACT is 0 (none) or 1 (gelu_pk)");
    bf16_t* O; int ldc; const float* bias; int split_cols; size_t split_stride; float scale0;
    __device__ __forceinline__ void operator()(const f32x4 (&acc)[2][2][4][2], const Unit& u, int wr, int wc, int fr, int fq) const {
        const int row0 = u.pm * BM + wr * 64 + fr; int colt = u.pn * BM; bf16_t* base = O;
        float sc = 1.f; if (split_cols) { const int t = colt / split_cols; base += (size_t)t * split_stride; colt -= t * split_cols; if (t == 0) sc = scale0; }
        const int col0 = colt + wc * 32 + 8 * fq, bcol0 = u.pn * BM + wc * 32 + 8 * fq;
        f32x4 bv[2][2];
#pragma unroll
        for (int bj = 0; bj < 2; ++bj)
#pragma unroll
            for (int n = 0; n < 2; ++n) bv[bj][n] = bias ? *(const f32x4*)(bias + bcol0 + bj * HALF + 4 * n) : (f32x4){0.f, 0.f, 0.f, 0.f};
#pragma unroll
        for (int ai = 0; ai < 2; ++ai)
#pragma unroll
            for (int m = 0; m < 4; ++m) { bf16_t* rowp = base + (size_t)(row0 + ai * HALF + m * 16) * ldc + col0;
#pragma unroll
                for (int bj = 0; bj < 2; ++bj) { f32x4 v0 = acc[ai][bj][m][0] + bv[bj][0], v1 = acc[ai][bj][m][1] + bv[bj][1];
                    if (ACT == 1) { f32x2 a = gelu_pk((f32x2){v0[0], v0[1]}), b = gelu_pk((f32x2){v0[2], v0[3]}), c = gelu_pk((f32x2){v1[0], v1[1]}), d = gelu_pk((f32x2){v1[2], v1[3]});
                        v0 = (f32x4){a.x, a.y, b.x, b.y}; v1 = (f32x4){c.x, c.y, d.x, d.y}; }
                    v0 = v0 * sc; v1 = v1 * sc; u32x4 w; w.x = cvt_pk_bf16(v0[0], v0[1]); w.y = cvt_pk_bf16(v0[2], v0[3]); w.z = cvt_pk_bf16(v1[0], v1[1]); w.w = cvt_pk_bf16(v1[2], v1[3]);
                    *(u32x4*)(rowp + bj * HALF) = w; } }
    }
};

template <class Epi, class Sched, bool ALIGN_EPI = false, bool SP2 = false>
__device__ __forceinline__ void gemm_phase(PG8_LAS unsigned char* lds, const Gemm g, const Sched& S, const Epi& E, int tid_in) {
    int tid_ = tid_in; asm volatile("" : "+v"(tid_));
    const int tid = tid_, wid = __builtin_amdgcn_readfirstlane(tid >> 6), lane = tid & 63, wr = wid >> 2, wc = wid & 3, fr = lane & 15, fq = lane >> 4;
    const int K = g.K, nt = K / BK;
    unsigned voffA[2], voffB[2];
#pragma unroll
    for (int i = 0; i < 2; ++i) { int R, C; stage_rc(tid * 16 + i * 8192, R, C); const int Rb = Epi::PERM ? ((R & ~31) + perm32(R & 31)) : R;
        voffA[i] = (unsigned)(R * g.lda + C) * 2u; voffB[i] = (unsigned)(Rb * g.ldb + C) * 2u; }
    const size_t kstep = (size_t)(BK * 2);
    const size_t hstepA = (size_t)HALF * g.lda * 2, hstepB = (size_t)HALF * g.ldb * 2;
    const size_t tstepA = 2 * hstepA, tstepB = 2 * hstepB;
    const unsigned ldsw = (unsigned)wid * 1024u;
    const int aoff = lds_byte(wr * 64 + fr, fq * 8), boff = lds_byte(wc * 32 + fr, fq * 8);
#define PG8_SA(b, h) (((b) * 2 + (h)) * HTB)
#define PG8_SB(b, h) ((4 + (b) * 2 + (h)) * HTB)
#define PG8_STAGE(bufoff, gbase, voff) do { _Pragma("unroll") for (int _i = 0; _i < 2; ++_i) \
        __builtin_amdgcn_global_load_lds((const unsigned*)((const char*)(gbase) + (voff)[_i]), (PG8_LAS unsigned*)(lds + (bufoff) + ldsw + _i * 8192), 16, 0, 0); } while (0)
#define PG8_LDA(dst, b, h) do { _Pragma("unroll") for (int m = 0; m < 4; ++m) _Pragma("unroll") for (int k = 0; k < 2; ++k) dst[m][k] = *(const PG8_LAS bf16x8*)(lds + PG8_SA(b, h) + aoff + m * 2048 + k * 1024); } while (0)
#define PG8_LDB(dst, b, h) do { _Pragma("unroll") for (int n = 0; n < 2; ++n) _Pragma("unroll") for (int k = 0; k < 2; ++k) dst[n][k] = *(const PG8_LAS bf16x8*)(lds + PG8_SB(b, h) + boff + n * 2048 + k * 1024); } while (0)
#define PG8_MMA(ai, bj, At, Bt) do { __builtin_amdgcn_s_setprio(1); _Pragma("unroll") for (int m = 0; m < 4; ++m) _Pragma("unroll") for (int n = 0; n < 2; ++n) _Pragma("unroll") for (int k = 0; k < 2; ++k) \
        acc[ai][bj][m][n] = __builtin_amdgcn_mfma_f32_16x16x32_bf16(Bt[n][k], At[m][k], acc[ai][bj][m][n], 0, 0, 0); __builtin_amdgcn_s_setprio(0); } while (0)
#define PG8_WAIT_V(n) asm volatile("s_waitcnt vmcnt(" #n ")" ::: "memory")
#define PG8_WAIT_L(n) asm volatile("s_waitcnt lgkmcnt(" #n ")" ::: "memory")
#define PG8_BAR __builtin_amdgcn_s_barrier()
#define PG8_SCHED __builtin_amdgcn_sched_barrier(0)
    Unit cur, nxt; int ui = 0;
    if (!S.next(0, cur)) return;
    f32x4 acc[2][2][4][2];
#pragma unroll
    for (int a = 0; a < 2; ++a)
#pragma unroll
        for (int b = 0; b < 2; ++b)
#pragma unroll
            for (int m = 0; m < 4; ++m)
#pragma unroll
                for (int n = 0; n < 2; ++n) acc[a][b][m][n] = (f32x4){0.f, 0.f, 0.f, 0.f};
    bf16x8 At[4][2], B0[2][2], B1[2][2];
    const char* cA = (const char*)g.A + (size_t)cur.pm * tstepA + (size_t)cur.kt0 * kstep; const char* cB = (const char*)g.Bt + (size_t)(cur.pm / g.bgrp) * g.bgrp_stride * 2 + (size_t)cur.pn * tstepB + (size_t)cur.kt0 * kstep;
    S.a_ready(cur);
    if constexpr (SP2) {
        PG8_STAGE(PG8_SB(0, 0), cB, voffB); PG8_STAGE(PG8_SB(0, 1), cB + hstepB, voffB); PG8_STAGE(PG8_SA(0, 0), cA, voffA); PG8_STAGE(PG8_SA(0, 1), cA + hstepA, voffA);
        if (wr == 1) PG8_BAR;
        PG8_WAIT_V(2); PG8_BAR;
        PG8_STAGE(PG8_SB(1, 0), cB + kstep, voffB); PG8_STAGE(PG8_SA(1, 0), cA + kstep, voffA); PG8_STAGE(PG8_SB(1, 1), cB + hstepB + kstep, voffB);
        PG8_WAIT_V(6); PG8_BAR;
    } else {
        PG8_STAGE(PG8_SB(0, 0), cB, voffB); PG8_STAGE(PG8_SA(0, 0), cA, voffA); PG8_STAGE(PG8_SB(0, 1), cB + hstepB, voffB); PG8_STAGE(PG8_SA(0, 1), cA + hstepA, voffA);
        if (wr == 1) PG8_BAR;
        PG8_WAIT_V(4); PG8_BAR;
        PG8_STAGE(PG8_SB(1, 0), cB + kstep, voffB); PG8_STAGE(PG8_SA(1, 0), cA + kstep, voffA); PG8_STAGE(PG8_SB(1, 1), cB + hstepB + kstep, voffB);
        PG8_WAIT_V(6); PG8_BAR;
    }
    for (;;) {
        const bool has_next = S.next(ui + 1, nxt);
        const char* nA = has_next ? (const char*)g.A + (size_t)nxt.pm * tstepA + (size_t)nxt.kt0 * kstep : cA; const char* nB = has_next ? (const char*)g.Bt + (size_t)(nxt.pm / g.bgrp) * g.bgrp_stride * 2 + (size_t)nxt.pn * tstepB + (size_t)nxt.kt0 * kstep : cB;
        for (int t = 0; t < nt; t += 2) {
            const bool last = (t == nt - 2);
            const char* a1 = cA + (size_t)(t + 1) * kstep;
            const char* a2 = last ? nA : cA + (size_t)(t + 2) * kstep; const char* b2 = last ? nB : cB + (size_t)(t + 2) * kstep;
            const char* a3 = a2 + kstep; const char* b3 = b2 + kstep;
            if (last && has_next) S.a_ready(nxt);
            if constexpr (SP2) {
            PG8_LDB(B0, 0, 0); PG8_LDB(B1, 0, 1); PG8_SCHED; PG8_LDA(At, 0, 0); PG8_STAGE(PG8_SA(1, 1), a1 + hstepA, voffA);
            PG8_WAIT_V(8); PG8_WAIT_L(0); PG8_BAR; PG8_MMA(0, 0, At, B0); PG8_MMA(0, 1, At, B1); PG8_BAR; PG8_SCHED;
            PG8_LDA(At, 0, 1); PG8_STAGE(PG8_SB(0, 0), b2, voffB); PG8_STAGE(PG8_SB(0, 1), b2 + hstepB, voffB); PG8_STAGE(PG8_SA(0, 0), a2, voffA);
            PG8_WAIT_V(8); PG8_WAIT_L(0); PG8_BAR; PG8_MMA(1, 0, At, B0); PG8_MMA(1, 1, At, B1); PG8_BAR; PG8_SCHED;
            PG8_LDB(B0, 1, 0); PG8_LDB(B1, 1, 1); PG8_SCHED; PG8_LDA(At, 1, 0); PG8_STAGE(PG8_SA(0, 1), a2 + hstepA, voffA);
            PG8_WAIT_V(8); PG8_WAIT_L(0); PG8_BAR; PG8_MMA(0, 0, At, B0); PG8_MMA(0, 1, At, B1); PG8_BAR; PG8_SCHED;
            PG8_LDA(At, 1, 1); PG8_STAGE(PG8_SB(1, 0), b3, voffB); PG8_STAGE(PG8_SB(1, 1), b3 + hstepB, voffB); PG8_STAGE(PG8_SA(1, 0), a3, voffA);
            PG8_WAIT_V(8); PG8_WAIT_L(0); PG8_BAR; PG8_MMA(1, 0, At, B0); PG8_MMA(1, 1, At, B1); PG8_BAR; PG8_SCHED;
            } else {
            PG8_LDB(B0, 0, 0); PG8_SCHED; PG8_LDA(At, 0, 0); PG8_STAGE(PG8_SA(1, 1), a1 + hstepA, voffA);
            PG8_WAIT_L(8); PG8_BAR; PG8_WAIT_L(0); PG8_MMA(0, 0, At, B0); PG8_BAR; PG8_SCHED;
            PG8_LDB(B1, 0, 1); PG8_STAGE(PG8_SB(0, 0), b2, voffB);
            PG8_BAR; PG8_WAIT_L(0); PG8_MMA(0, 1, At, B1); PG8_BAR;
            PG8_LDA(At, 0, 1); PG8_STAGE(PG8_SA(0, 0), a2, voffA);
            PG8_BAR; PG8_WAIT_L(0); PG8_MMA(1, 0, At, B0); PG8_BAR; PG8_SCHED;
            PG8_STAGE(PG8_SB(0, 1), b2 + hstepB, voffB);
            PG8_WAIT_V(6); PG8_BAR; PG8_MMA(1, 1, At, B1); PG8_BAR;
            PG8_LDB(B0, 1, 0); PG8_SCHED; PG8_LDA(At, 1, 0); PG8_STAGE(PG8_SA(0, 1), a2 + hstepA, voffA);
            PG8_WAIT_L(8); PG8_BAR; PG8_WAIT_L(0); PG8_MMA(0, 0, At, B0); PG8_BAR; PG8_SCHED;
            PG8_LDB(B1, 1, 1); PG8_STAGE(PG8_SB(1, 0), b3, voffB);
            PG8_BAR; PG8_WAIT_L(0); PG8_MMA(0, 1, At, B1); PG8_BAR;
            PG8_LDA(At, 1, 1); PG8_STAGE(PG8_SA(1, 0), a3, voffA);
            PG8_BAR; PG8_WAIT_L(0); PG8_MMA(1, 0, At, B0); PG8_BAR; PG8_SCHED;
            PG8_STAGE(PG8_SB(1, 1), b3 + hstepB, voffB);
            PG8_WAIT_V(6); PG8_BAR; PG8_MMA(1, 1, At, B1); PG8_BAR;
            }
        }
        if constexpr (ALIGN_EPI) { if (wr == 0) PG8_BAR; }
        if constexpr (!Epi::AFTER_DRAIN) { E(acc, cur, wr, wc, fr, fq); S.done(cur); }
        if (!has_next) break;
#pragma unroll
        for (int a = 0; a < 2; ++a)
#pragma unroll
            for (int b = 0; b < 2; ++b)
#pragma unroll
                for (int m = 0; m < 4; ++m)
#pragma unroll
                    for (int n = 0; n < 2; ++n) acc[a][b][m][n] = (f32x4){0.f, 0.f, 0.f, 0.f};
        cur = nxt; cA = nA; cB = nB; ++ui;
        if constexpr (ALIGN_EPI) { if (wr == 1) PG8_BAR; }
    }
    PG8_WAIT_V(0);
    if constexpr (!ALIGN_EPI) { if (wr == 0) PG8_BAR; }
    PG8_BAR;
    if constexpr (Epi::AFTER_DRAIN) { E.fused(acc, cur, wr, wc, fr, fq, lds, wid, lane); S.done(cur); }
#undef PG8_SA
#undef PG8_SB
#undef PG8_STAGE
#undef PG8_LDA
#undef PG8_LDB
#undef PG8_MMA
#undef PG8_WAIT_V
#undef PG8_WAIT_L
#undef PG8_BAR
#undef PG8_SCHED
}
}

constexpr int DM = 2048, NPB = 16, SEQ = 256, DEPTH = 4, NDB = 4, DSEQ = 4096, PAST = 256;
constexpr int MP = NPB * SEQ, MS = NDB * DSEQ, M = MP + MS;
constexpr int NIN = 4544, NINP = 4608;
constexpr int C_AQ = 0, C_AK = 512, C_AV = 1024, C_BQ = 1536, C_BK = 1920, C_BV = 2304, C_BR = 3072, C_BG = 3840, C_CQ = 3872, C_CKV = 4256, C_CKR = 4512;
constexpr int DFF = 5632, NQC = 576, NQCP = 768, NKV = 1152, NKVP = 1280;
constexpr float EPS = 1e-6f;
constexpr int NOATT = 14 * 128, NOGLA = 2 * 768;
enum { I_XP = 0, I_XS, I_CAK, I_CAV, I_STB, I_CCKV, I_CCKR, I_C, I_CCTX, I_N1G, I_ADAW, I_ADAB, I_WIN, I_LQ1, I_LK1, I_LQ2, I_LK2, I_ANG, I_BGW, I_BGB, I_BNG, I_CQG, I_CQUP, I_CKVG, I_CKVUP, I_WOUT, I_N2G, I_WUP, I_CONVW, I_CONVB, I_WDOWN, I_FING, N_INPUTS };
constexpr size_t O_YP = 0, O_YS = O_YP + (size_t)MP * DM, O_AK = O_YS + (size_t)MS * DM, O_AV = O_AK + (size_t)NPB * DEPTH * SEQ * 512, O_SB = O_AV + (size_t)NPB * DEPTH * SEQ * 512,
                 O_CKV = O_SB + (size_t)NPB * DEPTH * 2 * 6 * 64 * 128, O_CKR = O_CKV + (size_t)NPB * DEPTH * SEQ * 256, O_END = O_CKR + (size_t)NPB * DEPTH * SEQ * 32;
static_assert(O_END == 69730304, "output size");

constexpr size_t al256(size_t x) { return (x + 255) & ~(size_t)255; }
constexpr size_t WS_CTL = 0, CTL_ZERO_BYTES = 2u << 20;
constexpr size_t WS_SSQ = 1u << 20;
constexpr size_t SZ_WIN = (size_t)NINP * DM * 2, SZ_WOUT = (size_t)DM * DM * 2, SZ_WUP = (size_t)2 * DFF * DM * 2, SZ_WDN = (size_t)DM * DFF * 2, SZ_WQ = (size_t)NQCP * 384 * 2, SZ_WKV = (size_t)NKVP * 256 * 2;
constexpr size_t WS_WIN = WS_CTL + CTL_ZERO_BYTES, WS_WOUT = WS_WIN + 4 * SZ_WIN, WS_WUP = WS_WOUT + 4 * SZ_WOUT, WS_WDN = WS_WUP + 4 * SZ_WUP, WS_WQ = WS_WDN + 4 * SZ_WDN, WS_WKV = WS_WQ + 4 * SZ_WQ;
constexpr size_t SZ_MOD = (size_t)DEPTH * 5 * 6 * DM * 4;
constexpr size_t WS_MOD = WS_WKV + 4 * SZ_WKV, WS_MODP = WS_MOD + SZ_MOD, WS_RTA = WS_MODP + 8 * SZ_MOD, WS_RTC = WS_RTA + (size_t)DSEQ * 64 * 4, WS_LAM = WS_RTC + (size_t)DSEQ * 32 * 4;
constexpr size_t WS_CAK = WS_LAM + 256, WS_CAV = WS_CAK + (size_t)NDB * DEPTH * PAST * 512 * 2, WS_CKRX = WS_CAV + (size_t)NDB * DEPTH * PAST * 512 * 2, WS_CKVA = WS_CKRX + (size_t)NDB * DEPTH * PAST * 32 * 2,
                 WS_KVCTX = WS_CKVA + (size_t)DEPTH * NDB * PAST * 256 * 2, WS_SIDE = WS_KVCTX + (size_t)DEPTH * NDB * PAST * NKVP * 2, WS_GM = WS_SIDE + (size_t)(M / 256) * 2 * 3 * DFF * 4, WS_SHWI = WS_GM + (size_t)DEPTH * 2 * 5 * DM * 4,
                 WS_SHWU = WS_SHWI + (size_t)DEPTH * 5 * NINP * 4, WS_SSQP = WS_SHWU + (size_t)DEPTH * 5 * 2 * DFF * 4, WS_X = WS_SSQP + (size_t)8 * M * 32 * 4;
constexpr size_t WS_H = WS_X + (size_t)M * DM * 4, WS_T0 = WS_H + (size_t)M * DM * 2;
constexpr size_t WS_P = WS_T0, WS_MIX = WS_P + (size_t)M * NINP * 2, WS_QC = WS_MIX + (size_t)M * DM * 2, WS_KVC = WS_QC + (size_t)M * NQCP * 2, WS_CQN = WS_KVC + (size_t)M * NKVP * 2, WS_CKVN = WS_CQN + (size_t)M * 384 * 2,
                 WS_KRA = WS_CKVN + (size_t)M * 256 * 2, WS_KRC = WS_KRA + (size_t)MS * 512 * 2, WS_OATT = WS_KRC + (size_t)MS * 32 * 2, WS_OGLA = WS_OATT + (size_t)M * NOATT * 4, WS_GATE = WS_OGLA + (size_t)M * NOGLA * 4,
                 WS_ST = WS_GATE + (size_t)M * 768 * 4, WS_DD = WS_ST + (size_t)(M / 64) * 12 * 8192 * 2, WS_END1 = WS_DD + (size_t)(M / 64) * 12 * 64 * 4;
constexpr size_t WS_U = WS_OGLA, WS_QK4 = WS_GATE;
constexpr size_t WS_GU = WS_T0, WS_ACT = WS_GU + (size_t)M * 2 * DFF * 2, WS_END2 = WS_ACT + (size_t)M * DFF * 2;


static_assert(WS_WIN % 256 == 0 && WS_X % 256 == 0 && WS_H % 256 == 0 && WS_T0 % 256 == 0 && WS_QC % 256 == 0 && WS_KVC % 256 == 0 && WS_CQN % 256 == 0 && WS_CKVN % 256 == 0 && WS_OATT % 256 == 0 && WS_ACT % 256 == 0, "alignment");

constexpr size_t WS_SPLITK = WS_END1 > WS_END2 ? WS_END1 : WS_END2, WS_END3 = WS_SPLITK + (size_t)128 * 2 * 65536 * 4;
constexpr size_t WS_END = WS_END3;
static_assert(WS_END <= (size_t)1536 << 20, "workspace map must fit 4 x the largest tensor");
constexpr int CW_TICKET = 65536;

constexpr int RING_BYTES = 131072, MISC_OFF = RING_BYTES + 320, LDS_BYTES = 147456;

#define GAS __attribute__((address_space(1)))
#define LAS __attribute__((address_space(3)))
typedef unsigned short bf16;
typedef unsigned v4u __attribute__((ext_vector_type(4)));
typedef unsigned v2u __attribute__((ext_vector_type(2)));
typedef float f32x4 __attribute__((ext_vector_type(4)));
#define LDS_WAIT() asm volatile("s_waitcnt lgkmcnt(0)" ::: "memory")
__device__ __forceinline__ unsigned f2bf(float f) { unsigned u = __builtin_bit_cast(unsigned, f); return (u + 0x7fffu + ((u >> 16) & 1u)) >> 16; }
__device__ __forceinline__ unsigned pk2(float lo, float hi) { return f2bf(lo) | (f2bf(hi) << 16); }
__device__ __forceinline__ float bf2f(bf16 b) { return __builtin_bit_cast(float, (unsigned)b << 16); }
__device__ __forceinline__ float wave_sum(float v) {
#pragma unroll
    for (int o = 1; o < 64; o <<= 1) v += __shfl_xor(v, o);
    return v;
}
__device__ __forceinline__ float siluf(float x) { return x / (1.f + __expf(-x)); }

namespace pg8 {
__device__ __forceinline__ void rstd_table(const float* ssq, int pm, PG8_LAS float* rtab, int tid, int npart) {
    const int row = tid >> 1, half = tid & 1; const float* p = ssq + (size_t)pm * BM + row;
    float s;
    if (npart == 32) { float v[16];
#pragma unroll
        for (int j = 0; j < 16; ++j) v[j] = p[(size_t)(half * 16 + j) * 20480];
        s = (((v[0] + v[1]) + (v[2] + v[3])) + ((v[4] + v[5]) + (v[6] + v[7]))) + (((v[8] + v[9]) + (v[10] + v[11])) + ((v[12] + v[13]) + (v[14] + v[15])));
    } else s = half == 0 ? p[0] : 0.f;
    s += __shfl_xor(s, 1);
    if (half == 0) rtab[row] = 1.0f / sqrtf(s * (1.f / 2048.f) + 1e-6f);
    asm volatile("s_waitcnt lgkmcnt(0)" ::: "memory"); __builtin_amdgcn_s_barrier(); asm volatile("" ::: "memory");
}
struct EpiResid {
    static constexpr bool PERM = true, AFTER_DRAIN = false;
    const float* xin0; const float* xin1;
    float* out; const float* gate;
    bf16_t* H; const float* gm; float* ssq;
    __device__ __forceinline__ void operator()(const f32x4 (&acc)[2][2][4][2], const Unit& u, int wr, int wc, int fr, int fq) const {
        const int mi = u.pm < 16 ? 0 : 1 + ((u.pm - 16) >> 4);
        const float* gp = gate + (size_t)mi * 6 * 2048; const float* xin = u.pm < 16 ? xin0 : xin1;
        const int col0 = u.pn * BM + wc * 32 + 8 * fq;
        f32x4 gv[2][2], gm4[2][2];
#pragma unroll
        for (int bj = 0; bj < 2; ++bj)
#pragma unroll
            for (int n = 0; n < 2; ++n) { gv[bj][n] = *(const f32x4*)(gp + col0 + bj * HALF + 4 * n); gm4[bj][n] = H ? *(const f32x4*)(gm + (size_t)mi * 2048 + col0 + bj * HALF + 4 * n) : (f32x4){0.f, 0.f, 0.f, 0.f}; }
#pragma unroll
        for (int ai = 0; ai < 2; ++ai)
#pragma unroll
            for (int m = 0; m < 4; ++m) { const int row = u.pm * BM + ai * HALF + wr * 64 + m * 16 + fr; const size_t off = (size_t)row * 2048 + col0; float ss = 0.f;
#pragma unroll
                for (int bj = 0; bj < 2; ++bj) { const f32x4 x0 = *(const f32x4*)(xin + off + bj * HALF), x1 = *(const f32x4*)(xin + off + bj * HALF + 4);
                    const f32x4 y0 = x0 + gv[bj][0] * acc[ai][bj][m][0], y1 = x1 + gv[bj][1] * acc[ai][bj][m][1];
                    *(f32x4*)(out + off + bj * HALF) = y0; *(f32x4*)(out + off + bj * HALF + 4) = y1;
                    ss += ((y0[0] * y0[0] + y0[1] * y0[1]) + (y0[2] * y0[2] + y0[3] * y0[3])) + ((y1[0] * y1[0] + y1[1] * y1[1]) + (y1[2] * y1[2] + y1[3] * y1[3]));
                    if (H) { const f32x4 h0 = y0 * gm4[bj][0], h1 = y1 * gm4[bj][1]; u32x4 w; w.x = cvt_pk_bf16(h0[0], h0[1]); w.y = cvt_pk_bf16(h0[2], h0[3]); w.z = cvt_pk_bf16(h1[0], h1[1]); w.w = cvt_pk_bf16(h1[2], h1[3]);
                        *(u32x4*)(H + off + bj * HALF) = w; } }
                if (H) { ss += __shfl_xor(ss, 16); ss += __shfl_xor(ss, 32); if (fq == 0) ssq[(size_t)(u.pn * 4 + wc) * 20480 + row] = ss; } }
    }
};
struct EpiBf16Norm {
    static constexpr bool PERM = true, AFTER_DRAIN = false;
    bf16_t* O; int ldc; const float* ssq; const float* shw; int shw_ld; PG8_LAS float* rtab; int npart;
    static constexpr int qtiles = 2; static constexpr float qscale = 0.125f * 1.4426950408889634f;
    __device__ __forceinline__ void operator()(const f32x4 (&acc)[2][2][4][2], const Unit& u, int wr, int wc, int fr, int fq) const {
        const int mi = u.pm < 16 ? 0 : 1 + ((u.pm - 16) >> 4);
        rstd_table(ssq, u.pm, rtab, (wr * 4 + wc) * 64 + fq * 16 + fr, npart);
        const int row0 = u.pm * BM + wr * 64 + fr, col0 = u.pn * BM + wc * 32 + 8 * fq; const float* sp = shw + (size_t)mi * shw_ld + col0;
        const float qs = u.pn < qtiles ? qscale : 1.f;
        f32x4 sv[2][2];
#pragma unroll
        for (int bj = 0; bj < 2; ++bj)
#pragma unroll
            for (int n = 0; n < 2; ++n) sv[bj][n] = *(const f32x4*)(sp + bj * HALF + 4 * n);
#pragma unroll
        for (int ai = 0; ai < 2; ++ai)
#pragma unroll
            for (int m = 0; m < 4; ++m) { const int row = row0 + ai * HALF + m * 16; const float rs = rtab[row - u.pm * BM];
                bf16_t* rowp = O + (size_t)row * ldc + col0;
#pragma unroll
                for (int bj = 0; bj < 2; ++bj) { const f32x4 v0 = (acc[ai][bj][m][0] * rs + sv[bj][0]) * qs, v1 = (acc[ai][bj][m][1] * rs + sv[bj][1]) * qs;
                    u32x4 w; w.x = cvt_pk_bf16(v0[0], v0[1]); w.y = cvt_pk_bf16(v0[2], v0[3]); w.z = cvt_pk_bf16(v1[0], v1[1]); w.w = cvt_pk_bf16(v1[2], v1[3]);
                    *(u32x4*)(rowp + bj * HALF) = w; } }
    }
};

struct EpiResidTail {
    static constexpr bool PERM = false, AFTER_DRAIN = false;
    float* X; const float* gate; float* scratch; unsigned* ticket; PG8_LAS unsigned* lw;
    __device__ __forceinline__ void operator()(const f32x4 (&acc)[2][2][4][2], const Unit& u, int wr, int wc, int fr, int fq) const {
        const int t = blockIdx.x >> 1, half = blockIdx.x & 1, tid = threadIdx.x;
        { const __amdgpu_buffer_rsrc_t rs = __builtin_amdgcn_make_buffer_rsrc(scratch + ((size_t)t * 2 + half) * 65536, 0, 65536 * 4, 0x00020000);
#pragma unroll
          for (int ai = 0; ai < 2; ++ai)
#pragma unroll
            for (int bj = 0; bj < 2; ++bj)
#pragma unroll
                for (int m = 0; m < 4; ++m)
#pragma unroll
                    for (int n = 0; n < 2; ++n) { const int j = ((ai * 2 + bj) * 4 + m) * 2 + n; __builtin_amdgcn_raw_buffer_store_b128(__builtin_bit_cast(u32x4, acc[ai][bj][m][n]), rs, (j * 512 + tid) * 16, 0, 16); } }
        asm volatile("s_waitcnt vmcnt(0)" ::: "memory"); __builtin_amdgcn_s_barrier(); asm volatile("" ::: "memory");
        if (tid == 0) { const unsigned old = __hip_atomic_fetch_add(ticket + 64 * t, 1u, __ATOMIC_RELAXED, __HIP_MEMORY_SCOPE_AGENT); *lw = old; }
        asm volatile("s_waitcnt vmcnt(0) lgkmcnt(0)" ::: "memory"); __builtin_amdgcn_s_barrier(); asm volatile("" ::: "memory");
        const unsigned old = *lw;
        if (old == 0u) return;
        __builtin_amdgcn_fence(__ATOMIC_ACQUIRE, "agent"); asm volatile("s_waitcnt vmcnt(0)" ::: "memory");
        const float* oth = scratch + ((size_t)t * 2 + (half ^ 1)) * 65536; const float* own = scratch + ((size_t)t * 2 + half) * 65536;
        const int mi = u.pm < 16 ? 0 : 1 + ((u.pm - 16) >> 4);
        const float* gp = gate + (size_t)mi * 6 * 2048;
        const int col0 = u.pn * BM + wc * 32 + 4 * fq;
#pragma unroll
        for (int ai = 0; ai < 2; ++ai)
#pragma unroll
            for (int m = 0; m < 4; ++m) { const size_t off = (size_t)(u.pm * BM + ai * HALF + wr * 64 + m * 16 + fr) * 2048 + col0;
#pragma unroll
                for (int bj = 0; bj < 2; ++bj)
#pragma unroll
                    for (int n = 0; n < 2; ++n) { const int j = ((ai * 2 + bj) * 4 + m) * 2 + n; const f32x4 pv = *(const f32x4*)(oth + (size_t)(j * 512 + tid) * 4) + *(const f32x4*)(own + (size_t)(j * 512 + tid) * 4);
                        const f32x4 gv = *(const f32x4*)(gp + col0 + bj * HALF + n * 16), xv = *(const f32x4*)(X + off + bj * HALF + n * 16);
                        *(f32x4*)(X + off + bj * HALF + n * 16) = xv + gv * pv; }
                asm volatile("" ::: "memory"); }
    }
};

__device__ __forceinline__ float dpp_ror1(float x) { return __builtin_bit_cast(float, __builtin_amdgcn_update_dpp(__builtin_bit_cast(int, x), __builtin_bit_cast(int, x), 0x121, 0xf, 0xf, false)); }
__device__ __forceinline__ float dpp_rol1(float x) { return __builtin_bit_cast(float, __builtin_amdgcn_update_dpp(__builtin_bit_cast(int, x), __builtin_bit_cast(int, x), 0x12F, 0xf, 0xf, false)); }
struct EpiConvAct {
    static constexpr bool PERM = true, AFTER_DRAIN = false;
    bf16_t* ACT; const float* cw; const float* cb; float* side; PG8_LAS float* ex;
    const float* ssq; const float* shw; PG8_LAS float* rtab; int npart;
    __device__ __forceinline__ void operator()(const f32x4 (&acc_)[2][2][4][2], const Unit& u, int wr, int wc, int fr, int fq) const {
        constexpr int FF = 5632;
        const int colw = wc * 32 + 8 * fq, j0 = u.pn * HALF + colw;
        f32x4 (&acc)[2][2][4][2] = const_cast<f32x4 (&)[2][2][4][2]>(acc_);
#pragma unroll
        for (int ai = 0; ai < 2; ++ai) { const int blk = 2 * ai + wr;
            if (fr == 0) {
#pragma unroll
                for (int n = 0; n < 2; ++n) *(PG8_LAS f32x4*)(ex + (blk * 2 + 0) * HALF + colw + 4 * n) = acc[ai][0][0][n]; }
            if (fr == 15) {
#pragma unroll
                for (int n = 0; n < 2; ++n) *(PG8_LAS f32x4*)(ex + (blk * 2 + 1) * HALF + colw + 4 * n) = acc[ai][0][3][n]; } }
        rstd_table(ssq, u.pm, rtab, (wr * 4 + wc) * 64 + fq * 16 + fr, npart);
        f32x4 sv[2][2];
        { const int mi = u.pm < 16 ? 0 : 1 + ((u.pm - 16) >> 4); const float* sp = shw + (size_t)mi * (2 * FF) + u.pn * BM + colw;
#pragma unroll
          for (int bj = 0; bj < 2; ++bj)
#pragma unroll
              for (int n = 0; n < 2; ++n) sv[bj][n] = *(const f32x4*)(sp + bj * HALF + 4 * n);
#pragma unroll
          for (int ai = 0; ai < 2; ++ai)
#pragma unroll
              for (int m = 0; m < 4; ++m) { const int row = u.pm * BM + ai * HALF + wr * 64 + m * 16 + fr; const float rs = rtab[row - u.pm * BM];
#pragma unroll
                  for (int bj = 0; bj < 2; ++bj)
#pragma unroll
                      for (int n = 0; n < 2; ++n) acc[ai][bj][m][n] = acc[ai][bj][m][n] * rs + sv[bj][n]; } }
        float w0[8], w1[8], w2[8], bb[8];
#pragma unroll
        for (int q = 0; q < 2; ++q) { const f32x4 a0 = *(const f32x4*)(cw + j0 + 4 * q), a1 = *(const f32x4*)(cw + FF + j0 + 4 * q), a2 = *(const f32x4*)(cw + 2 * FF + j0 + 4 * q), a3 = *(const f32x4*)(cb + j0 + 4 * q);
#pragma unroll
            for (int i = 0; i < 4; ++i) { w0[4 * q + i] = a0[i]; w1[4 * q + i] = a1[i]; w2[4 * q + i] = a2[i]; bb[4 * q + i] = a3[i]; } }
#pragma unroll
        for (int ai = 0; ai < 2; ++ai) { const int blk = 2 * ai + wr;
#pragma unroll
            for (int m = 0; m < 4; ++m) { float ov[8]; float gcv[8]; float pe[8], ne[8];
                if (m == 0) {
#pragma unroll
                    for (int n = 0; n < 2; ++n) { const f32x4 p4 = blk > 0 ? *(const PG8_LAS f32x4*)(ex + ((blk - 1) * 2 + 1) * HALF + colw + 4 * n) * rtab[blk > 0 ? blk * 64 - 1 : 0] + sv[0][n] : (f32x4){0.f, 0.f, 0.f, 0.f};
#pragma unroll
                        for (int i = 0; i < 4; ++i) pe[4 * n + i] = p4[i]; } }
                if (m == 3) {
#pragma unroll
                    for (int n = 0; n < 2; ++n) { const f32x4 n4 = blk < 3 ? *(const PG8_LAS f32x4*)(ex + ((blk + 1) * 2 + 0) * HALF + colw + 4 * n) * rtab[blk < 3 ? (blk + 1) * 64 : 0] + sv[0][n] : (f32x4){0.f, 0.f, 0.f, 0.f};
#pragma unroll
                        for (int i = 0; i < 4; ++i) ne[4 * n + i] = n4[i]; } }
#pragma unroll
                for (int kp = 0; kp < 4; ++kp) { const int k = 2 * kp, n = k >> 2, i = k & 3;
                    typedef float f32x2 __attribute__((ext_vector_type(2)));
                    f32x2 G, GP, GN;
#pragma unroll
                    for (int e = 0; e < 2; ++e) { const float g = acc[ai][0][m][n][i + e];
                        const float sp_ = fr == 15 ? (m > 0 ? acc[ai][0][m > 0 ? m - 1 : 0][n][i + e] : pe[k + e]) : g;
                        const float sn_ = fr == 0 ? (m < 3 ? acc[ai][0][m < 3 ? m + 1 : 3][n][i + e] : ne[k + e]) : g;
                        G[e] = g; GP[e] = dpp_ror1(sp_); GN[e] = dpp_rol1(sn_); }
                    const f32x2 W0 = {w0[k], w0[k + 1]}, W1 = {w1[k], w1[k + 1]}, W2 = {w2[k], w2[k + 1]}, BB = {bb[k], bb[k + 1]}, UU = {acc[ai][1][m][n][i], acc[ai][1][m][n][i + 1]};
                    const f32x2 GC = __builtin_elementwise_fma(W0, GP, __builtin_elementwise_fma(W1, G, __builtin_elementwise_fma(W2, GN, BB)));
                    const f32x2 T = GC * (f32x2){-1.4426950408889634f, -1.4426950408889634f};
                    f32x2 D = {__builtin_amdgcn_exp2f(T.x), __builtin_amdgcn_exp2f(T.y)}; D += (f32x2){1.f, 1.f};
                    const f32x2 R = {__builtin_amdgcn_rcpf(D.x), __builtin_amdgcn_rcpf(D.y)};
                    const f32x2 O = GC * R * UU;
                    gcv[k] = GC.x; gcv[k + 1] = GC.y; ov[k] = O.x; ov[k + 1] = O.y; }
                const int row = u.pm * BM + ai * HALF + wr * 64 + m * 16 + fr;
                u32x4 w; w.x = cvt_pk_bf16(ov[0], ov[1]); w.y = cvt_pk_bf16(ov[2], ov[3]); w.z = cvt_pk_bf16(ov[4], ov[5]); w.w = cvt_pk_bf16(ov[6], ov[7]);
                *(u32x4*)(ACT + (size_t)row * FF + j0) = w;
                const bool first = (ai == 0 && m == 0) && wr == 0 && fr == 0, last = (ai == 1 && m == 3) && wr == 1 && fr == 15;
                if ((ai == 0 && m == 0) || (ai == 1 && m == 3)) { if (first || last) { float* sp = side + ((size_t)(u.pm * 2 + (last ? 1 : 0)) * 3) * FF + j0;
#pragma unroll
                    for (int n = 0; n < 2; ++n) { *(f32x4*)(sp + 4 * n) = (f32x4){gcv[4 * n], gcv[4 * n + 1], gcv[4 * n + 2], gcv[4 * n + 3]}; *(f32x4*)(sp + FF + 4 * n) = acc[ai][1][m][n]; *(f32x4*)(sp + 2 * FF + 4 * n) = acc[ai][0][m][n]; } } }
            } }
    }
};
}

#define XB_TMO      128
#define XB_XCNT(j)  (256  + 64 * (j))
#define XB_XSUB(j)  (1280 + 64 * (j))
#define XB_XGEN(j)  (2304 + 64 * (j))
#define XB_TOP      3328
#define XB_TOPGEN   3392
#define XCD_BAR_WORDS 3456
#define XB_SPIN_CAP (1u << 18)
__device__ __forceinline__ unsigned xb_ld(unsigned* p)              { return __hip_atomic_load(p, __ATOMIC_RELAXED, __HIP_MEMORY_SCOPE_AGENT); }
__device__ __forceinline__ unsigned xb_add(unsigned* p, unsigned v) { return __hip_atomic_fetch_add(p, v, __ATOMIC_RELAXED, __HIP_MEMORY_SCOPE_AGENT); }
__device__ __forceinline__ unsigned xb_xcc_id() { return (unsigned)__builtin_amdgcn_s_getreg((3 << 11) | 20) & 0xFu; }
#define XB_SPIN(cond, bar) do { unsigned _sp = 0; while (cond) { __builtin_amdgcn_s_sleep(1); \
    if ((++_sp & 255u) == 0u) { if (xb_ld(&(bar)[XB_TMO])) break; if (_sp > XB_SPIN_CAP) { atomicAdd(&(bar)[XB_TMO], 1u); break; } } } } while (0)
struct XcdBarrier { unsigned* bar; unsigned x; volatile LAS unsigned* st; };
__device__ __forceinline__ XcdBarrier xcd_barrier_post(unsigned* bar, volatile LAS unsigned* st) {
    XcdBarrier b; b.bar = bar; b.x = xb_xcc_id(); b.st = st;
    if (threadIdx.x == 0) (void)xb_add(&bar[XB_XCNT(b.x)], 1u);
    return b;
}
__device__ __forceinline__ void xcd_barrier_complete(unsigned* bar, unsigned x, unsigned& nloc, unsigned& nx) {
    const unsigned G = gridDim.x * gridDim.y * gridDim.z;
    unsigned sum, cnt, mine, sp = 0u;
    for (;;) {
        sum = 0u; cnt = 0u; mine = 0u;
#pragma unroll
        for (unsigned j = 0; j < 16; ++j) { const unsigned c = xb_ld(&bar[XB_XCNT(j)]); sum += c; cnt += (c > 0u) ? 1u : 0u; mine = (j == x) ? c : mine; }
        if (sum == G) break;
        __builtin_amdgcn_s_sleep(1);
        if ((++sp & 255u) == 0u) { if (xb_ld(&bar[XB_TMO])) break; if (sp > XB_SPIN_CAP) { atomicAdd(&bar[XB_TMO], 1u); break; } }
    }
    nloc = mine > 0u ? mine : 1u; nx = cnt > 0u ? cnt : 1u;
}
__device__ __forceinline__ void xcd_barrier(const XcdBarrier& b, int tid) {
    asm volatile("s_waitcnt vmcnt(0)" ::: "memory");
    __syncthreads();
    if (tid == 0) {
        unsigned* bar = b.bar;
        __builtin_amdgcn_s_waitcnt(0);
        unsigned nloc = b.st[0], nx = b.st[1];
        if (nloc == 0u) { xcd_barrier_complete(bar, b.x, nloc, nx); b.st[0] = nloc; b.st[1] = nx; }
        const unsigned old = xb_add(&bar[XB_XSUB(b.x)], 1u);
        const unsigned gen = old / nloc;
        if (old + 1u == (gen + 1u) * nloc) {
            __builtin_amdgcn_fence(__ATOMIC_RELEASE, "agent");
            asm volatile("s_waitcnt vmcnt(0)" ::: "memory");
            const unsigned og = xb_add(&bar[XB_TOP], 1u);
            const unsigned tg = og / nx;
            if (og + 1u == (tg + 1u) * nx) xb_add(&bar[XB_TOPGEN], 1u);
            else XB_SPIN(xb_ld(&bar[XB_TOPGEN]) == tg, bar);
            __builtin_amdgcn_fence(__ATOMIC_ACQUIRE, "agent");
            xb_add(&bar[XB_XGEN(b.x)], 1u);
            asm volatile("s_waitcnt vmcnt(0)" ::: "memory");
        } else {
            XB_SPIN(xb_ld(&bar[XB_XGEN(b.x)]) == gen, bar);
            __builtin_amdgcn_fence(__ATOMIC_ACQUIRE, "agent");
            asm volatile("s_waitcnt vmcnt(0)" ::: "memory");
        }
    }
    __syncthreads();
}

#ifndef MK_MFMA_ATT
#define MK_MFMA_ATT 1
#endif
#ifndef MK_MFMA_GLA
#define MK_MFMA_GLA 1
#endif
#ifndef MK_SPLITK
#define MK_SPLITK 0
#endif
constexpr int NWV = 8, NTH = 512;

template <bool UPMAP = false>
__device__ __forceinline__ void transpose_item(const float* W, int K, int N, bf16* WT, LAS float* scr, int item, int lane) {
    const int nblk = N / 32, kb = item / nblk, nb = item % nblk, k0 = 64 * kb, n0 = 32 * nb;
    const int nd0 = UPMAP ? (n0 < DFF ? 256 * (n0 >> 7) + (n0 & 127) : 256 * ((n0 - DFF) >> 7) + 128 + ((n0 - DFF) & 127)) : n0;
    float wv[32];
#pragma unroll
    for (int i = 0; i < 32; ++i) wv[i] = __builtin_nontemporal_load(W + (size_t)(k0 + 2 * i + (lane >> 5)) * N + n0 + (lane & 31));
#pragma unroll
    for (int i = 0; i < 32; ++i) scr[(2 * i + (lane >> 5)) * 33 + (lane & 31)] = wv[i];
    LDS_WAIT(); asm volatile("" ::: "memory");
    const int c = lane & 7;
#pragma unroll
    for (int j = 0; j < 4; ++j) { const int n = (lane >> 3) + 8 * j; const LAS float* s = scr + (8 * c) * 33 + n;
        v4u o; o.x = pk2(s[0 * 33], s[1 * 33]); o.y = pk2(s[2 * 33], s[3 * 33]); o.z = pk2(s[4 * 33], s[5 * 33]); o.w = pk2(s[6 * 33], s[7 * 33]);
        *(v4u*)(WT + (size_t)(nd0 + n) * K + k0 + 8 * c) = o; }
    LDS_WAIT(); asm volatile("" ::: "memory");
}

struct Args { const float* in[N_INPUTS]; float* out; unsigned char* ws; int ph_lo, ph_hi, use_bar, pad; };

__device__ __forceinline__ void pro0_phase(const Args& a, LAS unsigned char* lds, int tid, int lane, int wave, int bid, int G) {
    unsigned char* ws = a.ws;
    const int gw = bid * NWV + wave, NGW = G * NWV;
    LAS float* scr = (LAS float*)(lds + wave * 16384);
    constexpr int IT_IN = (DM / 64) * (NIN / 32), IT_OUT = (DM / 64) * (DM / 32), IT_UP = (DM / 64) * (2 * DFF / 32), IT_DN = (DFF / 64) * (DM / 32), IT_Q = (384 / 64) * (NQC / 32), IT_KV = (256 / 64) * (NKV / 32);
    constexpr int IT_L = IT_IN + IT_OUT + IT_UP + IT_DN + IT_Q + IT_KV;
    for (int it = gw; it < DEPTH * IT_L; it += NGW) {
        const int l = it / IT_L; int r = it % IT_L;
        if (r < IT_IN) { transpose_item(a.in[I_WIN] + (size_t)l * DM * NIN, DM, NIN, (bf16*)(ws + WS_WIN + l * SZ_WIN), scr, r, lane); continue; } r -= IT_IN;
        if (r < IT_OUT) { transpose_item(a.in[I_WOUT] + (size_t)l * DM * DM, DM, DM, (bf16*)(ws + WS_WOUT + l * SZ_WOUT), scr, r, lane); continue; } r -= IT_OUT;
        if (r < IT_UP) { transpose_item<true>(a.in[I_WUP] + (size_t)l * DM * 2 * DFF, DM, 2 * DFF, (bf16*)(ws + WS_WUP + l * SZ_WUP), scr, r, lane); continue; } r -= IT_UP;
        if (r < IT_DN) { transpose_item(a.in[I_WDOWN] + (size_t)l * DFF * DM, DFF, DM, (bf16*)(ws + WS_WDN + l * SZ_WDN), scr, r, lane); continue; } r -= IT_DN;
        if (r < IT_Q) { transpose_item(a.in[I_CQUP] + (size_t)l * 384 * NQC, 384, NQC, (bf16*)(ws + WS_WQ + l * SZ_WQ), scr, r, lane); continue; } r -= IT_Q;
        transpose_item(a.in[I_CKVUP] + (size_t)l * 256 * NKV, 256, NKV, (bf16*)(ws + WS_WKV + l * SZ_WKV), scr, r, lane);
    }
    const int gt = bid * NTH + tid, NGT = G * NTH;
    for (int i = gt; i < DEPTH * (NINP - NIN) * DM / 8; i += NGT) { const int l = i / ((NINP - NIN) * DM / 8), r = i % ((NINP - NIN) * DM / 8); *(v4u*)(ws + WS_WIN + l * SZ_WIN + (size_t)NIN * DM * 2 + (size_t)r * 16) = (v4u){0u, 0u, 0u, 0u}; }
    for (int i = gt; i < DEPTH * (NQCP - NQC) * 384 / 8; i += NGT) { const int l = i / ((NQCP - NQC) * 384 / 8), r = i % ((NQCP - NQC) * 384 / 8); *(v4u*)(ws + WS_WQ + l * SZ_WQ + (size_t)NQC * 384 * 2 + (size_t)r * 16) = (v4u){0u, 0u, 0u, 0u}; }
    for (int i = gt; i < DEPTH * (NKVP - NKV) * 256 / 8; i += NGT) { const int l = i / ((NKVP - NKV) * 256 / 8), r = i % ((NKVP - NKV) * 256 / 8); *(v4u*)(ws + WS_WKV + l * SZ_WKV + (size_t)NKV * 256 * 2 + (size_t)r * 16) = (v4u){0u, 0u, 0u, 0u}; }
    {
        LAS float* sc = (LAS float*)lds;
        __syncthreads();
        for (int it = bid; it < DEPTH * 24 * 8; it += G) {
            const int l = it / 192, cb = (it / 8) % 24, ks = it % 8;
            __syncthreads();
            for (int e = tid; e < 5 * 256; e += NTH) { const int mi = e >> 8, k = ks * 256 + (e & 255); const float cv = mi == 0 ? a.in[I_CCTX][k] : a.in[I_C][(mi - 1) * DM + k]; sc[e] = cv / (1.f + expf(-cv)); }
            __syncthreads();
            const float* wp = a.in[I_ADAW] + ((size_t)l * DM + ks * 256) * (6 * DM) + cb * 512 + tid;
            float s0 = 0.f, s1 = 0.f, s2 = 0.f, s3 = 0.f, s4 = 0.f;
#pragma unroll 8
            for (int k = 0; k < 256; ++k) { const float w = __builtin_nontemporal_load(wp + (size_t)k * (6 * DM)); s0 += sc[k] * w; s1 += sc[256 + k] * w; s2 += sc[512 + k] * w; s3 += sc[768 + k] * w; s4 += sc[1024 + k] * w; }
            float* mp = (float*)(ws + WS_MODP) + ((size_t)ks * DEPTH + l) * 5 * 6 * DM + cb * 512 + tid;
            mp[0] = s0; mp[6 * DM] = s1; mp[2 * 6 * DM] = s2; mp[3 * 6 * DM] = s3; mp[4 * 6 * DM] = s4;
        }
        __syncthreads();
    }
    { const float* s = a.in[I_CAK]; bf16* d = (bf16*)(ws + WS_CAK); for (int i = gt; i < NDB * DEPTH * PAST * 512; i += NGT) d[i] = (bf16)f2bf(s[i]); }
    { const float* s = a.in[I_CAV]; bf16* d = (bf16*)(ws + WS_CAV); for (int i = gt; i < NDB * DEPTH * PAST * 512; i += NGT) d[i] = (bf16)f2bf(s[i]); }
    { const float* s = a.in[I_CCKR]; bf16* d = (bf16*)(ws + WS_CKRX); for (int i = gt; i < NDB * DEPTH * PAST * 32; i += NGT) d[i] = (bf16)f2bf(s[i]); }
    { const float* s = a.in[I_CCKV]; bf16* d = (bf16*)(ws + WS_CKVA);
      for (int i = gt; i < NDB * DEPTH * PAST * 256; i += NGT) { const int c = i & 255, j = (i >> 8) & 255, bl = i >> 16, b = bl >> 2, l = bl & 3; d[(((size_t)l * NDB + b) * PAST + j) * 256 + c] = (bf16)f2bf(s[i]); } }
    { float* ra = (float*)(ws + WS_RTA); float* rc = (float*)(ws + WS_RTC);
      for (int i = gt; i < DSEQ * 16; i += NGT) { const int t = i >> 4, j = i & 15; const float inv = powf(10000.f, -(float)j / 16.f); const float ar = (float)(t >> 6) * inv, ac = (float)(t & 63) * inv;
          ra[t * 64 + j] = cosf(ar); ra[t * 64 + 16 + j] = sinf(ar); ra[t * 64 + 32 + j] = cosf(ac); ra[t * 64 + 48 + j] = sinf(ac); }
      for (int i = gt; i < DSEQ * 8; i += NGT) { const int t = i >> 3, j = i & 7; const float inv = powf(10000.f, -(float)j / 8.f); const float ar = (float)(t >> 6) * inv, ac = (float)(t & 63) * inv;
          rc[t * 32 + j] = cosf(ar); rc[t * 32 + 8 + j] = sinf(ar); rc[t * 32 + 16 + j] = cosf(ac); rc[t * 32 + 24 + j] = sinf(ac); } }
    if (gt < DEPTH) { const int l = gt; float d1 = 0.f, d2 = 0.f;
        for (int i = 0; i < 64; ++i) { d1 += a.in[I_LQ1][l * 64 + i] * a.in[I_LK1][l * 64 + i]; d2 += a.in[I_LQ2][l * 64 + i] * a.in[I_LK2][l * 64 + i]; }
        const float li = 0.8f - 0.6f * expf(-0.3f * (float)l);
        float* lam = (float*)(ws + WS_LAM); lam[l] = expf(d1) - expf(d2) + li; lam[4 + l] = li; }
}

__device__ __forceinline__ void modfin_phase(const Args& a, int gt, int NGT) {
    const float* mp = (const float*)(a.ws + WS_MODP); float* mo = (float*)(a.ws + WS_MOD);
    for (int i = gt; i < DEPTH * 5 * 6 * DM; i += NGT) { const int l = i / (5 * 6 * DM), n = i % (6 * DM); float s = a.in[I_ADAB][l * 6 * DM + n];
#pragma unroll
        for (int ks = 0; ks < 8; ++ks) s += mp[(size_t)ks * DEPTH * 5 * 6 * DM + i];
        mo[i] = s; }
}


namespace att {
using bf16x8 = __attribute__((ext_vector_type(8))) short;
using s16x4  = __attribute__((ext_vector_type(4))) short;
using f32x16 = __attribute__((ext_vector_type(16))) float;
using u32x4  = __attribute__((ext_vector_type(4))) unsigned;
constexpr int SHM_V = 64 * 128 * 2;
#define ATT_SBAR() __builtin_amdgcn_sched_barrier(0)
#define ATT_LBAR() asm volatile("s_waitcnt lgkmcnt(0)\n\ts_barrier" ::: "memory")
__device__ __forceinline__ int crow(int r, int hi) { return (r & 3) + 8 * (r >> 2) + 4 * hi; }
__device__ __forceinline__ float max3f(float a, float b, float c) { return fmaxf(fmaxf(a, b), c); }
__device__ __forceinline__ float max2f(float a, float b) { return fmaxf(a, b); }
__device__ __forceinline__ unsigned cvtpk(float lo, float hi) { unsigned r; asm volatile("v_cvt_pk_bf16_f32 %0, %1, %2" : "=v"(r) : "v"(lo), "v"(hi)); return r; }
template <bool TUP> __device__ __forceinline__ void partialSM(f32x16& p0, f32x16& p1, float& m_reg, f32x16& negm, float& alpha, float thr, bool first, float pmax) {
  if constexpr (!TUP) {
    typedef float f32x2 __attribute__((ext_vector_type(2))); const f32x2 M2 = {-m_reg, -m_reg};
#pragma unroll
    for (int r = 0; r < 16; r += 2) { f32x2 v = {p0[r], p0[r + 1]}; v += M2; p0[r] = v.x; p0[r + 1] = v.y; f32x2 w = {p1[r], p1[r + 1]}; w += M2; p1[r] = w.x; p1[r + 1] = w.y; }
    pmax -= m_reg; }
  { auto rr = __builtin_amdgcn_permlane32_swap(__float_as_uint(pmax), __float_as_uint(pmax), false, false);
    pmax = max2f(__uint_as_float(rr[0]), __uint_as_float(rr[1])); }
  if (__builtin_expect(!first && __all(pmax <= thr), 1)) { alpha = 1.f; }
  else { const float delta = first ? pmax : max2f(pmax, 0.f); alpha = __builtin_amdgcn_exp2f(-delta); m_reg += delta;
#pragma unroll
    for (int r = 0; r < 16; ++r) { p0[r] -= delta; p1[r] -= delta; }
    if constexpr (TUP) { const float nm = -m_reg;
#pragma unroll
      for (int r = 0; r < 16; ++r) negm[r] = nm;
      asm volatile("" : "+v"(negm)); } }
}
__device__ __forceinline__ void finishSM(f32x16& p0, f32x16& p1, float alpha, float& l_reg, bf16x8& pa0, bf16x8& pa1, bf16x8& pa2, bf16x8& pa3) {
  float ps;
  { typedef float f32x2 __attribute__((ext_vector_type(2))); f32x2 s2 = {p0[0], p0[1]};
#pragma unroll
    for (int r = 2; r < 16; r += 2) s2 += (f32x2){p0[r], p0[r + 1]};
#pragma unroll
    for (int r = 0; r < 16; r += 2) s2 += (f32x2){p1[r], p1[r + 1]};
    ps = s2.x + s2.y; }
  { auto rr = __builtin_amdgcn_permlane32_swap(__float_as_uint(ps), __float_as_uint(ps), false, false);
    ps = __uint_as_float(rr[0]) + __uint_as_float(rr[1]); }
  l_reg = l_reg * alpha + ps;
#define ATT_PKD(P, BASE) __builtin_bit_cast(bf16x8, (u32x4){cvtpk(P[BASE + 0], P[BASE + 1]), cvtpk(P[BASE + 2], P[BASE + 3]), cvtpk(P[BASE + 4], P[BASE + 5]), cvtpk(P[BASE + 6], P[BASE + 7])})
  pa0 = ATT_PKD(p0, 0); pa1 = ATT_PKD(p0, 8); pa2 = ATT_PKD(p1, 0); pa3 = ATT_PKD(p1, 8);
#undef ATT_PKD
}
template <int DQK, bool TUP>
__device__ __forceinline__ void qkt(f32x16& p0, f32x16& p1, const LAS unsigned char* Ks, const bf16x8* qr, int r32, int hi, const f32x16& negm) {
  constexpr int RS = DQK * 2 + 16;
  if constexpr (TUP) { p0 = negm; p1 = negm; } else { p0 = f32x16{}; p1 = f32x16{}; }
#pragma unroll
  for (int d0 = 0; d0 < DQK / 16; ++d0) { const int cb = d0 * 32 + hi * 16;
    const bf16x8 b0 = *(const LAS bf16x8*)(Ks + r32 * RS + cb);
    const bf16x8 b1 = *(const LAS bf16x8*)(Ks + (32 + r32) * RS + cb);
    p0 = __builtin_amdgcn_mfma_f32_32x32x16_bf16(b0, qr[d0], p0, 0, 0, 0);
    p1 = __builtin_amdgcn_mfma_f32_32x32x16_bf16(b1, qr[d0], p1, 0, 0, 0); }
}
__device__ __forceinline__ int v_st(int k, int c) { const int kk = (k & ~0xC) | ((k & 4) << 1) | ((k & 8) >> 1); return ((kk >> 3) * 4 + (c >> 5)) * 512 + ((kk & 7) * 32 + (c & 31)) * 2; }
__device__ __forceinline__ int v_rd_base(int lane) { return ((lane & 3) << 3) | (((lane >> 2) & 3) << 6) | (((lane >> 4) & 1) << 5) | (((lane >> 5) & 1) << 8); }
constexpr int v_rd_off(int d0, int ks, int half) { return d0 * 512 + ks * 4096 + half * 2048; }
__device__ __forceinline__ int v_st_n(int k, int c) { return (c >> 5) * 4096 + k * 64 + (c & 31) * 2; }
__device__ __forceinline__ int v_rd_base_n(int lane) { return ((lane >> 4) & 1) * 32 + (lane & 3) * 8 + (4 * (lane >> 5) + ((lane & 15) >> 2)) * 64; }
constexpr int v_rd_off_n(int d0, int ks, int half) { return d0 * 4096 + ks * 1024 + half * 512; }
template <int OFF> __device__ __forceinline__ s16x4 tr_read(int vb) {
  s16x4 r; asm volatile("ds_read_b64_tr_b16 %0, %1 offset:%2" : "=&v"(r) : "v"(vb), "i"(OFF) : "memory"); return r;
}
template <int D0, bool EX> __device__ __forceinline__ void pv_one(f32x16& od, int vb, bf16x8 pa0, bf16x8 pa1, bf16x8 pa2, bf16x8 pa3, f32x16& s) {
  const s16x4 l0 = tr_read<v_rd_off_n(D0, 0, 0)>(vb), h0 = tr_read<v_rd_off_n(D0, 0, 1)>(vb), l1 = tr_read<v_rd_off_n(D0, 1, 0)>(vb), h1 = tr_read<v_rd_off_n(D0, 1, 1)>(vb);
  const s16x4 l2 = tr_read<v_rd_off_n(D0, 2, 0)>(vb), h2 = tr_read<v_rd_off_n(D0, 2, 1)>(vb), l3 = tr_read<v_rd_off_n(D0, 3, 0)>(vb), h3 = tr_read<v_rd_off_n(D0, 3, 1)>(vb);
  asm volatile("s_waitcnt lgkmcnt(0)" ::: "memory"); ATT_SBAR();
#define ATT_PK(L, H) (bf16x8){L[0], L[1], L[2], L[3], H[0], H[1], H[2], H[3]}
  constexpr int B = (D0 & 1) * 8;
  od = __builtin_amdgcn_mfma_f32_32x32x16_bf16(pa0, ATT_PK(l0, h0), od, 0, 0, 0);
  if constexpr (EX) { s[B] = __builtin_amdgcn_exp2f(s[B]); s[B + 1] = __builtin_amdgcn_exp2f(s[B + 1]); }
  od = __builtin_amdgcn_mfma_f32_32x32x16_bf16(pa1, ATT_PK(l1, h1), od, 0, 0, 0);
  if constexpr (EX) { s[B + 2] = __builtin_amdgcn_exp2f(s[B + 2]); s[B + 3] = __builtin_amdgcn_exp2f(s[B + 3]); }
  od = __builtin_amdgcn_mfma_f32_32x32x16_bf16(pa2, ATT_PK(l2, h2), od, 0, 0, 0);
  if constexpr (EX) { s[B + 4] = __builtin_amdgcn_exp2f(s[B + 4]); s[B + 5] = __builtin_amdgcn_exp2f(s[B + 5]); }
  od = __builtin_amdgcn_mfma_f32_32x32x16_bf16(pa3, ATT_PK(l3, h3), od, 0, 0, 0);
  if constexpr (EX) { s[B + 6] = __builtin_amdgcn_exp2f(s[B + 6]); s[B + 7] = __builtin_amdgcn_exp2f(s[B + 7]); asm volatile("" : "+v"(s)); }
#undef ATT_PK
}
__device__ __forceinline__ void pv_ex(f32x16* o, int vb, bf16x8 pa0, bf16x8 pa1, bf16x8 pa2, bf16x8 pa3, f32x16& s0, f32x16& s1) {
  pv_one<0, true>(o[0], vb, pa0, pa1, pa2, pa3, s0); pv_one<1, true>(o[1], vb, pa0, pa1, pa2, pa3, s0); pv_one<2, true>(o[2], vb, pa0, pa1, pa2, pa3, s1); pv_one<3, true>(o[3], vb, pa0, pa1, pa2, pa3, s1);
}
__device__ __forceinline__ void pv_last(f32x16* o, int vb, bf16x8 pa0, bf16x8 pa1, bf16x8 pa2, bf16x8 pa3) { f32x16 z = {};
  pv_one<0, false>(o[0], vb, pa0, pa1, pa2, pa3, z); pv_one<1, false>(o[1], vb, pa0, pa1, pa2, pa3, z); pv_one<2, false>(o[2], vb, pa0, pa1, pa2, pa3, z); pv_one<3, false>(o[3], vb, pa0, pa1, pa2, pa3, z); }
__device__ __forceinline__ float rowmax32(const f32x16& p0, const f32x16& p1) {
  float a = max3f(p0[0], p0[1], p1[0]), b = max3f(p0[2], p0[3], p1[1]); a = max3f(a, p1[2], p1[3]);
#pragma unroll
  for (int r = 4; r < 16; r += 4) { a = max3f(a, p0[r], p0[r + 1]); b = max3f(b, p0[r + 2], p0[r + 3]); a = max3f(a, p1[r], p1[r + 1]); b = max3f(b, p1[r + 2], p1[r + 3]); }
  return max2f(a, b);
}
__device__ __forceinline__ float bfe(bf16x8 v, int e) { return __builtin_bit_cast(float, (unsigned)(unsigned short)v[e] << 16); }
}

struct KSeg { const bf16* kn; int ldn; const bf16* kr; int ldr; const bf16* v; int ldv; int n; };

template <int DQK, int SD, bool OUTBF>
__device__ __forceinline__ void attn_mfma_unit(LAS unsigned char* lds, const bf16* Qp, int ldq, bool rot, const float* rt, int t0, const KSeg& ctx, const KSeg& lat, float scale, void* Opv, int tid,
                                               bool fin = false, float lam = 0.f, float gsc = 0.f, const float* ag = nullptr, bf16* Mx = nullptr) {
  using namespace att;
  constexpr int NF = DQK / 16, RS = DQK * 2 + 16, SHM_K = 64 * RS;
  const int wid = tid >> 6, lane = tid & 63, r32 = lane & 31, hi = lane >> 5;
  constexpr int NSL = 3;
  LAS unsigned char* V_lds = lds; LAS unsigned char* K_lds = lds + NSL * SHM_V;
  LAS float* wsf = (LAS float*)(lds + NSL * SHM_V + NSL * SHM_K) + wid * 64; LAS float* li_l = wsf; LAS float* al_l = wsf + 32;
  (void)scale;
  const float thr = 8.f * 1.4426950408889634f;
  float m_reg = 0.f, l_reg = 0; f32x16 negm = {}; f32x16 o[4] = {}; bf16x8 qr[NF];
  const bf16* Qw = Qp + (size_t)(wid * 32 + r32) * ldq + hi * 8;
#pragma unroll
  for (int d0 = 0; d0 < NF; ++d0) qr[d0] = *reinterpret_cast<const bf16x8*>(Qw + d0 * 16);
  const int sr = tid >> 4, sc = (tid & 15) * 8, vst0 = v_st_n(sr, sc), vst1 = v_st_n(32 + sr, sc);
  const int krow = tid >> 3, kch = tid & 7, xrow = tid >> 2, xch = tid & 3; const bool xld = (DQK == 96) && tid < 256;
  const int vb0 = (int)(unsigned)(uintptr_t)V_lds + v_rd_base_n(lane);
  const int nct = ctx.n >> 6, NT = nct + (lat.n >> 6);
  struct { bf16x8 vs0, vs1, kn, kx; } st;
#define ATT_SLOAD(j) do { const int j_ = (j); const bool c_ = j_ < nct; const KSeg& S_ = c_ ? ctx : lat; const int k0_ = (c_ ? j_ : j_ - nct) * 64; \
    st.vs0 = *reinterpret_cast<const bf16x8*>(S_.v + (size_t)(k0_ + sr) * S_.ldv + sc); st.vs1 = *reinterpret_cast<const bf16x8*>(S_.v + (size_t)(k0_ + 32 + sr) * S_.ldv + sc); \
    st.kn = *reinterpret_cast<const bf16x8*>(S_.kn + (size_t)(k0_ + krow) * S_.ldn + kch * 8); \
    if (xld) st.kx = *reinterpret_cast<const bf16x8*>(S_.kr + (size_t)(k0_ + xrow) * S_.ldr + xch * 8); } while (0)
#define ATT_SWRITE(b) do { *(LAS bf16x8*)(V_lds + (b) * SHM_V + vst0) = st.vs0; *(LAS bf16x8*)(V_lds + (b) * SHM_V + vst1) = st.vs1; \
    *(LAS bf16x8*)(K_lds + (b) * SHM_K + krow * RS + kch * 16) = st.kn; \
    if (xld) *(LAS bf16x8*)(K_lds + (b) * SHM_K + xrow * RS + 128 + xch * 16) = st.kx; } while (0)
#define ATT_SWAIT() asm volatile("s_waitcnt vmcnt(0)" ::: "memory")
#define ATT_RESC(a) do { if (__any((a) < 1.f)) { if (hi == 0) al_l[r32] = (a); asm volatile("s_waitcnt lgkmcnt(0)" ::: "memory"); \
    _Pragma("unroll") for (int d = 0; d < 4; ++d) _Pragma("unroll") for (int r = 0; r < 16; ++r) o[d][r] *= al_l[crow(r, hi)]; } } while (0)
#define ATT_ROTQ() do { const int t_ = t0 + wid * 32 + r32; \
    if constexpr (DQK == 64) { const float* tb = rt + (size_t)t_ * 64 + hi * 8; u32x4 w0, w1, w2, w3; \
        float y0[8], y1[8], y2[8], y3[8]; \
        _Pragma("unroll") for (int e = 0; e < 8; ++e) { const float cr = tb[e], sn = tb[16 + e], cc = tb[32 + e], sc2 = tb[48 + e]; \
            const float x0 = bfe(qr[0], e), x1 = bfe(qr[1], e), x2 = bfe(qr[2], e), x3 = bfe(qr[3], e); \
            y0[e] = x0 * cr - x1 * sn; y1[e] = x1 * cr + x0 * sn; y2[e] = x2 * cc - x3 * sc2; y3[e] = x3 * cc + x2 * sc2; } \
        w0 = (u32x4){cvtpk(y0[0], y0[1]), cvtpk(y0[2], y0[3]), cvtpk(y0[4], y0[5]), cvtpk(y0[6], y0[7])}; w1 = (u32x4){cvtpk(y1[0], y1[1]), cvtpk(y1[2], y1[3]), cvtpk(y1[4], y1[5]), cvtpk(y1[6], y1[7])}; \
        w2 = (u32x4){cvtpk(y2[0], y2[1]), cvtpk(y2[2], y2[3]), cvtpk(y2[4], y2[5]), cvtpk(y2[6], y2[7])}; w3 = (u32x4){cvtpk(y3[0], y3[1]), cvtpk(y3[2], y3[3]), cvtpk(y3[4], y3[5]), cvtpk(y3[6], y3[7])}; \
        qr[0] = __builtin_bit_cast(bf16x8, w0); qr[1] = __builtin_bit_cast(bf16x8, w1); qr[2] = __builtin_bit_cast(bf16x8, w2); qr[3] = __builtin_bit_cast(bf16x8, w3); \
    } else { const float* tb = rt + (size_t)t_ * 32; const float sg = hi ? 1.f : -1.f; \
        const u32x4 a4 = __builtin_bit_cast(u32x4, qr[NF - 2]), a5 = __builtin_bit_cast(u32x4, qr[NF - 1]); u32x4 p4, p5; \
        _Pragma("unroll") for (int i = 0; i < 4; ++i) { p4[i] = (unsigned)__shfl_xor((int)a4[i], 32); p5[i] = (unsigned)__shfl_xor((int)a5[i], 32); } \
        const bf16x8 q4 = __builtin_bit_cast(bf16x8, p4), q5 = __builtin_bit_cast(bf16x8, p5); float y4[8], y5[8]; \
        _Pragma("unroll") for (int e = 0; e < 8; ++e) { const float cr = tb[e], sn = tb[8 + e], cc = tb[16 + e], sc2 = tb[24 + e]; \
            y4[e] = bfe(qr[NF - 2], e) * cr + sg * bfe(q4, e) * sn; y5[e] = bfe(qr[NF - 1], e) * cc + sg * bfe(q5, e) * sc2; } \
        const u32x4 w4 = {cvtpk(y4[0], y4[1]), cvtpk(y4[2], y4[3]), cvtpk(y4[4], y4[5]), cvtpk(y4[6], y4[7])}, w5 = {cvtpk(y5[0], y5[1]), cvtpk(y5[2], y5[3]), cvtpk(y5[4], y5[5]), cvtpk(y5[6], y5[7])}; \
        qr[NF - 2] = __builtin_bit_cast(bf16x8, w4); qr[NF - 1] = __builtin_bit_cast(bf16x8, w5); } } while (0)
  f32x16 pA0, pA1, pB0, pB1; float alA, alB; bf16x8 pa0, pa1, pa2, pa3;
  ATT_SLOAD(0); ATT_SWAIT(); ATT_SWRITE(0);
  ATT_SLOAD(1); ATT_SWAIT(); ATT_SWRITE(1); ATT_LBAR();
  qkt<DQK, true>(pA0, pA1, K_lds, qr, r32, hi, negm);
  partialSM<true>(pA0, pA1, m_reg, negm, alA, thr, true, rowmax32(pA0, pA1));
#pragma unroll
  for (int r = 0; r < 16; ++r) { pA0[r] = __builtin_amdgcn_exp2f(pA0[r]); pA1[r] = __builtin_amdgcn_exp2f(pA1[r]); }
  int s_cur = 0, s_nxt = 1, s_nn = 2;
#define ATT_STEP(t, X0, X1, alX, Y0, Y1, alY, HAS1, HAS2) do { \
    if (HAS1) { if (rot && (t) + 1 == nct) ATT_ROTQ(); } \
    ATT_SBAR(); if (HAS1) qkt<DQK, true>(Y0, Y1, K_lds + s_nxt * SHM_K, qr, r32, hi, negm); \
    finishSM(X0, X1, alX, l_reg, pa0, pa1, pa2, pa3); ATT_SBAR(); \
    if (HAS2) ATT_SLOAD((t) + 2); ATT_SBAR(); \
    if (HAS1) { partialSM<true>(Y0, Y1, m_reg, negm, alY, thr, false, rowmax32(Y0, Y1)); ATT_SBAR(); pv_ex(o, vb0 + s_cur * SHM_V, pa0, pa1, pa2, pa3, Y0, Y1); } \
    else pv_last(o, vb0 + s_cur * SHM_V, pa0, pa1, pa2, pa3); \
    if (HAS2) { ATT_SWAIT(); ATT_SWRITE(s_nn); } \
    if (HAS1) ATT_RESC(alY); \
    ATT_LBAR(); { const int tmp_ = s_cur; s_cur = s_nxt; s_nxt = s_nn; s_nn = tmp_; } } while (0)
  for (int t = 0; t + 2 < NT; t += 2) {
    ATT_STEP(t, pA0, pA1, alA, pB0, pB1, alB, true, true);
    ATT_STEP(t + 1, pB0, pB1, alB, pA0, pA1, alA, true, true);
  }
  ATT_STEP(NT - 2, pA0, pA1, alA, pB0, pB1, alB, true, false);
  ATT_STEP(NT - 1, pB0, pB1, alB, pA0, pA1, alA, false, false);
#undef ATT_STEP
  if (hi == 0) li_l[r32] = l_reg; asm volatile("s_waitcnt lgkmcnt(0)" ::: "memory");
  float rli[16];
#pragma unroll
  for (int r = 0; r < 16; ++r) rli[r] = __builtin_amdgcn_rcpf(li_l[crow(r, hi)]);
  if constexpr (OUTBF) { bf16* Ow = (bf16*)Opv + (size_t)(wid * 32) * DM;
#pragma unroll
    for (int r = 0; r < 16; ++r) { const int orow = crow(r, hi);
#pragma unroll
      for (int d0 = 0; d0 < 4; ++d0) Ow[(size_t)orow * DM + d0 * 32 + r32] = (bf16)f2bf(o[d0][r] * rli[r]); }
  } else { float* Ow = (float*)Opv + (size_t)(wid * 32) * NOATT;
    if (!fin) {
#pragma unroll
      for (int r = 0; r < 16; ++r) { const int orow = crow(r, hi);
#pragma unroll
        for (int d0 = 0; d0 < 4; ++d0) Ow[(size_t)orow * NOATT + d0 * 32 + r32] = o[d0][r] * rli[r]; }
    } else {
      bf16* Mw = Mx + (size_t)(wid * 32) * DM; float gv[4];
#pragma unroll
      for (int d0 = 0; d0 < 4; ++d0) gv[d0] = ag[d0 * 32 + r32] * gsc;
#pragma unroll
      for (int r = 0; r < 16; ++r) { const int orow = crow(r, hi); float v[4]; float ss = 0.f;
#pragma unroll
        for (int d0 = 0; d0 < 4; ++d0) { v[d0] = Ow[(size_t)orow * NOATT + d0 * 32 + r32] - lam * (o[d0][r] * rli[r]); ss += v[d0] * v[d0]; }
        ss += __shfl_xor(ss, 1); ss += __shfl_xor(ss, 2); ss += __shfl_xor(ss, 4); ss += __shfl_xor(ss, 8); ss += __shfl_xor(ss, 16);
        const float rs = 1.0f / sqrtf(ss * (1.f / 128.f) + EPS);
#pragma unroll
        for (int d0 = 0; d0 < 4; ++d0) Mw[(size_t)orow * DM + d0 * 32 + r32] = (bf16)f2bf(v[d0] * rs * gv[d0]); } } }
  __syncthreads();
#undef ATT_SLOAD
#undef ATT_SWRITE
#undef ATT_SWAIT
#undef ATT_RESC
#undef ATT_ROTQ
}

__device__ __forceinline__ void norm0_phase(const float* xp, const float* xs_off, const float* gm, bf16* H, float* ssq, int gw, int NGW, int lane) {
    for (int m = gw; m < M; m += NGW) {
        const float* xr = (m < MP ? xp : xs_off) + (size_t)m * DM;
        const int mi = m < MP ? 0 : 1 + (m - MP) / DSEQ; const float* g = gm + (size_t)mi * DM;
        f32x4 v[8]; float s = 0.f;
#pragma unroll
        for (int j = 0; j < 8; ++j) { v[j] = ((const f32x4*)xr)[lane + 64 * j]; s += (v[j].x * v[j].x + v[j].y * v[j].y) + (v[j].z * v[j].z + v[j].w * v[j].w); }
        s = wave_sum(s); if (lane == 0) ssq[m] = s;
#pragma unroll
        for (int j = 0; j < 8; ++j) { const int c = (lane + 64 * j) * 4; const f32x4 y = v[j] * *(const f32x4*)(g + c); v2u o; o.x = pk2(y.x, y.y); o.y = pk2(y.z, y.w); *(v2u*)(H + (size_t)m * DM + c) = o; }
    }
}
__device__ __forceinline__ void pro2_phase(const Args& a, LAS unsigned char* lds, int tid, int bid, int G, int gt, int NGT) {
    using att::bf16x8; using att::f32x16; using att::crow;
    unsigned char* ws = a.ws; const float* MOD = (const float*)(ws + WS_MOD); float* GM = (float*)(ws + WS_GM);
    for (int i = gt; i < DEPTH * 2 * 5 * DM; i += NGT) { const int c = i % DM, mi = (i / DM) % 5, w = (i / (5 * DM)) & 1, l = i / (2 * 5 * DM);
        const float g = a.in[w ? I_N2G : I_N1G][l * DM + c]; GM[i] = g * (1.f + MOD[((size_t)(l * 5 + mi) * 6 + (w ? 4 : 1)) * DM + c]); }
    const int wave = tid >> 6, lane = tid & 63, r32 = lane & 31, hi = lane >> 5;
    LAS bf16* T = (LAS bf16*)lds;
#pragma unroll 1
    for (int kind = 0; kind < 2; ++kind) {
        __syncthreads();
        for (int e = tid; e < DEPTH * 5 * DM; e += NTH) { const int l = e / (5 * DM), mi = (e / DM) % 5, k = e % DM; T[e] = (bf16)f2bf(MOD[((size_t)(l * 5 + mi) * 6 + (kind ? 3 : 0)) * DM + k]); }
        __syncthreads();
        const int ld = kind ? 2 * DFF : NINP, items_l = ld / 32;
        for (int it = bid * NWV + wave; it < DEPTH * items_l; it += G * NWV) { const int l = it / items_l, rb = it % items_l;
            const bf16* Wr = (kind ? (const bf16*)(ws + WS_WUP + l * SZ_WUP) : (const bf16*)(ws + WS_WIN + l * SZ_WIN)) + (size_t)(rb * 32 + r32) * DM + hi * 8;
            const LAS bf16* Tb = T + (size_t)(l * 5 + (r32 < 5 ? r32 : 4)) * DM + hi * 8;
            f32x16 acc = {};
#pragma unroll 1
            for (int ks = 0; ks < DM / 16; ks += 8) { bf16x8 af[8];
#pragma unroll
                for (int j = 0; j < 8; ++j) af[j] = *reinterpret_cast<const bf16x8*>(Wr + (ks + j) * 16);
#pragma unroll
                for (int j = 0; j < 8; ++j) { bf16x8 bfv = *(const LAS bf16x8*)(Tb + (ks + j) * 16); if (r32 >= 5) bfv = (bf16x8){0, 0, 0, 0, 0, 0, 0, 0};
                    acc = __builtin_amdgcn_mfma_f32_32x32x16_bf16(af[j], bfv, acc, 0, 0, 0); } }
            if (r32 < 5) { float* dst = (kind ? (float*)(ws + WS_SHWU) + (size_t)l * 5 * 2 * DFF : (float*)(ws + WS_SHWI) + (size_t)l * 5 * NINP) + (size_t)r32 * ld + rb * 32;
#pragma unroll
                for (int r = 0; r < 16; ++r) dst[crow(r, hi)] = acc[r]; }
        }
    }
    __syncthreads();
}
__device__ __forceinline__ void final_norm_phase(const float* X, const float* g, float* out, int gw, int NGW, int lane) {
    for (int m = gw; m < M; m += NGW) {
        const float* xr = X + (size_t)m * DM; f32x4 v[8]; float s = 0.f;
#pragma unroll
        for (int j = 0; j < 8; ++j) { v[j] = ((const f32x4*)xr)[lane + 64 * j]; s += (v[j].x * v[j].x + v[j].y * v[j].y) + (v[j].z * v[j].z + v[j].w * v[j].w); }
        const float rstd = 1.0f / sqrtf(wave_sum(s) * (1.f / DM) + EPS);
#pragma unroll
        for (int j = 0; j < 8; ++j) { const int c = (lane + 64 * j) * 4; *(f32x4*)(out + (size_t)m * DM + c) = v[j] * rstd * *(const f32x4*)(g + c); }
    }
}

__device__ __forceinline__ void post_phase(const Args& a, int l, int gw, int NGW, int lane) {
    using att::bf16x8; using att::bfe; using att::cvtpk; using att::u32x4;
    unsigned char* ws = a.ws;
    const bf16* P = (const bf16*)(ws + WS_P); bf16* KRA = (bf16*)(ws + WS_KRA); bf16* KRC = (bf16*)(ws + WS_KRC); bf16* CQN = (bf16*)(ws + WS_CQN); bf16* CKVN = (bf16*)(ws + WS_CKVN);
    const float* RTA = (const float*)(ws + WS_RTA); const float* RTC = (const float*)(ws + WS_RTC);
    const float* gq = a.in[I_CQG] + l * 384; const float* gkv = a.in[I_CKVG] + l * 256;
    for (int m = gw; m < M; m += NGW) {
        const bf16* pr = P + (size_t)m * NINP;
        float xq[8], xk[8]; float sq = 0.f, sk = 0.f;
        if (lane < 48) { const bf16x8 v = *reinterpret_cast<const bf16x8*>(pr + C_CQ + lane * 8);
#pragma unroll
            for (int i = 0; i < 8; ++i) { xq[i] = bfe(v, i); sq += xq[i] * xq[i]; } }
        if (lane < 32) { const bf16x8 v = *reinterpret_cast<const bf16x8*>(pr + C_CKV + lane * 8);
#pragma unroll
            for (int i = 0; i < 8; ++i) { xk[i] = bfe(v, i); sk += xk[i] * xk[i]; } }
        const float rq = 1.0f / sqrtf(wave_sum(sq) * (1.f / 384.f) + EPS), rk = 1.0f / sqrtf(wave_sum(sk) * (1.f / 256.f) + EPS);
        if (lane < 48) { const f32x4 g0 = *(const f32x4*)(gq + lane * 8), g1 = *(const f32x4*)(gq + lane * 8 + 4);
            *(u32x4*)(CQN + (size_t)m * 384 + lane * 8) = (u32x4){cvtpk(xq[0] * rq * g0.x, xq[1] * rq * g0.y), cvtpk(xq[2] * rq * g0.z, xq[3] * rq * g0.w), cvtpk(xq[4] * rq * g1.x, xq[5] * rq * g1.y), cvtpk(xq[6] * rq * g1.z, xq[7] * rq * g1.w)}; }
        if (lane < 32) { const f32x4 g0 = *(const f32x4*)(gkv + lane * 8), g1 = *(const f32x4*)(gkv + lane * 8 + 4);
            const f32x4 y0 = {xk[0] * rk * g0.x, xk[1] * rk * g0.y, xk[2] * rk * g0.z, xk[3] * rk * g0.w}, y1 = {xk[4] * rk * g1.x, xk[5] * rk * g1.y, xk[6] * rk * g1.z, xk[7] * rk * g1.w};
            *(u32x4*)(CKVN + (size_t)m * 256 + lane * 8) = (u32x4){cvtpk(y0.x, y0.y), cvtpk(y0.z, y0.w), cvtpk(y1.x, y1.y), cvtpk(y1.z, y1.w)};
            if (m < MP) { float* o = a.out + O_CKV + (((size_t)(m / SEQ) * DEPTH + l) * SEQ + (m % SEQ)) * 256 + lane * 8; *(f32x4*)o = y0; *(f32x4*)(o + 4) = y1; } }
        if (m >= MP) { const int ms = m - MP, t = ms % DSEQ;
            if (lane < 34) { const bool isa = lane < 32; const int hh = isa ? (lane >> 1) & 1 : lane - 32;
                const int base = isa ? (lane >> 2) * 64 + hh * 32 + (lane & 1) * 8 : hh * 16, dist = isa ? 16 : 8;
                const bf16* src = pr + (isa ? C_AK : C_CKR) + base; const float* tb = isa ? RTA + (size_t)t * 64 + hh * 32 + (lane & 1) * 8 : RTC + (size_t)t * 32 + hh * 16;
                const bf16x8 v0 = *reinterpret_cast<const bf16x8*>(src), v1 = *reinterpret_cast<const bf16x8*>(src + dist);
                const f32x4 c0 = *(const f32x4*)(tb), c1 = *(const f32x4*)(tb + 4), s0 = *(const f32x4*)(tb + dist), s1 = *(const f32x4*)(tb + dist + 4);
                float y0[8], y1[8];
#pragma unroll
                for (int i = 0; i < 8; ++i) { const float cs = i < 4 ? c0[i & 3] : c1[i & 3], sn = i < 4 ? s0[i & 3] : s1[i & 3]; const float x0 = bfe(v0, i), x1 = bfe(v1, i); y0[i] = x0 * cs - x1 * sn; y1[i] = x1 * cs + x0 * sn; }
                bf16* dst = isa ? KRA + (size_t)ms * 512 + base : KRC + (size_t)ms * 32 + base;
                *(u32x4*)dst = (u32x4){cvtpk(y0[0], y0[1]), cvtpk(y0[2], y0[3]), cvtpk(y0[4], y0[5]), cvtpk(y0[6], y0[7])};
                *(u32x4*)(dst + dist) = (u32x4){cvtpk(y1[0], y1[1]), cvtpk(y1[2], y1[3]), cvtpk(y1[4], y1[5]), cvtpk(y1[6], y1[7])}; }
        } else { const size_t ro = ((size_t)(m / SEQ) * DEPTH + l) * SEQ + (m % SEQ);
            { const bf16x8 v = *reinterpret_cast<const bf16x8*>(pr + C_AK + lane * 8); float* o = a.out + O_AK + ro * 512 + lane * 8;
              *(f32x4*)o = (f32x4){bfe(v, 0), bfe(v, 1), bfe(v, 2), bfe(v, 3)}; *(f32x4*)(o + 4) = (f32x4){bfe(v, 4), bfe(v, 5), bfe(v, 6), bfe(v, 7)}; }
            { const bf16x8 v = *reinterpret_cast<const bf16x8*>(pr + C_AV + lane * 8); float* o = a.out + O_AV + ro * 512 + lane * 8;
              *(f32x4*)o = (f32x4){bfe(v, 0), bfe(v, 1), bfe(v, 2), bfe(v, 3)}; *(f32x4*)(o + 4) = (f32x4){bfe(v, 4), bfe(v, 5), bfe(v, 6), bfe(v, 7)}; }
            if (lane < 4) { const bf16x8 v = *reinterpret_cast<const bf16x8*>(pr + C_CKR + lane * 8); float* o = a.out + O_CKR + ro * 32 + lane * 8;
              *(f32x4*)o = (f32x4){bfe(v, 0), bfe(v, 1), bfe(v, 2), bfe(v, 3)}; *(f32x4*)(o + 4) = (f32x4){bfe(v, 4), bfe(v, 5), bfe(v, 6), bfe(v, 7)}; } }
    }
}


constexpr int NCHUNK = M / 64, GLA_UNITS = NCHUNK * 6;
constexpr int TS = 144;

__device__ __forceinline__ void gla_g1_unit(const Args& a, int l, int unit, LAS unsigned char* lds, int tid) {
    using namespace att;
    unsigned char* ws = a.ws; const bf16* P = (const bf16*)(ws + WS_P); bf16* QK4 = (bf16*)(ws + WS_QK4); float* U = (float*)(ws + WS_U); float* DD = (float*)(ws + WS_DD);
    const int gc = unit / 6, h = unit % 6, m0 = gc * 64;
    const int wave = tid >> 6, lane = tid & 63, r32 = lane & 31, hi = lane >> 5;
    LAS float* glr = (LAS float*)lds;
    LAS float* gw = (LAS float*)(lds + 8192);
    LAS float* gbs = (LAS float*)(lds + 16384);
    LAS float* segtot = (LAS float*)(lds + 16896);
    LAS unsigned char* KfT = lds + 20992;
    LAS unsigned char* KbT = lds + 30208;
    LAS unsigned char* Vt = lds + 39424;
    LAS float* Dl = (LAS float*)(lds + 55808);
    const float* gwt = a.in[I_BGW] + (size_t)l * 2 * 16 * 384; const float* gb = a.in[I_BGB] + l * 2 * 384;
    const int k = tid & 63, tq = tid >> 6;
    if (tid < 256) { const int t = tid >> 2, part = tid & 3; const bf16x8 v = *reinterpret_cast<const bf16x8*>(P + (size_t)(m0 + t) * NINP + C_BG + part * 8);
#pragma unroll
        for (int i = 0; i < 8; ++i) glr[t * 32 + part * 8 + i] = bfe(v, i); }
#pragma unroll
    for (int i = 0; i < 4; ++i) { const int idx = tid + NTH * i, dr = idx >> 6, kk = idx & 63; gw[idx] = gwt[(size_t)dr * 384 + h * 64 + kk]; }
    if (tid < 128) gbs[tid] = gb[(tid >> 6) * 384 + h * 64 + (tid & 63)];
    { const int sr = tid >> 4, sc = (tid & 15) * 8;
      const bf16x8 v0 = *reinterpret_cast<const bf16x8*>(P + (size_t)(m0 + sr) * NINP + C_BV + h * 128 + sc), v1 = *reinterpret_cast<const bf16x8*>(P + (size_t)(m0 + 32 + sr) * NINP + C_BV + h * 128 + sc);
      *(LAS bf16x8*)(Vt + v_st(sr, sc)) = v0; *(LAS bf16x8*)(Vt + v_st(32 + sr, sc)) = v1; }
    bf16 qv[8], kv[8];
#pragma unroll
    for (int j = 0; j < 8; ++j) { const bf16* pr = P + (size_t)(m0 + 8 * tq + j) * NINP + h * 64 + k; qv[j] = pr[C_BQ]; kv[j] = pr[C_BK]; }
    __syncthreads();
    float bf_[8], bb_[8];
#pragma unroll
    for (int dir = 0; dir < 2; ++dir) { float wr_[16];
#pragma unroll
        for (int r = 0; r < 16; ++r) wr_[r] = gw[(dir * 16 + r) * 64 + k];
        const float bias = gbs[dir * 64 + k];
#pragma unroll
        for (int j = 0; j < 8; ++j) { const LAS float* gp = glr + (8 * tq + j) * 32 + dir * 16; float pre = bias;
#pragma unroll
            for (int r4 = 0; r4 < 4; ++r4) { const f32x4 x = *(const LAS f32x4*)(gp + 4 * r4); pre += (x.x * wr_[4 * r4] + x.y * wr_[4 * r4 + 1]) + (x.z * wr_[4 * r4 + 2] + x.w * wr_[4 * r4 + 3]); }
            const float gl = (fminf(pre, 0.f) - __logf(1.f + __expf(-fabsf(pre)))) * (1.f / 16.f);
            if (dir == 0) bf_[j] = gl; else bb_[j] = gl; } }
#pragma unroll
    for (int j = 1; j < 8; ++j) bf_[j] += bf_[j - 1];
#pragma unroll
    for (int j = 6; j >= 0; --j) bb_[j] += bb_[j + 1];
    segtot[tq * 64 + k] = bf_[7]; segtot[(8 + tq) * 64 + k] = bb_[0];
    __syncthreads();
    { float of = 0.f, ob = 0.f;
#pragma unroll
      for (int q2 = 0; q2 < 8; ++q2) { const float sf = segtot[q2 * 64 + k], sb = segtot[(8 + q2) * 64 + k]; of += q2 < tq ? sf : 0.f; ob += q2 > tq ? sb : 0.f; }
      float kf[8], kb[8];
      bf16* dst = QK4 + (size_t)(m0 + 8 * tq) * 1536 + h * 64 + k;
#pragma unroll
      for (int j = 0; j < 8; ++j) { const float bfv = bf_[j] + of, bbv = bb_[j] + ob; const float ef = __expf(bfv), eb = __expf(bbv); const float q = bf2f(qv[j]) * 0.125f, kk = bf2f(kv[j]);
          kf[j] = kk * __expf(-bfv); kb[j] = kk * __expf(-bbv);
          dst[(size_t)j * 1536] = (bf16)f2bf(q * ef); dst[(size_t)j * 1536 + 384] = (bf16)f2bf(kf[j]); dst[(size_t)j * 1536 + 768] = (bf16)f2bf(q * eb); dst[(size_t)j * 1536 + 1152] = (bf16)f2bf(kb[j]);
          if (j == 7 && tq == 7) Dl[k] = ef;
          if (j == 0 && tq == 0) Dl[64 + k] = eb; }
      *(LAS u32x4*)(KfT + k * TS + tq * 16) = (u32x4){cvtpk(kf[0], kf[1]), cvtpk(kf[2], kf[3]), cvtpk(kf[4], kf[5]), cvtpk(kf[6], kf[7])};
      *(LAS u32x4*)(KbT + k * TS + tq * 16) = (u32x4){cvtpk(kb[0], kb[1]), cvtpk(kb[2], kb[3]), cvtpk(kb[4], kb[5]), cvtpk(kb[6], kb[7])}; }
    __syncthreads();
    { const int dir = wave >> 2, vb = wave & 3; const LAS unsigned char* KT = dir ? KbT : KfT;
      const int vbase = (int)(unsigned)(uintptr_t)Vt + v_rd_base(lane) + vb * 512;
      const s16x4 l0 = tr_read<v_rd_off(0, 0, 0)>(vbase), h0 = tr_read<v_rd_off(0, 0, 1)>(vbase), l1 = tr_read<v_rd_off(0, 1, 0)>(vbase), h1 = tr_read<v_rd_off(0, 1, 1)>(vbase);
      const s16x4 l2 = tr_read<v_rd_off(0, 2, 0)>(vbase), h2 = tr_read<v_rd_off(0, 2, 1)>(vbase), l3 = tr_read<v_rd_off(0, 3, 0)>(vbase), h3 = tr_read<v_rd_off(0, 3, 1)>(vbase);
      asm volatile("s_waitcnt lgkmcnt(0)" ::: "memory");
#define GLA_PK(L, H) (bf16x8){L[0], L[1], L[2], L[3], H[0], H[1], H[2], H[3]}
      const bf16x8 vf0 = GLA_PK(l0, h0), vf1 = GLA_PK(l1, h1), vf2 = GLA_PK(l2, h2), vf3 = GLA_PK(l3, h3);
      float* Ub = U + ((size_t)unit * 2 + dir) * 8192;
#pragma unroll
      for (int rb = 0; rb < 2; ++rb) { f32x16 acc = {};
          const LAS unsigned char* ar = KT + (rb * 32 + r32) * TS + hi * 16;
          acc = __builtin_amdgcn_mfma_f32_32x32x16_bf16(*(const LAS bf16x8*)(ar), vf0, acc, 0, 0, 0);
          acc = __builtin_amdgcn_mfma_f32_32x32x16_bf16(*(const LAS bf16x8*)(ar + 32), vf1, acc, 0, 0, 0);
          acc = __builtin_amdgcn_mfma_f32_32x32x16_bf16(*(const LAS bf16x8*)(ar + 64), vf2, acc, 0, 0, 0);
          acc = __builtin_amdgcn_mfma_f32_32x32x16_bf16(*(const LAS bf16x8*)(ar + 96), vf3, acc, 0, 0, 0);
#pragma unroll
          for (int r = 0; r < 16; ++r) { const int k = rb * 32 + crow(r, hi); Ub[k * 128 + vb * 32 + r32] = acc[r] * Dl[dir * 64 + k]; } }
      if (tid < 128) DD[(size_t)unit * 128 + tid] = Dl[tid]; }
    __syncthreads();
}

constexpr int GLA_G2_ITEMS = (NPB + NDB) * 6 * 2 * 4;
__device__ __forceinline__ void gla_g2_item(const Args& a, int l, int item, int tid) {
    unsigned char* ws = a.ws; const float* U = (const float*)(ws + WS_U); const float* DD = (const float*)(ws + WS_DD); bf16* ST = (bf16*)(ws + WS_ST);
    const int kq = item & 3, dir = (item >> 2) & 1, hs = item >> 3, h = hs % 6, sq = hs / 6;
    const bool smp = sq < NDB; const int b = smp ? sq : sq - NDB, nc = smp ? DSEQ / 64 : SEQ / 64, gc0 = smp ? (MP / 64) + b * (DSEQ / 64) : b * (SEQ / 64);
    const int v = tid & 127, k0 = kq * 16 + (tid >> 7) * 4;
    f32x4 s;
#pragma unroll
    for (int i = 0; i < 4; ++i) s[i] = smp ? a.in[I_STB][((((size_t)b * DEPTH + l) * 2 + dir) * 6 + h) * 8192 + (k0 + i) * 128 + v] : 0.f;
    const int step = smp ? 8 : 4;
    for (int ci = 0; ci < nc; ci += step) {
        float u[8][4]; f32x4 d[8];
#pragma unroll
        for (int j = 0; j < 8; ++j) if (j < step) { const int c = dir ? nc - 1 - (ci + j) : ci + j; const size_t ub = ((size_t)(gc0 + c) * 6 + h) * 2 + dir; d[j] = *(const f32x4*)(DD + ub * 64 + k0);
#pragma unroll
            for (int i = 0; i < 4; ++i) u[j][i] = U[ub * 8192 + (k0 + i) * 128 + v]; }
#pragma unroll
        for (int j = 0; j < 8; ++j) if (j < step) { const int c = dir ? nc - 1 - (ci + j) : ci + j; const size_t ub = ((size_t)(gc0 + c) * 6 + h) * 2 + dir;
#pragma unroll
            for (int i = 0; i < 4; ++i) { ST[ub * 8192 + (size_t)(k0 + i) * 128 + v] = (bf16)f2bf(s[i]); s[i] = d[j][i] * s[i] + u[j][i]; } }
    }
    if (!smp) {
#pragma unroll
        for (int i = 0; i < 4; ++i) a.out[O_SB + ((((size_t)b * DEPTH + l) * 2 + dir) * 6 + h) * 8192 + (k0 + i) * 128 + v] = s[i];
    }
}

__device__ __forceinline__ void gla_g3_unit(const Args& a, int l, int unit, LAS unsigned char* lds, int tid) {
    using namespace att;
    unsigned char* ws = a.ws; const bf16* P = (const bf16*)(ws + WS_P); const bf16* QK4 = (const bf16*)(ws + WS_QK4); const bf16* ST = (const bf16*)(ws + WS_ST); bf16* MIX = (bf16*)(ws + WS_MIX);
    const int gc = unit / 6, h = unit % 6, m0 = gc * 64;
    const int wave = tid >> 6, lane = tid & 63, r32 = lane & 31, hi = lane >> 5;
    LAS unsigned char* T4 = lds;
    LAS unsigned char* Vt = lds + 36864;
    LAS unsigned char* AT = lds + 53248;
    LAS unsigned char* St = lds + 71680;
    LAS float* OT = (LAS float*)(lds + 71680);
    { const int row = tid >> 3, ch = tid & 7; const bf16* src = QK4 + (size_t)(m0 + row) * 1536 + h * 64 + ch * 8;
#pragma unroll
      for (int var = 0; var < 4; ++var) *(LAS bf16x8*)(T4 + var * 9216 + row * TS + ch * 16) = *reinterpret_cast<const bf16x8*>(src + var * 384);
      const int sr = tid >> 4, sc = (tid & 15) * 8;
      const bf16x8 v0 = *reinterpret_cast<const bf16x8*>(P + (size_t)(m0 + sr) * NINP + C_BV + h * 128 + sc), v1 = *reinterpret_cast<const bf16x8*>(P + (size_t)(m0 + 32 + sr) * NINP + C_BV + h * 128 + sc);
      *(LAS bf16x8*)(Vt + v_st(sr, sc)) = v0; *(LAS bf16x8*)(Vt + v_st(32 + sr, sc)) = v1;
#pragma unroll
      for (int dir = 0; dir < 2; ++dir) { const bf16* Sg = ST + (((size_t)unit) * 2 + dir) * 8192;
          const bf16x8 a0 = *reinterpret_cast<const bf16x8*>(Sg + (size_t)sr * 128 + sc), a1 = *reinterpret_cast<const bf16x8*>(Sg + (size_t)(32 + sr) * 128 + sc);
          *(LAS bf16x8*)(St + dir * 16384 + v_st(sr, sc)) = a0; *(LAS bf16x8*)(St + dir * 16384 + v_st(32 + sr, sc)) = a1; } }
    __syncthreads();
    { const int dir = wave >> 2, tb = (wave >> 1) & 1, sb = wave & 1;
      const LAS unsigned char* Qt = T4 + (dir * 2) * 9216 + (tb * 32 + r32) * TS + hi * 16; const LAS unsigned char* Kt = T4 + (dir * 2 + 1) * 9216 + (sb * 32 + r32) * TS + hi * 16;
      f32x16 acc = {};
#pragma unroll
      for (int ks = 0; ks < 4; ++ks) acc = __builtin_amdgcn_mfma_f32_32x32x16_bf16(*(const LAS bf16x8*)(Kt + ks * 32), *(const LAS bf16x8*)(Qt + ks * 32), acc, 0, 0, 0);
      const int t = tb * 32 + r32;
#pragma unroll
      for (int r = 0; r < 16; ++r) { const int s = sb * 32 + crow(r, hi); const bool keep = dir ? (s >= t) : (s <= t); acc[r] = keep ? acc[r] : 0.f; }
#pragma unroll
      for (int g = 0; g < 4; ++g) { v2u w; w.x = cvtpk(acc[4 * g], acc[4 * g + 1]); w.y = cvtpk(acc[4 * g + 2], acc[4 * g + 3]);
          *(LAS v2u*)(AT + dir * 9216 + t * TS + (sb * 32 + 8 * g + 4 * hi) * 2) = w; } }
    __syncthreads();
    { const int tb = wave >> 2, vb = wave & 3; f32x16 o = {};
      const int vbase = (int)(unsigned)(uintptr_t)Vt + v_rd_base(lane) + vb * 512;
      const s16x4 l0 = tr_read<v_rd_off(0, 0, 0)>(vbase), h0 = tr_read<v_rd_off(0, 0, 1)>(vbase), l1 = tr_read<v_rd_off(0, 1, 0)>(vbase), h1 = tr_read<v_rd_off(0, 1, 1)>(vbase);
      const s16x4 l2 = tr_read<v_rd_off(0, 2, 0)>(vbase), h2 = tr_read<v_rd_off(0, 2, 1)>(vbase), l3 = tr_read<v_rd_off(0, 3, 0)>(vbase), h3 = tr_read<v_rd_off(0, 3, 1)>(vbase);
      asm volatile("s_waitcnt lgkmcnt(0)" ::: "memory");
      const bf16x8 vf0 = GLA_PK(l0, h0), vf1 = GLA_PK(l1, h1), vf2 = GLA_PK(l2, h2), vf3 = GLA_PK(l3, h3);
#pragma unroll
      for (int dir = 0; dir < 2; ++dir) {
          const int sbase = (int)(unsigned)(uintptr_t)(St + dir * 16384) + v_rd_base(lane) + vb * 512;
          const s16x4 a0 = tr_read<v_rd_off(0, 0, 0)>(sbase), b0 = tr_read<v_rd_off(0, 0, 1)>(sbase), a1 = tr_read<v_rd_off(0, 1, 0)>(sbase), b1 = tr_read<v_rd_off(0, 1, 1)>(sbase);
          const s16x4 a2 = tr_read<v_rd_off(0, 2, 0)>(sbase), b2 = tr_read<v_rd_off(0, 2, 1)>(sbase), a3 = tr_read<v_rd_off(0, 3, 0)>(sbase), b3 = tr_read<v_rd_off(0, 3, 1)>(sbase);
          asm volatile("s_waitcnt lgkmcnt(0)" ::: "memory");
          const bf16x8 s0 = GLA_PK(a0, b0), s1 = GLA_PK(a1, b1), s2 = GLA_PK(a2, b2), s3 = GLA_PK(a3, b3);
          const LAS unsigned char* Qt = T4 + (dir * 2) * 9216 + (tb * 32 + r32) * TS + hi * 16; const LAS unsigned char* At = AT + dir * 9216 + (tb * 32 + r32) * TS + hi * 16;
          o = __builtin_amdgcn_mfma_f32_32x32x16_bf16(*(const LAS bf16x8*)(Qt), s0, o, 0, 0, 0);
          o = __builtin_amdgcn_mfma_f32_32x32x16_bf16(*(const LAS bf16x8*)(Qt + 32), s1, o, 0, 0, 0);
          o = __builtin_amdgcn_mfma_f32_32x32x16_bf16(*(const LAS bf16x8*)(Qt + 64), s2, o, 0, 0, 0);
          o = __builtin_amdgcn_mfma_f32_32x32x16_bf16(*(const LAS bf16x8*)(Qt + 96), s3, o, 0, 0, 0);
          o = __builtin_amdgcn_mfma_f32_32x32x16_bf16(*(const LAS bf16x8*)(At), vf0, o, 0, 0, 0);
          o = __builtin_amdgcn_mfma_f32_32x32x16_bf16(*(const LAS bf16x8*)(At + 32), vf1, o, 0, 0, 0);
          o = __builtin_amdgcn_mfma_f32_32x32x16_bf16(*(const LAS bf16x8*)(At + 64), vf2, o, 0, 0, 0);
          o = __builtin_amdgcn_mfma_f32_32x32x16_bf16(*(const LAS bf16x8*)(At + 96), vf3, o, 0, 0, 0); }
      __syncthreads();
#pragma unroll
      for (int r = 0; r < 16; ++r) OT[(tb * 32 + crow(r, hi)) * 132 + vb * 32 + r32] = o[r]; }
    __syncthreads();
    { const int t = tid >> 3, c0 = (tid & 7) * 16; const float* bg = a.in[I_BNG] + l * 128 + c0;
      f32x4 x[4]; float ss = 0.f;
#pragma unroll
      for (int i = 0; i < 4; ++i) { x[i] = *(const LAS f32x4*)(OT + t * 132 + c0 + 4 * i); ss += (x[i].x * x[i].x + x[i].y * x[i].y) + (x[i].z * x[i].z + x[i].w * x[i].w); }
      ss += __shfl_xor(ss, 1); ss += __shfl_xor(ss, 2); ss += __shfl_xor(ss, 4);
      const float rs = 1.0f / sqrtf(ss * (1.f / 128.f) + EPS);
      const bf16* rg = P + (size_t)(m0 + t) * NINP + C_BR + h * 128 + c0; const bf16x8 r0 = *reinterpret_cast<const bf16x8*>(rg), r1 = *reinterpret_cast<const bf16x8*>(rg + 8);
      float y[16];
#pragma unroll
      for (int i = 0; i < 4; ++i) { const f32x4 gv = *(const f32x4*)(bg + 4 * i); y[4 * i] = x[i].x * rs * gv.x; y[4 * i + 1] = x[i].y * rs * gv.y; y[4 * i + 2] = x[i].z * rs * gv.z; y[4 * i + 3] = x[i].w * rs * gv.w; }
#pragma unroll
      for (int i = 0; i < 8; ++i) { y[i] *= siluf(bfe(r0, i)); y[8 + i] *= siluf(bfe(r1, i)); }
      bf16* dst = MIX + (size_t)(m0 + t) * DM + 512 + h * 128 + c0;
      *(u32x4*)(dst) = (u32x4){cvtpk(y[0], y[1]), cvtpk(y[2], y[3]), cvtpk(y[4], y[5]), cvtpk(y[6], y[7])};
      *(u32x4*)(dst + 8) = (u32x4){cvtpk(y[8], y[9]), cvtpk(y[10], y[11]), cvtpk(y[12], y[13]), cvtpk(y[14], y[15])}; }
    __syncthreads();
#undef GLA_PK
}

__device__ __forceinline__ void mixer_phase(const Args& a, int l, LAS unsigned char* lds, int tid_in, int bid, int G) {
    unsigned char* ws = a.ws;
    const bf16* P = (const bf16*)(ws + WS_P); const bf16* QC = (const bf16*)(ws + WS_QC); const bf16* KVC = (const bf16*)(ws + WS_KVC); const bf16* KRA = (const bf16*)(ws + WS_KRA); const bf16* KRC = (const bf16*)(ws + WS_KRC);
    const bf16* CAK = (const bf16*)(ws + WS_CAK); const bf16* CAV = (const bf16*)(ws + WS_CAV); const bf16* CKRX = (const bf16*)(ws + WS_CKRX); const bf16* KVCTX = (const bf16*)(ws + WS_KVCTX);
    const float* RTA = (const float*)(ws + WS_RTA); const float* RTC = (const float*)(ws + WS_RTC); float* OATT = (float*)(ws + WS_OATT); bf16* MIXB = (bf16*)(ws + WS_MIX);
    const float lam = ((const float*)(ws + WS_LAM))[l], li = ((const float*)(ws + WS_LAM))[4 + l]; const float* ag = a.in[I_ANG] + l * 128;
    constexpr int NAS = 256, NCS = 384, NAP = 64, NCP = 96, NFILL = NAP + NCP + GLA_UNITS;
    const bool tuned = G == 256;
    const int per = G / 8, vb = (bid % 8) * per + bid / 8, wx = vb % per, hx = per / 2;
    const bool heavy = wx < hx; const int hidx = (vb / per) * hx + wx, lidx = (vb / per) * hx + (wx - hx);
    const int nl = G / 2;
    const int nslots = tuned ? 3 + (!heavy ? (NFILL + nl - 1) / nl : 0) : (NAS + NCS + NFILL + G - 1) / G;
    for (int sl = 0; sl < nslots; ++sl) {
        int tid = tid_in; asm volatile("" : "+v"(tid));
        int kind, u, f = -1;
        if (!tuned) { const int g = bid + sl * G; if (g >= NAS + NCS + NFILL) continue; if (g < NAS) { kind = 0; u = g; } else if (g < NAS + NCS) { kind = 1; u = g - NAS; } else { kind = 5; u = 0; f = g - NAS - NCS; } }
        else if (sl == 0) { kind = 0; u = vb; }
        else if (sl == 1) { kind = 1; u = vb; }
        else if (sl == 2) { if (heavy) { kind = 1; u = G + hidx; } else continue; }
        else { kind = 5; u = 0; f = lidx + (sl - 3) * nl; if (f >= NFILL) continue; }
        if (kind == 5) { if (f < NAP) { kind = 2; u = f; } else if (f < NAP + NCP) { kind = 3; u = f - NAP; } else { kind = 4; u = f - NAP - NCP; } }
        if (kind == 0 && u >= NAS) continue;
        if (kind == 1 && u >= NCS) continue;
        if (kind == 4) { gla_g3_unit(a, l, u, lds, tid); continue; }
        if (kind == 0 || kind == 2) {
            int b, head, qb; size_t r0;
            if (kind == 0) { b = u >> 6; head = (u >> 4) & 3; qb = u & 15; r0 = (size_t)MP + (size_t)b * DSEQ; } else { b = u >> 2; head = u & 3; qb = 0; r0 = (size_t)b * SEQ; }
#pragma unroll 1
            for (int ps = 0; ps < 2; ++ps) { const int combo = head * 2 + ps; int tid2 = tid; asm volatile("" : "+v"(tid2));
                KSeg ctx{nullptr, 0, nullptr, 0, nullptr, 0, 0}, lat;
                if (kind == 0) { ctx = KSeg{CAK + ((size_t)(b * DEPTH + l) * PAST) * 512 + combo * 64, 512, nullptr, 0, CAV + ((size_t)(b * DEPTH + l) * PAST) * 512 + head * 128, 512, PAST};
                                 lat = KSeg{KRA + ((size_t)b * DSEQ) * 512 + combo * 64, 512, nullptr, 0, P + r0 * NINP + C_AV + head * 128, NINP, DSEQ}; }
                else lat = KSeg{P + r0 * NINP + C_AK + combo * 64, NINP, nullptr, 0, P + r0 * NINP + C_AV + head * 128, NINP, SEQ};
                attn_mfma_unit<64, 1, false>(lds, P + (r0 + qb * 256) * NINP + C_AQ + combo * 64, NINP, kind == 0, RTA, qb * 256, ctx, lat, 0.125f, OATT + (r0 + qb * 256) * NOATT + head * 128, tid2,
                                             ps == 1, lam, 1.f - li, ag, MIXB + (r0 + qb * 256) * DM + head * 128); }
        } else {
            KSeg ctx{nullptr, 0, nullptr, 0, nullptr, 0, 0}, lat; const bf16* Qp; int t0 = 0; bf16* Op;
            if (kind == 1) { const int b = u / 96, h = (u >> 4) % 6, qb = u & 15; const size_t r0 = (size_t)MP + (size_t)b * DSEQ; const size_t c0 = (size_t)(l * NDB + b) * PAST;
                ctx = KSeg{KVCTX + c0 * NKVP + h * 192, NKVP, CKRX + ((size_t)(b * DEPTH + l) * PAST) * 32, 32, KVCTX + c0 * NKVP + h * 192 + 64, NKVP, PAST};
                lat = KSeg{KVC + r0 * NKVP + h * 192, NKVP, KRC + ((size_t)b * DSEQ) * 32, 32, KVC + r0 * NKVP + h * 192 + 64, NKVP, DSEQ};
                Qp = QC + (r0 + qb * 256) * NQCP + h * 96; t0 = qb * 256; Op = MIXB + (r0 + qb * 256) * DM + 1280 + h * 128; }
            else { const int b = u / 6, h = u % 6; const size_t r0 = (size_t)b * SEQ;
                lat = KSeg{KVC + r0 * NKVP + h * 192, NKVP, P + r0 * NINP + C_CKR, NINP, KVC + r0 * NKVP + h * 192 + 64, NKVP, SEQ};
                Qp = QC + r0 * NQCP + h * 96; Op = MIXB + r0 * DM + 1280 + h * 128; }
            attn_mfma_unit<96, 1, true>(lds, Qp, NQCP, kind == 1, RTC, t0, ctx, lat, 0.10206207261596575f, Op, tid);
        }
    }
}

__device__ __forceinline__ void combine_phase(const Args& a, int l, int gw, int NGW, int lane) {
    using att::cvtpk; using att::u32x4;
    unsigned char* ws = a.ws; const float* OATT = (const float*)(ws + WS_OATT); bf16* MIX = (bf16*)(ws + WS_MIX);
    const float lam = ((const float*)(ws + WS_LAM))[l], li = ((const float*)(ws + WS_LAM))[4 + l];
    const int h = lane >> 4, c8 = (lane & 15) * 8; const float* ag = a.in[I_ANG] + l * 128 + c8;
    const f32x4 g0 = *(const f32x4*)ag * (1.f - li), g1 = *(const f32x4*)(ag + 4) * (1.f - li);
    for (int m = gw; m < M; m += NGW) {
        const float* oa = OATT + (size_t)m * NOATT + (2 * h) * 128 + c8;
        const f32x4 a0 = *(const f32x4*)oa, a1 = *(const f32x4*)(oa + 4), b0 = *(const f32x4*)(oa + 128), b1 = *(const f32x4*)(oa + 132);
        const f32x4 o0 = a0 - b0 * lam, o1 = a1 - b1 * lam;
        float ss = (o0.x * o0.x + o0.y * o0.y) + (o0.z * o0.z + o0.w * o0.w) + (o1.x * o1.x + o1.y * o1.y) + (o1.z * o1.z + o1.w * o1.w);
        ss += __shfl_xor(ss, 1); ss += __shfl_xor(ss, 2); ss += __shfl_xor(ss, 4); ss += __shfl_xor(ss, 8);
        const float r = 1.0f / sqrtf(ss * (1.f / 128.f) + EPS);
        const f32x4 y0 = o0 * r * g0, y1 = o1 * r * g1;
        *(u32x4*)(MIX + (size_t)m * DM + h * 128 + c8) = (u32x4){cvtpk(y0.x, y0.y), cvtpk(y0.z, y0.w), cvtpk(y1.x, y1.y), cvtpk(y1.z, y1.w)};
    }
}

__device__ __forceinline__ void convact_phase(const Args& a, int l, int gw, int NGW, int lane) {
    const bf16* GU = (const bf16*)(a.ws + WS_GU); bf16* ACT = (bf16*)(a.ws + WS_ACT);
    const float* cw = a.in[I_CONVW] + (size_t)l * 3 * DFF; const float* cb = a.in[I_CONVB] + (size_t)l * DFF;
    for (int m = gw; m < M; m += NGW) {
        int t, n; if (m < MP) { t = m % SEQ; n = SEQ; } else { t = (m - MP) % DSEQ; n = DSEQ; }
        const bool hp = t > 0, hn = t < n - 1;
        const bf16* g1 = GU + (size_t)m * (2 * DFF);
        for (int c = lane; c < DFF; c += 64) {
            const float gm = bf2f(g1[c]), gp = hp ? bf2f(g1[c - 2 * DFF]) : 0.f, gn = hn ? bf2f(g1[c + 2 * DFF]) : 0.f, uu = bf2f(g1[DFF + c]);
            const float gc = gp * cw[c] + gm * cw[DFF + c] + gn * cw[2 * DFF + c] + cb[c];
            ACT[(size_t)m * DFF + c] = (bf16)f2bf(siluf(gc) * uu);
        }
    }
}

__device__ __forceinline__ void ffn_fix_phase(const Args& a, int l, int gt, int NGT) {
    const float* side = (const float*)(a.ws + WS_SIDE); bf16* ACT = (bf16*)(a.ws + WS_ACT);
    const float* cw = a.in[I_CONVW] + (size_t)l * 3 * DFF;
    for (int i = gt; i < (MS / 256) * 2 * DFF; i += NGT) { const int j = i % DFF, w = (i / DFF) & 1, pm = 16 + i / (2 * DFF), q = (pm - 16) & 15;
        if (w == 0 ? q == 0 : q == 15) continue;
        const float* sp = side + ((size_t)(pm * 2 + w) * 3) * DFF + j;
        const float gnb = w == 0 ? side[((size_t)((pm - 1) * 2 + 1) * 3 + 2) * DFF + j] : side[((size_t)((pm + 1) * 2 + 0) * 3 + 2) * DFF + j];
        const float gc = sp[0] + cw[(w == 0 ? 0 : 2) * DFF + j] * gnb;
        ACT[(size_t)(pm * 256 + (w == 0 ? 0 : 255)) * DFF + j] = (bf16)f2bf(siluf(gc) * sp[DFF]); }
}

constexpr int PH_PER_LAYER = 11, PH_L0 = 3, PH_FIN = PH_L0 + DEPTH * PH_PER_LAYER, N_PHASES = PH_FIN + 1;
__global__ void __launch_bounds__(NTH, 2) mk_fwd(Args a) {
    extern __shared__ __attribute__((aligned(16))) unsigned char lds_raw[];
    LAS unsigned char* lds = (LAS unsigned char*)lds_raw;
    const int bid = blockIdx.x, G = gridDim.x, wave0 = __builtin_amdgcn_readfirstlane((int)threadIdx.x >> 6);
#define PH_BEGIN int tid = TID_NOW; asm volatile("" : "+v"(tid)); unsigned char* ws = a.ws; asm volatile("" : "+s"(ws)); \
    const int lane = tid & 63, wave = __builtin_amdgcn_readfirstlane(tid >> 6), gw = bid * NWV + wave, NGW = G * NWV, gt = bid * NTH + tid, NGT = G * NTH; (void)lane; (void)gw; (void)NGW; (void)gt; (void)NGT; (void)ws
    {
        volatile LAS unsigned* Z = (volatile LAS unsigned*)(lds + RING_BYTES);
        for (int u = threadIdx.x; u < (LDS_BYTES - RING_BYTES) / 4; u += NTH) Z[u] = 0u;
        __syncthreads();
    }
    if (a.use_bar) (void)xcd_barrier_post((unsigned*)(a.ws + WS_CTL) + 4096, (volatile LAS unsigned*)(lds + MISC_OFF) + 8);
#define bar (XcdBarrier{(unsigned*)(a.ws + WS_CTL) + 4096, xb_xcc_id(), (volatile LAS unsigned*)(lds + MISC_OFF) + 8})
    const int lo = a.ph_lo, hi = a.ph_hi;
#define IN(k) (lo <= (k) && (k) < hi)
#define TID_NOW (wave0 * 64 + (int)__builtin_amdgcn_mbcnt_hi(~0u, __builtin_amdgcn_mbcnt_lo(~0u, 0u)))
#define SEAM(k) do { if (IN(k) && IN((k) + 1)) xcd_barrier(bar, TID_NOW); } while (0)
#ifndef MK_DUP
#define MK_DUP 0
#endif
#define DUP(bit) _Pragma("unroll 1") for (int rep_ = 0; rep_ < (((MK_DUP) & (bit)) ? 2 : 1); ++rep_)

    if (IN(0)) DUP(512) { PH_BEGIN; pro0_phase(a, lds, tid, lane, wave, bid, G); SEAM(0); }
    if (IN(1)) { PH_BEGIN;
        modfin_phase(a, gt, NGT);
        pg8::Gemm g{(const bf16*)(ws + WS_CKVA), (const bf16*)(ws + WS_WKV), DEPTH * NDB * PAST, NKVP, 256, 256, 256, 4, (size_t)NKVP * 256}; pg8::StaticOrder S; S.init(DEPTH * NDB * PAST, NKVP, G, bid);
        pg8::EpiBf16<0> E{(bf16*)(ws + WS_KVCTX), NKVP, nullptr, 0, 0, 1.f};
        pg8::gemm_phase<pg8::EpiBf16<0>, pg8::StaticOrder, true, true>(lds, g, S, E, tid);
        SEAM(1);
    }
    if (IN(2)) DUP(8192) { PH_BEGIN; pro2_phase(a, lds, tid, bid, G, gt, NGT); SEAM(2); }
    for (int l = 0; l < DEPTH; ++l) {
        const int pb = PH_L0 + PH_PER_LAYER * l;
        if (pb + PH_PER_LAYER <= lo || pb >= hi) continue;
#define LAYER_PTRS const float* modl = (const float*)(ws + WS_MOD) + (size_t)l * 5 * 6 * DM; const float* xin0 = l == 0 ? a.in[I_XP] : (const float*)(ws + WS_X); \
        const float* xin1 = l == 0 ? a.in[I_XS] - (size_t)MP * DM : (const float*)(ws + WS_X); float* X = (float*)(ws + WS_X); (void)modl; (void)xin0; (void)xin1; (void)X
        if (IN(pb + 0) && l == 0) { PH_BEGIN; norm0_phase(a.in[I_XP], a.in[I_XS] - (size_t)MP * DM, (const float*)(ws + WS_GM), (bf16*)(ws + WS_H), (float*)(ws + WS_SSQP), gw, NGW, lane); SEAM(pb + 0); }
        if (IN(pb + 1)) DUP(2) { PH_BEGIN;
            pg8::Gemm g{(const bf16*)(ws + WS_H), (const bf16*)(ws + WS_WIN + l * SZ_WIN), M, NINP, DM, DM, DM, 1 << 20, 0}; pg8::StaticOrder S; S.init(M, NINP, G, bid);
            pg8::EpiBf16Norm E{(bf16*)(ws + WS_P), NINP, (const float*)(ws + WS_SSQP) + (size_t)(2 * l) * M * 32, (const float*)(ws + WS_SHWI) + (size_t)l * 5 * NINP, NINP, (LAS float*)(lds + RING_BYTES + 8192), l == 0 ? 1 : 32};
            pg8::gemm_phase<pg8::EpiBf16Norm, pg8::StaticOrder, true, true>(lds, g, S, E, tid);
            SEAM(pb + 1);
        }
        if (IN(pb + 2)) DUP(4) { PH_BEGIN; post_phase(a, l, gw, NGW, lane);
#if 1
            __syncthreads();
            for (int u = bid; u < GLA_UNITS; u += G) { int t2 = tid; asm volatile("" : "+v"(t2)); gla_g1_unit(a, l, u, lds, t2); }
#endif
            SEAM(pb + 2); }
        if (IN(pb + 3)) DUP(8) {
            { PH_BEGIN; pg8::Gemm g{(const bf16*)(ws + WS_CQN), (const bf16*)(ws + WS_WQ + l * SZ_WQ), M, NQCP, 384, 384, 384, 1 << 20, 0}; pg8::StaticOrder S; S.init(M, NQCP, G, bid);
              pg8::EpiBf16<0> E{(bf16*)(ws + WS_QC), NQCP, nullptr, NQCP, 0, 0.10206207261596575f * 1.4426950408889634f};
              pg8::gemm_phase<pg8::EpiBf16<0>, pg8::StaticOrder, true, true>(lds, g, S, E, tid); }
            __syncthreads();
            { PH_BEGIN; pg8::Gemm g{(const bf16*)(ws + WS_CKVN), (const bf16*)(ws + WS_WKV + l * SZ_WKV), M, NKVP, 256, 256, 256, 1 << 20, 0}; pg8::StaticOrder S; S.init(M, NKVP, G, bid);
              pg8::EpiBf16<0> E{(bf16*)(ws + WS_KVC), NKVP, nullptr, 0, 0, 1.f};
              pg8::gemm_phase<pg8::EpiBf16<0>, pg8::StaticOrder, true, true>(lds, g, S, E, tid); }
#if MK_MFMA_GLA
            { PH_BEGIN; for (int it = bid; it < GLA_G2_ITEMS; it += G) gla_g2_item(a, l, it, tid); }
#endif
            SEAM(pb + 3);
        }
        if (IN(pb + 4)) DUP(16) { PH_BEGIN; mixer_phase(a, l, lds, tid, bid, G); if (IN(pb + 6)) xcd_barrier(bar, TID_NOW); }
        if (IN(pb + 6)) { PH_BEGIN; LAYER_PTRS;
            constexpr int NFULL = 512;
            { pg8::Gemm g{(const bf16*)(ws + WS_MIX), (const bf16*)(ws + WS_WOUT + l * SZ_WOUT), M, DM, DM, DM, DM, 1 << 20, 0}; pg8::StaticOrder S; S.init(M, DM, G, bid); S.lim = (MK_SPLITK && G == 256) ? NFULL : S.nwg;
              pg8::EpiResid E{MK_SPLITK ? X : xin0, MK_SPLITK ? X : xin1, X, modl + 2 * DM, (bf16*)(ws + WS_H), (const float*)(ws + WS_GM) + (size_t)(l * 2 + 1) * 5 * DM, (float*)(ws + WS_SSQP) + (size_t)(2 * l + 1) * M * 32};
              pg8::gemm_phase<pg8::EpiResid, pg8::StaticOrder, true, true>(lds, g, S, E, tid); }
            if (MK_SPLITK && G == 256) { __syncthreads(); int t3 = tid; asm volatile("" : "+v"(t3)); (void)t3;
              pg8::Gemm g{(const bf16*)(ws + WS_MIX), (const bf16*)(ws + WS_WOUT + l * SZ_WOUT), M, DM, DM / 2, DM, DM, 1 << 20, 0}; pg8::TailOrder S; S.init(M, DM, G, bid); S.base = NFULL; S.nth = DM / 128;
              pg8::EpiResidTail E{X, modl + 2 * DM, (float*)(ws + WS_SPLITK), (unsigned*)(ws + WS_CTL) + CW_TICKET + (l * 2 + 0) * 128 * 64, (LAS unsigned*)(lds + RING_BYTES + 2048)};
              pg8::gemm_phase<pg8::EpiResidTail, pg8::TailOrder, true, true>(lds, g, S, E, tid); }
            SEAM(pb + 6);
        }
        if (IN(pb + 8)) DUP(128) { PH_BEGIN;
            pg8::Gemm g{(const bf16*)(ws + WS_H), (const bf16*)(ws + WS_WUP + l * SZ_WUP), M, 2 * DFF, DM, DM, DM, 1 << 20, 0}; pg8::StaticOrder S; S.init(M, 2 * DFF, G, bid);
            pg8::EpiConvAct E{(bf16*)(ws + WS_ACT), a.in[I_CONVW] + (size_t)l * 3 * DFF, a.in[I_CONVB] + (size_t)l * DFF, (float*)(ws + WS_SIDE), (LAS float*)(lds + RING_BYTES + 4096),
                               (const float*)(ws + WS_SSQP) + (size_t)(2 * l + 1) * M * 32, (const float*)(ws + WS_SHWU) + (size_t)l * 5 * 2 * DFF, (LAS float*)(lds + RING_BYTES + 8192), 32};
            pg8::gemm_phase<pg8::EpiConvAct, pg8::StaticOrder, true, true>(lds, g, S, E, tid);
            SEAM(pb + 8);
        }
        if (IN(pb + 9)) DUP(256) { PH_BEGIN; ffn_fix_phase(a, l, gt, NGT); SEAM(pb + 9); }
        if (IN(pb + 10)) { PH_BEGIN; LAYER_PTRS;
            constexpr int NFULL = 512;
            { pg8::Gemm g{(const bf16*)(ws + WS_ACT), (const bf16*)(ws + WS_WDN + l * SZ_WDN), M, DM, DFF, DFF, DFF, 1 << 20, 0}; pg8::StaticOrder S; S.init(M, DM, G, bid); S.lim = (MK_SPLITK && G == 256) ? NFULL : S.nwg;
              pg8::EpiResid E{X, X, X, modl + 5 * DM, l + 1 < DEPTH ? (bf16*)(ws + WS_H) : nullptr, (const float*)(ws + WS_GM) + (size_t)((l + 1 < DEPTH ? l + 1 : l) * 2) * 5 * DM, (float*)(ws + WS_SSQP) + (size_t)(2 * (l + 1 < DEPTH ? l + 1 : l)) * M * 32};
              pg8::gemm_phase<pg8::EpiResid, pg8::StaticOrder, true, true>(lds, g, S, E, tid); }
            if (MK_SPLITK && G == 256) { __syncthreads(); int t3 = tid; asm volatile("" : "+v"(t3)); (void)t3;
              pg8::Gemm g{(const bf16*)(ws + WS_ACT), (const bf16*)(ws + WS_WDN + l * SZ_WDN), M, DM, DFF / 2, DFF, DFF, 1 << 20, 0}; pg8::TailOrder S; S.init(M, DM, G, bid); S.base = NFULL; S.nth = DFF / 128;
              pg8::EpiResidTail E{X, modl + 5 * DM, (float*)(ws + WS_SPLITK), (unsigned*)(ws + WS_CTL) + CW_TICKET + (l * 2 + 1) * 128 * 64, (LAS unsigned*)(lds + RING_BYTES + 2048)};
              pg8::gemm_phase<pg8::EpiResidTail, pg8::TailOrder, true, true>(lds, g, S, E, tid); }
            SEAM(pb + 10);
        }
    }
    if (IN(PH_FIN)) { PH_BEGIN; final_norm_phase((const float*)(ws + WS_X), a.in[I_FING], a.out, gw, NGW, lane); }
#undef IN
#undef SEAM
#undef bar
}

#ifndef MK_ONE_LAUNCH
#define MK_ONE_LAUNCH 1
#endif
extern "C" void kernel_launch(void* const* d_in, const int* in_sizes, int n_in, void* d_out, int out_size, void* d_ws, size_t ws_size, hipStream_t stream) {
    static int grid = 0;
    if (grid == 0) {
        if (n_in != N_INPUTS || (size_t)out_size != O_END || ws_size < WS_END) { fprintf(stderr, "kernel_launch: shape mismatch: n_in %d out %d ws %zu (need %zu)\n", n_in, out_size, ws_size, (size_t)WS_END); grid = -1; return; }
        int dev = 0, cus = 0, per_cu = 0;
        if (hipGetDevice(&dev) != hipSuccess || hipDeviceGetAttribute(&cus, hipDeviceAttributeMultiprocessorCount, dev) != hipSuccess) { grid = -1; return; }
        if (hipFuncSetAttribute((const void*)mk_fwd, hipFuncAttributeMaxDynamicSharedMemorySize, LDS_BYTES) != hipSuccess) { fprintf(stderr, "kernel_launch: hipFuncSetAttribute failed\n"); grid = -1; return; }
        if (hipOccupancyMaxActiveBlocksPerMultiprocessor(&per_cu, (const void*)mk_fwd, NTH, LDS_BYTES) != hipSuccess || per_cu < 1) fprintf(stderr, "kernel_launch: occupancy query reports %d\n", per_cu);
        (void)hipGetLastError();
        grid = cus;
    }
    if (grid < 0) return;
    if (hipMemsetAsync((char*)d_ws + WS_CTL, 0, CTL_ZERO_BYTES, stream) != hipSuccess) return;
    Args a{};
    for (int i = 0; i < N_INPUTS; ++i) a.in[i] = (const float*)d_in[i];
    a.out = (float*)d_out; a.ws = (unsigned char*)d_ws; a.pad = 0;
#if MK_ONE_LAUNCH
    a.ph_lo = 0; a.ph_hi = N_PHASES; a.use_bar = 1;
    hipLaunchKernelGGL(mk_fwd, dim3(grid), dim3(NTH), LDS_BYTES, stream, a);
#else
    for (int p = 0; p < N_PHASES; ++p) { a.ph_lo = p; a.ph_hi = p + 1; a.use_bar = 0; hipLaunchKernelGGL(mk_fwd, dim3(grid), dim3(NTH), LDS_BYTES, stream, a); }
#endif
    const hipError_t le = hipPeekAtLastError();
    if (le != hipSuccess) fprintf(stderr, "kernel_launch: launch failed: %s\n", hipGetErrorName(le));
}
```
